# Optimizing an MI355X kernel written in HIP

```python
import functools
import jax
import jax.numpy as jnp
from jax import lax
import numpy as np

D_MODEL = 1024
BATCH = 8
SEQ = 2048
DEPTH = 4

GRID_W = 64
CTX_LEN = 256
ROPE_THETA = 10000.0
NORM_EPS = 1e-6
NEG_BIG = -1e30
LB_FLOOR = 1e-30

D_MIX = D_MODEL
GROUP_W = D_MIX // 4

MLA_HEADS = 4
MLA_NOPE = 64
MLA_ROPE = 32
MLA_V = GROUP_W // MLA_HEADS
MLA_Q_RANK = 3 * D_MODEL // 16
MLA_KV_RANK = D_MODEL // 8
ATTN_QBLOCK = 128

HG_HEADS = 4
HG_DK = 64
HG_DV = GROUP_W // HG_HEADS
HG_CHUNK = 16

SWA_HEADS = 4
SWA_KV_HEADS = 2
SWA_HD = GROUP_W // SWA_HEADS
SWA_WINDOW = 128
SWA_BLOCK = 128

RET_HEADS = 4
RET_DK = 32
RET_DV = GROUP_W // RET_HEADS
RET_CHUNK = 64

D_FF = 2816
N_EXPERTS = 8
TOP_K = 2
D_FF_EXPERT = 3584

IN_SIZES = (
    MLA_Q_RANK, MLA_KV_RANK, MLA_ROPE,
    HG_HEADS * HG_DK, HG_HEADS * HG_DK, HG_HEADS * HG_DK, HG_HEADS * HG_DV, HG_HEADS * HG_DV,
    SWA_HEADS * SWA_HD, SWA_KV_HEADS * SWA_HD, SWA_KV_HEADS * SWA_HD,
    RET_HEADS * RET_DK, RET_HEADS * RET_DK, RET_HEADS * RET_DV, RET_HEADS * RET_DV,
)
D_IN = sum(IN_SIZES)

kernel_name = 'hybrid_mla_hgrn2_swa_retnet_moe_dit'


def rms_norm(x, g):
    xf = x.astype(jnp.float32)
    y = xf * lax.rsqrt(jnp.mean(xf * xf, axis=-1, keepdims=True) + NORM_EPS)
    return (y * g.astype(jnp.float32)).astype(x.dtype)


def modulate(h, shift, scale):
    return h * (1 + scale) + shift


def to_heads(t, n_heads):
    B, T, _ = t.shape
    return t.reshape(B, T, n_heads, -1).transpose(0, 2, 1, 3)


def apply_rope(x, ang):
    cos = jnp.cos(ang).astype(x.dtype)
    sin = jnp.sin(ang).astype(x.dtype)
    x1, x2 = jnp.split(x, 2, axis=-1)
    return jnp.concatenate([x1 * cos - x2 * sin, x1 * sin + x2 * cos], axis=-1)


def axial_angles(n_tok, rot_dim):
    rows = n_tok // GRID_W
    row = jnp.broadcast_to(jnp.arange(rows)[:, None], (rows, GRID_W)).reshape(-1)
    col = jnp.broadcast_to(jnp.arange(GRID_W)[None, :], (rows, GRID_W)).reshape(-1)
    n_freq = rot_dim // 4
    inv = ROPE_THETA ** (-jnp.arange(n_freq, dtype=jnp.float32) / n_freq)
    return jnp.concatenate([row.astype(jnp.float32)[:, None] * inv,
                            col.astype(jnp.float32)[:, None] * inv], axis=-1)


def linear_angles(pos, rot_dim):
    n_freq = rot_dim // 2
    inv = ROPE_THETA ** (-jnp.arange(n_freq, dtype=jnp.float32) / n_freq)
    return pos.astype(jnp.float32)[:, None] * inv


def dense_block_attention(q, k, v, scale):
    B, T, H, Dk = q.shape
    nb = T // ATTN_QBLOCK
    qb = jnp.moveaxis(q.reshape(B, nb, ATTN_QBLOCK, H, Dk), 1, 0)

    def one_block(qi):
        s = jnp.einsum('bqhd,bkhd->bhqk', qi, k).astype(jnp.float32) * scale
        p = jax.nn.softmax(s, axis=-1).astype(v.dtype)
        return jnp.einsum('bhqk,bkhd->bqhd', p, v)

    o = lax.map(one_block, qb)
    return jnp.moveaxis(o, 0, 1).reshape(B, T, H * v.shape[-1])


def mla_qkv(q_lat, kv_lat, k_pe, q_norm_g, w_uq, kv_norm_g, w_ukv, ang):
    B, T, _ = q_lat.shape
    q = (rms_norm(q_lat, q_norm_g) @ w_uq).reshape(B, T, MLA_HEADS, MLA_NOPE + MLA_ROPE)
    kv = (rms_norm(kv_lat, kv_norm_g) @ w_ukv).reshape(B, T, MLA_HEADS, MLA_NOPE + MLA_V)
    q_nope, q_pe = q[..., :MLA_NOPE], q[..., MLA_NOPE:]
    k_nope, v = kv[..., :MLA_NOPE], kv[..., MLA_NOPE:]
    if ang is not None:
        q_pe = apply_rope(q_pe, ang[:, None, :])
        k_pe = apply_rope(k_pe, ang)
    k_pe = jnp.broadcast_to(k_pe[:, :, None, :], (B, T, MLA_HEADS, MLA_ROPE))
    return (jnp.concatenate([q_nope, q_pe], axis=-1),
            jnp.concatenate([k_nope, k_pe], axis=-1), v)


def mla_mixer(lat_in, ctx_in, ang, q_norm_g, w_uq, kv_norm_g, w_ukv, with_ctx):
    ql, kl, vl = mla_qkv(*lat_in, q_norm_g, w_uq, kv_norm_g, w_ukv, ang)
    qc, kc, vc = mla_qkv(*ctx_in, q_norm_g, w_uq, kv_norm_g, w_ukv, None)
    scale = (MLA_NOPE + MLA_ROPE) ** -0.5
    o_lat = dense_block_attention(ql, jnp.concatenate([kc, kl], axis=1),
                                  jnp.concatenate([vc, vl], axis=1), scale)
    o_ctx = dense_block_attention(qc, kc, vc, scale) if with_ctx else None
    return o_lat, o_ctx


def hgrn_log_forget(z, lb):
    return jnp.logaddexp(jnp.log(jnp.maximum(lb, LB_FLOOR)), jnp.log1p(-lb) + jax.nn.log_sigmoid(z))


def hgrn_chunk_scan(q, k, v, log_f, s0):
    B, H, T, dk = q.shape
    dv = v.shape[-1]
    C = HG_CHUNK
    nc = T // C
    q, k, log_f = (t.reshape(B, H, nc, C, dk) for t in (q, k, log_f))
    v = v.reshape(B, H, nc, C, dv)
    b = jnp.cumsum(log_f, axis=3)
    incl = jnp.tril(jnp.ones((C, C), dtype=bool))[:, :, None]
    diff = b[:, :, :, :, None, :] - b[:, :, :, None, :, :]
    decay = jnp.where(incl, jnp.exp(jnp.where(incl, diff, 0.0)), 0.0)
    a = jnp.einsum('bhctk,bhctsk,bhcsk->bhcts', q, decay, k)
    o = jnp.einsum('bhcts,bhcsv->bhctv', a, v)
    b_last = b[:, :, :, -1:, :]
    u = jnp.einsum('bhcsk,bhcsv->bhckv', k * jnp.exp(b_last - b), v)
    d = jnp.exp(b_last[:, :, :, 0, :])

    def step(s, inp):
        d_c, u_c = inp
        return d_c[..., None] * s + u_c, s

    s_fin, s_start = lax.scan(step, s0, (jnp.moveaxis(d, 2, 0), jnp.moveaxis(u, 2, 0)))
    s_start = jnp.moveaxis(s_start, 0, 2)
    o = o + jnp.einsum('bhctk,bhckv->bhctv', q * jnp.exp(b), s_start)
    return o.reshape(B, H, T, dv), s_fin


def retention_chunk_scan(q, k, v, s0, log_g):
    B, H, T, dk = q.shape
    dv = v.shape[-1]
    C = RET_CHUNK
    nc = T // C
    q = q.reshape(B, H, nc, C, dk)
    k = k.reshape(B, H, nc, C, dk)
    v = v.reshape(B, H, nc, C, dv)
    idx = jnp.arange(C, dtype=jnp.float32)
    rel = idx[:, None] - idx[None, :]
    lg = log_g[:, None, None]
    d_intra = jnp.where(rel >= 0, jnp.exp(jnp.maximum(rel, 0.0) * lg), 0.0)
    a = jnp.einsum('bhctd,bhcsd->bhcts', q, k) * d_intra[None, :, None]
    o = jnp.einsum('bhcts,bhcsv->bhctv', a, v)
    xi = jnp.exp((idx + 1.0)[None, :] * log_g[:, None])
    zeta = jnp.exp((C - 1.0 - idx)[None, :] * log_g[:, None])
    u = jnp.einsum('bhcsd,hs,bhcsv->bhcdv', k, zeta, v)
    dc = jnp.exp(C * log_g)[None, :, None, None]

    def step(s, u_c):
        return dc * s + u_c, s

    s_fin, s_start = lax.scan(step, s0, jnp.moveaxis(u, 2, 0))
    s_start = jnp.moveaxis(s_start, 0, 2)
    o = o + jnp.einsum('bhctd,ht,bhcdv->bhctv', q, xi, s_start)
    return o.reshape(B, H, T, dv), s_fin


def bidirectional_scan(fns, ctx_seqs, lat_seqs, s0):
    o_lat, o_ctx = [], []
    for fn, cs, ls, rev in zip(fns, ctx_seqs, lat_seqs, (False, True)):
        if rev:
            cs = tuple(jnp.flip(t, axis=2) for t in cs)
            ls = tuple(jnp.flip(t, axis=2) for t in ls)
        oc, s_ctx = fn(*cs, s0)
        ol, _ = fn(*ls, s_ctx)
        if rev:
            oc, ol = jnp.flip(oc, axis=2), jnp.flip(ol, axis=2)
        o_lat.append(ol)
        o_ctx.append(oc)
    return o_lat[0] + o_lat[1], o_ctx[0] + o_ctx[1]


def hgrn2_mixer(lat_in, ctx_in, lb, norm_g, with_ctx):
    def prep(q, z_fwd, z_bwd, i):
        qh = to_heads(q, HG_HEADS).astype(jnp.float32) * HG_DK ** -0.5
        vh = to_heads(i, HG_HEADS).astype(jnp.float32)
        dirs = []
        for z, lb_d in ((z_fwd, lb[0]), (z_bwd, lb[1])):
            log_f = hgrn_log_forget(to_heads(z, HG_HEADS).astype(jnp.float32),
                                    lb_d.reshape(HG_HEADS, 1, HG_DK))
            dirs.append((qh, -jnp.expm1(log_f), vh, log_f))
        return dirs

    def finish(o, g):
        B, _, T, _ = o.shape
        y = rms_norm(jnp.swapaxes(o, 1, 2), norm_g.reshape(HG_HEADS, HG_DV)).reshape(B, T, GROUP_W)
        return (y * jax.nn.silu(g.astype(jnp.float32))).astype(g.dtype)

    B = lat_in[0].shape[0]
    s0 = jnp.zeros((B, HG_HEADS, HG_DK, HG_DV), jnp.float32)
    o_lat, o_ctx = bidirectional_scan((hgrn_chunk_scan, hgrn_chunk_scan),
                                      prep(*ctx_in[:4]), prep(*lat_in[:4]), s0)
    return finish(o_lat, lat_in[4]), (finish(o_ctx, ctx_in[4]) if with_ctx else None)


def swa_mixer(lat_in, ctx_in, ang, sink, with_ctx):
    ql, kl, vl = lat_in
    qc, kc, vc = ctx_in
    B, N, _ = ql.shape
    L = qc.shape[1]
    G = SWA_HEADS // SWA_KV_HEADS
    KVH, HD, BLK = SWA_KV_HEADS, SWA_HD, SWA_BLOCK
    ql = apply_rope(ql.reshape(B, N, KVH, G, HD), ang[:, None, None, :])
    kl = apply_rope(kl.reshape(B, N, KVH, HD), ang[:, None, :])
    vl = vl.reshape(B, N, KVH, HD)
    qc = qc.reshape(B, L, KVH, G, HD)
    kc = kc.reshape(B, L, KVH, HD)
    vc = vc.reshape(B, L, KVH, HD)
    scale = HD ** -0.5
    sink_hg = sink.astype(jnp.float32).reshape(KVH, G)

    nb = N // BLK
    qb = ql.reshape(B, nb, BLK, KVH, G, HD)
    pad = ((0, 0), (BLK, BLK), (0, 0), (0, 0))
    kp = jnp.pad(kl, pad).reshape(B, nb + 2, BLK, KVH, HD)
    vp = jnp.pad(vl, pad).reshape(B, nb + 2, BLK, KVH, HD)
    kw = jnp.concatenate([kp[:, :-2], kp[:, 1:-1], kp[:, 2:]], axis=2)
    vw = jnp.concatenate([vp[:, :-2], vp[:, 1:-1], vp[:, 2:]], axis=2)
    s_band = jnp.einsum('bnqhgd,bnkhd->bhgnqk', qb, kw).astype(jnp.float32) * scale
    qpos = jnp.arange(nb)[:, None] * BLK + jnp.arange(BLK)[None, :]
    kpos = (jnp.arange(nb)[:, None] - 1) * BLK + jnp.arange(3 * BLK)[None, :]
    valid = ((kpos >= 0) & (kpos < N))[:, None, :] & \
        (jnp.abs(qpos[:, :, None] - kpos[:, None, :]) <= SWA_WINDOW)
    s_band = jnp.where(valid, s_band, NEG_BIG)
    s_ctx = jnp.einsum('bnqhgd,bchd->bhgnqc', qb, kc).astype(jnp.float32) * scale
    s_sink = jnp.broadcast_to(sink_hg[None, :, :, None, None, None], s_ctx.shape[:-1] + (1,))
    p = jax.nn.softmax(jnp.concatenate([s_sink, s_ctx, s_band], axis=-1), axis=-1)
    p_ctx = p[..., 1:1 + L].astype(vl.dtype)
    p_band = p[..., 1 + L:].astype(vl.dtype)
    o = jnp.einsum('bhgnqc,bchd->bnqhgd', p_ctx, vc) + jnp.einsum('bhgnqk,bnkhd->bnqhgd', p_band, vw)
    o_lat = o.reshape(B, N, SWA_HEADS * HD)
    if not with_ctx:
        return o_lat, None
    s_cc = jnp.einsum('bqhgd,bkhd->bhgqk', qc, kc).astype(jnp.float32) * scale
    s_csink = jnp.broadcast_to(sink_hg[None, :, :, None, None], s_cc.shape[:-1] + (1,))
    pc = jax.nn.softmax(jnp.concatenate([s_csink, s_cc], axis=-1), axis=-1)[..., 1:].astype(vc.dtype)
    o_ctx = jnp.einsum('bhgqk,bkhd->bqhgd', pc, vc).reshape(B, L, SWA_HEADS * HD)
    return o_lat, o_ctx


def group_norm_heads(o, gain, bias):
    o = jnp.swapaxes(o, 1, 2)
    mu = jnp.mean(o, axis=-1, keepdims=True)
    var = jnp.mean(jnp.square(o - mu), axis=-1, keepdims=True)
    y = (o - mu) * lax.rsqrt(var + NORM_EPS)
    B, T, H, dv = y.shape
    return y.reshape(B, T, H * dv) * gain.astype(jnp.float32) + bias.astype(jnp.float32)


def retention_mixer(lat_in, ctx_in, log_gamma, gn_g, gn_b, with_ctx):
    L = ctx_in[0].shape[1]
    N = lat_in[0].shape[1]

    def prep(q, k, v, pos):
        ang = linear_angles(pos, RET_DK)
        qh = apply_rope(to_heads(q, RET_HEADS).astype(jnp.float32), ang) * RET_DK ** -0.5
        kh = apply_rope(to_heads(k, RET_HEADS).astype(jnp.float32), ang)
        vh = to_heads(v, RET_HEADS).astype(jnp.float32)
        return (qh, kh, vh)

    def finish(o, g):
        y = group_norm_heads(o, gn_g, gn_b)
        return (y * jax.nn.silu(g.astype(jnp.float32))).astype(g.dtype)

    cs = prep(*ctx_in[:3], jnp.arange(L))
    ls = prep(*lat_in[:3], L + jnp.arange(N))
    fns = tuple(functools.partial(retention_chunk_scan, log_g=log_gamma[d]) for d in range(2))
    B = lat_in[0].shape[0]
    s0 = jnp.zeros((B, RET_HEADS, RET_DK, RET_DV), jnp.float32)
    o_lat, o_ctx = bidirectional_scan(fns, (cs, cs), (ls, ls), s0)
    return finish(o_lat, lat_in[3]), (finish(o_ctx, ctx_in[3]) if with_ctx else None)


def token_mixers(p_lat, p_ctx, ang_mla, ang_swa, mla_q_norm_g, mla_w_uq, mla_kv_norm_g, mla_w_ukv,
                 hg_lb, hg_norm_g, swa_sink, ret_log_gamma, ret_gn_g, ret_gn_b, with_ctx):
    a_l, a_c = mla_mixer(p_lat[0:3], p_ctx[0:3], ang_mla, mla_q_norm_g, mla_w_uq,
                         mla_kv_norm_g, mla_w_ukv, with_ctx)
    b_l, b_c = hgrn2_mixer(p_lat[3:8], p_ctx[3:8], hg_lb, hg_norm_g, with_ctx)
    c_l, c_c = swa_mixer(p_lat[8:11], p_ctx[8:11], ang_swa, swa_sink, with_ctx)
    d_l, d_c = retention_mixer(p_lat[11:15], p_ctx[11:15], ret_log_gamma, ret_gn_g, ret_gn_b, with_ctx)
    o_lat = jnp.concatenate([a_l, b_l, c_l, d_l], axis=-1)
    o_ctx = jnp.concatenate([a_c, b_c, c_c, d_c], axis=-1) if with_ctx else None
    return o_lat, o_ctx


def swiglu(h, w_gate, w_up, w_down):
    return (jax.nn.silu(h @ w_gate) * (h @ w_up)) @ w_down


def moe_swiglu(h, w_router, w_gate, w_up, w_down):
    logits = (h @ w_router).astype(jnp.float32)
    top_val, top_idx = lax.top_k(logits, TOP_K)
    top_w = jax.nn.softmax(top_val, axis=-1)
    gates = jnp.sum(jax.nn.one_hot(top_idx, N_EXPERTS, dtype=jnp.float32) * top_w[..., None],
                    axis=-2).astype(h.dtype)
    out = jnp.zeros_like(h)
    for e in range(N_EXPERTS):
        out = out + gates[..., e:e + 1] * swiglu(h, w_gate[e], w_up[e], w_down[e])
    return out


def setup_inputs(seed: int = 0) -> dict:
    key = jax.random.key(seed)
    ks = iter(jax.random.split(key, 40))
    D = D_MODEL
    n_dense = (DEPTH + 1) // 2
    n_moe = DEPTH // 2

    def nrm(shape, scale):
        return jax.random.normal(next(ks), shape, jnp.float32) * scale

    ret_base = jnp.log(2.0 ** (5.0 + jnp.arange(RET_HEADS, dtype=jnp.float32)) - 1.0)
    return {
        'x': nrm((BATCH, SEQ, D), 1.0),
        'c': nrm((BATCH, D), 1.0),
        'ctx': nrm((BATCH, CTX_LEN, D), 1.0),
        'c_ctx': nrm((D,), 1.0),
        'w_ada': nrm((DEPTH, D, 6 * D), 0.5 * D ** -0.5),
        'b_ada': nrm((DEPTH, 6 * D), 0.02),
        'norm_mix_g': 1.0 + nrm((DEPTH, D), 0.02),
        'norm_ffn_g': 1.0 + nrm((DEPTH, D), 0.02),
        'w_in': nrm((DEPTH, D, D_IN), D ** -0.5),
        'w_out': nrm((DEPTH, D_MIX, D), D_MIX ** -0.5),
        'mla_q_norm_g': 1.0 + nrm((DEPTH, MLA_Q_RANK), 0.02),
        'mla_w_uq': nrm((DEPTH, MLA_Q_RANK, MLA_HEADS * (MLA_NOPE + MLA_ROPE)), MLA_Q_RANK ** -0.5),
        'mla_kv_norm_g': 1.0 + nrm((DEPTH, MLA_KV_RANK), 0.02),
        'mla_w_ukv': nrm((DEPTH, MLA_KV_RANK, MLA_HEADS * (MLA_NOPE + MLA_V)), MLA_KV_RANK ** -0.5),
        'hg_lb_logits': nrm((DEPTH, 2, HG_HEADS * HG_DK), 0.5),
        'hg_norm_g': 1.0 + nrm((DEPTH, HG_HEADS * HG_DV), 0.02),
        'swa_sink': nrm((DEPTH, SWA_HEADS), 0.5),
        'ret_decay_logit': ret_base + nrm((DEPTH, 2, RET_HEADS), 0.01),
        'ret_gn_g': 1.0 + nrm((DEPTH, RET_HEADS * RET_DV), 0.02),
        'ret_gn_b': nrm((DEPTH, RET_HEADS * RET_DV), 0.02),
        'ffn_w_gate': nrm((n_dense, D, D_FF), D ** -0.5),
        'ffn_w_up': nrm((n_dense, D, D_FF), D ** -0.5),
        'ffn_w_down': nrm((n_dense, D_FF, D), D_FF ** -0.5),
        'moe_w_router': nrm((n_moe, D, N_EXPERTS), D ** -0.5),
        'moe_w_gate': nrm((n_moe, N_EXPERTS, D, D_FF_EXPERT), D ** -0.5),
        'moe_w_up': nrm((n_moe, N_EXPERTS, D, D_FF_EXPERT), D ** -0.5),
        'moe_w_down': nrm((n_moe, N_EXPERTS, D_FF_EXPERT, D), D_FF_EXPERT ** -0.5),
        'final_norm_g': 1.0 + nrm((D,), 0.02),
    }


def reference(x, c, ctx, c_ctx, w_ada, b_ada, norm_mix_g, norm_ffn_g, w_in, w_out,
              mla_q_norm_g, mla_w_uq, mla_kv_norm_g, mla_w_ukv, hg_lb_logits, hg_norm_g,
              swa_sink, ret_decay_logit, ret_gn_g, ret_gn_b, ffn_w_gate, ffn_w_up, ffn_w_down,
              moe_w_router, moe_w_gate, moe_w_up, moe_w_down, final_norm_g):
    N = x.shape[1]
    ang_mla = axial_angles(N, MLA_ROPE)
    ang_swa = axial_angles(N, SWA_HD)
    lb_p = jax.nn.softmax(hg_lb_logits.astype(jnp.float32), axis=0)
    hg_lb = jnp.cumsum(lb_p, axis=0) - lb_p[0:1]
    ret_log_gamma = jax.nn.log_sigmoid(ret_decay_logit.astype(jnp.float32))
    split_points = [int(s) for s in np.cumsum(IN_SIZES)[:-1]]
    silu_c = jax.nn.silu(c)
    silu_cc = jax.nn.silu(c_ctx)

    h_lat, h_ctx = x, ctx
    for l in range(DEPTH):
        with_ctx = l < DEPTH - 1
        mod_l = silu_c @ w_ada[l] + b_ada[l]
        mod_c = silu_cc @ w_ada[l] + b_ada[l]
        sh_a, sc_a, g_a, sh_f, sc_f, g_f = jnp.split(mod_l[:, None, :], 6, axis=-1)
        csh_a, csc_a, cg_a, csh_f, csc_f, cg_f = jnp.split(mod_c, 6)

        a_lat = modulate(rms_norm(h_lat, norm_mix_g[l]), sh_a, sc_a)
        a_ctx = modulate(rms_norm(h_ctx, norm_mix_g[l]), csh_a, csc_a)
        p_lat = jnp.split(a_lat @ w_in[l], split_points, axis=-1)
        p_ctx = jnp.split(a_ctx @ w_in[l], split_points, axis=-1)
        o_lat, o_ctx = token_mixers(p_lat, p_ctx, ang_mla, ang_swa, mla_q_norm_g[l], mla_w_uq[l],
                                    mla_kv_norm_g[l], mla_w_ukv[l], hg_lb[l], hg_norm_g[l],
                                    swa_sink[l], ret_log_gamma[l], ret_gn_g[l], ret_gn_b[l], with_ctx)
        h_lat = h_lat + g_a * (o_lat @ w_out[l])
        if with_ctx:
            h_ctx = h_ctx + cg_a * (o_ctx @ w_out[l])

        if l % 2 == 0:
            ffn = functools.partial(swiglu, w_gate=ffn_w_gate[l // 2], w_up=ffn_w_up[l // 2],
                                    w_down=ffn_w_down[l // 2])
        else:
            ffn = functools.partial(moe_swiglu, w_router=moe_w_router[l // 2], w_gate=moe_w_gate[l // 2],
                                    w_up=moe_w_up[l // 2], w_down=moe_w_down[l // 2])
        h_lat = h_lat + g_f * ffn(modulate(rms_norm(h_lat, norm_ffn_g[l]), sh_f, sc_f))
        if with_ctx:
            h_ctx = h_ctx + cg_f * ffn(modulate(rms_norm(h_ctx, norm_ffn_g[l]), csh_f, csc_f))

    return rms_norm(h_lat, final_norm_g)
```

```cpp
#include <hip/hip_runtime.h>
#include <cstdio>
#include <cstdint>
#include <cmath>
#ifndef NB
#define NB 8
#endif
constexpr int D = 1024, NL = 2048, NC = 256, TK = NL + NC, DEPTH = 4, GRIDW = 64;
constexpr int NLAT = NB * NL, NCTX = NB * NC, NTOK = NLAT + NCTX;
constexpr int NP = 3840;
constexpr int DIN = 2912;
constexpr int C_QLAT = 0, C_KVLAT = 192, C_KPE = 320, C_HQ = 352, C_HZF = 608, C_HZB = 864, C_HI = 1120, C_HG = 1376;
constexpr int C_SQ = 1632, C_SK = 1888, C_SV = 2016, C_RQ = 2144, C_RK = 2272, C_RV = 2400, C_RG = 2656, C_QE = 2912, C_KVE = 3296;
constexpr int DFF = 2816, NEXP = 8, DFE = 3584;
constexpr float NORM_EPS = 1e-6f, LOG2E = 1.4426950408889634f;
typedef unsigned short bf16;

#ifdef HOST_TEST
#define HD static inline
#else
#define HD __host__ __device__ __forceinline__
#endif

HD float bf2f(bf16 b) { unsigned u = ((unsigned)b) << 16; float f; __builtin_memcpy(&f, &u, 4); return f; }
HD bf16 f2bf(float f) { unsigned u; __builtin_memcpy(&u, &f, 4); return (bf16)((u + 0x7fffu + ((u >> 16) & 1u)) >> 16); }
#define CBAR() asm volatile("" ::: "memory")
struct U4 { unsigned x, y, z, w; };
HD void ld8(const bf16* p, float (&f)[8]) {
    U4 u; __builtin_memcpy(&u, __builtin_assume_aligned(p, 16), 16);
    unsigned t;
    t = u.x << 16; __builtin_memcpy(&f[0], &t, 4); t = u.x & 0xffff0000u; __builtin_memcpy(&f[1], &t, 4);
    t = u.y << 16; __builtin_memcpy(&f[2], &t, 4); t = u.y & 0xffff0000u; __builtin_memcpy(&f[3], &t, 4);
    t = u.z << 16; __builtin_memcpy(&f[4], &t, 4); t = u.z & 0xffff0000u; __builtin_memcpy(&f[5], &t, 4);
    t = u.w << 16; __builtin_memcpy(&f[6], &t, 4); t = u.w & 0xffff0000u; __builtin_memcpy(&f[7], &t, 4);
}
HD void ld4f(const float* p, float (&f)[4]) { __builtin_memcpy(&f[0], __builtin_assume_aligned(p, 16), 16); }
HD float silu_f(float x) { return x / (1.0f + expf(-x)); }
HD int row_of(int b, int tq) { return tq < NC ? NLAT + b * NC + tq : b * NL + (tq - NC); }
HD void row_split(int row, int& b, int& tq) { if (row < NLAT) { b = row / NL; tq = NC + row % NL; } else { const int r = row - NLAT; b = r / NC; tq = r % NC; } }
HD float log_sigmoid_f(float x) { return fminf(x, 0.f) - log1pf(expf(-fabsf(x))); }

struct Mix {
    const bf16* P;
    bf16 *Qm, *Km, *Vm;
    bf16 *Qs, *Ks, *Vs;
    float* HF;
    float* HO;
    float *RQ, *RK;
    float* RO;
    bf16* OC;
    const float *loglb, *log1mlb;
    const float* hg_norm_g;
    const float* sink;
    const float* log_gamma;
    const float *gn_g, *gn_b;
};

HD void mla_prep_item(const Mix& M, int item) {
    const int row = item >> 2, h = item & 3; int b, tq; row_split(row, b, tq);
    const bf16* p = M.P + (size_t)row * NP;
    float sq = 0.f, skv = 0.f;
    for (int j = 0; j < 192; ++j) { const float v = bf2f(p[C_QLAT + j]); sq += v * v; }
    for (int j = 0; j < 128; ++j) { const float v = bf2f(p[C_KVLAT + j]); skv += v * v; }
    const float rq = 1.0f / sqrtf(sq * (1.0f / 192.0f) + NORM_EPS), rkv = 1.0f / sqrtf(skv * (1.0f / 128.0f) + NORM_EPS);
    const float qs = rq * 0.10206207261596575f * LOG2E;
    const size_t o96 = ((size_t)(b * 4 + h) * TK + tq) * 96, o64 = ((size_t)(b * 4 + h) * TK + tq) * 64;
    for (int j = 0; j < 64; ++j) {
        M.Qm[o96 + j] = f2bf(bf2f(p[C_QE + h * 96 + j]) * qs);
        M.Km[o96 + j] = f2bf(bf2f(p[C_KVE + h * 128 + j]) * rkv);
        M.Vm[o64 + j] = f2bf(bf2f(p[C_KVE + h * 128 + 64 + j]) * rkv);
    }
    const bool lat = tq >= NC; const int t = tq - NC;
    for (int j = 0; j < 16; ++j) {
        float c = 1.f, s = 0.f;
        if (lat) { const float inv = powf(10000.0f, -(float)(j & 7) / 8.0f); const float ang = (float)(j < 8 ? t / GRIDW : t % GRIDW) * inv; c = cosf(ang); s = sinf(ang); }
        const float q1 = bf2f(p[C_QE + h * 96 + 64 + j]), q2 = bf2f(p[C_QE + h * 96 + 80 + j]);
        M.Qm[o96 + 64 + j] = f2bf((q1 * c - q2 * s) * qs); M.Qm[o96 + 80 + j] = f2bf((q1 * s + q2 * c) * qs);
        const float k1 = bf2f(p[C_KPE + j]), k2 = bf2f(p[C_KPE + 16 + j]);
        M.Km[o96 + 64 + j] = f2bf(k1 * c - k2 * s); M.Km[o96 + 80 + j] = f2bf(k1 * s + k2 * c);
    }
}
HD void swa_prep_item(const Mix& M, int item) {
    const int row = item >> 3, s = item & 7; int b, tq; row_split(row, b, tq);
    const bf16* p = M.P + (size_t)row * NP;
    const bool lat = tq >= NC; const int t = tq - NC;
    if (s >= 6) { const int kh = s - 6; bf16* o = M.Vs + ((size_t)(b * 2 + kh) * TK + tq) * 64; for (int j = 0; j < 64; ++j) o[j] = p[C_SV + kh * 64 + j]; return; }
    const bf16* src = s < 4 ? p + C_SQ + s * 64 : p + C_SK + (s - 4) * 64;
    bf16* o = s < 4 ? M.Qs + ((size_t)(b * 4 + s) * TK + tq) * 64 : M.Ks + ((size_t)(b * 2 + (s - 4)) * TK + tq) * 64;
    const float sc = s < 4 ? 0.125f * LOG2E : 1.0f;
    for (int j = 0; j < 32; ++j) {
        float c = 1.f, sn = 0.f;
        if (lat) { const float inv = powf(10000.0f, -(float)(j & 15) / 16.0f); const float ang = (float)(j < 16 ? t / GRIDW : t % GRIDW) * inv; c = cosf(ang); sn = sinf(ang); }
        const float x1 = bf2f(src[j]), x2 = bf2f(src[32 + j]);
        o[j] = f2bf((x1 * c - x2 * sn) * sc); o[32 + j] = f2bf((x1 * sn + x2 * c) * sc);
    }
}
HD void hg_prep_item(const Mix& M, int item) {
    const int row = item >> 8, c = item & 255;
    const bf16* p = M.P + (size_t)row * NP;
    for (int d = 0; d < 2; ++d) {
        const float z = bf2f(p[(d ? C_HZB : C_HZF) + c]);
        const float a = M.loglb[d * 256 + c], bb = M.log1mlb[d * 256 + c] + log_sigmoid_f(z);
        const float mx = fmaxf(a, bb), lf = mx + log1pf(expf(-fabsf(a - bb)));
        M.HF[((size_t)d * NTOK + row) * 256 + c] = expf(lf);
    }
}
HD void ret_prep_item(const Mix& M, int item) {
    const int row = item >> 3, w = (item >> 2) & 1, h = item & 3; int b, tq; row_split(row, b, tq);
    const bf16* src = M.P + (size_t)row * NP + (w ? C_RK : C_RQ) + h * 32;
    float* o = (w ? M.RK : M.RQ) + (size_t)row * 128 + h * 32;
    const float sc = w ? 1.0f : 0.17677669529663687f;
    for (int j = 0; j < 16; ++j) {
        const float inv = powf(10000.0f, -(float)j / 16.0f); const float ang = (float)tq * inv; const float c = cosf(ang), s = sinf(ang);
        const float x1 = bf2f(src[j]), x2 = bf2f(src[16 + j]);
        o[j] = (x1 * c - x2 * s) * sc; o[16 + j] = (x1 * s + x2 * c) * sc;
    }
}
HD void mla_attn_item(const Mix& M, int item) {
    const int tq = item % TK, bh = item / TK, b = bh >> 2, h = bh & 3;
    const bf16* qp = M.Qm + (size_t)item * 96;
    float q[96], o[64];
#pragma unroll
    for (int c8 = 0; c8 < 12; ++c8) { float t8[8]; ld8(qp + 8 * c8, t8);
#pragma unroll
        for (int j = 0; j < 8; ++j) q[8 * c8 + j] = t8[j]; }
#pragma unroll
    for (int j = 0; j < 64; ++j) o[j] = 0.f;
    float m = -1e30f, l = 0.f;
    const int nk = tq < NC ? NC : TK;
    const bf16* kb = M.Km + (size_t)bh * TK * 96; const bf16* vb = M.Vm + (size_t)bh * TK * 64;
    for (int k = 0; k < nk; ++k) {
        const bf16* kp = kb + (size_t)k * 96; float s = 0.f;
#pragma unroll
        for (int c8 = 0; c8 < 12; ++c8) { float t8[8]; ld8(kp + 8 * c8, t8);
#pragma unroll
            for (int j = 0; j < 8; ++j) s += q[8 * c8 + j] * t8[j];
            if ((c8 & 3) == 3) CBAR(); }
        const float mn = fmaxf(m, s), al = exp2f(m - mn), pr = exp2f(s - mn);
        l = l * al + pr; m = mn;
        const bf16* vp = vb + (size_t)k * 64;
#pragma unroll
        for (int c8 = 0; c8 < 8; ++c8) { float t8[8]; ld8(vp + 8 * c8, t8);
#pragma unroll
            for (int j = 0; j < 8; ++j) o[8 * c8 + j] = o[8 * c8 + j] * al + pr * t8[j];
            if ((c8 & 3) == 3) CBAR(); }
    }
    const float rl = 1.0f / l; bf16* op = M.OC + (size_t)row_of(b, tq) * D + h * 64;
#pragma unroll
    for (int j = 0; j < 64; ++j) op[j] = f2bf(o[j] * rl);
}
HD void swa_attn_item(const Mix& M, int item) {
    const int tq = item % TK, bh = item / TK, b = bh >> 2, hq = bh & 3, kh = hq >> 1;
    const bf16* qp = M.Qs + (size_t)item * 64;
    float q[64], o[64];
#pragma unroll
    for (int c8 = 0; c8 < 8; ++c8) { float t8[8]; ld8(qp + 8 * c8, t8);
#pragma unroll
        for (int j = 0; j < 8; ++j) { q[8 * c8 + j] = t8[j]; o[8 * c8 + j] = 0.f; } }
    float m = M.sink[hq] * LOG2E, l = 1.0f;
    const bf16* kb = M.Ks + (size_t)(b * 2 + kh) * TK * 64; const bf16* vb = M.Vs + (size_t)(b * 2 + kh) * TK * 64;
    const int t = tq - NC;
    const int lo2 = tq < NC ? 0 : (t - 128 < 0 ? 0 : t - 128), hi2 = tq < NC ? -1 : (t + 128 > NL - 1 ? NL - 1 : t + 128);
    const int n2 = hi2 - lo2 + 1;
    for (int i = 0; i < NC + n2; ++i) {
        const int k = i < NC ? i : NC + lo2 + (i - NC);
        const bf16* kp = kb + (size_t)k * 64; float s = 0.f;
#pragma unroll
        for (int c8 = 0; c8 < 8; ++c8) { float t8[8]; ld8(kp + 8 * c8, t8);
#pragma unroll
            for (int j = 0; j < 8; ++j) s += q[8 * c8 + j] * t8[j];
            if ((c8 & 3) == 3) CBAR(); }
        const float mn = fmaxf(m, s), al = exp2f(m - mn), pr = exp2f(s - mn);
        l = l * al + pr; m = mn;
        const bf16* vp = vb + (size_t)k * 64;
#pragma unroll
        for (int c8 = 0; c8 < 8; ++c8) { float t8[8]; ld8(vp + 8 * c8, t8);
#pragma unroll
            for (int j = 0; j < 8; ++j) o[8 * c8 + j] = o[8 * c8 + j] * al + pr * t8[j];
            if ((c8 & 3) == 3) CBAR(); }
    }
    const float rl = 1.0f / l; bf16* op = M.OC + (size_t)row_of(b, tq) * D + 512 + hq * 64;
#pragma unroll
    for (int j = 0; j < 64; ++j) op[j] = f2bf(o[j] * rl);
}
HD int dir_tq(int dir, int i) { return dir == 0 ? i : (i < NC ? NC - 1 - i : NC + (NL - 1 - (i - NC))); }
HD void hg_scan_item(const Mix& M, int item) {
    const int v = item & 63, h = (item >> 6) & 3, b = (item >> 8) % NB, dir = item / (256 * NB);
    float S[64];
#pragma unroll
    for (int k = 0; k < 64; ++k) S[k] = 0.f;
    for (int i = 0; i < TK; ++i) {
        const int row = row_of(b, dir_tq(dir, i));
        const bf16* p = M.P + (size_t)row * NP; const float* f = M.HF + ((size_t)dir * NTOK + row) * 256 + h * 64;
        const float vv = bf2f(p[C_HI + h * 64 + v]); float acc = 0.f;
#pragma unroll
        for (int c8 = 0; c8 < 8; ++c8) { float q8[8], fa[4], fb[4]; ld8(p + C_HQ + h * 64 + 8 * c8, q8); ld4f(f + 8 * c8, fa); ld4f(f + 8 * c8 + 4, fb);
#pragma unroll
            for (int j = 0; j < 8; ++j) { const int k = 8 * c8 + j; const float fk = j < 4 ? fa[j] : fb[j - 4]; S[k] = fk * S[k] + (1.0f - fk) * vv; acc += q8[j] * S[k]; }
            if ((c8 & 1) == 1) CBAR(); }
        M.HO[((size_t)dir * NTOK + row) * 256 + h * 64 + v] = acc * 0.125f;
    }
}
HD void ret_scan_item(const Mix& M, int item) {
    const int v = item & 63, h = (item >> 6) & 3, b = (item >> 8) % NB, dir = item / (256 * NB);
    const float g = expf(M.log_gamma[dir * 4 + h]);
    float S[32];
#pragma unroll
    for (int k = 0; k < 32; ++k) S[k] = 0.f;
    for (int i = 0; i < TK; ++i) {
        const int row = row_of(b, dir_tq(dir, i));
        const float vv = bf2f(M.P[(size_t)row * NP + C_RV + h * 64 + v]);
        const float* qk = M.RQ + (size_t)row * 128 + h * 32; const float* kk = M.RK + (size_t)row * 128 + h * 32; float acc = 0.f;
#pragma unroll
        for (int c4 = 0; c4 < 8; ++c4) { float qa[4], ka[4]; ld4f(qk + 4 * c4, qa); ld4f(kk + 4 * c4, ka);
#pragma unroll
            for (int j = 0; j < 4; ++j) { const int k = 4 * c4 + j; S[k] = g * S[k] + ka[j] * vv; acc += qa[j] * S[k]; }
            if ((c4 & 3) == 3) CBAR(); }
        M.RO[((size_t)dir * NTOK + row) * 256 + h * 64 + v] = acc;
    }
}
HD void hg_fin_item(const Mix& M, int item) {
    const int row = item >> 2, h = item & 3;
    const float* o0 = M.HO + (size_t)row * 256 + h * 64; const float* o1 = o0 + (size_t)NTOK * 256;
    float ss = 0.f;
    for (int v = 0; v < 64; ++v) { const float x = o0[v] + o1[v]; ss += x * x; }
    const float r = 1.0f / sqrtf(ss * (1.0f / 64.0f) + NORM_EPS);
    const bf16* gp = M.P + (size_t)row * NP + C_HG + h * 64; bf16* op = M.OC + (size_t)row * D + 256 + h * 64;
    for (int v = 0; v < 64; ++v) op[v] = f2bf((o0[v] + o1[v]) * r * M.hg_norm_g[h * 64 + v] * silu_f(bf2f(gp[v])));
}
HD void ret_fin_item(const Mix& M, int item) {
    const int row = item >> 2, h = item & 3;
    const float* o0 = M.RO + (size_t)row * 256 + h * 64; const float* o1 = o0 + (size_t)NTOK * 256;
    float s = 0.f;
    for (int v = 0; v < 64; ++v) s += o0[v] + o1[v];
    const float mu = s * (1.0f / 64.0f); float q = 0.f;
    for (int v = 0; v < 64; ++v) { const float d = o0[v] + o1[v] - mu; q += d * d; }
    const float r = 1.0f / sqrtf(q * (1.0f / 64.0f) + NORM_EPS);
    const bf16* gp = M.P + (size_t)row * NP + C_RG + h * 64; bf16* op = M.OC + (size_t)row * D + 768 + h * 64;
    for (int v = 0; v < 64; ++v) op[v] = f2bf(((o0[v] + o1[v] - mu) * r * M.gn_g[h * 64 + v] + M.gn_b[h * 64 + v]) * silu_f(bf2f(gp[v])));
}
namespace pg8 {
#define PG8_LAS __attribute__((address_space(3)))
typedef unsigned short bf16_t;
typedef short bf16x8 __attribute__((ext_vector_type(8)));
typedef float f32x4 __attribute__((ext_vector_type(4)));
typedef unsigned u32x4 __attribute__((ext_vector_type(4)));
constexpr int BM = 256, BK = 64, HALF = 128, HTB = HALF * BK * 2  , STAGE_BYTES = 8 * HTB, NXCD = 8, WGM = 8;

__host__ __device__ __forceinline__ int lds_byte(int r, int c) { const int st = (r >> 4) * 2 + (c >> 5), rr = r & 15, cc = c & 31, ob = rr * 64 + cc * 2; return st * 1024 + (ob ^ (((ob >> 9) & 1) << 5)); }
__host__ __device__ __forceinline__ void stage_rc(int b, int& R, int& C) { const int st = b / 1024, sb = b % 1024, swz = sb ^ (((sb >> 9) & 1) << 5); R = (st >> 1) * 16 + swz / 64; C = (st & 1) * 32 + (swz % 64) / 2; }
__host__ __device__ __forceinline__ int perm32(int rho) { const int n = rho >> 4, i = rho & 15; return 8 * (i >> 2) + 4 * n + (i & 3); }

struct Unit { int pm, pn; };
struct Gemm { const bf16_t* A; const bf16_t* Bt; int M, N, K; };

struct StaticOrder {
    int nM, nN, nwg, G, c;
    __host__ __device__ void init(int M, int N, int G_, int c_) { nM = M / BM; nN = N / BM; nwg = nM * nN; G = G_; c = c_; }
    __host__ __device__ bool next(int i, Unit& u) const {
        const long L = (long)i * G + c; if (L >= nwg) return false;
        int wgid = (int)L; { const int q = nwg / NXCD, r = nwg % NXCD, xcd = wgid % NXCD, off = wgid / NXCD; wgid = (xcd < r ? xcd * (q + 1) : r * (q + 1) + (xcd - r) * q) + off; }
        const int nig = WGM * nN, gid = wgid / nig, fm = gid * WGM, gsz = (nM - fm) < WGM ? (nM - fm) : WGM;
        u.pm = fm + ((wgid % nig) % gsz); u.pn = (wgid % nig) / gsz; return true;
    }
    __device__ __forceinline__ void a_ready(const Unit&) const {}
    __device__ __forceinline__ void done(const Unit&) const {}
};

__device__ __forceinline__ unsigned cvt_pk_bf16(float lo, float hi) { unsigned r; asm volatile("v_cvt_pk_bf16_f32 %0, %1, %2" : "=v"(r) : "v"(lo), "v"(hi)); return r; }
typedef unsigned u32x2 __attribute__((ext_vector_type(2)));
struct EpiBf16P {
    static constexpr bool PERM = true, AFTER_DRAIN = false;
    bf16_t* O; int ldc; int nN;
    __device__ __forceinline__ void operator()(const f32x4 (&acc)[2][2][4][2], const Unit& u, int wr, int wc, int fr, int fq) const {
        const int row0 = u.pm * BM + wr * 64 + fr, col0 = (u.pn % nN) * BM + wc * 32 + 8 * fq;
#pragma unroll
        for (int ai = 0; ai < 2; ++ai)
#pragma unroll
            for (int m = 0; m < 4; ++m) { bf16_t* rowp = O + (size_t)(row0 + ai * HALF + m * 16) * ldc + col0;
#pragma unroll
                for (int bj = 0; bj < 2; ++bj) { const f32x4 v0 = acc[ai][bj][m][0], v1 = acc[ai][bj][m][1];
                    u32x4 w; w.x = cvt_pk_bf16(v0[0], v0[1]); w.y = cvt_pk_bf16(v0[2], v0[3]); w.z = cvt_pk_bf16(v1[0], v1[1]); w.w = cvt_pk_bf16(v1[2], v1[3]);
                    *(u32x4*)(rowp + bj * HALF) = w; } }
    }
};
struct EpiRes {
    static constexpr bool PERM = false, AFTER_DRAIN = false;
    float* H; const float* gate; int lat_tiles, tiles_per_batch, ctx_bidx;
    __device__ __forceinline__ void operator()(const f32x4 (&acc)[2][2][4][2], const Unit& u, int wr, int wc, int fr, int fq) const {
        const int bidx = u.pm < lat_tiles ? u.pm / tiles_per_batch : ctx_bidx;
        const float* g = gate + (size_t)bidx * 6144;
        const int row0 = u.pm * BM + wr * 64 + fr, col0 = u.pn * BM + wc * 32 + 4 * fq;
        f32x4 gv[2][2];
#pragma unroll
        for (int bj = 0; bj < 2; ++bj)
#pragma unroll
            for (int n = 0; n < 2; ++n) gv[bj][n] = *(const f32x4*)(g + col0 + bj * HALF + n * 16);
#pragma unroll
        for (int ai = 0; ai < 2; ++ai)
#pragma unroll
            for (int m = 0; m < 4; ++m) { float* rowp = H + (size_t)(row0 + ai * HALF + m * 16) * 1024 + col0;
#pragma unroll
                for (int bj = 0; bj < 2; ++bj)
#pragma unroll
                    for (int n = 0; n < 2; ++n) { f32x4* p = (f32x4*)(rowp + bj * HALF + n * 16); *p = *p + gv[bj][n] * acc[ai][bj][m][n]; } }
    }
};
struct EpiSwiglu {
    static constexpr bool PERM = true, AFTER_DRAIN = false;
    bf16_t* O; int ldo; int nN;
    __device__ __forceinline__ void operator()(const f32x4 (&acc)[2][2][4][2], const Unit& u, int wr, int wc, int fr, int fq) const {
        const int row0 = u.pm * BM + wr * 64 + fr, col0 = (u.pn % nN) * 128 + wc * 16 + 4 * fq;
#pragma unroll
        for (int ai = 0; ai < 2; ++ai)
#pragma unroll
            for (int m = 0; m < 4; ++m) { bf16_t* rowp = O + (size_t)(row0 + ai * HALF + m * 16) * ldo + col0;
#pragma unroll
                for (int bj = 0; bj < 2; ++bj) { const f32x4 gt = acc[ai][bj][m][0], up = acc[ai][bj][m][1]; float r[4];
#pragma unroll
                    for (int i = 0; i < 4; ++i) r[i] = gt[i] * __builtin_amdgcn_rcpf(1.0f + __builtin_amdgcn_exp2f(-1.4426950408889634f * gt[i])) * up[i];
                    u32x2 w; w.x = cvt_pk_bf16(r[0], r[1]); w.y = cvt_pk_bf16(r[2], r[3]);
                    *(u32x2*)(rowp + bj * 64) = w; } }
    }
};
struct MoeOrder {
    const unsigned* list; int nwg, G, c;
    __device__ __forceinline__ bool next(int i, Unit& u) const {
        const long L = (long)i * G + c; if (L >= nwg) return false;
        const unsigned w = (unsigned)__builtin_amdgcn_readfirstlane((int)__hip_atomic_load(list + L, __ATOMIC_RELAXED, __HIP_MEMORY_SCOPE_AGENT));
        u.pm = (int)(w & 0xffffu); u.pn = (int)(w >> 16); return true;
    }
    __device__ __forceinline__ void a_ready(const Unit&) const {}
    __device__ __forceinline__ void done(const Unit&) const {}
};
template <class Epi, class Sched, bool ALIGN_EPI = false, bool SP2 = false>
__device__ __forceinline__ void gemm_phase(PG8_LAS unsigned char* lds, const Gemm g, const Sched& S, const Epi& E, const int tid_in) {
    const int tid = tid_in, wid = __builtin_amdgcn_readfirstlane(tid >> 6), lane = tid & 63, wr = wid >> 2, wc = wid & 3, fr = lane & 15, fq = lane >> 4;
    const int K = g.K, nt = K / BK;
    unsigned voffA[2], voffB[2];
#pragma unroll
    for (int i = 0; i < 2; ++i) { int R, C; stage_rc(tid * 16 + i * 8192, R, C); const int Rb = Epi::PERM ? ((R & ~31) + perm32(R & 31)) : R;
        voffA[i] = (unsigned)(R * K + C) * 2u; voffB[i] = (unsigned)(Rb * K + C) * 2u; }
    const size_t kstep = (size_t)(BK * 2);
    const size_t hstep = (size_t)HALF * K * 2;
    const size_t tstep = 2 * hstep;
    const unsigned ldsw = (unsigned)wid * 1024u;
    const int aoff = lds_byte(wr * 64 + fr, fq * 8), boff = lds_byte(wc * 32 + fr, fq * 8);
#define PG8_SA(b, h) (((b) * 2 + (h)) * HTB)
#define PG8_SB(b, h) ((4 + (b) * 2 + (h)) * HTB)
#define PG8_STAGE(bufoff, gbase, voff) do { _Pragma("unroll") for (int _i = 0; _i < 2; ++_i) \
        __builtin_amdgcn_global_load_lds((const unsigned*)((const char*)(gbase) + (voff)[_i]), (PG8_LAS unsigned*)(lds + (bufoff) + ldsw + _i * 8192), 16, 0, 0); } while (0)
#define PG8_LDA(dst, b, h) do { _Pragma("unroll") for (int m = 0; m < 4; ++m) _Pragma("unroll") for (int k = 0; k < 2; ++k) dst[m][k] = *(const PG8_LAS bf16x8*)(lds + PG8_SA(b, h) + aoff + m * 2048 + k * 1024); } while (0)
#define PG8_LDB(dst, b, h) do { _Pragma("unroll") for (int n = 0; n < 2; ++n) _Pragma("unroll") for (int k = 0; k < 2; ++k) dst[n][k] = *(const PG8_LAS bf16x8*)(lds + PG8_SB(b, h) + boff + n * 2048 + k * 1024); } while (0)
#define PG8_MMA(ai, bj, At, Bt) do { __builtin_amdgcn_s_setprio(1); _Pragma("unroll") for (int m = 0; m < 4; ++m) _Pragma("unroll") for (int n = 0; n < 2; ++n) _Pragma("unroll") for (int k = 0; k < 2; ++k) \
        acc[ai][bj][m][n] = __builtin_amdgcn_mfma_f32_16x16x32_bf16(Bt[n][k], At[m][k], acc[ai][bj][m][n], 0, 0, 0); __builtin_amdgcn_s_setprio(0); } while (0)
#define PG8_WAIT_V(n) asm volatile("s_waitcnt vmcnt(" #n ")" ::: "memory")
#define PG8_WAIT_L(n) asm volatile("s_waitcnt lgkmcnt(" #n ")" ::: "memory")
#define PG8_BAR __builtin_amdgcn_s_barrier()
#define PG8_SCHED __builtin_amdgcn_sched_barrier(0)
    Unit cur, nxt; int ui = 0;
    if (!S.next(0, cur)) return;
    f32x4 acc[2][2][4][2];
#pragma unroll
    for (int a = 0; a < 2; ++a)
#pragma unroll
        for (int b = 0; b < 2; ++b)
#pragma unroll
            for (int m = 0; m < 4; ++m)
#pragma unroll
                for (int n = 0; n < 2; ++n) acc[a][b][m][n] = (f32x4){0.f, 0.f, 0.f, 0.f};
    bf16x8 At[4][2], B0[2][2], B1[2][2];
    const char* cA = (const char*)g.A + (size_t)cur.pm * tstep; const char* cB = (const char*)g.Bt + (size_t)cur.pn * tstep;
    S.a_ready(cur);
    if constexpr (SP2) {
        PG8_STAGE(PG8_SB(0, 0), cB, voffB); PG8_STAGE(PG8_SB(0, 1), cB + hstep, voffB); PG8_STAGE(PG8_SA(0, 0), cA, voffA); PG8_STAGE(PG8_SA(0, 1), cA + hstep, voffA);
        if (wr == 1) PG8_BAR;
        PG8_WAIT_V(2); PG8_BAR;
        PG8_STAGE(PG8_SB(1, 0), cB + kstep, voffB); PG8_STAGE(PG8_SA(1, 0), cA + kstep, voffA); PG8_STAGE(PG8_SB(1, 1), cB + hstep + kstep, voffB);
        PG8_WAIT_V(6); PG8_BAR;
    } else {
        PG8_STAGE(PG8_SB(0, 0), cB, voffB); PG8_STAGE(PG8_SA(0, 0), cA, voffA); PG8_STAGE(PG8_SB(0, 1), cB + hstep, voffB); PG8_STAGE(PG8_SA(0, 1), cA + hstep, voffA);
        if (wr == 1) PG8_BAR;
        PG8_WAIT_V(4); PG8_BAR;
        PG8_STAGE(PG8_SB(1, 0), cB + kstep, voffB); PG8_STAGE(PG8_SA(1, 0), cA + kstep, voffA); PG8_STAGE(PG8_SB(1, 1), cB + hstep + kstep, voffB);
        PG8_WAIT_V(6); PG8_BAR;
    }
    for (;;) {
        const bool has_next = S.next(ui + 1, nxt);
        const char* nA = has_next ? (const char*)g.A + (size_t)nxt.pm * tstep : cA; const char* nB = has_next ? (const char*)g.Bt + (size_t)nxt.pn * tstep : cB;
        for (int t = 0; t < nt; t += 2) {
            const bool last = (t == nt - 2);
            const char* a1 = cA + (size_t)(t + 1) * kstep;
            const char* a2 = last ? nA : cA + (size_t)(t + 2) * kstep; const char* b2 = last ? nB : cB + (size_t)(t + 2) * kstep;
            const char* a3 = a2 + kstep; const char* b3 = b2 + kstep;
            if (last && has_next) S.a_ready(nxt);
            if constexpr (SP2) {
            PG8_LDB(B0, 0, 0); PG8_LDB(B1, 0, 1); PG8_SCHED; PG8_LDA(At, 0, 0); PG8_STAGE(PG8_SA(1, 1), a1 + hstep, voffA);
            PG8_WAIT_V(8); PG8_WAIT_L(0); PG8_BAR; PG8_MMA(0, 0, At, B0); PG8_MMA(0, 1, At, B1); PG8_BAR; PG8_SCHED;
            PG8_LDA(At, 0, 1); PG8_STAGE(PG8_SB(0, 0), b2, voffB); PG8_STAGE(PG8_SB(0, 1), b2 + hstep, voffB); PG8_STAGE(PG8_SA(0, 0), a2, voffA);
            PG8_WAIT_V(8); PG8_WAIT_L(0); PG8_BAR; PG8_MMA(1, 0, At, B0); PG8_MMA(1, 1, At, B1); PG8_BAR; PG8_SCHED;
            PG8_LDB(B0, 1, 0); PG8_LDB(B1, 1, 1); PG8_SCHED; PG8_LDA(At, 1, 0); PG8_STAGE(PG8_SA(0, 1), a2 + hstep, voffA);
            PG8_WAIT_V(8); PG8_WAIT_L(0); PG8_BAR; PG8_MMA(0, 0, At, B0); PG8_MMA(0, 1, At, B1); PG8_BAR; PG8_SCHED;
            PG8_LDA(At, 1, 1); PG8_STAGE(PG8_SB(1, 0), b3, voffB); PG8_STAGE(PG8_SB(1, 1), b3 + hstep, voffB); PG8_STAGE(PG8_SA(1, 0), a3, voffA);
            PG8_WAIT_V(8); PG8_WAIT_L(0); PG8_BAR; PG8_MMA(1, 0, At, B0); PG8_MMA(1, 1, At, B1); PG8_BAR; PG8_SCHED;
            } else {
            PG8_LDB(B0, 0, 0); PG8_SCHED; PG8_LDA(At, 0, 0); PG8_STAGE(PG8_SA(1, 1), a1 + hstep, voffA);
            PG8_WAIT_L(8); PG8_BAR; PG8_WAIT_L(0); PG8_MMA(0, 0, At, B0); PG8_BAR; PG8_SCHED;
            PG8_LDB(B1, 0, 1); PG8_STAGE(PG8_SB(0, 0), b2, voffB);
            PG8_BAR; PG8_WAIT_L(0); PG8_MMA(0, 1, At, B1); PG8_BAR;
            PG8_LDA(At, 0, 1); PG8_STAGE(PG8_SA(0, 0), a2, voffA);
            PG8_BAR; PG8_WAIT_L(0); PG8_MMA(1, 0, At, B0); PG8_BAR; PG8_SCHED;
            PG8_STAGE(PG8_SB(0, 1), b2 + hstep, voffB);
            PG8_WAIT_V(6); PG8_BAR; PG8_MMA(1, 1, At, B1); PG8_BAR;
            PG8_LDB(B0, 1, 0); PG8_SCHED; PG8_LDA(At, 1, 0); PG8_STAGE(PG8_SA(0, 1), a2 + hstep, voffA);
            PG8_WAIT_L(8); PG8_BAR; PG8_WAIT_L(0); PG8_MMA(0, 0, At, B0); PG8_BAR; PG8_SCHED;
            PG8_LDB(B1, 1, 1); PG8_STAGE(PG8_SB(1, 0), b3, voffB);
            PG8_BAR; PG8_WAIT_L(0); PG8_MMA(0, 1, At, B1); PG8_BAR;
            PG8_LDA(At, 1, 1); PG8_STAGE(PG8_SA(1, 0), a3, voffA);
            PG8_BAR; PG8_WAIT_L(0); PG8_MMA(1, 0, At, B0); PG8_BAR; PG8_SCHED;
            PG8_STAGE(PG8_SB(1, 1), b3 + hstep, voffB);
            PG8_WAIT_V(6); PG8_BAR; PG8_MMA(1, 1, At, B1); PG8_BAR;
            }
        }
        if constexpr (ALIGN_EPI) { if (wr == 0) PG8_BAR; }
        if constexpr (!Epi::AFTER_DRAIN) { unsigned z_ = 0u; asm volatile("" : "+v"(z_)); const int l2_ = (int)__builtin_amdgcn_mbcnt_hi(~0u, __builtin_amdgcn_mbcnt_lo(~0u, z_)); E(acc, cur, wr, wc, l2_ & 15, l2_ >> 4); S.done(cur); }
        if (!has_next) break;
#pragma unroll
        for (int a = 0; a < 2; ++a)
#pragma unroll
            for (int b = 0; b < 2; ++b)
#pragma unroll
                for (int m = 0; m < 4; ++m)
#pragma unroll
                    for (int n = 0; n < 2; ++n) acc[a][b][m][n] = (f32x4){0.f, 0.f, 0.f, 0.f};
        cur = nxt; cA = nA; cB = nB; ++ui;
        if constexpr (ALIGN_EPI) { if (wr == 1) PG8_BAR; }
    }
    PG8_WAIT_V(0);
    if constexpr (!ALIGN_EPI) { if (wr == 0) PG8_BAR; }
    PG8_BAR;
    if constexpr (Epi::AFTER_DRAIN) { E.fused(acc, cur, wr, wc, fr, fq, lds, wid, lane); S.done(cur); }
#undef PG8_SA
#undef PG8_SB
#undef PG8_STAGE
#undef PG8_LDA
#undef PG8_LDB
#undef PG8_MMA
#undef PG8_WAIT_V
#undef PG8_WAIT_L
#undef PG8_BAR
#undef PG8_SCHED
}
}
#ifndef LAS
#define LAS __attribute__((address_space(3)))
#endif
#define XB_TMO      128
#define XB_XCNT(j)  (256  + 64 * (j))
#define XB_XSUB(j)  (1280 + 64 * (j))
#define XB_XGEN(j)  (2304 + 64 * (j))
#define XB_TOP      3328
#define XB_TOPGEN   3392
#define XCD_BAR_WORDS 3456
#define XB_SPIN_CAP (1u << 24)

__device__ __forceinline__ unsigned xb_ld(unsigned* p)              { return __hip_atomic_load(p, __ATOMIC_RELAXED, __HIP_MEMORY_SCOPE_AGENT); }
__device__ __forceinline__ unsigned xb_add(unsigned* p, unsigned v) { return __hip_atomic_fetch_add(p, v, __ATOMIC_RELAXED, __HIP_MEMORY_SCOPE_AGENT); }
__device__ __forceinline__ unsigned xb_xcc_id() { return (unsigned)__builtin_amdgcn_s_getreg((3 << 11) | 20) & 0xFu; }
#define XB_SPIN(cond, bar) do { unsigned _sp = 0; while (cond) { __builtin_amdgcn_s_sleep(1); \
    if ((++_sp & 255u) == 0u) { if (xb_ld(&(bar)[XB_TMO])) break; if (_sp > XB_SPIN_CAP) { atomicAdd(&(bar)[XB_TMO], 1u); break; } } } } while (0)

struct XcdBarrier {
    int w;
    unsigned* bar; unsigned x;
    volatile LAS unsigned* st;
};

__device__ __forceinline__ bool xb_thread0(int w) { unsigned z = 0u; asm volatile("" : "+v"(z), "+s"(w)); return w == 0 && __builtin_amdgcn_mbcnt_hi(~0u, __builtin_amdgcn_mbcnt_lo(~0u, z)) == 0u; }
__device__ __forceinline__ XcdBarrier xcd_barrier_post(unsigned* bar, volatile LAS unsigned* st, int w) {
    XcdBarrier b; b.w = w; b.bar = bar; b.x = xb_xcc_id(); b.st = st;
    if (xb_thread0(w)) (void)xb_add(&bar[XB_XCNT(b.x)], 1u);
    return b;
}
__device__ __forceinline__ void xcd_barrier_complete(unsigned* bar, unsigned x, unsigned& nloc, unsigned& nx) {
    const unsigned G = gridDim.x * gridDim.y * gridDim.z;
    unsigned sum, cnt, mine, sp = 0u;
    for (;;) {
        sum = 0u; cnt = 0u; mine = 0u;
#pragma unroll
        for (unsigned j = 0; j < 16; ++j) { const unsigned c = xb_ld(&bar[XB_XCNT(j)]); sum += c; cnt += (c > 0u) ? 1u : 0u; mine = (j == x) ? c : mine; }
        if (sum == G) break;
        __builtin_amdgcn_s_sleep(1);
        if ((++sp & 255u) == 0u) { if (xb_ld(&bar[XB_TMO])) break; if (sp > XB_SPIN_CAP) { atomicAdd(&bar[XB_TMO], 1u); break; } }
    }
    nloc = mine > 0u ? mine : 1u; nx = cnt > 0u ? cnt : 1u;
}

__device__ __forceinline__ void xcd_barrier(const XcdBarrier& b) {
    asm volatile("s_waitcnt vmcnt(0)" ::: "memory");
    __syncthreads();
    if (xb_thread0(b.w)) {
        unsigned* bar = b.bar;
        __builtin_amdgcn_s_waitcnt(0);
        unsigned nloc = b.st[0], nx = b.st[1];
        if (nloc == 0u) { xcd_barrier_complete(bar, b.x, nloc, nx); b.st[0] = nloc; b.st[1] = nx; }
        const unsigned old = xb_add(&bar[XB_XSUB(b.x)], 1u);
        const unsigned gen = old / nloc;
        if (old + 1u == (gen + 1u) * nloc) {
            __builtin_amdgcn_fence(__ATOMIC_RELEASE, "agent");
            asm volatile("s_waitcnt vmcnt(0)" ::: "memory");
            const unsigned og = xb_add(&bar[XB_TOP], 1u);
            const unsigned tg = og / nx;
            if (og + 1u == (tg + 1u) * nx) xb_add(&bar[XB_TOPGEN], 1u);
            else XB_SPIN(xb_ld(&bar[XB_TOPGEN]) == tg, bar);
            __builtin_amdgcn_fence(__ATOMIC_ACQUIRE, "agent");
            xb_add(&bar[XB_XGEN(b.x)], 1u);
            asm volatile("s_waitcnt vmcnt(0)" ::: "memory");
        } else {
            XB_SPIN(xb_ld(&bar[XB_XGEN(b.x)]) == gen, bar);
            __builtin_amdgcn_fence(__ATOMIC_ACQUIRE, "agent");
            asm volatile("s_waitcnt vmcnt(0)" ::: "memory");
        }
    }
    __syncthreads();
}
constexpr int NWAVES = 8, NTHREADS = NWAVES * 64;
constexpr size_t MiB = 1u << 20;
constexpr size_t WS_CTL = 0, CTL_ZERO_BYTES = 1 * MiB;
constexpr size_t WS_SMALL = 1 * MiB, WS_TOKINFO = 2 * MiB, WS_LIST = 3 * MiB;
constexpr size_t WS_WIN = 4 * MiB, WS_WOUT = 34 * MiB, WS_WFGU = 42 * MiB, WS_WFD = 64 * MiB, WS_WMGU = 75 * MiB, WS_WMD = 187 * MiB;
constexpr size_t WS_H = 243 * MiB, WS_A = 315 * MiB, WS_OC = 351 * MiB, WS_Y = 387 * MiB, WS_AM = 463 * MiB, WS_BIG = 539 * MiB;
constexpr size_t WS_P = WS_BIG, WS_QM = 674 * MiB, WS_KM = WS_QM + 14155776, WS_VM = WS_KM + 14155776, WS_QS = 710 * MiB, WS_KS = WS_QS + 9437184, WS_VS = WS_KS + 4718592;
constexpr size_t WS_HF = 728 * MiB, WS_HO = 764 * MiB, WS_RQ = 800 * MiB, WS_RK = 809 * MiB, WS_RO = 818 * MiB, WS_END = 854 * MiB;
constexpr size_t WS_ACT = WS_BIG;
constexpr int MAXTILES = 152;
static_assert(WS_P + (size_t)NTOK * NP * 2 <= WS_QM && WS_VM + (size_t)NB * 4 * TK * 64 * 2 <= WS_QS && WS_VS + 4718592 <= WS_HF, "ws map 1");
static_assert(WS_ACT + (size_t)MAXTILES * 256 * DFE * 2 <= WS_END && (size_t)MAXTILES * 256 * D * 2 <= 76 * MiB, "ws map 2");
constexpr int SM_MOD = 0;
constexpr int SM_LOGLB = 4 * 9 * 6144, SM_LOG1M = SM_LOGLB + 4 * 512, SM_LGAM = SM_LOG1M + 4 * 512, SM_META = SM_LGAM + 64, SM_ULIST = SM_META + 32;
constexpr int ULIST_GU = 0, ULIST_D = MAXTILES * 28;
static_assert((SM_ULIST + MAXTILES * 32) * 4 <= (int)MiB, "small region");
constexpr int CW_BAR = 4096, CW_CNT = 8192;
constexpr int LDS_BYTES = 147456, MISC_OFF = 131072 + 320;

#define GAS __attribute__((address_space(1)))
#define LAS __attribute__((address_space(3)))
typedef float f32x4 __attribute__((ext_vector_type(4)));
typedef unsigned v4u __attribute__((ext_vector_type(4)));
typedef unsigned v2u __attribute__((ext_vector_type(2)));
#define LDS_WAIT() asm volatile("s_waitcnt lgkmcnt(0)" ::: "memory")

struct Args { const float* in[28]; float* out; unsigned char* ws; int ph_lo, ph_hi; };
typedef __attribute__((address_space(4))) const unsigned long long ka_u64;
__device__ __forceinline__ const float* IN(int i) { ka_u64* ka = (ka_u64*)__builtin_amdgcn_kernarg_segment_ptr(); asm volatile("" : "+s"(ka)); return (const float*)ka[i]; }
__device__ __forceinline__ float* OUTP() { ka_u64* ka = (ka_u64*)__builtin_amdgcn_kernarg_segment_ptr(); asm volatile("" : "+s"(ka)); return (float*)ka[28]; }
__device__ __forceinline__ unsigned char* WSBASE() { ka_u64* ka = (ka_u64*)__builtin_amdgcn_kernarg_segment_ptr(); asm volatile("" : "+s"(ka)); return (unsigned char*)ka[29]; }
struct Frame {
    LAS unsigned char* lds;
    int tid, lane, wave, gtid, NT, gw, NGW;
    __device__ __forceinline__ unsigned char* base() const { return WSBASE(); }
};
#define WSP(T, off) ((T*)(ws + (off)))
#define F_ctl WSP(unsigned, WS_CTL)
#define F_sm WSP(float, WS_SMALL)
#define F_tokinfo WSP(int, WS_TOKINFO)
#define F_list WSP(int, WS_LIST)
#define F_H WSP(float, WS_H)
#define F_A WSP(bf16, WS_A)
#define F_OC WSP(bf16, WS_OC)
#define F_Y WSP(bf16, WS_Y)
#define F_AM WSP(bf16, WS_AM)
#define F_P WSP(bf16, WS_P)
#define F_ACT WSP(bf16, WS_ACT)
#define F_WIN WSP(bf16, WS_WIN)
#define F_WOUT WSP(bf16, WS_WOUT)
#define F_WFGU WSP(bf16, WS_WFGU)
#define F_WFD WSP(bf16, WS_WFD)
#define F_WMGU WSP(bf16, WS_WMGU)
#define F_WMD WSP(bf16, WS_WMD)
__device__ __forceinline__ float wave_sum(float v, int lane) {
#pragma unroll
    for (int o = 1; o < 64; o <<= 1) v += __int_as_float(__builtin_amdgcn_ds_bpermute((lane ^ o) << 2, __float_as_int(v)));
    return v;
}
__device__ __forceinline__ unsigned pk2(float lo, float hi) { return (unsigned)f2bf(lo) | ((unsigned)f2bf(hi) << 16); }

template <class SrcFn> __device__ __forceinline__ void transpose_item(const SrcFn& src, int K, int nblk, bf16* WT, LAS float* scr, int item, int lane) {
    const int kb = item / nblk, nb = item % nblk, k0 = 64 * kb, n0 = 32 * nb;
#pragma unroll 8
    for (int i = 0; i < 32; ++i) { const int kk = 2 * i + (lane >> 5); scr[kk * 33 + (lane & 31)] = src(k0 + kk, n0 + (lane & 31)); }
    LDS_WAIT(); asm volatile("" ::: "memory");
    const int c = lane & 7;
#pragma unroll
    for (int j = 0; j < 4; ++j) { const int n = (lane >> 3) + 8 * j; const LAS float* s = scr + (8 * c) * 33 + n;
        v4u o; o.x = pk2(s[0 * 33], s[1 * 33]); o.y = pk2(s[2 * 33], s[3 * 33]); o.z = pk2(s[4 * 33], s[5 * 33]); o.w = pk2(s[6 * 33], s[7 * 33]);
        *(v4u*)(WT + (size_t)(n0 + n) * K + k0 + 8 * c) = o; }
    LDS_WAIT(); asm volatile("" ::: "memory");
}
struct SrcPlain { const float* W; int N; __device__ __forceinline__ float operator()(int k, int n) const { return W[(size_t)k * N + n]; } };
struct SrcGU { const float* Wg; long du; int NF; __device__ __forceinline__ float operator()(int k, int c) const { const int j = c >> 3, w = c & 7; return Wg[(w < 4 ? 0l : du) + (long)k * NF + 4 * j + (w & 3)]; } };

__device__ __forceinline__ void convert_moe(Frame& F, int li) {
    unsigned char* ws = F.base();
    LAS float* scr = (LAS float*)(F.lds + 40960 + F.wave * 8704);
    constexpr int I_GU = 16 * 224, I_D = 56 * 32;
    for (int it = F.gw; it < 8 * (I_GU + I_D); it += F.NGW) {
        const int e = it / (I_GU + I_D); int r = it % (I_GU + I_D);
        if (r < I_GU) { SrcGU s{IN(24) + ((size_t)li * 8 + e) * D * DFE, (long)(IN(25) - IN(24)), DFE}; transpose_item(s, D, 224, F_WMGU + (size_t)e * 2 * DFE * D, scr, r, F.lane); }
        else { r -= I_GU; SrcPlain s{IN(26) + ((size_t)li * 8 + e) * DFE * D, D}; transpose_item(s, DFE, 32, F_WMD + (size_t)e * D * DFE, scr, r, F.lane); }
    }
}
__device__ __forceinline__ void prologue(Frame& F) {
    unsigned char* ws = F.base();
    LAS float* sil = (LAS float*)F.lds;
    for (int i = F.tid; i < 9 * 1024; i += NTHREADS) { const float cv = i < 8 * 1024 ? IN(1)[i] : IN(3)[i - 8 * 1024]; sil[i] = silu_f(cv); }
    __syncthreads();
    for (int it = F.gtid; it < DEPTH * 6144; it += F.NT) {
        const int l = it / 6144, j = it % 6144; const float* w = IN(4) + (size_t)l * D * 6144 + j;
        float acc[9];
#pragma unroll
        for (int b = 0; b < 9; ++b) acc[b] = IN(5)[l * 6144 + j];
        for (int k = 0; k < D; ++k) { const float wv = w[(size_t)k * 6144];
#pragma unroll
            for (int b = 0; b < 9; ++b) acc[b] += sil[b * 1024 + k] * wv; }
#pragma unroll
        for (int b = 0; b < 9; ++b) F_sm[SM_MOD + ((size_t)l * 9 + b) * 6144 + j] = acc[b];
    }
    for (int it = F.gtid; it < 512; it += F.NT) {
        float lg[DEPTH], mx = -1e30f, s = 0.f;
#pragma unroll
        for (int l = 0; l < DEPTH; ++l) { lg[l] = IN(14)[l * 512 + it]; mx = fmaxf(mx, lg[l]); }
#pragma unroll
        for (int l = 0; l < DEPTH; ++l) { lg[l] = expf(lg[l] - mx); s += lg[l]; }
        float cum = 0.f; const float p0 = lg[0] / s;
#pragma unroll
        for (int l = 0; l < DEPTH; ++l) { cum += lg[l] / s; const float lb = cum - p0; F_sm[SM_LOGLB + l * 512 + it] = logf(fmaxf(lb, 1e-30f)); F_sm[SM_LOG1M + l * 512 + it] = log1pf(-lb); }
    }
    for (int it = F.gtid; it < DEPTH * 8; it += F.NT) F_sm[SM_LGAM + it] = log_sigmoid_f(IN(17)[it]);
    LAS float* scr = (LAS float*)(F.lds + 40960 + F.wave * 8704);
    constexpr int I_IN = 16 * 91, I_OUT = 16 * 32, I_FGU = 16 * 176, I_FD = 44 * 32;
    constexpr int N_IN = DEPTH * I_IN, N_OUT = DEPTH * I_OUT, N_FGU = 2 * I_FGU, N_FD = 2 * I_FD;
    for (int it = F.gw; it < N_IN + N_OUT + N_FGU + N_FD; it += F.NGW) {
        int r = it;
        if (r < N_IN) { const int l = r / I_IN; SrcPlain s{IN(8) + (size_t)l * D * DIN, DIN}; transpose_item(s, D, 91, F_WIN + (size_t)l * NP * D, scr, r % I_IN, F.lane); continue; } r -= N_IN;
        if (r < N_OUT) { const int l = r / I_OUT; SrcPlain s{IN(9) + (size_t)l * D * D, D}; transpose_item(s, D, 32, F_WOUT + (size_t)l * D * D, scr, r % I_OUT, F.lane); continue; } r -= N_OUT;
        if (r < N_FGU) { const int l = r / I_FGU; SrcGU s{IN(20) + (size_t)l * D * DFF, (long)(IN(21) - IN(20)), DFF}; transpose_item(s, D, 176, F_WFGU + (size_t)l * 2 * DFF * D, scr, r % I_FGU, F.lane); continue; } r -= N_FGU;
        { const int l = r / I_FD; SrcPlain s{IN(22) + (size_t)l * DFF * D, D}; transpose_item(s, DFF, 32, F_WFD + (size_t)l * D * DFF, scr, r % I_FD, F.lane); }
    }
    convert_moe(F, 0);
    for (int it = F.gtid; it < DEPTH * D * 928; it += F.NT) {
        const int n = it % 928, k = (it / 928) % D, l = it / (928 * D);
        const float* wi = IN(8) + ((size_t)l * D + k) * DIN; float acc = 0.f;
        if (n < 384) { const float* g = IN(10) + l * 192; const float* wu = IN(11) + (size_t)l * 192 * 384 + n; for (int j = 0; j < 192; ++j) acc += wi[j] * g[j] * wu[(size_t)j * 384]; }
        else if (n < 896) { const float* g = IN(12) + l * 128; const float* wu = IN(13) + (size_t)l * 128 * 512 + (n - 384); for (int j = 0; j < 128; ++j) acc += wi[192 + j] * g[j] * wu[(size_t)j * 512]; }
        F_WIN[((size_t)l * NP + DIN + n) * D + k] = f2bf(acc);
    }
}

template <int KIND> __device__ __forceinline__ void norm_phase(Frame& F, int l) {
    unsigned char* ws = F.base();
    const bool combine = (KIND != 1) && l > 0 && ((l - 1) & 1);
    const bool first = (KIND == 0 && l == 0);
    const int nrows = (KIND == 2) ? NLAT : NTOK;
    const float* modl = F_sm + SM_MOD + (size_t)(KIND == 2 ? 0 : l) * 9 * 6144;
    const float* modp = F_sm + SM_MOD + (size_t)(l > 0 ? l - 1 : 0) * 9 * 6144;
    const int* offs = (const int*)(F_sm + SM_META) + ((l > 0 ? l - 1 : 0) >> 1) * 16;
    const float* gain = KIND == 0 ? IN(6) + l * D : (KIND == 1 ? IN(7) + l * D : IN(27));
    for (int row = F.gw; row < nrows; row += F.NGW) {
        const int bidx = row < NLAT ? row / NL : NB;
        const float* src = first ? (row < NLAT ? IN(0) + (size_t)row * D : IN(2) + (size_t)(row - NLAT) * D) : F_H + (size_t)row * D;
        f32x4 v[4];
#pragma unroll
        for (int j = 0; j < 4; ++j) v[j] = *(const f32x4*)(src + 4 * F.lane + 256 * j);
        if (combine) {
            const int* ti = F_tokinfo + (size_t)row * 8;
            const int e1 = ti[0], p1 = ti[1], e2 = ti[3], p2 = ti[4]; const float w1 = __int_as_float(ti[2]), w2 = __int_as_float(ti[5]);
            const bf16* y1 = F_Y + (size_t)(offs[e1] + p1) * D; const bf16* y2 = F_Y + (size_t)(offs[e2] + p2) * D;
#pragma unroll
            for (int j = 0; j < 4; ++j) { const int col = 4 * F.lane + 256 * j;
                const f32x4 gf = *(const f32x4*)(modp + (size_t)bidx * 6144 + 5 * 1024 + col);
                const v2u a = *(const v2u*)(y1 + col), b = *(const v2u*)(y2 + col);
                f32x4 ya, yb; ya[0] = bf2f((bf16)(a.x & 0xffff)); ya[1] = bf2f((bf16)(a.x >> 16)); ya[2] = bf2f((bf16)(a.y & 0xffff)); ya[3] = bf2f((bf16)(a.y >> 16));
                yb[0] = bf2f((bf16)(b.x & 0xffff)); yb[1] = bf2f((bf16)(b.x >> 16)); yb[2] = bf2f((bf16)(b.y & 0xffff)); yb[3] = bf2f((bf16)(b.y >> 16));
                v[j] = v[j] + gf * (ya * w1 + yb * w2); }
        }
        if (combine || first) {
#pragma unroll
            for (int j = 0; j < 4; ++j) *(f32x4*)(F_H + (size_t)row * D + 4 * F.lane + 256 * j) = v[j];
        }
        float ss = 0.f;
#pragma unroll
        for (int j = 0; j < 4; ++j) ss += (v[j][0] * v[j][0] + v[j][1] * v[j][1]) + (v[j][2] * v[j][2] + v[j][3] * v[j][3]);
        const float rstd = 1.0f / sqrtf(wave_sum(ss, F.lane) * (1.0f / D) + NORM_EPS);
        if (KIND == 2) {
#pragma unroll
            for (int j = 0; j < 4; ++j) { const int col = 4 * F.lane + 256 * j; const f32x4 g = *(const f32x4*)(gain + col); *(f32x4*)(OUTP() + (size_t)row * D + col) = v[j] * rstd * g; }
            continue;
        }
        const float* mrow = modl + (size_t)bidx * 6144 + (KIND == 0 ? 0 : 3 * 1024);
#pragma unroll
        for (int j = 0; j < 4; ++j) { const int col = 4 * F.lane + 256 * j;
            const f32x4 g = *(const f32x4*)(gain + col), sh = *(const f32x4*)(mrow + col), sc = *(const f32x4*)(mrow + 1024 + col);
            v[j] = v[j] * rstd * g * (sc + 1.0f) + sh;
            v2u o; o.x = pk2(v[j][0], v[j][1]); o.y = pk2(v[j][2], v[j][3]);
            *(v2u*)(F_A + (size_t)row * D + col) = o; }
        if (KIND == 1 && (l & 1)) {
            const int li = l >> 1; const float* wr = IN(23) + (size_t)li * D * 8;
            float lg[8];
#pragma unroll
            for (int e = 0; e < 8; ++e) lg[e] = 0.f;
#pragma unroll
            for (int j = 0; j < 4; ++j)
#pragma unroll
                for (int i = 0; i < 4; ++i) { const int col = 4 * F.lane + 256 * j + i; const f32x4 w0 = *(const f32x4*)(wr + (size_t)col * 8), w1 = *(const f32x4*)(wr + (size_t)col * 8 + 4);
#pragma unroll
                    for (int e = 0; e < 4; ++e) { lg[e] += v[j][i] * w0[e]; lg[4 + e] += v[j][i] * w1[e]; } }
#pragma unroll
            for (int e = 0; e < 8; ++e) lg[e] = wave_sum(lg[e], F.lane);
            int e1 = 0; float v1 = lg[0];
#pragma unroll
            for (int e = 1; e < 8; ++e) if (lg[e] > v1) { v1 = lg[e]; e1 = e; }
            int e2 = -1; float v2 = -3.0e38f;
#pragma unroll
            for (int e = 0; e < 8; ++e) if (e != e1 && lg[e] > v2) { v2 = lg[e]; e2 = e; }
            if (F.lane == 0) {
                const float w2 = 1.0f / (1.0f + expf(v1 - v2)), w1 = 1.0f - w2;
                const int p1 = (int)atomicAdd(F_ctl + CW_CNT + li * 8 + e1, 1u), p2 = (int)atomicAdd(F_ctl + CW_CNT + li * 8 + e2, 1u);
                F_list[(size_t)e1 * NTOK + p1] = row; F_list[(size_t)e2 * NTOK + p2] = row;
                int* ti = F_tokinfo + (size_t)row * 8; ti[0] = e1; ti[1] = p1; ti[2] = __float_as_int(w1); ti[3] = e2; ti[4] = p2; ti[5] = __float_as_int(w2);
            }
        }
    }
}
__device__ __forceinline__ void moe_tiles(Frame& F, int li, int (&tb)[9], int (&cnt)[8]) {
    unsigned char* ws = F.base();
    tb[0] = 0;
#pragma unroll
    for (int e = 0; e < 8; ++e) { cnt[e] = (int)__hip_atomic_load(F_ctl + CW_CNT + li * 8 + e, __ATOMIC_RELAXED, __HIP_MEMORY_SCOPE_AGENT); tb[e + 1] = tb[e] + ((cnt[e] + 255) >> 8); }
}
__device__ __forceinline__ void moe_gather(Frame& F, int li) {
    unsigned char* ws = F.base();
    int tb[9], cnt[8]; moe_tiles(F, li, tb, cnt);
    if (blockIdx.x == 0 && F.tid < 9) { int* meta = (int*)(F_sm + SM_META) + li * 16; int val = 0;
#pragma unroll
        for (int e = 0; e < 9; ++e) if (F.tid == e) val = tb[e] * 256;
        meta[F.tid] = val; }
    { const int T = tb[8]; unsigned* ul = (unsigned*)(F_sm + SM_ULIST);
      for (int L = F.gtid; L < T * 32; L += F.NT) {
          const bool gu = L < T * 28; const int nN = gu ? 28 : 4, nwg = T * nN; int wgid = gu ? L : L - T * 28;
          { const int q = nwg / 8, r = nwg % 8, xcd = wgid % 8, off = wgid / 8; wgid = (xcd < r ? xcd * (q + 1) : r * (q + 1) + (xcd - r) * q) + off; }
          const int nig = 8 * nN, gid = wgid / nig, fm = gid * 8, gsz = (T - fm) < 8 ? (T - fm) : 8;
          const int pm = fm + ((wgid % nig) % gsz), pnl = (wgid % nig) / gsz; int e = 0;
#pragma unroll
          for (int j = 1; j < 8; ++j) e += (pm >= tb[j]) ? 1 : 0;
          ul[(gu ? ULIST_GU : ULIST_D) + (gu ? L : L - T * 28)] = (unsigned)pm | ((unsigned)(e * nN + pnl) << 16);
      } }
    const int nslot = tb[8] * 256;
    for (int s = F.gw; s < nslot; s += F.NGW) {
        const int tile = s >> 8; int e = 0, base = 0, c = 0;
#pragma unroll
        for (int j = 0; j < 8; ++j) if (tile >= tb[j] && tile < tb[j + 1]) { e = j; base = tb[j] * 256; c = cnt[j]; }
        const int pos = s - base; const int tok = pos < c ? F_list[(size_t)e * NTOK + pos] : -1;
        v4u a = (v4u){0u, 0u, 0u, 0u}, b = a;
        if (tok >= 0) { const v4u* sp = (const v4u*)(F_A + (size_t)tok * D); a = sp[F.lane]; b = sp[64 + F.lane]; }
        v4u* dp = (v4u*)(F_AM + (size_t)s * D); dp[F.lane] = a; dp[64 + F.lane] = b;
    }
}

__device__ __forceinline__ void make_mix(Mix& M, unsigned char* ws, int l) {
    M.P = F_P; M.Qm = WSP(bf16, WS_QM); M.Km = WSP(bf16, WS_KM); M.Vm = WSP(bf16, WS_VM); M.Qs = WSP(bf16, WS_QS); M.Ks = WSP(bf16, WS_KS); M.Vs = WSP(bf16, WS_VS);
    M.HF = WSP(float, WS_HF); M.HO = WSP(float, WS_HO); M.RQ = WSP(float, WS_RQ); M.RK = WSP(float, WS_RK); M.RO = WSP(float, WS_RO); M.OC = F_OC;
    M.loglb = F_sm + SM_LOGLB + l * 512; M.log1mlb = F_sm + SM_LOG1M + l * 512; M.hg_norm_g = IN(15) + l * 256; M.sink = IN(16) + l * 4; M.log_gamma = F_sm + SM_LGAM + l * 8;
    M.gn_g = IN(18) + l * 256; M.gn_b = IN(19) + l * 256;
}
__device__ __forceinline__ void frame_init(Frame& F, LAS unsigned char* lds, int wave_s) {
    unsigned z = 0u; asm volatile("" : "+v"(z)); int t = (int)__builtin_amdgcn_mbcnt_hi(~0u, __builtin_amdgcn_mbcnt_lo(~0u, z)); t += wave_s * 64;
    F.lds = lds; F.tid = t; F.lane = t & 63; F.wave = wave_s;
    F.gtid = blockIdx.x * NTHREADS + t; F.NT = gridDim.x * NTHREADS; { int gw_ = blockIdx.x * NWAVES + wave_s; asm volatile("" : "+s"(gw_)); F.gw = gw_; } F.NGW = gridDim.x * NWAVES;
}
__global__ void __launch_bounds__(NTHREADS, 2) fwd_kernel(Args args) {
    extern __shared__ __attribute__((aligned(16))) unsigned char lds[];
    const int wave_s = __builtin_amdgcn_readfirstlane((int)threadIdx.x >> 6);
    volatile LAS unsigned* MISC = (volatile LAS unsigned*)((LAS unsigned char*)lds + MISC_OFF);
    for (int u = threadIdx.x; u < (LDS_BYTES - 131072) / 4; u += NTHREADS) ((LAS unsigned*)((LAS unsigned char*)lds + 131072))[u] = 0u;
    __syncthreads();
    const int lo = args.ph_lo, hi = args.ph_hi;
    XcdBarrier bar; bar.w = wave_s; bar.bar = (unsigned*)(WSBASE() + WS_CTL) + CW_BAR; bar.x = 0; bar.st = nullptr;
    if (hi - lo > 1) bar = xcd_barrier_post((unsigned*)(WSBASE() + WS_CTL) + CW_BAR, MISC + 8, wave_s);
    int p = 0;
#ifndef PHMASK
#define PHMASK 0xffffffffu
#endif
#define PH_BEGIN_(k) if (((PHMASK >> (k)) & 1u) && p >= lo && p < hi) { Frame F; frame_init(F, (LAS unsigned char*)lds, wave_s); unsigned char* ws = F.base();
#define PH_END if (p + 1 < hi) xcd_barrier(bar); } ++p;

    PH_BEGIN_(0) (void)ws; prologue(F); PH_END

    for (int l = 0; l < DEPTH; ++l) {
        PH_BEGIN_(1) (void)ws; norm_phase<0>(F, l); if (l == 2) convert_moe(F, 1); PH_END
        PH_BEGIN_(2) { pg8::Gemm g{F_A, F_WIN + (size_t)l * NP * D, NTOK, NP, D}; pg8::StaticOrder S; S.init(NTOK, NP, gridDim.x, blockIdx.x);
                   pg8::EpiBf16P E{F_P, NP, NP / 256}; pg8::gemm_phase<pg8::EpiBf16P, pg8::StaticOrder, true, true>(F.lds, g, S, E, F.tid); } PH_END
#ifndef NO_MIX
        PH_BEGIN_(3) { Mix M; make_mix(M, ws, l);
            for (int it = F.gtid; it < NTOK * 4; it += F.NT) mla_prep_item(M, it);
            for (int it = F.gtid; it < NTOK * 8; it += F.NT) swa_prep_item(M, it);
            for (int it = F.gtid; it < NTOK * 256; it += F.NT) hg_prep_item(M, it);
            for (int it = F.gtid; it < NTOK * 8; it += F.NT) ret_prep_item(M, it); }
        PH_END
        PH_BEGIN_(4) { Mix M; make_mix(M, ws, l);
            for (int it = F.gtid; it < NB * 4 * TK; it += F.NT) mla_attn_item(M, it);
            for (int it = F.gtid; it < NB * 4 * TK; it += F.NT) swa_attn_item(M, it);
            if (F.wave == 0) { for (int sw = blockIdx.x; sw < 2 * NB * 4; sw += gridDim.x) hg_scan_item(M, sw * 64 + F.lane); }
            if (F.wave == 4) { for (int sw = (blockIdx.x + 128) % gridDim.x; sw < 2 * NB * 4; sw += gridDim.x) ret_scan_item(M, sw * 64 + F.lane); } }
        PH_END
        PH_BEGIN_(5) { Mix M; make_mix(M, ws, l);
            for (int it = F.gtid; it < NTOK * 4; it += F.NT) hg_fin_item(M, it);
            for (int it = F.gtid; it < NTOK * 4; it += F.NT) ret_fin_item(M, it); }
        PH_END
#endif
        PH_BEGIN_(6) { pg8::Gemm g{F_OC, F_WOUT + (size_t)l * D * D, NTOK, D, D}; pg8::StaticOrder S; S.init(NTOK, D, gridDim.x, blockIdx.x);
                   pg8::EpiRes E{F_H, F_sm + SM_MOD + (size_t)l * 9 * 6144 + 2 * 1024, NLAT / 256, NL / 256, NB}; pg8::gemm_phase<pg8::EpiRes, pg8::StaticOrder, true, true>(F.lds, g, S, E, F.tid); } PH_END
        PH_BEGIN_(7) (void)ws; norm_phase<1>(F, l); PH_END
        if ((l & 1) == 0) {
            const int li = l >> 1;
            PH_BEGIN_(8) { pg8::Gemm g{F_A, F_WFGU + (size_t)li * 2 * DFF * D, NTOK, 2 * DFF, D}; pg8::StaticOrder S; S.init(NTOK, 2 * DFF, gridDim.x, blockIdx.x);
                       pg8::EpiSwiglu E{F_ACT, DFF, 2 * DFF / 256}; pg8::gemm_phase<pg8::EpiSwiglu, pg8::StaticOrder, true, true>(F.lds, g, S, E, F.tid); } PH_END
            PH_BEGIN_(9) { pg8::Gemm g{F_ACT, F_WFD + (size_t)li * D * DFF, NTOK, D, DFF}; pg8::StaticOrder S; S.init(NTOK, D, gridDim.x, blockIdx.x);
                       pg8::EpiRes E{F_H, F_sm + SM_MOD + (size_t)l * 9 * 6144 + 5 * 1024, NLAT / 256, NL / 256, NB}; pg8::gemm_phase<pg8::EpiRes, pg8::StaticOrder, true, true>(F.lds, g, S, E, F.tid); } PH_END
        } else {
            const int li = l >> 1;
            PH_BEGIN_(10) (void)ws; moe_gather(F, li); PH_END
            PH_BEGIN_(11) { const int T = (int)__hip_atomic_load((unsigned*)(F_sm + SM_META) + li * 16 + 8, __ATOMIC_RELAXED, __HIP_MEMORY_SCOPE_AGENT) >> 8;
                       pg8::MoeOrder S; S.list = (const unsigned*)(F_sm + SM_ULIST) + ULIST_GU; S.nwg = T * (2 * DFE / 256); S.G = gridDim.x; S.c = blockIdx.x;
                       pg8::Gemm g{F_AM, F_WMGU, MAXTILES * 256, 8 * 2 * DFE, D};
                       pg8::EpiSwiglu E{F_ACT, DFE, 2 * DFE / 256}; pg8::gemm_phase<pg8::EpiSwiglu, pg8::MoeOrder, true, true>(F.lds, g, S, E, F.tid); } PH_END
            PH_BEGIN_(12) { const int T = (int)__hip_atomic_load((unsigned*)(F_sm + SM_META) + li * 16 + 8, __ATOMIC_RELAXED, __HIP_MEMORY_SCOPE_AGENT) >> 8;
                       pg8::MoeOrder S; S.list = (const unsigned*)(F_sm + SM_ULIST) + ULIST_D; S.nwg = T * (D / 256); S.G = gridDim.x; S.c = blockIdx.x;
                       pg8::Gemm g{F_ACT, F_WMD, MAXTILES * 256, 8 * D, DFE};
                       pg8::EpiBf16P E{F_Y, D, D / 256}; pg8::gemm_phase<pg8::EpiBf16P, pg8::MoeOrder, true, true>(F.lds, g, S, E, F.tid); } PH_END
        }
    }
    PH_BEGIN_(13) (void)ws; norm_phase<2>(F, DEPTH); PH_END
#undef PH_BEGIN_
#undef PH_END
}
constexpr int NPHASES = 1 + 2 * 9 + 2 * 10 + 1;

#ifndef MK_PER_PHASE
#define MK_PER_PHASE 1
#endif
extern "C" void kernel_launch(void* const* d_in, const int* in_sizes, int n_in, void* d_out, int out_size, void* d_ws, size_t ws_size, hipStream_t stream) {
    static int grid = 0;
    if (grid == 0) {
        if (n_in != 28 || ws_size < WS_END || out_size != NLAT * D) { fprintf(stderr, "kernel_launch: unexpected problem shape (n_in %d, ws %zu, out %d)\n", n_in, ws_size, out_size); grid = -1; return; }
        int dev = 0, cus = 0;
        if (hipGetDevice(&dev) != hipSuccess || hipDeviceGetAttribute(&cus, hipDeviceAttributeMultiprocessorCount, dev) != hipSuccess) { grid = -1; return; }
        if (hipFuncSetAttribute((const void*)fwd_kernel, hipFuncAttributeMaxDynamicSharedMemorySize, LDS_BYTES) != hipSuccess) { fprintf(stderr, "kernel_launch: hipFuncSetAttribute failed\n"); grid = -1; return; }
        int per_cu = 0;
        if (hipOccupancyMaxActiveBlocksPerMultiprocessor(&per_cu, (const void*)fwd_kernel, NTHREADS, LDS_BYTES) != hipSuccess || per_cu < 1) { fprintf(stderr, "kernel_launch: occupancy query says %d\n", per_cu); }
        (void)hipGetLastError();
        grid = cus;
    }
    if (grid < 0) return;
    (void)hipMemsetAsync((char*)d_ws + WS_CTL, 0, CTL_ZERO_BYTES, stream);
    Args a{};
    for (int i = 0; i < 28; ++i) a.in[i] = (const float*)d_in[i];
    a.out = (float*)d_out; a.ws = (unsigned char*)d_ws;
#if MK_PER_PHASE
    for (int p = 0; p < NPHASES; ++p) { a.ph_lo = p; a.ph_hi = p + 1; hipLaunchKernelGGL(fwd_kernel, dim3(grid), dim3(NTHREADS), LDS_BYTES, stream, a); }
#else
    a.ph_lo = 0; a.ph_hi = NPHASES; hipLaunchKernelGGL(fwd_kernel, dim3(grid), dim3(NTHREADS), LDS_BYTES, stream, a);
#endif
}
```

```cpp
#include <hip/hip_runtime.h>
#include <cstdio>
#include <cstdint>
#include <cmath>
#ifndef NB
#define NB 8
#endif
constexpr int D = 1024, NL = 2048, NC = 256, TK = NL + NC, DEPTH = 4, GRIDW = 64;
constexpr int NLAT = NB * NL, NCTX = NB * NC, NTOK = NLAT + NCTX;
constexpr int NP = 3840;
constexpr int DIN = 2912;
constexpr int C_QLAT = 0, C_KVLAT = 192, C_KPE = 320, C_HQ = 352, C_HZF = 608, C_HZB = 864, C_HI = 1120, C_HG = 1376;
constexpr int C_SQ = 1632, C_SK = 1888, C_SV = 2016, C_RQ = 2144, C_RK = 2272, C_RV = 2400, C_RG = 2656, C_QE = 2912, C_KVE = 3296;
constexpr int DFF = 2816, NEXP = 8, DFE = 3584;
constexpr float NORM_EPS = 1e-6f, LOG2E = 1.4426950408889634f;
typedef unsigned short bf16;

#ifdef HOST_TEST
#define HD static inline
#else
#define HD __host__ __device__ __forceinline__
#endif

HD float bf2f(bf16 b) { unsigned u = ((unsigned)b) << 16; float f; __builtin_memcpy(&f, &u, 4); return f; }
HD bf16 f2bf(float f) { unsigned u; __builtin_memcpy(&u, &f, 4); return (bf16)((u + 0x7fffu + ((u >> 16) & 1u)) >> 16); }
#define CBAR() asm volatile("" ::: "memory")
struct U4 { unsigned x, y, z, w; };
HD void ld8(const bf16* p, float (&f)[8]) {
    U4 u; __builtin_memcpy(&u, __builtin_assume_aligned(p, 16), 16);
    unsigned t;
    t = u.x << 16; __builtin_memcpy(&f[0], &t, 4); t = u.x & 0xffff0000u; __builtin_memcpy(&f[1], &t, 4);
    t = u.y << 16; __builtin_memcpy(&f[2], &t, 4); t = u.y & 0xffff0000u; __builtin_memcpy(&f[3], &t, 4);
    t = u.z << 16; __builtin_memcpy(&f[4], &t, 4); t = u.z & 0xffff0000u; __builtin_memcpy(&f[5], &t, 4);
    t = u.w << 16; __builtin_memcpy(&f[6], &t, 4); t = u.w & 0xffff0000u; __builtin_memcpy(&f[7], &t, 4);
}
HD void ld4f(const float* p, float (&f)[4]) { __builtin_memcpy(&f[0], __builtin_assume_aligned(p, 16), 16); }
HD float silu_f(float x) { return x / (1.0f + expf(-x)); }
HD int row_of(int b, int tq) { return tq < NC ? NLAT + b * NC + tq : b * NL + (tq - NC); }
HD void row_split(int row, int& b, int& tq) { if (row < NLAT) { b = row / NL; tq = NC + row % NL; } else { const int r = row - NLAT; b = r / NC; tq = r % NC; } }
HD float log_sigmoid_f(float x) { return fminf(x, 0.f) - log1pf(expf(-fabsf(x))); }

struct Mix {
    const bf16* P;
    bf16 *Qm, *Km, *Vm;
    bf16 *Qs, *Ks, *Vs;
    float* HF;
    float* HO;
    float *RQ, *RK;
    float* RO;
    bf16* OC;
    const float *loglb, *log1mlb;
    const float* hg_norm_g;
    const float* sink;
    const float* log_gamma;
    const float *gn_g, *gn_b;
};

HD void mla_prep_item(const Mix& M, int item) {
    const int row = item >> 2, h = item & 3; int b, tq; row_split(row, b, tq);
    const bf16* p = M.P + (size_t)row * NP;
    float sq = 0.f, skv = 0.f;
    for (int j = 0; j < 192; ++j) { const float v = bf2f(p[C_QLAT + j]); sq += v * v; }
    for (int j = 0; j < 128; ++j) { const float v = bf2f(p[C_KVLAT + j]); skv += v * v; }
    const float rq = 1.0f / sqrtf(sq * (1.0f / 192.0f) + NORM_EPS), rkv = 1.0f / sqrtf(skv * (1.0f / 128.0f) + NORM_EPS);
    const float qs = rq * 0.10206207261596575f * LOG2E;
    const size_t o96 = ((size_t)(b * 4 + h) * TK + tq) * 96, o64 = ((size_t)(b * 4 + h) * TK + tq) * 64;
    for (int j = 0; j < 64; ++j) {
        M.Qm[o96 + j] = f2bf(bf2f(p[C_QE + h * 96 + j]) * qs);
        M.Km[o96 + j] = f2bf(bf2f(p[C_KVE + h * 128 + j]) * rkv);
        M.Vm[o64 + j] = f2bf(bf2f(p[C_KVE + h * 128 + 64 + j]) * rkv);
    }
    const bool lat = tq >= NC; const int t = tq - NC;
    for (int j = 0; j < 16; ++j) {
        float c = 1.f, s = 0.f;
        if (lat) { const float inv = powf(10000.0f, -(float)(j & 7) / 8.0f); const float ang = (float)(j < 8 ? t / GRIDW : t % GRIDW) * inv; c = cosf(ang); s = sinf(ang); }
        const float q1 = bf2f(p[C_QE + h * 96 + 64 + j]), q2 = bf2f(p[C_QE + h * 96 + 80 + j]);
        M.Qm[o96 + 64 + j] = f2bf((q1 * c - q2 * s) * qs); M.Qm[o96 + 80 + j] = f2bf((q1 * s + q2 * c) * qs);
        const float k1 = bf2f(p[C_KPE + j]), k2 = bf2f(p[C_KPE + 16 + j]);
        M.Km[o96 + 64 + j] = f2bf(k1 * c - k2 * s); M.Km[o96 + 80 + j] = f2bf(k1 * s + k2 * c);
    }
}
HD void swa_prep_item(const Mix& M, int item) {
    const int row = item >> 3, s = item & 7; int b, tq; row_split(row, b, tq);
    const bf16* p = M.P + (size_t)row * NP;
    const bool lat = tq >= NC; const int t = tq - NC;
    if (s >= 6) { const int kh = s - 6; bf16* o = M.Vs + ((size_t)(b * 2 + kh) * TK + tq) * 64; for (int j = 0; j < 64; ++j) o[j] = p[C_SV + kh * 64 + j]; return; }
    const bf16* src = s < 4 ? p + C_SQ + s * 64 : p + C_SK + (s - 4) * 64;
    bf16* o = s < 4 ? M.Qs + ((size_t)(b * 4 + s) * TK + tq) * 64 : M.Ks + ((size_t)(b * 2 + (s - 4)) * TK + tq) * 64;
    const float sc = s < 4 ? 0.125f * LOG2E : 1.0f;
    for (int j = 0; j < 32; ++j) {
        float c = 1.f, sn = 0.f;
        if (lat) { const float inv = powf(10000.0f, -(float)(j & 15) / 16.0f); const float ang = (float)(j < 16 ? t / GRIDW : t % GRIDW) * inv; c = cosf(ang); sn = sinf(ang); }
        const float x1 = bf2f(src[j]), x2 = bf2f(src[32 + j]);
        o[j] = f2bf((x1 * c - x2 * sn) * sc); o[32 + j] = f2bf((x1 * sn + x2 * c) * sc);
    }
}
HD void hg_prep_item(const Mix& M, int item) {
    const int row = item >> 8, c = item & 255;
    const bf16* p = M.P + (size_t)row * NP;
    for (int d = 0; d < 2; ++d) {
        const float z = bf2f(p[(d ? C_HZB : C_HZF) + c]);
        const float a = M.loglb[d * 256 + c], bb = M.log1mlb[d * 256 + c] + log_sigmoid_f(z);
        const float mx = fmaxf(a, bb), lf = mx + log1pf(expf(-fabsf(a - bb)));
        M.HF[((size_t)d * NTOK + row) * 256 + c] = expf(lf);
    }
}
HD void ret_prep_item(const Mix& M, int item) {
    const int row = item >> 3, w = (item >> 2) & 1, h = item & 3; int b, tq; row_split(row, b, tq);
    const bf16* src = M.P + (size_t)row * NP + (w ? C_RK : C_RQ) + h * 32;
    float* o = (w ? M.RK : M.RQ) + (size_t)row * 128 + h * 32;
    const float sc = w ? 1.0f : 0.17677669529663687f;
    for (int j = 0; j < 16; ++j) {
        const float inv = powf(10000.0f, -(float)j / 16.0f); const float ang = (float)tq * inv; const float c = cosf(ang), s = sinf(ang);
        const float x1 = bf2f(src[j]), x2 = bf2f(src[16 + j]);
        o[j] = (x1 * c - x2 * s) * sc; o[16 + j] = (x1 * s + x2 * c) * sc;
    }
}
HD void mla_attn_item(const Mix& M, int item) {
    const int tq = item % TK, bh = item / TK, b = bh >> 2, h = bh & 3;
    const bf16* qp = M.Qm + (size_t)item * 96;
    float q[96], o[64];
#pragma unroll
    for (int c8 = 0; c8 < 12; ++c8) { float t8[8]; ld8(qp + 8 * c8, t8);
#pragma unroll
        for (int j = 0; j < 8; ++j) q[8 * c8 + j] = t8[j]; }
#pragma unroll
    for (int j = 0; j < 64; ++j) o[j] = 0.f;
    float m = -1e30f, l = 0.f;
    const int nk = tq < NC ? NC : TK;
    const bf16* kb = M.Km + (size_t)bh * TK * 96; const bf16* vb = M.Vm + (size_t)bh * TK * 64;
    for (int k = 0; k < nk; ++k) {
        const bf16* kp = kb + (size_t)k * 96; float s = 0.f;
#pragma unroll
        for (int c8 = 0; c8 < 12; ++c8) { float t8[8]; ld8(kp + 8 * c8, t8);
#pragma unroll
            for (int j = 0; j < 8; ++j) s += q[8 * c8 + j] * t8[j];
            if ((c8 & 3) == 3) CBAR(); }
        const float mn = fmaxf(m, s), al = exp2f(m - mn), pr = exp2f(s - mn);
        l = l * al + pr; m = mn;
        const bf16* vp = vb + (size_t)k * 64;
#pragma unroll
        for (int c8 = 0; c8 < 8; ++c8) { float t8[8]; ld8(vp + 8 * c8, t8);
#pragma unroll
            for (int j = 0; j < 8; ++j) o[8 * c8 + j] = o[8 * c8 + j] * al + pr * t8[j];
            if ((c8 & 3) == 3) CBAR(); }
    }
    const float rl = 1.0f / l; bf16* op = M.OC + (size_t)row_of(b, tq) * D + h * 64;
#pragma unroll
    for (int j = 0; j < 64; ++j) op[j] = f2bf(o[j] * rl);
}
HD void swa_attn_item(const Mix& M, int item) {
    const int tq = item % TK, bh = item / TK, b = bh >> 2, hq = bh & 3, kh = hq >> 1;
    const bf16* qp = M.Qs + (size_t)item * 64;
    float q[64], o[64];
#pragma unroll
    for (int c8 = 0; c8 < 8; ++c8) { float t8[8]; ld8(qp + 8 * c8, t8);
#pragma unroll
        for (int j = 0; j < 8; ++j) { q[8 * c8 + j] = t8[j]; o[8 * c8 + j] = 0.f; } }
    float m = M.sink[hq] * LOG2E, l = 1.0f;
    const bf16* kb = M.Ks + (size_t)(b * 2 + kh) * TK * 64; const bf16* vb = M.Vs + (size_t)(b * 2 + kh) * TK * 64;
    const int t = tq - NC;
    const int lo2 = tq < NC ? 0 : (t - 128 < 0 ? 0 : t - 128), hi2 = tq < NC ? -1 : (t + 128 > NL - 1 ? NL - 1 : t + 128);
    const int n2 = hi2 - lo2 + 1;
    for (int i = 0; i < NC + n2; ++i) {
        const int k = i < NC ? i : NC + lo2 + (i - NC);
        const bf16* kp = kb + (size_t)k * 64; float s = 0.f;
#pragma unroll
        for (int c8 = 0; c8 < 8; ++c8) { float t8[8]; ld8(kp + 8 * c8, t8);
#pragma unroll
            for (int j = 0; j < 8; ++j) s += q[8 * c8 + j] * t8[j];
            if ((c8 & 3) == 3) CBAR(); }
        const float mn = fmaxf(m, s), al = exp2f(m - mn), pr = exp2f(s - mn);
        l = l * al + pr; m = mn;
        const bf16* vp = vb + (size_t)k * 64;
#pragma unroll
        for (int c8 = 0; c8 < 8; ++c8) { float t8[8]; ld8(vp + 8 * c8, t8);
#pragma unroll
            for (int j = 0; j < 8; ++j) o[8 * c8 + j] = o[8 * c8 + j] * al + pr * t8[j];
            if ((c8 & 3) == 3) CBAR(); }
    }
    const float rl = 1.0f / l; bf16* op = M.OC + (size_t)row_of(b, tq) * D + 512 + hq * 64;
#pragma unroll
    for (int j = 0; j < 64; ++j) op[j] = f2bf(o[j] * rl);
}
HD int dir_tq(int dir, int i) { return dir == 0 ? i : (i < NC ? NC - 1 - i : NC + (NL - 1 - (i - NC))); }
HD void hg_scan_item(const Mix& M, int item) {
    const int v = item & 63, h = (item >> 6) & 3, b = (item >> 8) % NB, dir = item / (256 * NB);
    float S[64];
#pragma unroll
    for (int k = 0; k < 64; ++k) S[k] = 0.f;
    for (int i = 0; i < TK; ++i) {
        const int row = row_of(b, dir_tq(dir, i));
        const bf16* p = M.P + (size_t)row * NP; const float* f = M.HF + ((size_t)dir * NTOK + row) * 256 + h * 64;
        const float vv = bf2f(p[C_HI + h * 64 + v]); float acc = 0.f;
#pragma unroll
        for (int c8 = 0; c8 < 8; ++c8) { float q8[8], fa[4], fb[4]; ld8(p + C_HQ + h * 64 + 8 * c8, q8); ld4f(f + 8 * c8, fa); ld4f(f + 8 * c8 + 4, fb);
#pragma unroll
            for (int j = 0; j < 8; ++j) { const int k = 8 * c8 + j; const float fk = j < 4 ? fa[j] : fb[j - 4]; S[k] = fk * S[k] + (1.0f - fk) * vv; acc += q8[j] * S[k]; }
            if ((c8 & 1) == 1) CBAR(); }
        M.HO[((size_t)dir * NTOK + row) * 256 + h * 64 + v] = acc * 0.125f;
    }
}
HD void ret_scan_item(const Mix& M, int item) {
    const int v = item & 63, h = (item >> 6) & 3, b = (item >> 8) % NB, dir = item / (256 * NB);
    const float g = expf(M.log_gamma[dir * 4 + h]);
    float S[32];
#pragma unroll
    for (int k = 0; k < 32; ++k) S[k] = 0.f;
    for (int i = 0; i < TK; ++i) {
        const int row = row_of(b, dir_tq(dir, i));
        const float vv = bf2f(M.P[(size_t)row * NP + C_RV + h * 64 + v]);
        const float* qk = M.RQ + (size_t)row * 128 + h * 32; const float* kk = M.RK + (size_t)row * 128 + h * 32; float acc = 0.f;
#pragma unroll
        for (int c4 = 0; c4 < 8; ++c4) { float qa[4], ka[4]; ld4f(qk + 4 * c4, qa); ld4f(kk + 4 * c4, ka);
#pragma unroll
            for (int j = 0; j < 4; ++j) { const int k = 4 * c4 + j; S[k] = g * S[k] + ka[j] * vv; acc += qa[j] * S[k]; }
            if ((c4 & 3) == 3) CBAR(); }
        M.RO[((size_t)dir * NTOK + row) * 256 + h * 64 + v] = acc;
    }
}
HD void hg_fin_item(const Mix& M, int item) {
    const int row = item >> 2, h = item & 3;
    const float* o0 = M.HO + (size_t)row * 256 + h * 64; const float* o1 = o0 + (size_t)NTOK * 256;
    float ss = 0.f;
    for (int v = 0; v < 64; ++v) { const float x = o0[v] + o1[v]; ss += x * x; }
    const float r = 1.0f / sqrtf(ss * (1.0f / 64.0f) + NORM_EPS);
    const bf16* gp = M.P + (size_t)row * NP + C_HG + h * 64; bf16* op = M.OC + (size_t)row * D + 256 + h * 64;
    for (int v = 0; v < 64; ++v) op[v] = f2bf((o0[v] + o1[v]) * r * M.hg_norm_g[h * 64 + v] * silu_f(bf2f(gp[v])));
}
HD void ret_fin_item(const Mix& M, int item) {
    const int row = item >> 2, h = item & 3;
    const float* o0 = M.RO + (size_t)row * 256 + h * 64; const float* o1 = o0 + (size_t)NTOK * 256;
    float s = 0.f;
    for (int v = 0; v < 64; ++v) s += o0[v] + o1[v];
    const float mu = s * (1.0f / 64.0f); float q = 0.f;
    for (int v = 0; v < 64; ++v) { const float d = o0[v] + o1[v] - mu; q += d * d; }
    const float r = 1.0f / sqrtf(q * (1.0f / 64.0f) + NORM_EPS);
    const bf16* gp = M.P + (size_t)row * NP + C_RG + h * 64; bf16* op = M.OC + (size_t)row * D + 768 + h * 64;
    for (int v = 0; v < 64; ++v) op[v] = f2bf(((o0[v] + o1[v] - mu) * r * M.gn_g[h * 64 + v] + M.gn_b[h * 64 + v]) * silu_f(bf2f(gp[v])));
}
namespace pg8 {
#define PG8_LAS __attribute__((address_space(3)))
typedef unsigned short bf16_t;
typedef short bf16x8 __attribute__((ext_vector_type(8)));
typedef float f32x4 __attribute__((ext_vector_type(4)));
typedef unsigned u32x4 __attribute__((ext_vector_type(4)));
constexpr int BM = 256, BK = 64, HALF = 128, HTB = HALF * BK * 2  , STAGE_BYTES = 8 * HTB, NXCD = 8, WGM = 8;

__host__ __device__ __forceinline__ int lds_byte(int r, int c) { const int st = (r >> 4) * 2 + (c >> 5), rr = r & 15, cc = c & 31, ob = rr * 64 + cc * 2; return st * 1024 + (ob ^ (((ob >> 9) & 1) << 5)); }
__host__ __device__ __forceinline__ void stage_rc(int b, int& R, int& C) { const int st = b / 1024, sb = b % 1024, swz = sb ^ (((sb >> 9) & 1) << 5); R = (st >> 1) * 16 + swz / 64; C = (st & 1) * 32 + (swz % 64) / 2; }
__host__ __device__ __forceinline__ int perm32(int rho) { const int n = rho >> 4, i = rho & 15; return 8 * (i >> 2) + 4 * n + (i & 3); }

struct Unit { int pm, pn; };
struct Gemm { const bf16_t* A; const bf16_t* Bt; int M, N, K; };

struct StaticOrder {
    int nM, nN, nwg, G, c;
    __host__ __device__ void init(int M, int N, int G_, int c_) { nM = M / BM; nN = N / BM; nwg = nM * nN; G = G_; c = c_; }
    __host__ __device__ bool next(int i, Unit& u) const {
        const long L = (long)i * G + c; if (L >= nwg) return false;
        int wgid = (int)L; { const int q = nwg / NXCD, r = nwg % NXCD, xcd = wgid % NXCD, off = wgid / NXCD; wgid = (xcd < r ? xcd * (q + 1) : r * (q + 1) + (xcd - r) * q) + off; }
        const int nig = WGM * nN, gid = wgid / nig, fm = gid * WGM, gsz = (nM - fm) < WGM ? (nM - fm) : WGM;
        u.pm = fm + ((wgid % nig) % gsz); u.pn = (wgid % nig) / gsz; return true;
    }
    __device__ __forceinline__ void a_ready(const Unit&) const {}
    __device__ __forceinline__ void done(const Unit&) const {}
};

__device__ __forceinline__ unsigned cvt_pk_bf16(float lo, float hi) { unsigned r; asm volatile("v_cvt_pk_bf16_f32 %0, %1, %2" : "=v"(r) : "v"(lo), "v"(hi)); return r; }
typedef unsigned u32x2 __attribute__((ext_vector_type(2)));
struct EpiBf16P {
    static constexpr bool PERM = true, AFTER_DRAIN = false;
    bf16_t* O; int ldc; int nN;
    __device__ __forceinline__ void operator()(const f32x4 (&acc)[2][2][4][2], const Unit& u, int wr, int wc, int fr, int fq) const {
        const int row0 = u.pm * BM + wr * 64 + fr, col0 = (u.pn % nN) * BM + wc * 32 + 8 * fq;
#pragma unroll
        for (int ai = 0; ai < 2; ++ai)
#pragma unroll
            for (int m = 0; m < 4; ++m) { bf16_t* rowp = O + (size_t)(row0 + ai * HALF + m * 16) * ldc + col0;
#pragma unroll
                for (int bj = 0; bj < 2; ++bj) { const f32x4 v0 = acc[ai][bj][m][0], v1 = acc[ai][bj][m][1];
                    u32x4 w; w.x = cvt_pk_bf16(v0[0], v0[1]); w.y = cvt_pk_bf16(v0[2], v0[3]); w.z = cvt_pk_bf16(v1[0], v1[1]); w.w = cvt_pk_bf16(v1[2], v1[3]);
                    *(u32x4*)(rowp + bj * HALF) = w; } }
    }
};
struct EpiRes {
    static constexpr bool PERM = false, AFTER_DRAIN = false;
    float* H; const float* gate; int lat_tiles, tiles_per_batch, ctx_bidx;
    __device__ __forceinline__ void operator()(const f32x4 (&acc)[2][2][4][2], const Unit& u, int wr, int wc, int fr, int fq) const {
        const int bidx = u.pm < lat_tiles ? u.pm / tiles_per_batch : ctx_bidx;
        const float* g = gate + (size_t)bidx * 6144;
        const int row0 = u.pm * BM + wr * 64 + fr, col0 = u.pn * BM + wc * 32 + 4 * fq;
        f32x4 gv[2][2];
#pragma unroll
        for (int bj = 0; bj < 2; ++bj)
#pragma unroll
            for (int n = 0; n < 2; ++n) gv[bj][n] = *(const f32x4*)(g + col0 + bj * HALF + n * 16);
#pragma unroll
        for (int ai = 0; ai < 2; ++ai)
#pragma unroll
            for (int m = 0; m < 4; ++m) { float* rowp = H + (size_t)(row0 + ai * HALF + m * 16) * 1024 + col0;
#pragma unroll
                for (int bj = 0; bj < 2; ++bj)
#pragma unroll
                    for (int n = 0; n < 2; ++n) { f32x4* p = (f32x4*)(rowp + bj * HALF + n * 16); *p = *p + gv[bj][n] * acc[ai][bj][m][n]; } }
    }
};
struct EpiSwiglu {
    static constexpr bool PERM = true, AFTER_DRAIN = false;
    bf16_t* O; int ldo; int nN;
    __device__ __forceinline__ void operator()(const f32x4 (&acc)[2][2][4][2], const Unit& u, int wr, int wc, int fr, int fq) const {
        const int row0 = u.pm * BM + wr * 64 + fr, col0 = (u.pn % nN) * 128 + wc * 16 + 4 * fq;
#pragma unroll
        for (int ai = 0; ai < 2; ++ai)
#pragma unroll
            for (int m = 0; m < 4; ++m) { bf16_t* rowp = O + (size_t)(row0 + ai * HALF + m * 16) * ldo + col0;
#pragma unroll
                for (int bj = 0; bj < 2; ++bj) { const f32x4 gt = acc[ai][bj][m][0], up = acc[ai][bj][m][1]; float r[4];
#pragma unroll
                    for (int i = 0; i < 4; ++i) r[i] = gt[i] * __builtin_amdgcn_rcpf(1.0f + __builtin_amdgcn_exp2f(-1.4426950408889634f * gt[i])) * up[i];
                    u32x2 w; w.x = cvt_pk_bf16(r[0], r[1]); w.y = cvt_pk_bf16(r[2], r[3]);
                    *(u32x2*)(rowp + bj * 64) = w; } }
    }
};
struct MoeOrder {
    const unsigned* list; int nwg, G, c;
    __device__ __forceinline__ bool next(int i, Unit& u) const {
        const long L = (long)i * G + c; if (L >= nwg) return false;
        const unsigned w = (unsigned)__builtin_amdgcn_readfirstlane((int)__hip_atomic_load(list + L, __ATOMIC_RELAXED, __HIP_MEMORY_SCOPE_AGENT));
        u.pm = (int)(w & 0xffffu); u.pn = (int)(w >> 16); return true;
    }
    __device__ __forceinline__ void a_ready(const Unit&) const {}
    __device__ __forceinline__ void done(const Unit&) const {}
};
template <class Epi, class Sched, bool ALIGN_EPI = false, bool SP2 = false>
__device__ __forceinline__ void gemm_phase(PG8_LAS unsigned char* lds, const Gemm g, const Sched& S, const Epi& E, const int tid_in) {
    const int tid = tid_in, wid = __builtin_amdgcn_readfirstlane(tid >> 6), lane = tid & 63, wr = wid >> 2, wc = wid & 3, fr = lane & 15, fq = lane >> 4;
    const int K = g.K, nt = K / BK;
    unsigned voffA[2], voffB[2];
#pragma unroll
    for (int i = 0; i < 2; ++i) { int R, C; stage_rc(tid * 16 + i * 8192, R, C); const int Rb = Epi::PERM ? ((R & ~31) + perm32(R & 31)) : R;
        voffA[i] = (unsigned)(R * K + C) * 2u; voffB[i] = (unsigned)(Rb * K + C) * 2u; }
    const size_t kstep = (size_t)(BK * 2);
    const size_t hstep = (size_t)HALF * K * 2;
    const size_t tstep = 2 * hstep;
    const unsigned ldsw = (unsigned)wid * 1024u;
    const int aoff = lds_byte(wr * 64 + fr, fq * 8), boff = lds_byte(wc * 32 + fr, fq * 8);
#define PG8_SA(b, h) (((b) * 2 + (h)) * HTB)
#define PG8_SB(b, h) ((4 + (b) * 2 + (h)) * HTB)
#define PG8_STAGE(bufoff, gbase, voff) do { _Pragma("unroll") for (int _i = 0; _i < 2; ++_i) \
        __builtin_amdgcn_global_load_lds((const unsigned*)((const char*)(gbase) + (voff)[_i]), (PG8_LAS unsigned*)(lds + (bufoff) + ldsw + _i * 8192), 16, 0, 0); } while (0)
#define PG8_LDA(dst, b, h) do { _Pragma("unroll") for (int m = 0; m < 4; ++m) _Pragma("unroll") for (int k = 0; k < 2; ++k) dst[m][k] = *(const PG8_LAS bf16x8*)(lds + PG8_SA(b, h) + aoff + m * 2048 + k * 1024); } while (0)
#define PG8_LDB(dst, b, h) do { _Pragma("unroll") for (int n = 0; n < 2; ++n) _Pragma("unroll") for (int k = 0; k < 2; ++k) dst[n][k] = *(const PG8_LAS bf16x8*)(lds + PG8_SB(b, h) + boff + n * 2048 + k * 1024); } while (0)
#define PG8_MMA(ai, bj, At, Bt) do { __builtin_amdgcn_s_setprio(1); _Pragma("unroll") for (int m = 0; m < 4; ++m) _Pragma("unroll") for (int n = 0; n < 2; ++n) _Pragma("unroll") for (int k = 0; k < 2; ++k) \
        acc[ai][bj][m][n] = __builtin_amdgcn_mfma_f32_16x16x32_bf16(Bt[n][k], At[m][k], acc[ai][bj][m][n], 0, 0, 0); __builtin_amdgcn_s_setprio(0); } while (0)
#define PG8_WAIT_V(n) asm volatile("s_waitcnt vmcnt(" #n ")" ::: "memory")
#define PG8_WAIT_L(n) asm volatile("s_waitcnt lgkmcnt(" #n ")" ::: "memory")
#define PG8_BAR __builtin_amdgcn_s_barrier()
#define PG8_SCHED __builtin_amdgcn_sched_barrier(0)
    Unit cur, nxt; int ui = 0;
    if (!S.next(0, cur)) return;
    f32x4 acc[2][2][4][2];
#pragma unroll
    for (int a = 0; a < 2; ++a)
#pragma unroll
        for (int b = 0; b < 2; ++b)
#pragma unroll
            for (int m = 0; m < 4; ++m)
#pragma unroll
                for (int n = 0; n < 2; ++n) acc[a][b][m][n] = (f32x4){0.f, 0.f, 0.f, 0.f};
    bf16x8 At[4][2], B0[2][2], B1[2][2];
    const char* cA = (const char*)g.A + (size_t)cur.pm * tstep; const char* cB = (const char*)g.Bt + (size_t)cur.pn * tstep;
    S.a_ready(cur);
    if constexpr (SP2) {
        PG8_STAGE(PG8_SB(0, 0), cB, voffB); PG8_STAGE(PG8_SB(0, 1), cB + hstep, voffB); PG8_STAGE(PG8_SA(0, 0), cA, voffA); PG8_STAGE(PG8_SA(0, 1), cA + hstep, voffA);
        if (wr == 1) PG8_BAR;
        PG8_WAIT_V(2); PG8_BAR;
        PG8_STAGE(PG8_SB(1, 0), cB + kstep, voffB); PG8_STAGE(PG8_SA(1, 0), cA + kstep, voffA); PG8_STAGE(PG8_SB(1, 1), cB + hstep + kstep, voffB);
        PG8_WAIT_V(6); PG8_BAR;
    } else {
        PG8_STAGE(PG8_SB(0, 0), cB, voffB); PG8_STAGE(PG8_SA(0, 0), cA, voffA); PG8_STAGE(PG8_SB(0, 1), cB + hstep, voffB); PG8_STAGE(PG8_SA(0, 1), cA + hstep, voffA);
        if (wr == 1) PG8_BAR;
        PG8_WAIT_V(4); PG8_BAR;
        PG8_STAGE(PG8_SB(1, 0), cB + kstep, voffB); PG8_STAGE(PG8_SA(1, 0), cA + kstep, voffA); PG8_STAGE(PG8_SB(1, 1), cB + hstep + kstep, voffB);
        PG8_WAIT_V(6); PG8_BAR;
    }
    for (;;) {
        const bool has_next = S.next(ui + 1, nxt);
        const char* nA = has_next ? (const char*)g.A + (size_t)nxt.pm * tstep : cA; const char* nB = has_next ? (const char*)g.Bt + (size_t)nxt.pn * tstep : cB;
        for (int t = 0; t < nt; t += 2) {
            const bool last = (t == nt - 2);
            const char* a1 = cA + (size_t)(t + 1) * kstep;
            const char* a2 = last ? nA : cA + (size_t)(t + 2) * kstep; const char* b2 = last ? nB : cB + (size_t)(t + 2) * kstep;
            const char* a3 = a2 + kstep; const char* b3 = b2 + kstep;
            if (last && has_next) S.a_ready(nxt);
            if constexpr (SP2) {
            PG8_LDB(B0, 0, 0); PG8_LDB(B1, 0, 1); PG8_SCHED; PG8_LDA(At, 0, 0); PG8_STAGE(PG8_SA(1, 1), a1 + hstep, voffA);
            PG8_WAIT_V(8); PG8_WAIT_L(0); PG8_BAR; PG8_MMA(0, 0, At, B0); PG8_MMA(0, 1, At, B1); PG8_BAR; PG8_SCHED;
            PG8_LDA(At, 0, 1); PG8_STAGE(PG8_SB(0, 0), b2, voffB); PG8_STAGE(PG8_SB(0, 1), b2 + hstep, voffB); PG8_STAGE(PG8_SA(0, 0), a2, voffA);
            PG8_WAIT_V(8); PG8_WAIT_L(0); PG8_BAR; PG8_MMA(1, 0, At, B0); PG8_MMA(1, 1, At, B1); PG8_BAR; PG8_SCHED;
            PG8_LDB(B0, 1, 0); PG8_LDB(B1, 1, 1); PG8_SCHED; PG8_LDA(At, 1, 0); PG8_STAGE(PG8_SA(0, 1), a2 + hstep, voffA);
            PG8_WAIT_V(8); PG8_WAIT_L(0); PG8_BAR; PG8_MMA(0, 0, At, B0); PG8_MMA(0, 1, At, B1); PG8_BAR; PG8_SCHED;
            PG8_LDA(At, 1, 1); PG8_STAGE(PG8_SB(1, 0), b3, voffB); PG8_STAGE(PG8_SB(1, 1), b3 + hstep, voffB); PG8_STAGE(PG8_SA(1, 0), a3, voffA);
            PG8_WAIT_V(8); PG8_WAIT_L(0); PG8_BAR; PG8_MMA(1, 0, At, B0); PG8_MMA(1, 1, At, B1); PG8_BAR; PG8_SCHED;
            } else {
            PG8_LDB(B0, 0, 0); PG8_SCHED; PG8_LDA(At, 0, 0); PG8_STAGE(PG8_SA(1, 1), a1 + hstep, voffA);
            PG8_WAIT_L(8); PG8_BAR; PG8_WAIT_L(0); PG8_MMA(0, 0, At, B0); PG8_BAR; PG8_SCHED;
            PG8_LDB(B1, 0, 1); PG8_STAGE(PG8_SB(0, 0), b2, voffB);
            PG8_BAR; PG8_WAIT_L(0); PG8_MMA(0, 1, At, B1); PG8_BAR;
            PG8_LDA(At, 0, 1); PG8_STAGE(PG8_SA(0, 0), a2, voffA);
            PG8_BAR; PG8_WAIT_L(0); PG8_MMA(1, 0, At, B0); PG8_BAR; PG8_SCHED;
            PG8_STAGE(PG8_SB(0, 1), b2 + hstep, voffB);
            PG8_WAIT_V(6); PG8_BAR; PG8_MMA(1, 1, At, B1); PG8_BAR;
            PG8_LDB(B0, 1, 0); PG8_SCHED; PG8_LDA(At, 1, 0); PG8_STAGE(PG8_SA(0, 1), a2 + hstep, voffA);
            PG8_WAIT_L(8); PG8_BAR; PG8_WAIT_L(0); PG8_MMA(0, 0, At, B0); PG8_BAR; PG8_SCHED;
            PG8_LDB(B1, 1, 1); PG8_STAGE(PG8_SB(1, 0), b3, voffB);
            PG8_BAR; PG8_WAIT_L(0); PG8_MMA(0, 1, At, B1); PG8_BAR;
            PG8_LDA(At, 1, 1); PG8_STAGE(PG8_SA(1, 0), a3, voffA);
            PG8_BAR; PG8_WAIT_L(0); PG8_MMA(1, 0, At, B0); PG8_BAR; PG8_SCHED;
            PG8_STAGE(PG8_SB(1, 1), b3 + hstep, voffB);
            PG8_WAIT_V(6); PG8_BAR; PG8_MMA(1, 1, At, B1); PG8_BAR;
            }
        }
        if constexpr (ALIGN_EPI) { if (wr == 0) PG8_BAR; }
        if constexpr (!Epi::AFTER_DRAIN) { unsigned z_ = 0u; asm volatile("" : "+v"(z_)); const int l2_ = (int)__builtin_amdgcn_mbcnt_hi(~0u, __builtin_amdgcn_mbcnt_lo(~0u, z_)); E(acc, cur, wr, wc, l2_ & 15, l2_ >> 4); S.done(cur); }
        if (!has_next) break;
#pragma unroll
        for (int a = 0; a < 2; ++a)
#pragma unroll
            for (int b = 0; b < 2; ++b)
#pragma unroll
                for (int m = 0; m < 4; ++m)
#pragma unroll
                    for (int n = 0; n < 2; ++n) acc[a][b][m][n] = (f32x4){0.f, 0.f, 0.f, 0.f};
        cur = nxt; cA = nA; cB = nB; ++ui;
        if constexpr (ALIGN_EPI) { if (wr == 1) PG8_BAR; }
    }
    PG8_WAIT_V(0);
    if constexpr (!ALIGN_EPI) { if (wr == 0) PG8_BAR; }
    PG8_BAR;
    if constexpr (Epi::AFTER_DRAIN) { E.fused(acc, cur, wr, wc, fr, fq, lds, wid, lane); S.done(cur); }
#undef PG8_SA
#undef PG8_SB
#undef PG8_STAGE
#undef PG8_LDA
#undef PG8_LDB
#undef PG8_MMA
#undef PG8_WAIT_V
#undef PG8_WAIT_L
#undef PG8_BAR
#undef PG8_SCHED
}
}
#ifndef LAS
#define LAS __attribute__((address_space(3)))
#endif
#define XB_TMO      128
#define XB_XCNT(j)  (256  + 64 * (j))
#define XB_XSUB(j)  (1280 + 64 * (j))
#define XB_XGEN(j)  (2304 + 64 * (j))
#define XB_TOP      3328
#define XB_TOPGEN   3392
#define XCD_BAR_WORDS 3456
#define XB_SPIN_CAP (1u << 24)

__device__ __forceinline__ unsigned xb_ld(unsigned* p)              { return __hip_atomic_load(p, __ATOMIC_RELAXED, __HIP_MEMORY_SCOPE_AGENT); }
__device__ __forceinline__ unsigned xb_add(unsigned* p, unsigned v) { return __hip_atomic_fetch_add(p, v, __ATOMIC_RELAXED, __HIP_MEMORY_SCOPE_AGENT); }
__device__ __forceinline__ unsigned xb_xcc_id() { return (unsigned)__builtin_amdgcn_s_getreg((3 << 11) | 20) & 0xFu; }
#define XB_SPIN(cond, bar) do { unsigned _sp = 0; while (cond) { __builtin_amdgcn_s_sleep(1); \
    if ((++_sp & 255u) == 0u) { if (xb_ld(&(bar)[XB_TMO])) break; if (_sp > XB_SPIN_CAP) { atomicAdd(&(bar)[XB_TMO], 1u); break; } } } } while (0)

struct XcdBarrier {
    int w;
    unsigned* bar; unsigned x;
    volatile LAS unsigned* st;
};

__device__ __forceinline__ bool xb_thread0(int w) { unsigned z = 0u; asm volatile("" : "+v"(z), "+s"(w)); return w == 0 && __builtin_amdgcn_mbcnt_hi(~0u, __builtin_amdgcn_mbcnt_lo(~0u, z)) == 0u; }
__device__ __forceinline__ XcdBarrier xcd_barrier_post(unsigned* bar, volatile LAS unsigned* st, int w) {
    XcdBarrier b; b.w = w; b.bar = bar; b.x = xb_xcc_id(); b.st = st;
    if (xb_thread0(w)) (void)xb_add(&bar[XB_XCNT(b.x)], 1u);
    return b;
}
__device__ __forceinline__ void xcd_barrier_complete(unsigned* bar, unsigned x, unsigned& nloc, unsigned& nx) {
    const unsigned G = gridDim.x * gridDim.y * gridDim.z;
    unsigned sum, cnt, mine, sp = 0u;
    for (;;) {
        sum = 0u; cnt = 0u; mine = 0u;
#pragma unroll
        for (unsigned j = 0; j < 16; ++j) { const unsigned c = xb_ld(&bar[XB_XCNT(j)]); sum += c; cnt += (c > 0u) ? 1u : 0u; mine = (j == x) ? c : mine; }
        if (sum == G) break;
        __builtin_amdgcn_s_sleep(1);
        if ((++sp & 255u) == 0u) { if (xb_ld(&bar[XB_TMO])) break; if (sp > XB_SPIN_CAP) { atomicAdd(&bar[XB_TMO], 1u); break; } }
    }
    nloc = mine > 0u ? mine : 1u; nx = cnt > 0u ? cnt : 1u;
}

__device__ __forceinline__ void xcd_barrier(const XcdBarrier& b) {
    asm volatile("s_waitcnt vmcnt(0)" ::: "memory");
    __syncthreads();
    if (xb_thread0(b.w)) {
        unsigned* bar = b.bar;
        __builtin_amdgcn_s_waitcnt(0);
        unsigned nloc = b.st[0], nx = b.st[1];
        if (nloc == 0u) { xcd_barrier_complete(bar, b.x, nloc, nx); b.st[0] = nloc; b.st[1] = nx; }
        const unsigned old = xb_add(&bar[XB_XSUB(b.x)], 1u);
        const unsigned gen = old / nloc;
        if (old + 1u == (gen + 1u) * nloc) {
            __builtin_amdgcn_fence(__ATOMIC_RELEASE, "agent");
            asm volatile("s_waitcnt vmcnt(0)" ::: "memory");
            const unsigned og = xb_add(&bar[XB_TOP], 1u);
            const unsigned tg = og / nx;
            if (og + 1u == (tg + 1u) * nx) xb_add(&bar[XB_TOPGEN], 1u);
            else XB_SPIN(xb_ld(&bar[XB_TOPGEN]) == tg, bar);
            __builtin_amdgcn_fence(__ATOMIC_ACQUIRE, "agent");
            xb_add(&bar[XB_XGEN(b.x)], 1u);
            asm volatile("s_waitcnt vmcnt(0)" ::: "memory");
        } else {
            XB_SPIN(xb_ld(&bar[XB_XGEN(b.x)]) == gen, bar);
            __builtin_amdgcn_fence(__ATOMIC_ACQUIRE, "agent");
            asm volatile("s_waitcnt vmcnt(0)" ::: "memory");
        }
    }
    __syncthreads();
}
constexpr int NWAVES = 8, NTHREADS = NWAVES * 64;
constexpr size_t MiB = 1u << 20;
constexpr size_t WS_CTL = 0, CTL_ZERO_BYTES = 1 * MiB;
constexpr size_t WS_SMALL = 1 * MiB, WS_TOKINFO = 2 * MiB, WS_LIST = 3 * MiB;
constexpr size_t WS_WIN = 4 * MiB, WS_WOUT = 34 * MiB, WS_WFGU = 42 * MiB, WS_WFD = 64 * MiB, WS_WMGU = 75 * MiB, WS_WMD = 187 * MiB;
constexpr size_t WS_H = 243 * MiB, WS_A = 315 * MiB, WS_OC = 351 * MiB, WS_Y = 387 * MiB, WS_AM = 463 * MiB, WS_BIG = 539 * MiB;
constexpr size_t WS_P = WS_BIG, WS_QM = 674 * MiB, WS_KM = WS_QM + 14155776, WS_VM = WS_KM + 14155776, WS_QS = 710 * MiB, WS_KS = WS_QS + 9437184, WS_VS = WS_KS + 4718592;
constexpr size_t WS_HF = 728 * MiB, WS_HO = 764 * MiB, WS_RQ = 800 * MiB, WS_RK = 809 * MiB, WS_RO = 818 * MiB, WS_END = 854 * MiB;
constexpr size_t WS_ACT = WS_BIG;
constexpr int MAXTILES = 152;
static_assert(WS_P + (size_t)NTOK * NP * 2 <= WS_QM && WS_VM + (size_t)NB * 4 * TK * 64 * 2 <= WS_QS && WS_VS + 4718592 <= WS_HF, "ws map 1");
static_assert(WS_ACT + (size_t)MAXTILES * 256 * DFE * 2 <= WS_END && (size_t)MAXTILES * 256 * D * 2 <= 76 * MiB, "ws map 2");
constexpr int SM_MOD = 0;
constexpr int SM_LOGLB = 4 * 9 * 6144, SM_LOG1M = SM_LOGLB + 4 * 512, SM_LGAM = SM_LOG1M + 4 * 512, SM_META = SM_LGAM + 64, SM_ULIST = SM_META + 32;
constexpr int ULIST_GU = 0, ULIST_D = MAXTILES * 28;
static_assert((SM_ULIST + MAXTILES * 32) * 4 <= (int)MiB, "small region");
constexpr int CW_BAR = 4096, CW_CNT = 8192;
constexpr int LDS_BYTES = 147456, MISC_OFF = 131072 + 320;

#define GAS __attribute__((address_space(1)))
#define LAS __attribute__((address_space(3)))
typedef float f32x4 __attribute__((ext_vector_type(4)));
typedef unsigned v4u __attribute__((ext_vector_type(4)));
typedef unsigned v2u __attribute__((ext_vector_type(2)));
#define LDS_WAIT() asm volatile("s_waitcnt lgkmcnt(0)" ::: "memory")

struct Args { const float* in[28]; float* out; unsigned char* ws; int ph_lo, ph_hi; };
typedef __attribute__((address_space(4))) const unsigned long long ka_u64;
__device__ __forceinline__ const float* IN(int i) { ka_u64* ka = (ka_u64*)__builtin_amdgcn_kernarg_segment_ptr(); asm volatile("" : "+s"(ka)); return (const float*)ka[i]; }
__device__ __forceinline__ float* OUTP() { ka_u64* ka = (ka_u64*)__builtin_amdgcn_kernarg_segment_ptr(); asm volatile("" : "+s"(ka)); return (float*)ka[28]; }
__device__ __forceinline__ unsigned char* WSBASE() { ka_u64* ka = (ka_u64*)__builtin_amdgcn_kernarg_segment_ptr(); asm volatile("" : "+s"(ka)); return (unsigned char*)ka[29]; }
struct Frame {
    LAS unsigned char* lds;
    int tid, lane, wave, gtid, NT, gw, NGW;
    __device__ __forceinline__ unsigned char* base() const { return WSBASE(); }
};
#define WSP(T, off) ((T*)(ws + (off)))
#define F_ctl WSP(unsigned, WS_CTL)
#define F_sm WSP(float, WS_SMALL)
#define F_tokinfo WSP(int, WS_TOKINFO)
#define F_list WSP(int, WS_LIST)
#define F_H WSP(float, WS_H)
#define F_A WSP(bf16, WS_A)
#define F_OC WSP(bf16, WS_OC)
#define F_Y WSP(bf16, WS_Y)
#define F_AM WSP(bf16, WS_AM)
#define F_P WSP(bf16, WS_P)
#define F_ACT WSP(bf16, WS_ACT)
#define F_WIN WSP(bf16, WS_WIN)
#define F_WOUT WSP(bf16, WS_WOUT)
#define F_WFGU WSP(bf16, WS_WFGU)
#define F_WFD WSP(bf16, WS_WFD)
#define F_WMGU WSP(bf16, WS_WMGU)
#define F_WMD WSP(bf16, WS_WMD)
__device__ __forceinline__ float wave_sum(float v, int lane) {
#pragma unroll
    for (int o = 1; o < 64; o <<= 1) v += __int_as_float(__builtin_amdgcn_ds_bpermute((lane ^ o) << 2, __float_as_int(v)));
    return v;
}
__device__ __forceinline__ unsigned pk2(float lo, float hi) { return (unsigned)f2bf(lo) | ((unsigned)f2bf(hi) << 16); }

template <class SrcFn> __device__ __forceinline__ void transpose_item(const SrcFn& src, int K, int nblk, bf16* WT, LAS float* scr, int item, int lane) {
    const int kb = item / nblk, nb = item % nblk, k0 = 64 * kb, n0 = 32 * nb;
#pragma unroll 8
    for (int i = 0; i < 32; ++i) { const int kk = 2 * i + (lane >> 5); scr[kk * 33 + (lane & 31)] = src(k0 + kk, n0 + (lane & 31)); }
    LDS_WAIT(); asm volatile("" ::: "memory");
    const int c = lane & 7;
#pragma unroll
    for (int j = 0; j < 4; ++j) { const int n = (lane >> 3) + 8 * j; const LAS float* s = scr + (8 * c) * 33 + n;
        v4u o; o.x = pk2(s[0 * 33], s[1 * 33]); o.y = pk2(s[2 * 33], s[3 * 33]); o.z = pk2(s[4 * 33], s[5 * 33]); o.w = pk2(s[6 * 33], s[7 * 33]);
        *(v4u*)(WT + (size_t)(n0 + n) * K + k0 + 8 * c) = o; }
    LDS_WAIT(); asm volatile("" ::: "memory");
}
struct SrcPlain { const float* W; int N; __device__ __forceinline__ float operator()(int k, int n) const { return W[(size_t)k * N + n]; } };
struct SrcGU { const float* Wg; long du; int NF; __device__ __forceinline__ float operator()(int k, int c) const { const int j = c >> 3, w = c & 7; return Wg[(w < 4 ? 0l : du) + (long)k * NF + 4 * j + (w & 3)]; } };

__device__ __forceinline__ void convert_moe(Frame& F, int li) {
    unsigned char* ws = F.base();
    LAS float* scr = (LAS float*)(F.lds + 40960 + F.wave * 8704);
    constexpr int I_GU = 16 * 224, I_D = 56 * 32;
    for (int it = F.gw; it < 8 * (I_GU + I_D); it += F.NGW) {
        const int e = it / (I_GU + I_D); int r = it % (I_GU + I_D);
        if (r < I_GU) { SrcGU s{IN(24) + ((size_t)li * 8 + e) * D * DFE, (long)(IN(25) - IN(24)), DFE}; transpose_item(s, D, 224, F_WMGU + (size_t)e * 2 * DFE * D, scr, r, F.lane); }
        else { r -= I_GU; SrcPlain s{IN(26) + ((size_t)li * 8 + e) * DFE * D, D}; transpose_item(s, DFE, 32, F_WMD + (size_t)e * D * DFE, scr, r, F.lane); }
    }
}
__device__ __forceinline__ void prologue(Frame& F) {
    unsigned char* ws = F.base();
    LAS float* sil = (LAS float*)F.lds;
    for (int i = F.tid; i < 9 * 1024; i += NTHREADS) { const float cv = i < 8 * 1024 ? IN(1)[i] : IN(3)[i - 8 * 1024]; sil[i] = silu_f(cv); }
    __syncthreads();
    for (int it = F.gtid; it < DEPTH * 6144; it += F.NT) {
        const int l = it / 6144, j = it % 6144; const float* w = IN(4) + (size_t)l * D * 6144 + j;
        float acc[9];
#pragma unroll
        for (int b = 0; b < 9; ++b) acc[b] = IN(5)[l * 6144 + j];
        for (int k = 0; k < D; ++k) { const float wv = w[(size_t)k * 6144];
#pragma unroll
            for (int b = 0; b < 9; ++b) acc[b] += sil[b * 1024 + k] * wv; }
#pragma unroll
        for (int b = 0; b < 9; ++b) F_sm[SM_MOD + ((size_t)l * 9 + b) * 6144 + j] = acc[b];
    }
    for (int it = F.gtid; it < 512; it += F.NT) {
        float lg[DEPTH], mx = -1e30f, s = 0.f;
#pragma unroll
        for (int l = 0; l < DEPTH; ++l) { lg[l] = IN(14)[l * 512 + it]; mx = fmaxf(mx, lg[l]); }
#pragma unroll
        for (int l = 0; l < DEPTH; ++l) { lg[l] = expf(lg[l] - mx); s += lg[l]; }
        float cum = 0.f; const float p0 = lg[0] / s;
#pragma unroll
        for (int l = 0; l < DEPTH; ++l) { cum += lg[l] / s; const float lb = cum - p0; F_sm[SM_LOGLB + l * 512 + it] = logf(fmaxf(lb, 1e-30f)); F_sm[SM_LOG1M + l * 512 + it] = log1pf(-lb); }
    }
    for (int it = F.gtid; it < DEPTH * 8; it += F.NT) F_sm[SM_LGAM + it] = log_sigmoid_f(IN(17)[it]);
    LAS float* scr = (LAS float*)(F.lds + 40960 + F.wave * 8704);
    constexpr int I_IN = 16 * 91, I_OUT = 16 * 32, I_FGU = 16 * 176, I_FD = 44 * 32;
    constexpr int N_IN = DEPTH * I_IN, N_OUT = DEPTH * I_OUT, N_FGU = 2 * I_FGU, N_FD = 2 * I_FD;
    for (int it = F.gw; it < N_IN + N_OUT + N_FGU + N_FD; it += F.NGW) {
        int r = it;
        if (r < N_IN) { const int l = r / I_IN; SrcPlain s{IN(8) + (size_t)l * D * DIN, DIN}; transpose_item(s, D, 91, F_WIN + (size_t)l * NP * D, scr, r % I_IN, F.lane); continue; } r -= N_IN;
        if (r < N_OUT) { const int l = r / I_OUT; SrcPlain s{IN(9) + (size_t)l * D * D, D}; transpose_item(s, D, 32, F_WOUT + (size_t)l * D * D, scr, r % I_OUT, F.lane); continue; } r -= N_OUT;
        if (r < N_FGU) { const int l = r / I_FGU; SrcGU s{IN(20) + (size_t)l * D * DFF, (long)(IN(21) - IN(20)), DFF}; transpose_item(s, D, 176, F_WFGU + (size_t)l * 2 * DFF * D, scr, r % I_FGU, F.lane); continue; } r -= N_FGU;
        { const int l = r / I_FD; SrcPlain s{IN(22) + (size_t)l * DFF * D, D}; transpose_item(s, DFF, 32, F_WFD + (size_t)l * D * DFF, scr, r % I_FD, F.lane); }
    }
    convert_moe(F, 0);
    for (int it = F.gtid; it < DEPTH * D * 928; it += F.NT) {
        const int n = it % 928, k = (it / 928) % D, l = it / (928 * D);
        const float* wi = IN(8) + ((size_t)l * D + k) * DIN; float acc = 0.f;
        if (n < 384) { const float* g = IN(10) + l * 192; const float* wu = IN(11) + (size_t)l * 192 * 384 + n; for (int j = 0; j < 192; ++j) acc += wi[j] * g[j] * wu[(size_t)j * 384]; }
        else if (n < 896) { const float* g = IN(12) + l * 128; const float* wu = IN(13) + (size_t)l * 128 * 512 + (n - 384); for (int j = 0; j < 128; ++j) acc += wi[192 + j] * g[j] * wu[(size_t)j * 512]; }
        F_WIN[((size_t)l * NP + DIN + n) * D + k] = f2bf(acc);
    }
}

template <int KIND> __device__ __forceinline__ void norm_phase(Frame& F, int l) {
    unsigned char* ws = F.base();
    const bool combine = (KIND != 1) && l > 0 && ((l - 1) & 1);
    const bool first = (KIND == 0 && l == 0);
    const int nrows = (KIND == 2) ? NLAT : NTOK;
    const float* modl = F_sm + SM_MOD + (size_t)(KIND == 2 ? 0 : l) * 9 * 6144;
    const float* modp = F_sm + SM_MOD + (size_t)(l > 0 ? l - 1 : 0) * 9 * 6144;
    const int* offs = (const int*)(F_sm + SM_META) + ((l > 0 ? l - 1 : 0) >> 1) * 16;
    const float* gain = KIND == 0 ? IN(6) + l * D : (KIND == 1 ? IN(7) + l * D : IN(27));
    for (int row = F.gw; row < nrows; row += F.NGW) {
        const int bidx = row < NLAT ? row / NL : NB;
        const float* src = first ? (row < NLAT ? IN(0) + (size_t)row * D : IN(2) + (size_t)(row - NLAT) * D) : F_H + (size_t)row * D;
        f32x4 v[4];
#pragma unroll
        for (int j = 0; j < 4; ++j) v[j] = *(const f32x4*)(src + 4 * F.lane + 256 * j);
        if (combine) {
            const int* ti = F_tokinfo + (size_t)row * 8;
            const int e1 = ti[0], p1 = ti[1], e2 = ti[3], p2 = ti[4]; const float w1 = __int_as_float(ti[2]), w2 = __int_as_float(ti[5]);
            const bf16* y1 = F_Y + (size_t)(offs[e1] + p1) * D; const bf16* y2 = F_Y + (size_t)(offs[e2] + p2) * D;
#pragma unroll
            for (int j = 0; j < 4; ++j) { const int col = 4 * F.lane + 256 * j;
                const f32x4 gf = *(const f32x4*)(modp + (size_t)bidx * 6144 + 5 * 1024 + col);
                const v2u a = *(const v2u*)(y1 + col), b = *(const v2u*)(y2 + col);
                f32x4 ya, yb; ya[0] = bf2f((bf16)(a.x & 0xffff)); ya[1] = bf2f((bf16)(a.x >> 16)); ya[2] = bf2f((bf16)(a.y & 0xffff)); ya[3] = bf2f((bf16)(a.y >> 16));
                yb[0] = bf2f((bf16)(b.x & 0xffff)); yb[1] = bf2f((bf16)(b.x >> 16)); yb[2] = bf2f((bf16)(b.y & 0xffff)); yb[3] = bf2f((bf16)(b.y >> 16));
                v[j] = v[j] + gf * (ya * w1 + yb * w2); }
        }
        if (combine || first) {
#pragma unroll
            for (int j = 0; j < 4; ++j) *(f32x4*)(F_H + (size_t)row * D + 4 * F.lane + 256 * j) = v[j];
        }
        float ss = 0.f;
#pragma unroll
        for (int j = 0; j < 4; ++j) ss += (v[j][0] * v[j][0] + v[j][1] * v[j][1]) + (v[j][2] * v[j][2] + v[j][3] * v[j][3]);
        const float rstd = 1.0f / sqrtf(wave_sum(ss, F.lane) * (1.0f / D) + NORM_EPS);
        if (KIND == 2) {
#pragma unroll
            for (int j = 0; j < 4; ++j) { const int col = 4 * F.lane + 256 * j; const f32x4 g = *(const f32x4*)(gain + col); *(f32x4*)(OUTP() + (size_t)row * D + col) = v[j] * rstd * g; }
            continue;
        }
        const float* mrow = modl + (size_t)bidx * 6144 + (KIND == 0 ? 0 : 3 * 1024);
#pragma unroll
        for (int j = 0; j < 4; ++j) { const int col = 4 * F.lane + 256 * j;
            const f32x4 g = *(const f32x4*)(gain + col), sh = *(const f32x4*)(mrow + col), sc = *(const f32x4*)(mrow + 1024 + col);
            v[j] = v[j] * rstd * g * (sc + 1.0f) + sh;
            v2u o; o.x = pk2(v[j][0], v[j][1]); o.y = pk2(v[j][2], v[j][3]);
            *(v2u*)(F_A + (size_t)row * D + col) = o; }
        if (KIND == 1 && (l & 1)) {
            const int li = l >> 1; const float* wr = IN(23) + (size_t)li * D * 8;
            float lg[8];
#pragma unroll
            for (int e = 0; e < 8; ++e) lg[e] = 0.f;
#pragma unroll
            for (int j = 0; j < 4; ++j)
#pragma unroll
                for (int i = 0; i < 4; ++i) { const int col = 4 * F.lane + 256 * j + i; const f32x4 w0 = *(const f32x4*)(wr + (size_t)col * 8), w1 = *(const f32x4*)(wr + (size_t)col * 8 + 4);
#pragma unroll
                    for (int e = 0; e < 4; ++e) { lg[e] += v[j][i] * w0[e]; lg[4 + e] += v[j][i] * w1[e]; } }
#pragma unroll
            for (int e = 0; e < 8; ++e) lg[e] = wave_sum(lg[e], F.lane);
            int e1 = 0; float v1 = lg[0];
#pragma unroll
            for (int e = 1; e < 8; ++e) if (lg[e] > v1) { v1 = lg[e]; e1 = e; }
            int e2 = -1; float v2 = -3.0e38f;
#pragma unroll
            for (int e = 0; e < 8; ++e) if (e != e1 && lg[e] > v2) { v2 = lg[e]; e2 = e; }
            if (F.lane == 0) {
                const float w2 = 1.0f / (1.0f + expf(v1 - v2)), w1 = 1.0f - w2;
                const int p1 = (int)atomicAdd(F_ctl + CW_CNT + li * 8 + e1, 1u), p2 = (int)atomicAdd(F_ctl + CW_CNT + li * 8 + e2, 1u);
                F_list[(size_t)e1 * NTOK + p1] = row; F_list[(size_t)e2 * NTOK + p2] = row;
                int* ti = F_tokinfo + (size_t)row * 8; ti[0] = e1; ti[1] = p1; ti[2] = __float_as_int(w1); ti[3] = e2; ti[4] = p2; ti[5] = __float_as_int(w2);
            }
        }
    }
}
__device__ __forceinline__ void moe_tiles(Frame& F, int li, int (&tb)[9], int (&cnt)[8]) {
    unsigned char* ws = F.base();
    tb[0] = 0;
#pragma unroll
    for (int e = 0; e < 8; ++e) { cnt[e] = (int)__hip_atomic_load(F_ctl + CW_CNT + li * 8 + e, __ATOMIC_RELAXED, __HIP_MEMORY_SCOPE_AGENT); tb[e + 1] = tb[e] + ((cnt[e] + 255) >> 8); }
}
__device__ __forceinline__ void moe_gather(Frame& F, int li) {
    unsigned char* ws = F.base();
    int tb[9], cnt[8]; moe_tiles(F, li, tb, cnt);
    if (blockIdx.x == 0 && F.tid < 9) { int* meta = (int*)(F_sm + SM_META) + li * 16; int val = 0;
#pragma unroll
        for (int e = 0; e < 9; ++e) if (F.tid == e) val = tb[e] * 256;
        meta[F.tid] = val; }
    { const int T = tb[8]; unsigned* ul = (unsigned*)(F_sm + SM_ULIST);
      for (int L = F.gtid; L < T * 32; L += F.NT) {
          const bool gu = L < T * 28; const int nN = gu ? 28 : 4, nwg = T * nN; int wgid = gu ? L : L - T * 28;
          { const int q = nwg / 8, r = nwg % 8, xcd = wgid % 8, off = wgid / 8; wgid = (xcd < r ? xcd * (q + 1) : r * (q + 1) + (xcd - r) * q) + off; }
          const int nig = 8 * nN, gid = wgid / nig, fm = gid * 8, gsz = (T - fm) < 8 ? (T - fm) : 8;
          const int pm = fm + ((wgid % nig) % gsz), pnl = (wgid % nig) / gsz; int e = 0;
#pragma unroll
          for (int j = 1; j < 8; ++j) e += (pm >= tb[j]) ? 1 : 0;
          ul[(gu ? ULIST_GU : ULIST_D) + (gu ? L : L - T * 28)] = (unsigned)pm | ((unsigned)(e * nN + pnl) << 16);
      } }
    const int nslot = tb[8] * 256;
    for (int s = F.gw; s < nslot; s += F.NGW) {
        const int tile = s >> 8; int e = 0, base = 0, c = 0;
#pragma unroll
        for (int j = 0; j < 8; ++j) if (tile >= tb[j] && tile < tb[j + 1]) { e = j; base = tb[j] * 256; c = cnt[j]; }
        const int pos = s - base; const int tok = pos < c ? F_list[(size_t)e * NTOK + pos] : -1;
        v4u a = (v4u){0u, 0u, 0u, 0u}, b = a;
        if (tok >= 0) { const v4u* sp = (const v4u*)(F_A + (size_t)tok * D); a = sp[F.lane]; b = sp[64 + F.lane]; }
        v4u* dp = (v4u*)(F_AM + (size_t)s * D); dp[F.lane] = a; dp[64 + F.lane] = b;
    }
}

__device__ __forceinline__ void make_mix(Mix& M, unsigned char* ws, int l) {
    M.P = F_P; M.Qm = WSP(bf16, WS_QM); M.Km = WSP(bf16, WS_KM); M.Vm = WSP(bf16, WS_VM); M.Qs = WSP(bf16, WS_QS); M.Ks = WSP(bf16, WS_KS); M.Vs = WSP(bf16, WS_VS);
    M.HF = WSP(float, WS_HF); M.HO = WSP(float, WS_HO); M.RQ = WSP(float, WS_RQ); M.RK = WSP(float, WS_RK); M.RO = WSP(float, WS_RO); M.OC = F_OC;
    M.loglb = F_sm + SM_LOGLB + l * 512; M.log1mlb = F_sm + SM_LOG1M + l * 512; M.hg_norm_g = IN(15) + l * 256; M.sink = IN(16) + l * 4; M.log_gamma = F_sm + SM_LGAM + l * 8;
    M.gn_g = IN(18) + l * 256; M.gn_b = IN(19) + l * 256;
}
__device__ __forceinline__ void frame_init(Frame& F, LAS unsigned char* lds, int wave_s) {
    unsigned z = 0u; asm volatile("" : "+v"(z)); int t = (int)__builtin_amdgcn_mbcnt_hi(~0u, __builtin_amdgcn_mbcnt_lo(~0u, z)); t += wave_s * 64;
    F.lds = lds; F.tid = t; F.lane = t & 63; F.wave = wave_s;
    F.gtid = blockIdx.x * NTHREADS + t; F.NT = gridDim.x * NTHREADS; { int gw_ = blockIdx.x * NWAVES + wave_s; asm volatile("" : "+s"(gw_)); F.gw = gw_; } F.NGW = gridDim.x * NWAVES;
}
__global__ void __launch_bounds__(NTHREADS, 2) fwd_kernel(Args args) {
    extern __shared__ __attribute__((aligned(16))) unsigned char lds[];
    const int wave_s = __builtin_amdgcn_readfirstlane((int)threadIdx.x >> 6);
    volatile LAS unsigned* MISC = (volatile LAS unsigned*)((LAS unsigned char*)lds + MISC_OFF);
    for (int u = threadIdx.x; u < (LDS_BYTES - 131072) / 4; u += NTHREADS) ((LAS unsigned*)((LAS unsigned char*)lds + 131072))[u] = 0u;
    __syncthreads();
    const int lo = args.ph_lo, hi = args.ph_hi;
    XcdBarrier bar; bar.w = wave_s; bar.bar = (unsigned*)(WSBASE() + WS_CTL) + CW_BAR; bar.x = 0; bar.st = nullptr;
    if (hi - lo > 1) bar = xcd_barrier_post((unsigned*)(WSBASE() + WS_CTL) + CW_BAR, MISC + 8, wave_s);
    int p = 0;
#ifndef PHMASK
#define PHMASK 0xffffffffu
#endif
#define PH_BEGIN_(k) if (((PHMASK >> (k)) & 1u) && p >= lo && p < hi) { Frame F; frame_init(F, (LAS unsigned char*)lds, wave_s); unsigned char* ws = F.base();
#define PH_END if (p + 1 < hi) xcd_barrier(bar); } ++p;

    PH_BEGIN_(0) (void)ws; prologue(F); PH_END

    for (int l = 0; l < DEPTH; ++l) {
        PH_BEGIN_(1) (void)ws; norm_phase<0>(F, l); if (l == 2) convert_moe(F, 1); PH_END
        PH_BEGIN_(2) { pg8::Gemm g{F_A, F_WIN + (size_t)l * NP * D, NTOK, NP, D}; pg8::StaticOrder S; S.init(NTOK, NP, gridDim.x, blockIdx.x);
                   pg8::EpiBf16P E{F_P, NP, NP / 256}; pg8::gemm_phase<pg8::EpiBf16P, pg8::StaticOrder, true, true>(F.lds, g, S, E, F.tid); } PH_END
#ifndef NO_MIX
        PH_BEGIN_(3) { Mix M; make_mix(M, ws, l);
            for (int it = F.gtid; it < NTOK * 4; it += F.NT) mla_prep_item(M, it);
            for (int it = F.gtid; it < NTOK * 8; it += F.NT) swa_prep_item(M, it);
            for (int it = F.gtid; it < NTOK * 256; it += F.NT) hg_prep_item(M, it);
            for (int it = F.gtid; it < NTOK * 8; it += F.NT) ret_prep_item(M, it); }
        PH_END
        PH_BEGIN_(4) { Mix M; make_mix(M, ws, l);
            for (int it = F.gtid; it < NB * 4 * TK; it += F.NT) mla_attn_item(M, it);
            for (int it = F.gtid; it < NB * 4 * TK; it += F.NT) swa_attn_item(M, it);
            if (F.wave == 0) { for (int sw = blockIdx.x; sw < 2 * NB * 4; sw += gridDim.x) hg_scan_item(M, sw * 64 + F.lane); }
            if (F.wave == 4) { for (int sw = (blockIdx.x + 128) % gridDim.x; sw < 2 * NB * 4; sw += gridDim.x) ret_scan_item(M, sw * 64 + F.lane); } }
        PH_END
        PH_BEGIN_(5) { Mix M; make_mix(M, ws, l);
            for (int it = F.gtid; it < NTOK * 4; it += F.NT) hg_fin_item(M, it);
            for (int it = F.gtid; it < NTOK * 4; it += F.NT) ret_fin_item(M, it); }
        PH_END
#endif
        PH_BEGIN_(6) { pg8::Gemm g{F_OC, F_WOUT + (size_t)l * D * D, NTOK, D, D}; pg8::StaticOrder S; S.init(NTOK, D, gridDim.x, blockIdx.x);
                   pg8::EpiRes E{F_H, F_sm + SM_MOD + (size_t)l * 9 * 6144 + 2 * 1024, NLAT / 256, NL / 256, NB}; pg8::gemm_phase<pg8::EpiRes, pg8::StaticOrder, true, true>(F.lds, g, S, E, F.tid); } PH_END
        PH_BEGIN_(7) (void)ws; norm_phase<1>(F, l); PH_END
        if ((l & 1) == 0) {
            const int li = l >> 1;
            PH_BEGIN_(8) { pg8::Gemm g{F_A, F_WFGU + (size_t)li * 2 * DFF * D, NTOK, 2 * DFF, D}; pg8::StaticOrder S; S.init(NTOK, 2 * DFF, gridDim.x, blockIdx.x);
                       pg8::EpiSwiglu E{F_ACT, DFF, 2 * DFF / 256}; pg8::gemm_phase<pg8::EpiSwiglu, pg8::StaticOrder, true, true>(F.lds, g, S, E, F.tid); } PH_END
            PH_BEGIN_(9) { pg8::Gemm g{F_ACT, F_WFD + (size_t)li * D * DFF, NTOK, D, DFF}; pg8::StaticOrder S; S.init(NTOK, D, gridDim.x, blockIdx.x);
                       pg8::EpiRes E{F_H, F_sm + SM_MOD + (size_t)l * 9 * 6144 + 5 * 1024, NLAT / 256, NL / 256, NB}; pg8::gemm_phase<pg8::EpiRes, pg8::StaticOrder, true, true>(F.lds, g, S, E, F.tid); } PH_END
        } else {
            const int li = l >> 1;
            PH_BEGIN_(10) (void)ws; moe_gather(F, li); PH_END
            PH_BEGIN_(11) { const int T = (int)__hip_atomic_load((unsigned*)(F_sm + SM_META) + li * 16 + 8, __ATOMIC_RELAXED, __HIP_MEMORY_SCOPE_AGENT) >> 8;
                       pg8::MoeOrder S; S.list = (const unsigned*)(F_sm + SM_ULIST) + ULIST_GU; S.nwg = T * (2 * DFE / 256); S.G = gridDim.x; S.c = blockIdx.x;
                       pg8::Gemm g{F_AM, F_WMGU, MAXTILES * 256, 8 * 2 * DFE, D};
                       pg8::EpiSwiglu E{F_ACT, DFE, 2 * DFE / 256}; pg8::gemm_phase<pg8::EpiSwiglu, pg8::MoeOrder, true, true>(F.lds, g, S, E, F.tid); } PH_END
            PH_BEGIN_(12) { const int T = (int)__hip_atomic_load((unsigned*)(F_sm + SM_META) + li * 16 + 8, __ATOMIC_RELAXED, __HIP_MEMORY_SCOPE_AGENT) >> 8;
                       pg8::MoeOrder S; S.list = (const unsigned*)(F_sm + SM_ULIST) + ULIST_D; S.nwg = T * (D / 256); S.G = gridDim.x; S.c = blockIdx.x;
                       pg8::Gemm g{F_ACT, F_WMD, MAXTILES * 256, 8 * D, DFE};
                       pg8::EpiBf16P E{F_Y, D, D / 256}; pg8::gemm_phase<pg8::EpiBf16P, pg8::MoeOrder, true, true>(F.lds, g, S, E, F.tid); } PH_END
        }
    }
    PH_BEGIN_(13) (void)ws; norm_phase<2>(F, DEPTH); PH_END
#undef PH_BEGIN_
#undef PH_END
}
constexpr int NPHASES = 1 + 2 * 9 + 2 * 10 + 1;

#ifndef MK_PER_PHASE
#define MK_PER_PHASE 0
#endif
extern "C" void kernel_launch(void* const* d_in, const int* in_sizes, int n_in, void* d_out, int out_size, void* d_ws, size_t ws_size, hipStream_t stream) {
    static int grid = 0;
    if (grid == 0) {
        if (n_in != 28 || ws_size < WS_END || out_size != NLAT * D) { fprintf(stderr, "kernel_launch: unexpected problem shape (n_in %d, ws %zu, out %d)\n", n_in, ws_size, out_size); grid = -1; return; }
        int dev = 0, cus = 0;
        if (hipGetDevice(&dev) != hipSuccess || hipDeviceGetAttribute(&cus, hipDeviceAttributeMultiprocessorCount, dev) != hipSuccess) { grid = -1; return; }
        if (hipFuncSetAttribute((const void*)fwd_kernel, hipFuncAttributeMaxDynamicSharedMemorySize, LDS_BYTES) != hipSuccess) { fprintf(stderr, "kernel_launch: hipFuncSetAttribute failed\n"); grid = -1; return; }
        int per_cu = 0;
        if (hipOccupancyMaxActiveBlocksPerMultiprocessor(&per_cu, (const void*)fwd_kernel, NTHREADS, LDS_BYTES) != hipSuccess || per_cu < 1) { fprintf(stderr, "kernel_launch: occupancy query says %d\n", per_cu); }
        (void)hipGetLastError();
        grid = cus;
    }
    if (grid < 0) return;
    (void)hipMemsetAsync((char*)d_ws + WS_CTL, 0, CTL_ZERO_BYTES, stream);
    Args a{};
    for (int i = 0; i < 28; ++i) a.in[i] = (const float*)d_in[i];
    a.out = (float*)d_out; a.ws = (unsigned char*)d_ws;
#if MK_PER_PHASE
    for (int p = 0; p < NPHASES; ++p) { a.ph_lo = p; a.ph_hi = p + 1; hipLaunchKernelGGL(fwd_kernel, dim3(grid), dim3(NTHREADS), LDS_BYTES, stream, a); }
#else
    a.ph_lo = 0; a.ph_hi = NPHASES; hipLaunchKernelGGL(fwd_kernel, dim3(grid), dim3(NTHREADS), LDS_BYTES, stream, a);
#endif
}
```

```cpp
#include <hip/hip_runtime.h>
#include <cstdio>
#include <cstdint>
#include <cmath>
#ifndef NB
#define NB 8
#endif
constexpr int D = 1024, NL = 2048, NC = 256, TK = NL + NC, DEPTH = 4, GRIDW = 64;
constexpr int NLAT = NB * NL, NCTX = NB * NC, NTOK = NLAT + NCTX;
constexpr int NP = 3840;
constexpr int DIN = 2912;
constexpr int C_QLAT = 0, C_KVLAT = 192, C_KPE = 320, C_HQ = 352, C_HZF = 608, C_HZB = 864, C_HI = 1120, C_HG = 1376;
constexpr int C_SQ = 1632, C_SK = 1888, C_SV = 2016, C_RQ = 2144, C_RK = 2272, C_RV = 2400, C_RG = 2656, C_QE = 2912, C_KVE = 3296;
constexpr int DFF = 2816, NEXP = 8, DFE = 3584;
constexpr float NORM_EPS = 1e-6f, LOG2E = 1.4426950408889634f;
typedef unsigned short bf16;

#ifdef HOST_TEST
#define HD static inline
#else
#define HD __host__ __device__ __forceinline__
#endif

HD float bf2f(bf16 b) { unsigned u = ((unsigned)b) << 16; float f; __builtin_memcpy(&f, &u, 4); return f; }
HD bf16 f2bf(float f) { unsigned u; __builtin_memcpy(&u, &f, 4); return (bf16)((u + 0x7fffu + ((u >> 16) & 1u)) >> 16); }
#define CBAR() asm volatile("" ::: "memory")
struct U4 { unsigned x, y, z, w; };
HD void ld8(const bf16* p, float (&f)[8]) {
    U4 u; __builtin_memcpy(&u, __builtin_assume_aligned(p, 16), 16);
    unsigned t;
    t = u.x << 16; __builtin_memcpy(&f[0], &t, 4); t = u.x & 0xffff0000u; __builtin_memcpy(&f[1], &t, 4);
    t = u.y << 16; __builtin_memcpy(&f[2], &t, 4); t = u.y & 0xffff0000u; __builtin_memcpy(&f[3], &t, 4);
    t = u.z << 16; __builtin_memcpy(&f[4], &t, 4); t = u.z & 0xffff0000u; __builtin_memcpy(&f[5], &t, 4);
    t = u.w << 16; __builtin_memcpy(&f[6], &t, 4); t = u.w & 0xffff0000u; __builtin_memcpy(&f[7], &t, 4);
}
HD void ld4f(const float* p, float (&f)[4]) { __builtin_memcpy(&f[0], __builtin_assume_aligned(p, 16), 16); }
HD float silu_f(float x) { return x / (1.0f + expf(-x)); }
HD int row_of(int b, int tq) { return tq < NC ? NLAT + b * NC + tq : b * NL + (tq - NC); }
HD void row_split(int row, int& b, int& tq) { if (row < NLAT) { b = row / NL; tq = NC + row % NL; } else { const int r = row - NLAT; b = r / NC; tq = r % NC; } }
HD float log_sigmoid_f(float x) { return fminf(x, 0.f) - log1pf(expf(-fabsf(x))); }

struct Mix {
    const bf16* P;
    bf16 *Qm, *Km, *Vm;
    bf16 *Qs, *Ks, *Vs;
    float* HF;
    float* HO;
    float *RQ, *RK;
    float* RO;
    bf16* OC;
    const float *loglb, *log1mlb;
    const float* hg_norm_g;
    const float* sink;
    const float* log_gamma;
    const float *gn_g, *gn_b;
    float *HU, *HDK, *HQC;
    float *RU, *RQC;
};
constexpr int CH = 72, NCH = TK / CH;
static_assert(NCH * CH == TK, "chunking");

HD void mla_prep_item(const Mix& M, int item) {
    const int row = item >> 2, h = item & 3; int b, tq; row_split(row, b, tq);
    const bf16* p = M.P + (size_t)row * NP;
    float sq = 0.f, skv = 0.f;
    for (int j = 0; j < 192; ++j) { const float v = bf2f(p[C_QLAT + j]); sq += v * v; }
    for (int j = 0; j < 128; ++j) { const float v = bf2f(p[C_KVLAT + j]); skv += v * v; }
    const float rq = 1.0f / sqrtf(sq * (1.0f / 192.0f) + NORM_EPS), rkv = 1.0f / sqrtf(skv * (1.0f / 128.0f) + NORM_EPS);
    const float qs = rq * 0.10206207261596575f * LOG2E;
    const size_t o96 = ((size_t)(b * 4 + h) * TK + tq) * 96;
    for (int j = 0; j < 64; ++j) {
        M.Qm[o96 + j] = f2bf(bf2f(p[C_QE + h * 96 + j]) * qs);
        M.Km[o96 + j] = f2bf(bf2f(p[C_KVE + h * 128 + j]) * rkv);
        M.Vm[((size_t)(b * 4 + h) * 64 + j) * TK + tq] = f2bf(bf2f(p[C_KVE + h * 128 + 64 + j]) * rkv);
    }
    const bool lat = tq >= NC; const int t = tq - NC;
    for (int j = 0; j < 16; ++j) {
        float c = 1.f, s = 0.f;
        if (lat) { const float inv = powf(10000.0f, -(float)(j & 7) / 8.0f); const float ang = (float)(j < 8 ? t / GRIDW : t % GRIDW) * inv; c = cosf(ang); s = sinf(ang); }
        const float q1 = bf2f(p[C_QE + h * 96 + 64 + j]), q2 = bf2f(p[C_QE + h * 96 + 80 + j]);
        M.Qm[o96 + 64 + j] = f2bf((q1 * c - q2 * s) * qs); M.Qm[o96 + 80 + j] = f2bf((q1 * s + q2 * c) * qs);
        const float k1 = bf2f(p[C_KPE + j]), k2 = bf2f(p[C_KPE + 16 + j]);
        M.Km[o96 + 64 + j] = f2bf(k1 * c - k2 * s); M.Km[o96 + 80 + j] = f2bf(k1 * s + k2 * c);
    }
}
HD void swa_prep_item(const Mix& M, int item) {
    const int row = item >> 3, s = item & 7; int b, tq; row_split(row, b, tq);
    const bf16* p = M.P + (size_t)row * NP;
    const bool lat = tq >= NC; const int t = tq - NC;
    if (s >= 6) { const int kh = s - 6; bf16* o = M.Vs + (size_t)(b * 2 + kh) * 64 * TK + tq; for (int j = 0; j < 64; ++j) o[(size_t)j * TK] = p[C_SV + kh * 64 + j]; return; }
    const bf16* src = s < 4 ? p + C_SQ + s * 64 : p + C_SK + (s - 4) * 64;
    bf16* o = s < 4 ? M.Qs + ((size_t)(b * 4 + s) * TK + tq) * 64 : M.Ks + ((size_t)(b * 2 + (s - 4)) * TK + tq) * 64;
    const float sc = s < 4 ? 0.125f * LOG2E : 1.0f;
    for (int j = 0; j < 32; ++j) {
        float c = 1.f, sn = 0.f;
        if (lat) { const float inv = powf(10000.0f, -(float)(j & 15) / 16.0f); const float ang = (float)(j < 16 ? t / GRIDW : t % GRIDW) * inv; c = cosf(ang); sn = sinf(ang); }
        const float x1 = bf2f(src[j]), x2 = bf2f(src[32 + j]);
        o[j] = f2bf((x1 * c - x2 * sn) * sc); o[32 + j] = f2bf((x1 * sn + x2 * c) * sc);
    }
}
HD void hg_prep_item(const Mix& M, int item) {
    const int row = item >> 8, c = item & 255;
    const bf16* p = M.P + (size_t)row * NP;
    for (int d = 0; d < 2; ++d) {
        const float z = bf2f(p[(d ? C_HZB : C_HZF) + c]);
        const float a = M.loglb[d * 256 + c], bb = M.log1mlb[d * 256 + c] + log_sigmoid_f(z);
        const float mx = fmaxf(a, bb), lf = mx + log1pf(expf(-fabsf(a - bb)));
        M.HF[((size_t)d * NTOK + row) * 256 + c] = expf(lf);
    }
}
HD void ret_prep_item(const Mix& M, int item) {
    const int row = item >> 3, w = (item >> 2) & 1, h = item & 3; int b, tq; row_split(row, b, tq);
    const bf16* src = M.P + (size_t)row * NP + (w ? C_RK : C_RQ) + h * 32;
    float* o = (w ? M.RK : M.RQ) + (size_t)row * 128 + h * 32;
    const float sc = w ? 1.0f : 0.17677669529663687f;
    for (int j = 0; j < 16; ++j) {
        const float inv = powf(10000.0f, -(float)j / 16.0f); const float ang = (float)tq * inv; const float c = cosf(ang), s = sinf(ang);
        const float x1 = bf2f(src[j]), x2 = bf2f(src[16 + j]);
        o[j] = (x1 * c - x2 * s) * sc; o[16 + j] = (x1 * s + x2 * c) * sc;
    }
}
HD void mla_attn_item(const Mix& M, int item) {
    const int tq = item % TK, bh = item / TK, b = bh >> 2, h = bh & 3;
    const bf16* qp = M.Qm + (size_t)item * 96;
    float q[96], o[64];
#pragma unroll
    for (int c8 = 0; c8 < 12; ++c8) { float t8[8]; ld8(qp + 8 * c8, t8);
#pragma unroll
        for (int j = 0; j < 8; ++j) q[8 * c8 + j] = t8[j]; }
#pragma unroll
    for (int j = 0; j < 64; ++j) o[j] = 0.f;
    float m = -1e30f, l = 0.f;
    const int nk = tq < NC ? NC : TK;
    const bf16* kb = M.Km + (size_t)bh * TK * 96; const bf16* vb = M.Vm + (size_t)bh * TK * 64;
    for (int k = 0; k < nk; ++k) {
        const bf16* kp = kb + (size_t)k * 96; float s = 0.f;
#pragma unroll
        for (int c8 = 0; c8 < 12; ++c8) { float t8[8]; ld8(kp + 8 * c8, t8);
#pragma unroll
            for (int j = 0; j < 8; ++j) s += q[8 * c8 + j] * t8[j];
            if ((c8 & 3) == 3) CBAR(); }
        const float mn = fmaxf(m, s), al = exp2f(m - mn), pr = exp2f(s - mn);
        l = l * al + pr; m = mn;
        const bf16* vp = vb + k;
#pragma unroll
        for (int j = 0; j < 64; ++j) o[j] = o[j] * al + pr * bf2f(vp[(size_t)j * TK]);
    }
    const float rl = 1.0f / l; bf16* op = M.OC + (size_t)row_of(b, tq) * D + h * 64;
#pragma unroll
    for (int j = 0; j < 64; ++j) op[j] = f2bf(o[j] * rl);
}
HD void swa_attn_item(const Mix& M, int item) {
    const int tq = item % TK, bh = item / TK, b = bh >> 2, hq = bh & 3, kh = hq >> 1;
    const bf16* qp = M.Qs + (size_t)item * 64;
    float q[64], o[64];
#pragma unroll
    for (int c8 = 0; c8 < 8; ++c8) { float t8[8]; ld8(qp + 8 * c8, t8);
#pragma unroll
        for (int j = 0; j < 8; ++j) { q[8 * c8 + j] = t8[j]; o[8 * c8 + j] = 0.f; } }
    float m = M.sink[hq] * LOG2E, l = 1.0f;
    const bf16* kb = M.Ks + (size_t)(b * 2 + kh) * TK * 64; const bf16* vb = M.Vs + (size_t)(b * 2 + kh) * TK * 64;
    const int t = tq - NC;
    const int lo2 = tq < NC ? 0 : (t - 128 < 0 ? 0 : t - 128), hi2 = tq < NC ? -1 : (t + 128 > NL - 1 ? NL - 1 : t + 128);
    const int n2 = hi2 - lo2 + 1;
    for (int i = 0; i < NC + n2; ++i) {
        const int k = i < NC ? i : NC + lo2 + (i - NC);
        const bf16* kp = kb + (size_t)k * 64; float s = 0.f;
#pragma unroll
        for (int c8 = 0; c8 < 8; ++c8) { float t8[8]; ld8(kp + 8 * c8, t8);
#pragma unroll
            for (int j = 0; j < 8; ++j) s += q[8 * c8 + j] * t8[j];
            if ((c8 & 3) == 3) CBAR(); }
        const float mn = fmaxf(m, s), al = exp2f(m - mn), pr = exp2f(s - mn);
        l = l * al + pr; m = mn;
        const bf16* vp = vb + k;
#pragma unroll
        for (int j = 0; j < 64; ++j) o[j] = o[j] * al + pr * bf2f(vp[(size_t)j * TK]);
    }
    const float rl = 1.0f / l; bf16* op = M.OC + (size_t)row_of(b, tq) * D + 512 + hq * 64;
#pragma unroll
    for (int j = 0; j < 64; ++j) op[j] = f2bf(o[j] * rl);
}
HD int dir_tq(int dir, int i) { return dir == 0 ? i : (i < NC ? NC - 1 - i : NC + (NL - 1 - (i - NC))); }
HD void hg_scan_item(const Mix& M, int item) {
    const int v = item & 63, h = (item >> 6) & 3, b = (item >> 8) % NB, dir = item / (256 * NB);
    float S[64];
#pragma unroll
    for (int k = 0; k < 64; ++k) S[k] = 0.f;
    for (int i = 0; i < TK; ++i) {
        const int row = row_of(b, dir_tq(dir, i));
        const bf16* p = M.P + (size_t)row * NP; const float* f = M.HF + ((size_t)dir * NTOK + row) * 256 + h * 64;
        const float vv = bf2f(p[C_HI + h * 64 + v]); float acc = 0.f;
#pragma unroll
        for (int c8 = 0; c8 < 8; ++c8) { float q8[8], fa[4], fb[4]; ld8(p + C_HQ + h * 64 + 8 * c8, q8); ld4f(f + 8 * c8, fa); ld4f(f + 8 * c8 + 4, fb);
#pragma unroll
            for (int j = 0; j < 8; ++j) { const int k = 8 * c8 + j; const float fk = j < 4 ? fa[j] : fb[j - 4]; S[k] = fk * S[k] + (1.0f - fk) * vv; acc += q8[j] * S[k]; }
            if ((c8 & 1) == 1) CBAR(); }
        M.HO[((size_t)dir * NTOK + row) * 256 + h * 64 + v] = acc * 0.125f;
    }
}
HD void ret_scan_item(const Mix& M, int item) {
    const int v = item & 63, h = (item >> 6) & 3, b = (item >> 8) % NB, dir = item / (256 * NB);
    const float g = expf(M.log_gamma[dir * 4 + h]);
    float S[32];
#pragma unroll
    for (int k = 0; k < 32; ++k) S[k] = 0.f;
    for (int i = 0; i < TK; ++i) {
        const int row = row_of(b, dir_tq(dir, i));
        const float vv = bf2f(M.P[(size_t)row * NP + C_RV + h * 64 + v]);
        const float* qk = M.RQ + (size_t)row * 128 + h * 32; const float* kk = M.RK + (size_t)row * 128 + h * 32; float acc = 0.f;
#pragma unroll
        for (int c4 = 0; c4 < 8; ++c4) { float qa[4], ka[4]; ld4f(qk + 4 * c4, qa); ld4f(kk + 4 * c4, ka);
#pragma unroll
            for (int j = 0; j < 4; ++j) { const int k = 4 * c4 + j; S[k] = g * S[k] + ka[j] * vv; acc += qa[j] * S[k]; }
            if ((c4 & 3) == 3) CBAR(); }
        M.RO[((size_t)dir * NTOK + row) * 256 + h * 64 + v] = acc;
    }
}
HD void hg_fin_item(const Mix& M, int item) {
    const int row = item >> 2, h = item & 3;
    const float* o0 = M.HO + (size_t)row * 256 + h * 64; const float* o1 = o0 + (size_t)NTOK * 256;
    float ss = 0.f;
    for (int v = 0; v < 64; ++v) { const float x = o0[v] + o1[v]; ss += x * x; }
    const float r = 1.0f / sqrtf(ss * (1.0f / 64.0f) + NORM_EPS);
    const bf16* gp = M.P + (size_t)row * NP + C_HG + h * 64; bf16* op = M.OC + (size_t)row * D + 256 + h * 64;
    for (int v = 0; v < 64; ++v) op[v] = f2bf((o0[v] + o1[v]) * r * M.hg_norm_g[h * 64 + v] * silu_f(bf2f(gp[v])));
}
HD void ret_fin_item(const Mix& M, int item) {
    const int row = item >> 2, h = item & 3;
    const float* o0 = M.RO + (size_t)row * 256 + h * 64; const float* o1 = o0 + (size_t)NTOK * 256;
    float s = 0.f;
    for (int v = 0; v < 64; ++v) s += o0[v] + o1[v];
    const float mu = s * (1.0f / 64.0f); float q = 0.f;
    for (int v = 0; v < 64; ++v) { const float d = o0[v] + o1[v] - mu; q += d * d; }
    const float r = 1.0f / sqrtf(q * (1.0f / 64.0f) + NORM_EPS);
    const bf16* gp = M.P + (size_t)row * NP + C_RG + h * 64; bf16* op = M.OC + (size_t)row * D + 768 + h * 64;
    for (int v = 0; v < 64; ++v) op[v] = f2bf(((o0[v] + o1[v] - mu) * r * M.gn_g[h * 64 + v] + M.gn_b[h * 64 + v]) * silu_f(bf2f(gp[v])));
}

HD void hg_local_item(const Mix& M, int item) {
    const int v = item & 63, c = (item >> 6) % NCH, seq = item / (64 * NCH), h = seq & 3, b = (seq >> 2) % NB, dir = seq / (4 * NB);
    float S[64];
#pragma unroll
    for (int k = 0; k < 64; ++k) S[k] = 0.f;
    float dk = 1.0f;
    for (int i = 0; i < CH; ++i) {
        const int row = row_of(b, dir_tq(dir, c * CH + i));
        const bf16* p = M.P + (size_t)row * NP; const float* f = M.HF + ((size_t)dir * NTOK + row) * 256 + h * 64;
        const float vv = bf2f(p[C_HI + h * 64 + v]); float acc = 0.f;
        dk *= f[v]; M.HQC[((size_t)dir * NTOK + row) * 256 + h * 64 + v] = bf2f(p[C_HQ + h * 64 + v]) * dk * 0.125f;
#pragma unroll
        for (int c8 = 0; c8 < 8; ++c8) { float q8[8], fa[4], fb[4]; ld8(p + C_HQ + h * 64 + 8 * c8, q8); ld4f(f + 8 * c8, fa); ld4f(f + 8 * c8 + 4, fb);
#pragma unroll
            for (int j = 0; j < 8; ++j) { const int k = 8 * c8 + j; const float fk = j < 4 ? fa[j] : fb[j - 4]; S[k] = fk * (S[k] - vv) + vv; acc += q8[j] * S[k]; }
            if ((c8 & 1) == 1) CBAR(); }
        M.HO[((size_t)dir * NTOK + row) * 256 + h * 64 + v] = acc * 0.125f;
    }
    float* u = M.HU + ((size_t)seq * NCH + c) * 4096 + v;
#pragma unroll
    for (int k = 0; k < 64; ++k) u[k * 64] = S[k];
    M.HDK[((size_t)seq * NCH + c) * 64 + v] = dk;
}
HD void hg_carry_item(const Mix& M, int item) {
    const int kv = item & 4095, seq = item >> 12, k = kv >> 6; float s = 0.f;
#pragma unroll 8
    for (int c = 0; c < NCH; ++c) { float* u = M.HU + ((size_t)seq * NCH + c) * 4096 + kv; const float uu = *u; *u = s; s = M.HDK[((size_t)seq * NCH + c) * 64 + k] * s + uu; }
}
HD void hg_fix_item(const Mix& M, int item) {
    const int v = item & 63, c = (item >> 6) % NCH, seq = item / (64 * NCH), h = seq & 3, b = (seq >> 2) % NB, dir = seq / (4 * NB);
    if (c == 0) return;
    float S[64]; const float* u = M.HU + ((size_t)seq * NCH + c) * 4096 + v;
#pragma unroll
    for (int k = 0; k < 64; ++k) S[k] = u[k * 64];
    for (int i = 0; i < CH; ++i) {
        const int row = row_of(b, dir_tq(dir, c * CH + i));
        const float* qc = M.HQC + ((size_t)dir * NTOK + row) * 256 + h * 64; float acc = 0.f;
#pragma unroll
        for (int c4 = 0; c4 < 16; ++c4) { float qa[4]; ld4f(qc + 4 * c4, qa);
#pragma unroll
            for (int j = 0; j < 4; ++j) acc += qa[j] * S[4 * c4 + j];
            if ((c4 & 3) == 3) CBAR(); }
        M.HO[((size_t)dir * NTOK + row) * 256 + h * 64 + v] += acc;
    }
}
HD void ret_local_item(const Mix& M, int item) {
    const int v = item & 63, c = (item >> 6) % NCH, seq = item / (64 * NCH), h = seq & 3, b = (seq >> 2) % NB, dir = seq / (4 * NB);
    const float g = expf(M.log_gamma[dir * 4 + h]);
    float S[32];
#pragma unroll
    for (int k = 0; k < 32; ++k) S[k] = 0.f;
    float gp = 1.0f;
    for (int i = 0; i < CH; ++i) {
        const int row = row_of(b, dir_tq(dir, c * CH + i));
        const float vv = bf2f(M.P[(size_t)row * NP + C_RV + h * 64 + v]);
        const float* qk = M.RQ + (size_t)row * 128 + h * 32; const float* kk = M.RK + (size_t)row * 128 + h * 32; float acc = 0.f;
        gp *= g; if (v < 32) M.RQC[((size_t)dir * NTOK + row) * 128 + h * 32 + v] = qk[v] * gp;
#pragma unroll
        for (int c4 = 0; c4 < 8; ++c4) { float qa[4], ka[4]; ld4f(qk + 4 * c4, qa); ld4f(kk + 4 * c4, ka);
#pragma unroll
            for (int j = 0; j < 4; ++j) { const int k = 4 * c4 + j; S[k] = g * S[k] + ka[j] * vv; acc += qa[j] * S[k]; }
            if ((c4 & 3) == 3) CBAR(); }
        M.RO[((size_t)dir * NTOK + row) * 256 + h * 64 + v] = acc;
    }
    float* u = M.RU + ((size_t)seq * NCH + c) * 2048 + v;
#pragma unroll
    for (int k = 0; k < 32; ++k) u[k * 64] = S[k];
}
HD void ret_carry_item(const Mix& M, int item) {
    const int kv = item & 2047, seq = item >> 11, h = seq & 3, dir = seq / (4 * NB); float s = 0.f;
    const float d = expf((float)CH * M.log_gamma[dir * 4 + h]);
#pragma unroll 8
    for (int c = 0; c < NCH; ++c) { float* u = M.RU + ((size_t)seq * NCH + c) * 2048 + kv; const float uu = *u; *u = s; s = d * s + uu; }
}
HD void ret_fix_item(const Mix& M, int item) {
    const int v = item & 63, c = (item >> 6) % NCH, seq = item / (64 * NCH), h = seq & 3, b = (seq >> 2) % NB, dir = seq / (4 * NB);
    if (c == 0) return;
    float S[32]; const float* u = M.RU + ((size_t)seq * NCH + c) * 2048 + v;
#pragma unroll
    for (int k = 0; k < 32; ++k) S[k] = u[k * 64];
    for (int i = 0; i < CH; ++i) {
        const int row = row_of(b, dir_tq(dir, c * CH + i));
        const float* qc = M.RQC + ((size_t)dir * NTOK + row) * 128 + h * 32; float acc = 0.f;
#pragma unroll
        for (int c4 = 0; c4 < 8; ++c4) { float qa[4]; ld4f(qc + 4 * c4, qa);
#pragma unroll
            for (int j = 0; j < 4; ++j) acc += qa[j] * S[4 * c4 + j];
            if ((c4 & 3) == 3) CBAR(); }
        M.RO[((size_t)dir * NTOK + row) * 256 + h * 64 + v] += acc;
    }
}
namespace pg8 {
#define PG8_LAS __attribute__((address_space(3)))
typedef unsigned short bf16_t;
typedef short bf16x8 __attribute__((ext_vector_type(8)));
typedef float f32x4 __attribute__((ext_vector_type(4)));
typedef unsigned u32x4 __attribute__((ext_vector_type(4)));
constexpr int BM = 256, BK = 64, HALF = 128, HTB = HALF * BK * 2  , STAGE_BYTES = 8 * HTB, NXCD = 8, WGM = 8;

__host__ __device__ __forceinline__ int lds_byte(int r, int c) { const int st = (r >> 4) * 2 + (c >> 5), rr = r & 15, cc = c & 31, ob = rr * 64 + cc * 2; return st * 1024 + (ob ^ (((ob >> 9) & 1) << 5)); }
__host__ __device__ __forceinline__ void stage_rc(int b, int& R, int& C) { const int st = b / 1024, sb = b % 1024, swz = sb ^ (((sb >> 9) & 1) << 5); R = (st >> 1) * 16 + swz / 64; C = (st & 1) * 32 + (swz % 64) / 2; }
__host__ __device__ __forceinline__ int perm32(int rho) { const int n = rho >> 4, i = rho & 15; return 8 * (i >> 2) + 4 * n + (i & 3); }

struct Unit { int pm, pn; };
struct Gemm { const bf16_t* A; const bf16_t* Bt; int M, N, K; };

struct StaticOrder {
    int nM, nN, nwg, G, c;
    __host__ __device__ void init(int M, int N, int G_, int c_) { nM = M / BM; nN = N / BM; nwg = nM * nN; G = G_; c = c_; }
    __host__ __device__ bool next(int i, Unit& u) const {
        const long L = (long)i * G + c; if (L >= nwg) return false;
        int wgid = (int)L; { const int q = nwg / NXCD, r = nwg % NXCD, xcd = wgid % NXCD, off = wgid / NXCD; wgid = (xcd < r ? xcd * (q + 1) : r * (q + 1) + (xcd - r) * q) + off; }
        const int nig = WGM * nN, gid = wgid / nig, fm = gid * WGM, gsz = (nM - fm) < WGM ? (nM - fm) : WGM;
        u.pm = fm + ((wgid % nig) % gsz); u.pn = (wgid % nig) / gsz; return true;
    }
    __device__ __forceinline__ void a_ready(const Unit&) const {}
    __device__ __forceinline__ void done(const Unit&) const {}
};

__device__ __forceinline__ unsigned cvt_pk_bf16(float lo, float hi) { unsigned r; asm volatile("v_cvt_pk_bf16_f32 %0, %1, %2" : "=v"(r) : "v"(lo), "v"(hi)); return r; }
typedef unsigned u32x2 __attribute__((ext_vector_type(2)));
struct EpiBf16P {
    static constexpr bool PERM = true, AFTER_DRAIN = false;
    bf16_t* O; int ldc; int nN;
    __device__ __forceinline__ void operator()(const f32x4 (&acc)[2][2][4][2], const Unit& u, int wr, int wc, int fr, int fq) const {
        const int row0 = u.pm * BM + wr * 64 + fr, col0 = (u.pn % nN) * BM + wc * 32 + 8 * fq;
#pragma unroll
        for (int ai = 0; ai < 2; ++ai)
#pragma unroll
            for (int m = 0; m < 4; ++m) { bf16_t* rowp = O + (size_t)(row0 + ai * HALF + m * 16) * ldc + col0;
#pragma unroll
                for (int bj = 0; bj < 2; ++bj) { const f32x4 v0 = acc[ai][bj][m][0], v1 = acc[ai][bj][m][1];
                    u32x4 w; w.x = cvt_pk_bf16(v0[0], v0[1]); w.y = cvt_pk_bf16(v0[2], v0[3]); w.z = cvt_pk_bf16(v1[0], v1[1]); w.w = cvt_pk_bf16(v1[2], v1[3]);
                    *(u32x4*)(rowp + bj * HALF) = w; } }
    }
};
struct EpiRes {
    static constexpr bool PERM = false, AFTER_DRAIN = false;
    float* H; const float* gate; int lat_tiles, tiles_per_batch, ctx_bidx;
    __device__ __forceinline__ void operator()(const f32x4 (&acc)[2][2][4][2], const Unit& u, int wr, int wc, int fr, int fq) const {
        const int bidx = u.pm < lat_tiles ? u.pm / tiles_per_batch : ctx_bidx;
        const float* g = gate + (size_t)bidx * 6144;
        const int row0 = u.pm * BM + wr * 64 + fr, col0 = u.pn * BM + wc * 32 + 4 * fq;
        f32x4 gv[2][2];
#pragma unroll
        for (int bj = 0; bj < 2; ++bj)
#pragma unroll
            for (int n = 0; n < 2; ++n) gv[bj][n] = *(const f32x4*)(g + col0 + bj * HALF + n * 16);
#pragma unroll
        for (int ai = 0; ai < 2; ++ai)
#pragma unroll
            for (int m = 0; m < 4; ++m) { float* rowp = H + (size_t)(row0 + ai * HALF + m * 16) * 1024 + col0;
#pragma unroll
                for (int bj = 0; bj < 2; ++bj)
#pragma unroll
                    for (int n = 0; n < 2; ++n) { f32x4* p = (f32x4*)(rowp + bj * HALF + n * 16); *p = *p + gv[bj][n] * acc[ai][bj][m][n]; } }
    }
};
struct EpiSwiglu {
    static constexpr bool PERM = true, AFTER_DRAIN = false;
    bf16_t* O; int ldo; int nN;
    __device__ __forceinline__ void operator()(const f32x4 (&acc)[2][2][4][2], const Unit& u, int wr, int wc, int fr, int fq) const {
        const int row0 = u.pm * BM + wr * 64 + fr, col0 = (u.pn % nN) * 128 + wc * 16 + 4 * fq;
#pragma unroll
        for (int ai = 0; ai < 2; ++ai)
#pragma unroll
            for (int m = 0; m < 4; ++m) { bf16_t* rowp = O + (size_t)(row0 + ai * HALF + m * 16) * ldo + col0;
#pragma unroll
                for (int bj = 0; bj < 2; ++bj) { const f32x4 gt = acc[ai][bj][m][0], up = acc[ai][bj][m][1]; float r[4];
#pragma unroll
                    for (int i = 0; i < 4; ++i) r[i] = gt[i] * __builtin_amdgcn_rcpf(1.0f + __builtin_amdgcn_exp2f(-1.4426950408889634f * gt[i])) * up[i];
                    u32x2 w; w.x = cvt_pk_bf16(r[0], r[1]); w.y = cvt_pk_bf16(r[2], r[3]);
                    *(u32x2*)(rowp + bj * 64) = w; } }
    }
};
struct MoeOrder {
    const unsigned* list; int nwg, G, c;
    __device__ __forceinline__ bool next(int i, Unit& u) const {
        const long L = (long)i * G + c; if (L >= nwg) return false;
        unsigned w; const unsigned* ptr = list + L;
        asm volatile("s_load_dword %0, %1, 0x0\n\ts_waitcnt lgkmcnt(0)" : "=s"(w) : "s"(ptr) : "memory");
        u.pm = (int)(w & 0xffffu); u.pn = (int)(w >> 16); return true;
    }
    __device__ __forceinline__ void a_ready(const Unit&) const {}
    __device__ __forceinline__ void done(const Unit&) const {}
};
template <class Epi, class Sched, bool ALIGN_EPI = false, bool SP2 = false>
__device__ __forceinline__ void gemm_phase(PG8_LAS unsigned char* lds, const Gemm g, const Sched& S, const Epi& E, const int tid_in) {
    const int tid = tid_in, wid = __builtin_amdgcn_readfirstlane(tid >> 6), lane = tid & 63, wr = wid >> 2, wc = wid & 3, fr = lane & 15, fq = lane >> 4;
    const int K = g.K, nt = K / BK;
    unsigned voffA[2], voffB[2];
#pragma unroll
    for (int i = 0; i < 2; ++i) { int R, C; stage_rc(tid * 16 + i * 8192, R, C); const int Rb = Epi::PERM ? ((R & ~31) + perm32(R & 31)) : R;
        voffA[i] = (unsigned)(R * K + C) * 2u; voffB[i] = (unsigned)(Rb * K + C) * 2u; }
    const size_t kstep = (size_t)(BK * 2);
    const size_t hstep = (size_t)HALF * K * 2;
    const size_t tstep = 2 * hstep;
    const unsigned ldsw = (unsigned)wid * 1024u;
    const int aoff = lds_byte(wr * 64 + fr, fq * 8), boff = lds_byte(wc * 32 + fr, fq * 8);
#define PG8_SA(b, h) (((b) * 2 + (h)) * HTB)
#define PG8_SB(b, h) ((4 + (b) * 2 + (h)) * HTB)
#define PG8_STAGE(bufoff, gbase, voff) do { _Pragma("unroll") for (int _i = 0; _i < 2; ++_i) \
        __builtin_amdgcn_global_load_lds((const unsigned*)((const char*)(gbase) + (voff)[_i]), (PG8_LAS unsigned*)(lds + (bufoff) + ldsw + _i * 8192), 16, 0, 0); } while (0)
#define PG8_LDA(dst, b, h) do { _Pragma("unroll") for (int m = 0; m < 4; ++m) _Pragma("unroll") for (int k = 0; k < 2; ++k) dst[m][k] = *(const PG8_LAS bf16x8*)(lds + PG8_SA(b, h) + aoff + m * 2048 + k * 1024); } while (0)
#define PG8_LDB(dst, b, h) do { _Pragma("unroll") for (int n = 0; n < 2; ++n) _Pragma("unroll") for (int k = 0; k < 2; ++k) dst[n][k] = *(const PG8_LAS bf16x8*)(lds + PG8_SB(b, h) + boff + n * 2048 + k * 1024); } while (0)
#define PG8_MMA(ai, bj, At, Bt) do { __builtin_amdgcn_s_setprio(1); _Pragma("unroll") for (int m = 0; m < 4; ++m) _Pragma("unroll") for (int n = 0; n < 2; ++n) _Pragma("unroll") for (int k = 0; k < 2; ++k) \
        acc[ai][bj][m][n] = __builtin_amdgcn_mfma_f32_16x16x32_bf16(Bt[n][k], At[m][k], acc[ai][bj][m][n], 0, 0, 0); __builtin_amdgcn_s_setprio(0); } while (0)
#define PG8_WAIT_V(n) asm volatile("s_waitcnt vmcnt(" #n ")" ::: "memory")
#define PG8_WAIT_L(n) asm volatile("s_waitcnt lgkmcnt(" #n ")" ::: "memory")
#define PG8_BAR __builtin_amdgcn_s_barrier()
#define PG8_SCHED __builtin_amdgcn_sched_barrier(0)
    Unit cur, nxt; int ui = 0;
    if (!S.next(0, cur)) return;
    f32x4 acc[2][2][4][2];
#pragma unroll
    for (int a = 0; a < 2; ++a)
#pragma unroll
        for (int b = 0; b < 2; ++b)
#pragma unroll
            for (int m = 0; m < 4; ++m)
#pragma unroll
                for (int n = 0; n < 2; ++n) acc[a][b][m][n] = (f32x4){0.f, 0.f, 0.f, 0.f};
    bf16x8 At[4][2], B0[2][2], B1[2][2];
    const char* cA = (const char*)g.A + (size_t)cur.pm * tstep; const char* cB = (const char*)g.Bt + (size_t)cur.pn * tstep;
    S.a_ready(cur);
    if constexpr (SP2) {
        PG8_STAGE(PG8_SB(0, 0), cB, voffB); PG8_STAGE(PG8_SB(0, 1), cB + hstep, voffB); PG8_STAGE(PG8_SA(0, 0), cA, voffA); PG8_STAGE(PG8_SA(0, 1), cA + hstep, voffA);
        if (wr == 1) PG8_BAR;
        PG8_WAIT_V(2); PG8_BAR;
        PG8_STAGE(PG8_SB(1, 0), cB + kstep, voffB); PG8_STAGE(PG8_SA(1, 0), cA + kstep, voffA); PG8_STAGE(PG8_SB(1, 1), cB + hstep + kstep, voffB);
        PG8_WAIT_V(6); PG8_BAR;
    } else {
        PG8_STAGE(PG8_SB(0, 0), cB, voffB); PG8_STAGE(PG8_SA(0, 0), cA, voffA); PG8_STAGE(PG8_SB(0, 1), cB + hstep, voffB); PG8_STAGE(PG8_SA(0, 1), cA + hstep, voffA);
        if (wr == 1) PG8_BAR;
        PG8_WAIT_V(4); PG8_BAR;
        PG8_STAGE(PG8_SB(1, 0), cB + kstep, voffB); PG8_STAGE(PG8_SA(1, 0), cA + kstep, voffA); PG8_STAGE(PG8_SB(1, 1), cB + hstep + kstep, voffB);
        PG8_WAIT_V(6); PG8_BAR;
    }
    for (;;) {
        const bool has_next = S.next(ui + 1, nxt);
        const char* nA = has_next ? (const char*)g.A + (size_t)nxt.pm * tstep : cA; const char* nB = has_next ? (const char*)g.Bt + (size_t)nxt.pn * tstep : cB;
        for (int t = 0; t < nt; t += 2) {
            const bool last = (t == nt - 2);
            const char* a1 = cA + (size_t)(t + 1) * kstep;
            const char* a2 = last ? nA : cA + (size_t)(t + 2) * kstep; const char* b2 = last ? nB : cB + (size_t)(t + 2) * kstep;
            const char* a3 = a2 + kstep; const char* b3 = b2 + kstep;
            if (last && has_next) S.a_ready(nxt);
            if constexpr (SP2) {
            PG8_LDB(B0, 0, 0); PG8_LDB(B1, 0, 1); PG8_SCHED; PG8_LDA(At, 0, 0); PG8_STAGE(PG8_SA(1, 1), a1 + hstep, voffA);
            PG8_WAIT_V(8); PG8_WAIT_L(0); PG8_BAR; PG8_MMA(0, 0, At, B0); PG8_MMA(0, 1, At, B1); PG8_BAR; PG8_SCHED;
            PG8_LDA(At, 0, 1); PG8_STAGE(PG8_SB(0, 0), b2, voffB); PG8_STAGE(PG8_SB(0, 1), b2 + hstep, voffB); PG8_STAGE(PG8_SA(0, 0), a2, voffA);
            PG8_WAIT_V(8); PG8_WAIT_L(0); PG8_BAR; PG8_MMA(1, 0, At, B0); PG8_MMA(1, 1, At, B1); PG8_BAR; PG8_SCHED;
            PG8_LDB(B0, 1, 0); PG8_LDB(B1, 1, 1); PG8_SCHED; PG8_LDA(At, 1, 0); PG8_STAGE(PG8_SA(0, 1), a2 + hstep, voffA);
            PG8_WAIT_V(8); PG8_WAIT_L(0); PG8_BAR; PG8_MMA(0, 0, At, B0); PG8_MMA(0, 1, At, B1); PG8_BAR; PG8_SCHED;
            PG8_LDA(At, 1, 1); PG8_STAGE(PG8_SB(1, 0), b3, voffB); PG8_STAGE(PG8_SB(1, 1), b3 + hstep, voffB); PG8_STAGE(PG8_SA(1, 0), a3, voffA);
            PG8_WAIT_V(8); PG8_WAIT_L(0); PG8_BAR; PG8_MMA(1, 0, At, B0); PG8_MMA(1, 1, At, B1); PG8_BAR; PG8_SCHED;
            } else {
            PG8_LDB(B0, 0, 0); PG8_SCHED; PG8_LDA(At, 0, 0); PG8_STAGE(PG8_SA(1, 1), a1 + hstep, voffA);
            PG8_WAIT_L(8); PG8_BAR; PG8_WAIT_L(0); PG8_MMA(0, 0, At, B0); PG8_BAR; PG8_SCHED;
            PG8_LDB(B1, 0, 1); PG8_STAGE(PG8_SB(0, 0), b2, voffB);
            PG8_BAR; PG8_WAIT_L(0); PG8_MMA(0, 1, At, B1); PG8_BAR;
            PG8_LDA(At, 0, 1); PG8_STAGE(PG8_SA(0, 0), a2, voffA);
            PG8_BAR; PG8_WAIT_L(0); PG8_MMA(1, 0, At, B0); PG8_BAR; PG8_SCHED;
            PG8_STAGE(PG8_SB(0, 1), b2 + hstep, voffB);
            PG8_WAIT_V(6); PG8_BAR; PG8_MMA(1, 1, At, B1); PG8_BAR;
            PG8_LDB(B0, 1, 0); PG8_SCHED; PG8_LDA(At, 1, 0); PG8_STAGE(PG8_SA(0, 1), a2 + hstep, voffA);
            PG8_WAIT_L(8); PG8_BAR; PG8_WAIT_L(0); PG8_MMA(0, 0, At, B0); PG8_BAR; PG8_SCHED;
            PG8_LDB(B1, 1, 1); PG8_STAGE(PG8_SB(1, 0), b3, voffB);
            PG8_BAR; PG8_WAIT_L(0); PG8_MMA(0, 1, At, B1); PG8_BAR;
            PG8_LDA(At, 1, 1); PG8_STAGE(PG8_SA(1, 0), a3, voffA);
            PG8_BAR; PG8_WAIT_L(0); PG8_MMA(1, 0, At, B0); PG8_BAR; PG8_SCHED;
            PG8_STAGE(PG8_SB(1, 1), b3 + hstep, voffB);
            PG8_WAIT_V(6); PG8_BAR; PG8_MMA(1, 1, At, B1); PG8_BAR;
            }
        }
        if constexpr (ALIGN_EPI) { if (wr == 0) PG8_BAR; }
        if constexpr (!Epi::AFTER_DRAIN) { unsigned z_ = 0u; asm volatile("" : "+v"(z_)); const int l2_ = (int)__builtin_amdgcn_mbcnt_hi(~0u, __builtin_amdgcn_mbcnt_lo(~0u, z_)); E(acc, cur, wr, wc, l2_ & 15, l2_ >> 4); S.done(cur); }
        if (!has_next) break;
#pragma unroll
        for (int a = 0; a < 2; ++a)
#pragma unroll
            for (int b = 0; b < 2; ++b)
#pragma unroll
                for (int m = 0; m < 4; ++m)
#pragma unroll
                    for (int n = 0; n < 2; ++n) acc[a][b][m][n] = (f32x4){0.f, 0.f, 0.f, 0.f};
        cur = nxt; cA = nA; cB = nB; ++ui;
        if constexpr (ALIGN_EPI) { if (wr == 1) PG8_BAR; }
    }
    PG8_WAIT_V(0);
    if constexpr (!ALIGN_EPI) { if (wr == 0) PG8_BAR; }
    PG8_BAR;
    if constexpr (Epi::AFTER_DRAIN) { E.fused(acc, cur, wr, wc, fr, fq, lds, wid, lane); S.done(cur); }
#undef PG8_SA
#undef PG8_SB
#undef PG8_STAGE
#undef PG8_LDA
#undef PG8_LDB
#undef PG8_MMA
#undef PG8_WAIT_V
#undef PG8_WAIT_L
#undef PG8_BAR
#undef PG8_SCHED
}
}
#ifndef LAS
#define LAS __attribute__((address_space(3)))
#endif
#define XB_TMO      128
#define XB_XCNT(j)  (256  + 64 * (j))
#define XB_XSUB(j)  (1280 + 64 * (j))
#define XB_XGEN(j)  (2304 + 64 * (j))
#define XB_TOP      3328
#define XB_TOPGEN   3392
#define XCD_BAR_WORDS 3456
#define XB_SPIN_CAP (1u << 24)

__device__ __forceinline__ unsigned xb_ld(unsigned* p)              { return __hip_atomic_load(p, __ATOMIC_RELAXED, __HIP_MEMORY_SCOPE_AGENT); }
__device__ __forceinline__ unsigned xb_add(unsigned* p, unsigned v) { return __hip_atomic_fetch_add(p, v, __ATOMIC_RELAXED, __HIP_MEMORY_SCOPE_AGENT); }
__device__ __forceinline__ unsigned xb_xcc_id() { return (unsigned)__builtin_amdgcn_s_getreg((3 << 11) | 20) & 0xFu; }
#define XB_SPIN(cond, bar) do { unsigned _sp = 0; while (cond) { __builtin_amdgcn_s_sleep(1); \
    if ((++_sp & 255u) == 0u) { if (xb_ld(&(bar)[XB_TMO])) break; if (_sp > XB_SPIN_CAP) { atomicAdd(&(bar)[XB_TMO], 1u); break; } } } } while (0)

struct XcdBarrier {
    int w;
    unsigned* bar; unsigned x;
    volatile LAS unsigned* st;
};

__device__ __forceinline__ bool xb_thread0(int w) { unsigned z = 0u; asm volatile("" : "+v"(z), "+s"(w)); return w == 0 && __builtin_amdgcn_mbcnt_hi(~0u, __builtin_amdgcn_mbcnt_lo(~0u, z)) == 0u; }
__device__ __forceinline__ XcdBarrier xcd_barrier_post(unsigned* bar, volatile LAS unsigned* st, int w) {
    XcdBarrier b; b.w = w; b.bar = bar; b.x = xb_xcc_id(); b.st = st;
    if (xb_thread0(w)) (void)xb_add(&bar[XB_XCNT(b.x)], 1u);
    return b;
}
__device__ __forceinline__ void xcd_barrier_complete(unsigned* bar, unsigned x, unsigned& nloc, unsigned& nx) {
    const unsigned G = gridDim.x * gridDim.y * gridDim.z;
    unsigned sum, cnt, mine, sp = 0u;
    for (;;) {
        sum = 0u; cnt = 0u; mine = 0u;
#pragma unroll
        for (unsigned j = 0; j < 16; ++j) { const unsigned c = xb_ld(&bar[XB_XCNT(j)]); sum += c; cnt += (c > 0u) ? 1u : 0u; mine = (j == x) ? c : mine; }
        if (sum == G) break;
        __builtin_amdgcn_s_sleep(1);
        if ((++sp & 255u) == 0u) { if (xb_ld(&bar[XB_TMO])) break; if (sp > XB_SPIN_CAP) { atomicAdd(&bar[XB_TMO], 1u); break; } }
    }
    nloc = mine > 0u ? mine : 1u; nx = cnt > 0u ? cnt : 1u;
}

__device__ __forceinline__ void xcd_barrier(const XcdBarrier& b) {
    asm volatile("s_waitcnt vmcnt(0)" ::: "memory");
    __syncthreads();
    if (xb_thread0(b.w)) {
        unsigned* bar = b.bar;
        __builtin_amdgcn_s_waitcnt(0);
        unsigned nloc = b.st[0], nx = b.st[1];
        if (nloc == 0u) { xcd_barrier_complete(bar, b.x, nloc, nx); b.st[0] = nloc; b.st[1] = nx; }
        const unsigned old = xb_add(&bar[XB_XSUB(b.x)], 1u);
        const unsigned gen = old / nloc;
        if (old + 1u == (gen + 1u) * nloc) {
            __builtin_amdgcn_fence(__ATOMIC_RELEASE, "agent");
            asm volatile("s_waitcnt vmcnt(0)" ::: "memory");
            const unsigned og = xb_add(&bar[XB_TOP], 1u);
            const unsigned tg = og / nx;
            if (og + 1u == (tg + 1u) * nx) xb_add(&bar[XB_TOPGEN], 1u);
            else XB_SPIN(xb_ld(&bar[XB_TOPGEN]) == tg, bar);
            __builtin_amdgcn_fence(__ATOMIC_ACQUIRE, "agent");
            xb_add(&bar[XB_XGEN(b.x)], 1u);
            asm volatile("s_waitcnt vmcnt(0)" ::: "memory");
        } else {
            XB_SPIN(xb_ld(&bar[XB_XGEN(b.x)]) == gen, bar);
            __builtin_amdgcn_fence(__ATOMIC_ACQUIRE, "agent");
            asm volatile("s_waitcnt vmcnt(0)" ::: "memory");
        }
    }
    __syncthreads();
}
constexpr int NWAVES = 8, NTHREADS = NWAVES * 64;
constexpr size_t MiB = 1u << 20;
constexpr size_t WS_CTL = 0, CTL_ZERO_BYTES = 1 * MiB;
constexpr size_t WS_SMALL = 1 * MiB, WS_TOKINFO = 2 * MiB, WS_LIST = 3 * MiB;
constexpr size_t WS_WIN = 4 * MiB, WS_WOUT = 34 * MiB, WS_WFGU = 42 * MiB, WS_WFD = 64 * MiB, WS_WMGU = 75 * MiB, WS_WMD = 187 * MiB;
constexpr size_t WS_H = 243 * MiB, WS_A = 315 * MiB, WS_OC = 351 * MiB, WS_Y = 387 * MiB, WS_AM = 463 * MiB, WS_BIG = 539 * MiB;
constexpr size_t WS_P = WS_BIG, WS_QM = 674 * MiB, WS_KM = WS_QM + 14155776, WS_VM = WS_KM + 14155776, WS_QS = 710 * MiB, WS_KS = WS_QS + 9437184, WS_VS = WS_KS + 4718592;
constexpr size_t WS_HF = 728 * MiB, WS_HO = 764 * MiB, WS_RQ = 800 * MiB, WS_RK = 809 * MiB, WS_RO = 818 * MiB, WS_HQC = 854 * MiB, WS_HU = 890 * MiB, WS_HDK = 922 * MiB, WS_RQC = 923 * MiB, WS_RU = 941 * MiB, WS_END = 957 * MiB;
constexpr size_t WS_ACT = WS_BIG;
constexpr int MAXTILES = 152;
static_assert(WS_P + (size_t)NTOK * NP * 2 <= WS_QM && WS_VM + (size_t)NB * 4 * TK * 64 * 2 <= WS_QS && WS_VS + 4718592 <= WS_HF, "ws map 1");
static_assert(WS_HQC + (size_t)2 * NTOK * 256 * 4 <= WS_HU && WS_HU + (size_t)2 * NB * 4 * NCH * 4096 * 4 <= WS_HDK && WS_RQC + (size_t)2 * NTOK * 128 * 4 <= WS_RU && WS_RU + (size_t)2 * NB * 4 * NCH * 2048 * 4 <= WS_END, "ws map 3");
static_assert(WS_ACT + (size_t)MAXTILES * 256 * DFE * 2 <= WS_END && (size_t)MAXTILES * 256 * D * 2 <= 76 * MiB, "ws map 2");
constexpr int SM_MOD = 0;
constexpr int SM_LOGLB = 4 * 9 * 6144, SM_LOG1M = SM_LOGLB + 4 * 512, SM_LGAM = SM_LOG1M + 4 * 512, SM_META = SM_LGAM + 64, SM_ULIST = SM_META + 32;
constexpr int ULIST_GU = 0, ULIST_D = MAXTILES * 28;
static_assert((SM_ULIST + 2 * MAXTILES * 32) * 4 <= (int)MiB, "small region");
constexpr int CW_BAR = 4096, CW_CNT = 8192;
constexpr int LDS_BYTES = 147456, MISC_OFF = 131072 + 320;

#define GAS __attribute__((address_space(1)))
#define LAS __attribute__((address_space(3)))
typedef float f32x4 __attribute__((ext_vector_type(4)));
typedef unsigned v4u __attribute__((ext_vector_type(4)));
typedef unsigned v2u __attribute__((ext_vector_type(2)));
#define LDS_WAIT() asm volatile("s_waitcnt lgkmcnt(0)" ::: "memory")

struct Args { const float* in[28]; float* out; unsigned char* ws; int ph_lo, ph_hi; };
typedef __attribute__((address_space(4))) const unsigned long long ka_u64;
__device__ __forceinline__ const float* IN(int i) { ka_u64* ka = (ka_u64*)__builtin_amdgcn_kernarg_segment_ptr(); asm volatile("" : "+s"(ka)); return (const float*)ka[i]; }
__device__ __forceinline__ float* OUTP() { ka_u64* ka = (ka_u64*)__builtin_amdgcn_kernarg_segment_ptr(); asm volatile("" : "+s"(ka)); return (float*)ka[28]; }
__device__ __forceinline__ unsigned char* WSBASE() { ka_u64* ka = (ka_u64*)__builtin_amdgcn_kernarg_segment_ptr(); asm volatile("" : "+s"(ka)); return (unsigned char*)ka[29]; }
struct Frame {
    LAS unsigned char* lds;
    int tid, lane, wave, gtid, NT, gw, NGW;
    __device__ __forceinline__ unsigned char* base() const { return WSBASE(); }
};
#define WSP(T, off) ((T*)(ws + (off)))
#define F_ctl WSP(unsigned, WS_CTL)
#define F_sm WSP(float, WS_SMALL)
#define F_tokinfo WSP(int, WS_TOKINFO)
#define F_list WSP(int, WS_LIST)
#define F_H WSP(float, WS_H)
#define F_A WSP(bf16, WS_A)
#define F_OC WSP(bf16, WS_OC)
#define F_Y WSP(bf16, WS_Y)
#define F_AM WSP(bf16, WS_AM)
#define F_P WSP(bf16, WS_P)
#define F_ACT WSP(bf16, WS_ACT)
#define F_WIN WSP(bf16, WS_WIN)
#define F_WOUT WSP(bf16, WS_WOUT)
#define F_WFGU WSP(bf16, WS_WFGU)
#define F_WFD WSP(bf16, WS_WFD)
#define F_WMGU WSP(bf16, WS_WMGU)
#define F_WMD WSP(bf16, WS_WMD)
__device__ __forceinline__ float wave_sum(float v, int lane) {
#pragma unroll
    for (int o = 1; o < 64; o <<= 1) v += __int_as_float(__builtin_amdgcn_ds_bpermute((lane ^ o) << 2, __float_as_int(v)));
    return v;
}
__device__ __forceinline__ unsigned pk2(float lo, float hi) { return (unsigned)f2bf(lo) | ((unsigned)f2bf(hi) << 16); }

template <class SrcFn> __device__ __forceinline__ void transpose_item(const SrcFn& src, int K, int nblk, bf16* WT, LAS float* scr, int item, int lane) {
    const int kb = item / nblk, nb = item % nblk, k0 = 64 * kb, n0 = 32 * nb;
#pragma unroll 8
    for (int i = 0; i < 32; ++i) { const int kk = 2 * i + (lane >> 5); scr[kk * 33 + (lane & 31)] = src(k0 + kk, n0 + (lane & 31)); }
    LDS_WAIT(); asm volatile("" ::: "memory");
    const int c = lane & 7;
#pragma unroll
    for (int j = 0; j < 4; ++j) { const int n = (lane >> 3) + 8 * j; const LAS float* s = scr + (8 * c) * 33 + n;
        v4u o; o.x = pk2(s[0 * 33], s[1 * 33]); o.y = pk2(s[2 * 33], s[3 * 33]); o.z = pk2(s[4 * 33], s[5 * 33]); o.w = pk2(s[6 * 33], s[7 * 33]);
        *(v4u*)(WT + (size_t)(n0 + n) * K + k0 + 8 * c) = o; }
    LDS_WAIT(); asm volatile("" ::: "memory");
}
struct SrcPlain { const float* W; int N; __device__ __forceinline__ float operator()(int k, int n) const { return W[(size_t)k * N + n]; } };
struct SrcGU { const float* Wg; long du; int NF; __device__ __forceinline__ float operator()(int k, int c) const { const int j = c >> 3, w = c & 7; return Wg[(w < 4 ? 0l : du) + (long)k * NF + 4 * j + (w & 3)]; } };

__device__ __forceinline__ void convert_moe(Frame& F, int li) {
    unsigned char* ws = F.base();
    LAS float* scr = (LAS float*)(F.lds + 40960 + F.wave * 8704);
    constexpr int I_GU = 16 * 224, I_D = 56 * 32;
    for (int it = F.gw; it < 8 * (I_GU + I_D); it += F.NGW) {
        const int e = it / (I_GU + I_D); int r = it % (I_GU + I_D);
        if (r < I_GU) { SrcGU s{IN(24) + ((size_t)li * 8 + e) * D * DFE, (long)(IN(25) - IN(24)), DFE}; transpose_item(s, D, 224, F_WMGU + (size_t)e * 2 * DFE * D, scr, r, F.lane); }
        else { r -= I_GU; SrcPlain s{IN(26) + ((size_t)li * 8 + e) * DFE * D, D}; transpose_item(s, DFE, 32, F_WMD + (size_t)e * D * DFE, scr, r, F.lane); }
    }
}
__device__ __forceinline__ void prologue(Frame& F) {
    unsigned char* ws = F.base();
    LAS float* sil = (LAS float*)F.lds;
    for (int i = F.tid; i < 9 * 1024; i += NTHREADS) { const float cv = i < 8 * 1024 ? IN(1)[i] : IN(3)[i - 8 * 1024]; sil[i] = silu_f(cv); }
    __syncthreads();
    for (int it = F.gtid; it < DEPTH * 6144; it += F.NT) {
        const int l = it / 6144, j = it % 6144; const float* w = IN(4) + (size_t)l * D * 6144 + j;
        float acc[9];
#pragma unroll
        for (int b = 0; b < 9; ++b) acc[b] = IN(5)[l * 6144 + j];
        for (int k = 0; k < D; ++k) { const float wv = w[(size_t)k * 6144];
#pragma unroll
            for (int b = 0; b < 9; ++b) acc[b] += sil[b * 1024 + k] * wv; }
#pragma unroll
        for (int b = 0; b < 9; ++b) F_sm[SM_MOD + ((size_t)l * 9 + b) * 6144 + j] = acc[b];
    }
    for (int it = F.gtid; it < 512; it += F.NT) {
        float lg[DEPTH], mx = -1e30f, s = 0.f;
#pragma unroll
        for (int l = 0; l < DEPTH; ++l) { lg[l] = IN(14)[l * 512 + it]; mx = fmaxf(mx, lg[l]); }
#pragma unroll
        for (int l = 0; l < DEPTH; ++l) { lg[l] = expf(lg[l] - mx); s += lg[l]; }
        float cum = 0.f; const float p0 = lg[0] / s;
#pragma unroll
        for (int l = 0; l < DEPTH; ++l) { cum += lg[l] / s; const float lb = cum - p0; F_sm[SM_LOGLB + l * 512 + it] = logf(fmaxf(lb, 1e-30f)); F_sm[SM_LOG1M + l * 512 + it] = log1pf(-lb); }
    }
    for (int it = F.gtid; it < DEPTH * 8; it += F.NT) F_sm[SM_LGAM + it] = log_sigmoid_f(IN(17)[it]);
    LAS float* scr = (LAS float*)(F.lds + 40960 + F.wave * 8704);
    constexpr int I_IN = 16 * 91, I_OUT = 16 * 32, I_FGU = 16 * 176, I_FD = 44 * 32;
    constexpr int N_IN = DEPTH * I_IN, N_OUT = DEPTH * I_OUT, N_FGU = 2 * I_FGU, N_FD = 2 * I_FD;
    for (int it = F.gw; it < N_IN + N_OUT + N_FGU + N_FD; it += F.NGW) {
        int r = it;
        if (r < N_IN) { const int l = r / I_IN; SrcPlain s{IN(8) + (size_t)l * D * DIN, DIN}; transpose_item(s, D, 91, F_WIN + (size_t)l * NP * D, scr, r % I_IN, F.lane); continue; } r -= N_IN;
        if (r < N_OUT) { const int l = r / I_OUT; SrcPlain s{IN(9) + (size_t)l * D * D, D}; transpose_item(s, D, 32, F_WOUT + (size_t)l * D * D, scr, r % I_OUT, F.lane); continue; } r -= N_OUT;
        if (r < N_FGU) { const int l = r / I_FGU; SrcGU s{IN(20) + (size_t)l * D * DFF, (long)(IN(21) - IN(20)), DFF}; transpose_item(s, D, 176, F_WFGU + (size_t)l * 2 * DFF * D, scr, r % I_FGU, F.lane); continue; } r -= N_FGU;
        { const int l = r / I_FD; SrcPlain s{IN(22) + (size_t)l * DFF * D, D}; transpose_item(s, DFF, 32, F_WFD + (size_t)l * D * DFF, scr, r % I_FD, F.lane); }
    }
    convert_moe(F, 0);
    for (int it = F.gtid; it < DEPTH * D * 928; it += F.NT) {
        const int n = it % 928, k = (it / 928) % D, l = it / (928 * D);
        const float* wi = IN(8) + ((size_t)l * D + k) * DIN; float acc = 0.f;
        if (n < 384) { const float* g = IN(10) + l * 192; const float* wu = IN(11) + (size_t)l * 192 * 384 + n; for (int j = 0; j < 192; ++j) acc += wi[j] * g[j] * wu[(size_t)j * 384]; }
        else if (n < 896) { const float* g = IN(12) + l * 128; const float* wu = IN(13) + (size_t)l * 128 * 512 + (n - 384); for (int j = 0; j < 128; ++j) acc += wi[192 + j] * g[j] * wu[(size_t)j * 512]; }
        F_WIN[((size_t)l * NP + DIN + n) * D + k] = f2bf(acc);
    }
}

typedef short bf16x8s __attribute__((ext_vector_type(8)));
typedef float f32x16 __attribute__((ext_vector_type(16)));
__device__ __forceinline__ int crow(int r, int hi) { return (r & 3) + 8 * (r >> 2) + 4 * hi; }
__device__ __forceinline__ float xlane32(float v, int lane) { return __int_as_float(__builtin_amdgcn_ds_bpermute((lane ^ 32) << 2, __float_as_int(v))); }
__device__ __forceinline__ unsigned cvtpk(float lo, float hi) { unsigned r; asm volatile("v_cvt_pk_bf16_f32 %0, %1, %2" : "=v"(r) : "v"(lo), "v"(hi)); return r; }

template <int DK, bool SWA>
__device__ __forceinline__ void attn_unit(LAS unsigned char* lds, const bf16* Qg, const bf16* Kg, const bf16* Vtg, bf16* OCp, int b, int hcol, int tq0,
                                          int t0a, int t1a, int t0b, int t1b, float sink2, int tid) {
    constexpr int KS = DK * 2 + 16, VS = 136, KT_BYTES = 64 * KS, STAGE = KT_BYTES + 64 * VS, KP = DK / 8, NKP = 64 * KP, NS = DK / 16;
    const int lane = tid & 63, wave = __builtin_amdgcn_readfirstlane(tid >> 6), q = lane & 31, hi = lane >> 5;
    LAS float* wsf = (LAS float*)(lds + 2 * STAGE) + wave * 64;
    const int tq = tq0 + wave * 32 + q;
    bf16x8s qf[NS];
#pragma unroll
    for (int s = 0; s < NS; ++s) qf[s] = *(const bf16x8s*)(Qg + (size_t)tq * DK + 16 * s + 8 * hi);
    f32x16 o0, o1;
#pragma unroll
    for (int r = 0; r < 16; ++r) { o0[r] = 0.f; o1[r] = 0.f; }
    float m = SWA ? sink2 : -1e30f, l = (SWA && hi == 0) ? 1.0f : 0.f;
    const int na = t1a - t0a, nt = na + (t1b - t0b);
    const int w0 = tq0 - NC + wave * 32;
    v4u kr0, kr1 = (v4u){0u, 0u, 0u, 0u}, vr;
    { const int t = na > 0 ? t0a : t0b; const v4u* kg = (const v4u*)(Kg + (size_t)t * 64 * DK); kr0 = kg[tid]; if (NKP > 512) { if (tid < NKP - 512) kr1 = kg[512 + tid]; }
      vr = *(const v4u*)(Vtg + (size_t)(tid >> 3) * TK + t * 64 + (tid & 7) * 8); }
    { LAS unsigned char* kb = lds; *(LAS v4u*)(kb + (tid / KP) * KS + (tid % KP) * 16) = kr0;
      if (NKP > 512) { if (tid < NKP - 512) { const int p = 512 + tid; *(LAS v4u*)(kb + (p / KP) * KS + (p % KP) * 16) = kr1; } }
      LAS unsigned char* vb = kb + KT_BYTES + (tid >> 3) * VS + (tid & 7) * 16; *(LAS v2u*)vb = (v2u){vr.x, vr.y}; *(LAS v2u*)(vb + 8) = (v2u){vr.z, vr.w}; }
    __syncthreads();
    for (int i = 0; i < nt; ++i) {
        const int t = i < na ? t0a + i : t0b + (i - na);
        if (i + 1 < nt) { const int tn = (i + 1) < na ? t0a + i + 1 : t0b + (i + 1 - na); const v4u* kg = (const v4u*)(Kg + (size_t)tn * 64 * DK); kr0 = kg[tid]; if (NKP > 512) { if (tid < NKP - 512) kr1 = kg[512 + tid]; }
            vr = *(const v4u*)(Vtg + (size_t)(tid >> 3) * TK + tn * 64 + (tid & 7) * 8); }
        LAS unsigned char* kb = lds + (i & 1) * STAGE; LAS unsigned char* vbs = kb + KT_BYTES;
        const int sb = 64 * t - NC;
        const bool band = SWA && t >= 4;
        const bool skip = band && (sb + 63 < w0 - 128 || sb > w0 + 31 + 128);
        if (!skip) {
            f32x16 p0, p1;
#pragma unroll
            for (int r = 0; r < 16; ++r) { p0[r] = 0.f; p1[r] = 0.f; }
#pragma unroll
            for (int s = 0; s < NS; ++s) {
                const bf16x8s k0 = *(const LAS bf16x8s*)(kb + q * KS + (16 * s + 8 * hi) * 2);
                const bf16x8s k1 = *(const LAS bf16x8s*)(kb + (32 + q) * KS + (16 * s + 8 * hi) * 2);
                p0 = __builtin_amdgcn_mfma_f32_32x32x16_bf16(k0, qf[s], p0, 0, 0, 0);
                p1 = __builtin_amdgcn_mfma_f32_32x32x16_bf16(k1, qf[s], p1, 0, 0, 0);
            }
            if (band) { const int tl = tq - NC;
#pragma unroll
                for (int r = 0; r < 16; ++r) { const int d0 = tl - (sb + crow(r, hi)), d1 = d0 - 32;
                    if (d0 > 128 || d0 < -128) p0[r] = -1e30f; if (d1 > 128 || d1 < -128) p1[r] = -1e30f; } }
            float mx = fmaxf(p0[0], p1[0]);
#pragma unroll
            for (int r = 1; r < 16; ++r) mx = fmaxf(mx, fmaxf(p0[r], p1[r]));
            mx = fmaxf(mx, xlane32(mx, lane));
            const float mn = fmaxf(m, mx), alpha = __builtin_amdgcn_exp2f(m - mn); m = mn;
            float ps = 0.f;
#pragma unroll
            for (int r = 0; r < 16; ++r) { p0[r] = __builtin_amdgcn_exp2f(p0[r] - mn); p1[r] = __builtin_amdgcn_exp2f(p1[r] - mn); ps += p0[r] + p1[r]; }
            l = l * alpha + ps;
            if (hi == 0) wsf[q] = alpha;
            bf16x8s pa[4];
            { v4u w;
              w.x = cvtpk(p0[0], p0[1]); w.y = cvtpk(p0[2], p0[3]); w.z = cvtpk(p0[4], p0[5]); w.w = cvtpk(p0[6], p0[7]); pa[0] = __builtin_bit_cast(bf16x8s, w);
              w.x = cvtpk(p0[8], p0[9]); w.y = cvtpk(p0[10], p0[11]); w.z = cvtpk(p0[12], p0[13]); w.w = cvtpk(p0[14], p0[15]); pa[1] = __builtin_bit_cast(bf16x8s, w);
              w.x = cvtpk(p1[0], p1[1]); w.y = cvtpk(p1[2], p1[3]); w.z = cvtpk(p1[4], p1[5]); w.w = cvtpk(p1[6], p1[7]); pa[2] = __builtin_bit_cast(bf16x8s, w);
              w.x = cvtpk(p1[8], p1[9]); w.y = cvtpk(p1[10], p1[11]); w.z = cvtpk(p1[12], p1[13]); w.w = cvtpk(p1[14], p1[15]); pa[3] = __builtin_bit_cast(bf16x8s, w); }
            asm volatile("s_waitcnt lgkmcnt(0)" ::: "memory");
#pragma unroll
            for (int r = 0; r < 16; ++r) { const float a = wsf[crow(r, hi)]; o0[r] *= a; o1[r] *= a; }
#pragma unroll
            for (int s4 = 0; s4 < 4; ++s4)
#pragma unroll
                for (int nb = 0; nb < 2; ++nb) {
                    const LAS unsigned char* vp = vbs + (32 * nb + q) * VS + (16 * s4 + 4 * hi) * 2;
                    const v2u lo = *(const LAS v2u*)vp, hh = *(const LAS v2u*)(vp + 16);
                    const bf16x8s vf = __builtin_bit_cast(bf16x8s, ((v4u){lo.x, lo.y, hh.x, hh.y}));
                    if (nb == 0) o0 = __builtin_amdgcn_mfma_f32_32x32x16_bf16(pa[s4], vf, o0, 0, 0, 0); else o1 = __builtin_amdgcn_mfma_f32_32x32x16_bf16(pa[s4], vf, o1, 0, 0, 0);
                }
        }
        if (i + 1 < nt) { LAS unsigned char* kn = lds + ((i + 1) & 1) * STAGE; *(LAS v4u*)(kn + (tid / KP) * KS + (tid % KP) * 16) = kr0;
            if (NKP > 512) { if (tid < NKP - 512) { const int p = 512 + tid; *(LAS v4u*)(kn + (p / KP) * KS + (p % KP) * 16) = kr1; } }
            LAS unsigned char* vb = kn + KT_BYTES + (tid >> 3) * VS + (tid & 7) * 16; *(LAS v2u*)vb = (v2u){vr.x, vr.y}; *(LAS v2u*)(vb + 8) = (v2u){vr.z, vr.w}; }
        __syncthreads();
    }
    const float lt = l + xlane32(l, lane);
    if (hi == 0) wsf[q] = 1.0f / lt;
    asm volatile("s_waitcnt lgkmcnt(0)" ::: "memory");
#pragma unroll
    for (int r = 0; r < 16; ++r) { const int qq = crow(r, hi); const float inv = wsf[qq];
        bf16* op = OCp + (size_t)row_of(b, tq0 + wave * 32 + qq) * D + hcol + q;
        op[0] = f2bf(o0[r] * inv); op[32] = f2bf(o1[r] * inv); }
    __syncthreads();
}
__device__ __forceinline__ void attn_phase(LAS unsigned char* lds, const Mix& M, const float* sink, bool with_ctx, int tid) {
    const int nunits = 512 + (with_ctx ? 64 : 0);
    for (int u = blockIdx.x; u < nunits; u += gridDim.x) {
        if (u < 512) {
            const int c = u & 255, bh = (c & 7) + 8 * (c >> 6), qb = (c >> 3) & 7, b = bh >> 2, h = bh & 3, tq0 = NC + 256 * qb;
            if (u < 256) attn_unit<96, false>(lds, M.Qm + (size_t)bh * TK * 96, M.Km + (size_t)bh * TK * 96, M.Vm + (size_t)bh * 64 * TK, M.OC, b, h * 64, tq0, 0, TK / 64, 0, 0, 0.f, tid);
            else { const int slo = 256 * qb - 128 < 0 ? 0 : 256 * qb - 128, shi = 256 * qb + 383 > NL - 1 ? NL - 1 : 256 * qb + 383;
                attn_unit<64, true>(lds, M.Qs + (size_t)bh * TK * 64, M.Ks + (size_t)(b * 2 + (h >> 1)) * TK * 64, M.Vs + (size_t)(b * 2 + (h >> 1)) * 64 * TK, M.OC, b, 512 + h * 64, tq0,
                                    0, NC / 64, (NC + slo) / 64, (NC + shi) / 64 + 1, sink[h] * LOG2E, tid); }
        } else {
            const int c = (u - 512) & 31, b = c >> 2, h = c & 3;
            if (u < 544) attn_unit<96, false>(lds, M.Qm + (size_t)c * TK * 96, M.Km + (size_t)c * TK * 96, M.Vm + (size_t)c * 64 * TK, M.OC, b, h * 64, 0, 0, NC / 64, 0, 0, 0.f, tid);
            else attn_unit<64, true>(lds, M.Qs + (size_t)c * TK * 64, M.Ks + (size_t)(b * 2 + (h >> 1)) * TK * 64, M.Vs + (size_t)(b * 2 + (h >> 1)) * 64 * TK, M.OC, b, 512 + h * 64, 0, 0, NC / 64, 0, 0, sink[h] * LOG2E, tid);
        }
    }
}
template <int KIND> __device__ __forceinline__ void norm_phase(Frame& F, int l) {
    unsigned char* ws = F.base();
    const bool combine = (KIND != 1) && l > 0 && ((l - 1) & 1);
    const bool first = (KIND == 0 && l == 0);
    const int nrows = (KIND == 2) ? NLAT : NTOK;
    const float* modl = F_sm + SM_MOD + (size_t)(KIND == 2 ? 0 : l) * 9 * 6144;
    const float* modp = F_sm + SM_MOD + (size_t)(l > 0 ? l - 1 : 0) * 9 * 6144;
    const int* offs = (const int*)(F_sm + SM_META) + ((l > 0 ? l - 1 : 0) >> 1) * 16;
    const float* gain = KIND == 0 ? IN(6) + l * D : (KIND == 1 ? IN(7) + l * D : IN(27));
    for (int row = F.gw; row < nrows; row += F.NGW) {
        const int bidx = row < NLAT ? row / NL : NB;
        const float* src = first ? (row < NLAT ? IN(0) + (size_t)row * D : IN(2) + (size_t)(row - NLAT) * D) : F_H + (size_t)row * D;
        f32x4 v[4];
#pragma unroll
        for (int j = 0; j < 4; ++j) v[j] = *(const f32x4*)(src + 4 * F.lane + 256 * j);
        if (combine) {
            const int* ti = F_tokinfo + (size_t)row * 8;
            const int e1 = ti[0], p1 = ti[1], e2 = ti[3], p2 = ti[4]; const float w1 = __int_as_float(ti[2]), w2 = __int_as_float(ti[5]);
            const bf16* y1 = F_Y + (size_t)(offs[e1] + p1) * D; const bf16* y2 = F_Y + (size_t)(offs[e2] + p2) * D;
#pragma unroll
            for (int j = 0; j < 4; ++j) { const int col = 4 * F.lane + 256 * j;
                const f32x4 gf = *(const f32x4*)(modp + (size_t)bidx * 6144 + 5 * 1024 + col);
                const v2u a = *(const v2u*)(y1 + col), b = *(const v2u*)(y2 + col);
                f32x4 ya, yb; ya[0] = bf2f((bf16)(a.x & 0xffff)); ya[1] = bf2f((bf16)(a.x >> 16)); ya[2] = bf2f((bf16)(a.y & 0xffff)); ya[3] = bf2f((bf16)(a.y >> 16));
                yb[0] = bf2f((bf16)(b.x & 0xffff)); yb[1] = bf2f((bf16)(b.x >> 16)); yb[2] = bf2f((bf16)(b.y & 0xffff)); yb[3] = bf2f((bf16)(b.y >> 16));
                v[j] = v[j] + gf * (ya * w1 + yb * w2); }
        }
        if (combine || first) {
#pragma unroll
            for (int j = 0; j < 4; ++j) *(f32x4*)(F_H + (size_t)row * D + 4 * F.lane + 256 * j) = v[j];
        }
        float ss = 0.f;
#pragma unroll
        for (int j = 0; j < 4; ++j) ss += (v[j][0] * v[j][0] + v[j][1] * v[j][1]) + (v[j][2] * v[j][2] + v[j][3] * v[j][3]);
        const float rstd = 1.0f / sqrtf(wave_sum(ss, F.lane) * (1.0f / D) + NORM_EPS);
        if (KIND == 2) {
#pragma unroll
            for (int j = 0; j < 4; ++j) { const int col = 4 * F.lane + 256 * j; const f32x4 g = *(const f32x4*)(gain + col); *(f32x4*)(OUTP() + (size_t)row * D + col) = v[j] * rstd * g; }
            continue;
        }
        const float* mrow = modl + (size_t)bidx * 6144 + (KIND == 0 ? 0 : 3 * 1024);
#pragma unroll
        for (int j = 0; j < 4; ++j) { const int col = 4 * F.lane + 256 * j;
            const f32x4 g = *(const f32x4*)(gain + col), sh = *(const f32x4*)(mrow + col), sc = *(const f32x4*)(mrow + 1024 + col);
            v[j] = v[j] * rstd * g * (sc + 1.0f) + sh;
            v2u o; o.x = pk2(v[j][0], v[j][1]); o.y = pk2(v[j][2], v[j][3]);
            *(v2u*)(F_A + (size_t)row * D + col) = o; }
        if (KIND == 1 && (l & 1)) {
            const int li = l >> 1; const float* wr = IN(23) + (size_t)li * D * 8;
            float lg[8];
#pragma unroll
            for (int e = 0; e < 8; ++e) lg[e] = 0.f;
#pragma unroll
            for (int j = 0; j < 4; ++j)
#pragma unroll
                for (int i = 0; i < 4; ++i) { const int col = 4 * F.lane + 256 * j + i; const f32x4 w0 = *(const f32x4*)(wr + (size_t)col * 8), w1 = *(const f32x4*)(wr + (size_t)col * 8 + 4);
#pragma unroll
                    for (int e = 0; e < 4; ++e) { lg[e] += v[j][i] * w0[e]; lg[4 + e] += v[j][i] * w1[e]; } }
#pragma unroll
            for (int e = 0; e < 8; ++e) lg[e] = wave_sum(lg[e], F.lane);
            int e1 = 0; float v1 = lg[0];
#pragma unroll
            for (int e = 1; e < 8; ++e) if (lg[e] > v1) { v1 = lg[e]; e1 = e; }
            int e2 = -1; float v2 = -3.0e38f;
#pragma unroll
            for (int e = 0; e < 8; ++e) if (e != e1 && lg[e] > v2) { v2 = lg[e]; e2 = e; }
            if (F.lane == 0) {
                const float w2 = 1.0f / (1.0f + expf(v1 - v2)), w1 = 1.0f - w2;
                const int p1 = (int)atomicAdd(F_ctl + CW_CNT + li * 8 + e1, 1u), p2 = (int)atomicAdd(F_ctl + CW_CNT + li * 8 + e2, 1u);
                F_list[(size_t)e1 * NTOK + p1] = row; F_list[(size_t)e2 * NTOK + p2] = row;
                int* ti = F_tokinfo + (size_t)row * 8; ti[0] = e1; ti[1] = p1; ti[2] = __float_as_int(w1); ti[3] = e2; ti[4] = p2; ti[5] = __float_as_int(w2);
            }
        }
    }
}
__device__ __forceinline__ void moe_tiles(Frame& F, int li, int (&tb)[9], int (&cnt)[8]) {
    unsigned char* ws = F.base();
    tb[0] = 0;
#pragma unroll
    for (int e = 0; e < 8; ++e) { cnt[e] = (int)__hip_atomic_load(F_ctl + CW_CNT + li * 8 + e, __ATOMIC_RELAXED, __HIP_MEMORY_SCOPE_AGENT); tb[e + 1] = tb[e] + ((cnt[e] + 255) >> 8); }
}
__device__ __forceinline__ void moe_gather(Frame& F, int li) {
    unsigned char* ws = F.base();
    int tb[9], cnt[8]; moe_tiles(F, li, tb, cnt);
    if (blockIdx.x == 0 && F.tid < 9) { int* meta = (int*)(F_sm + SM_META) + li * 16; int val = 0;
#pragma unroll
        for (int e = 0; e < 9; ++e) if (F.tid == e) val = tb[e] * 256;
        meta[F.tid] = val; }
    { const int T = tb[8]; unsigned* ul = (unsigned*)(F_sm + SM_ULIST) + li * (MAXTILES * 32);
      for (int L = F.gtid; L < T * 32; L += F.NT) {
          const bool gu = L < T * 28; const int nN = gu ? 28 : 4, nwg = T * nN; int wgid = gu ? L : L - T * 28;
          { const int q = nwg / 8, r = nwg % 8, xcd = wgid % 8, off = wgid / 8; wgid = (xcd < r ? xcd * (q + 1) : r * (q + 1) + (xcd - r) * q) + off; }
          const int nig = 8 * nN, gid = wgid / nig, fm = gid * 8, gsz = (T - fm) < 8 ? (T - fm) : 8;
          const int pm = fm + ((wgid % nig) % gsz), pnl = (wgid % nig) / gsz; int e = 0;
#pragma unroll
          for (int j = 1; j < 8; ++j) e += (pm >= tb[j]) ? 1 : 0;
          ul[(gu ? ULIST_GU : ULIST_D) + (gu ? L : L - T * 28)] = (unsigned)pm | ((unsigned)(e * nN + pnl) << 16);
      } }
    const int nslot = tb[8] * 256;
    for (int s = F.gw; s < nslot; s += F.NGW) {
        const int tile = s >> 8; int e = 0, base = 0, c = 0;
#pragma unroll
        for (int j = 0; j < 8; ++j) if (tile >= tb[j] && tile < tb[j + 1]) { e = j; base = tb[j] * 256; c = cnt[j]; }
        const int pos = s - base; const int tok = pos < c ? F_list[(size_t)e * NTOK + pos] : -1;
        v4u a = (v4u){0u, 0u, 0u, 0u}, b = a;
        if (tok >= 0) { const v4u* sp = (const v4u*)(F_A + (size_t)tok * D); a = sp[F.lane]; b = sp[64 + F.lane]; }
        v4u* dp = (v4u*)(F_AM + (size_t)s * D); dp[F.lane] = a; dp[64 + F.lane] = b;
    }
}

__device__ __forceinline__ void make_mix(Mix& M, unsigned char* ws, int l) {
    M.P = F_P; M.Qm = WSP(bf16, WS_QM); M.Km = WSP(bf16, WS_KM); M.Vm = WSP(bf16, WS_VM); M.Qs = WSP(bf16, WS_QS); M.Ks = WSP(bf16, WS_KS); M.Vs = WSP(bf16, WS_VS);
    M.HF = WSP(float, WS_HF); M.HO = WSP(float, WS_HO); M.RQ = WSP(float, WS_RQ); M.RK = WSP(float, WS_RK); M.RO = WSP(float, WS_RO); M.OC = F_OC;
    M.HU = WSP(float, WS_HU); M.HDK = WSP(float, WS_HDK); M.HQC = WSP(float, WS_HQC); M.RU = WSP(float, WS_RU); M.RQC = WSP(float, WS_RQC);
    M.loglb = F_sm + SM_LOGLB + l * 512; M.log1mlb = F_sm + SM_LOG1M + l * 512; M.hg_norm_g = IN(15) + l * 256; M.sink = IN(16) + l * 4; M.log_gamma = F_sm + SM_LGAM + l * 8;
    M.gn_g = IN(18) + l * 256; M.gn_b = IN(19) + l * 256;
}
__device__ __forceinline__ void frame_init(Frame& F, LAS unsigned char* lds, int wave_s) {
    unsigned z = 0u; asm volatile("" : "+v"(z)); int t = (int)__builtin_amdgcn_mbcnt_hi(~0u, __builtin_amdgcn_mbcnt_lo(~0u, z)); t += wave_s * 64;
    F.lds = lds; F.tid = t; F.lane = t & 63; F.wave = wave_s;
    F.gtid = blockIdx.x * NTHREADS + t; F.NT = gridDim.x * NTHREADS; { int gw_ = blockIdx.x * NWAVES + wave_s; asm volatile("" : "+s"(gw_)); F.gw = gw_; } F.NGW = gridDim.x * NWAVES;
}
__global__ void __launch_bounds__(NTHREADS, 2) fwd_kernel(Args args) {
    extern __shared__ __attribute__((aligned(16))) unsigned char lds[];
    const int wave_s = __builtin_amdgcn_readfirstlane((int)threadIdx.x >> 6);
    volatile LAS unsigned* MISC = (volatile LAS unsigned*)((LAS unsigned char*)lds + MISC_OFF);
    for (int u = threadIdx.x; u < (LDS_BYTES - 131072) / 4; u += NTHREADS) ((LAS unsigned*)((LAS unsigned char*)lds + 131072))[u] = 0u;
    __syncthreads();
    const int lo = args.ph_lo, hi = args.ph_hi;
    XcdBarrier bar; bar.w = wave_s; bar.bar = (unsigned*)(WSBASE() + WS_CTL) + CW_BAR; bar.x = 0; bar.st = nullptr;
    if (hi - lo > 1) bar = xcd_barrier_post((unsigned*)(WSBASE() + WS_CTL) + CW_BAR, MISC + 8, wave_s);
    int p = 0;
#ifndef PHMASK
#define PHMASK 0xffffffffu
#endif
#define PH_BEGIN_(k) if (((PHMASK >> (k)) & 1u) && p >= lo && p < hi) { Frame F; frame_init(F, (LAS unsigned char*)lds, wave_s); unsigned char* ws = F.base();
#define PH_END if (p + 1 < hi) xcd_barrier(bar); } ++p;

    PH_BEGIN_(0) (void)ws; prologue(F); PH_END

    for (int l = 0; l < DEPTH; ++l) {
        PH_BEGIN_(1) (void)ws; norm_phase<0>(F, l); if (l == 2) convert_moe(F, 1); PH_END
        PH_BEGIN_(2) { pg8::Gemm g{F_A, F_WIN + (size_t)l * NP * D, NTOK, NP, D}; pg8::StaticOrder S; S.init(NTOK, NP, gridDim.x, blockIdx.x);
                   pg8::EpiBf16P E{F_P, NP, NP / 256}; pg8::gemm_phase<pg8::EpiBf16P, pg8::StaticOrder, true, true>(F.lds, g, S, E, F.tid); } PH_END
#ifndef NO_MIX
        PH_BEGIN_(3) { Mix M; make_mix(M, ws, l);
            for (int it = F.gtid; it < NTOK * 4; it += F.NT) mla_prep_item(M, it);
            for (int it = F.gtid; it < NTOK * 8; it += F.NT) swa_prep_item(M, it);
            for (int it = F.gtid; it < NTOK * 256; it += F.NT) hg_prep_item(M, it);
            for (int it = F.gtid; it < NTOK * 8; it += F.NT) ret_prep_item(M, it); }
        PH_END
        PH_BEGIN_(4) { Mix M; make_mix(M, ws, l);
#ifdef NAIVE_ATTN
            for (int it = F.gtid; it < NB * 4 * TK; it += F.NT) mla_attn_item(M, it);
            for (int it = F.gtid; it < NB * 4 * TK; it += F.NT) swa_attn_item(M, it);
#else
            attn_phase(F.lds, M, M.sink, true, F.tid);
#endif
            for (int u = F.gw; u < 2 * NB * 4 * NCH; u += F.NGW) { hg_local_item(M, u * 64 + F.lane); ret_local_item(M, u * 64 + F.lane); } }
        PH_END
        PH_BEGIN_(14) { Mix M; make_mix(M, ws, l);
            for (int it = F.gtid; it < 2 * NB * 4 * 4096; it += F.NT) hg_carry_item(M, it);
            for (int it = F.gtid; it < 2 * NB * 4 * 2048; it += F.NT) ret_carry_item(M, it); }
        PH_END
        PH_BEGIN_(15) { Mix M; make_mix(M, ws, l);
            for (int u = F.gw; u < 2 * NB * 4 * NCH; u += F.NGW) { hg_fix_item(M, u * 64 + F.lane); ret_fix_item(M, u * 64 + F.lane); } }
        PH_END
        PH_BEGIN_(5) { Mix M; make_mix(M, ws, l);
            for (int it = F.gtid; it < NTOK * 4; it += F.NT) hg_fin_item(M, it);
            for (int it = F.gtid; it < NTOK * 4; it += F.NT) ret_fin_item(M, it); }
        PH_END
#endif
        PH_BEGIN_(6) { pg8::Gemm g{F_OC, F_WOUT + (size_t)l * D * D, NTOK, D, D}; pg8::StaticOrder S; S.init(NTOK, D, gridDim.x, blockIdx.x);
                   pg8::EpiRes E{F_H, F_sm + SM_MOD + (size_t)l * 9 * 6144 + 2 * 1024, NLAT / 256, NL / 256, NB}; pg8::gemm_phase<pg8::EpiRes, pg8::StaticOrder, true, true>(F.lds, g, S, E, F.tid); } PH_END
        PH_BEGIN_(7) (void)ws; norm_phase<1>(F, l); PH_END
        if ((l & 1) == 0) {
            const int li = l >> 1;
            PH_BEGIN_(8) { pg8::Gemm g{F_A, F_WFGU + (size_t)li * 2 * DFF * D, NTOK, 2 * DFF, D}; pg8::StaticOrder S; S.init(NTOK, 2 * DFF, gridDim.x, blockIdx.x);
                       pg8::EpiSwiglu E{F_ACT, DFF, 2 * DFF / 256}; pg8::gemm_phase<pg8::EpiSwiglu, pg8::StaticOrder, true, true>(F.lds, g, S, E, F.tid); } PH_END
            PH_BEGIN_(9) { pg8::Gemm g{F_ACT, F_WFD + (size_t)li * D * DFF, NTOK, D, DFF}; pg8::StaticOrder S; S.init(NTOK, D, gridDim.x, blockIdx.x);
                       pg8::EpiRes E{F_H, F_sm + SM_MOD + (size_t)l * 9 * 6144 + 5 * 1024, NLAT / 256, NL / 256, NB}; pg8::gemm_phase<pg8::EpiRes, pg8::StaticOrder, true, true>(F.lds, g, S, E, F.tid); } PH_END
        } else {
            const int li = l >> 1;
            PH_BEGIN_(10) (void)ws; moe_gather(F, li); PH_END
            PH_BEGIN_(11) { const int T = __builtin_amdgcn_readfirstlane((int)__hip_atomic_load((unsigned*)(F_sm + SM_META) + li * 16 + 8, __ATOMIC_RELAXED, __HIP_MEMORY_SCOPE_AGENT)) >> 8;
                       pg8::MoeOrder S; S.list = (const unsigned*)(F_sm + SM_ULIST) + li * (MAXTILES * 32) + ULIST_GU; S.nwg = T * (2 * DFE / 256); S.G = gridDim.x; S.c = blockIdx.x;
                       pg8::Gemm g{F_AM, F_WMGU, MAXTILES * 256, 8 * 2 * DFE, D};
                       pg8::EpiSwiglu E{F_ACT, DFE, 2 * DFE / 256}; pg8::gemm_phase<pg8::EpiSwiglu, pg8::MoeOrder, true, true>(F.lds, g, S, E, F.tid); } PH_END
            PH_BEGIN_(12) { const int T = __builtin_amdgcn_readfirstlane((int)__hip_atomic_load((unsigned*)(F_sm + SM_META) + li * 16 + 8, __ATOMIC_RELAXED, __HIP_MEMORY_SCOPE_AGENT)) >> 8;
                       pg8::MoeOrder S; S.list = (const unsigned*)(F_sm + SM_ULIST) + li * (MAXTILES * 32) + ULIST_D; S.nwg = T * (D / 256); S.G = gridDim.x; S.c = blockIdx.x;
                       pg8::Gemm g{F_ACT, F_WMD, MAXTILES * 256, 8 * D, DFE};
                       pg8::EpiBf16P E{F_Y, D, D / 256}; pg8::gemm_phase<pg8::EpiBf16P, pg8::MoeOrder, true, true>(F.lds, g, S, E, F.tid); } PH_END
        }
    }
    PH_BEGIN_(13) (void)ws; norm_phase<2>(F, DEPTH); PH_END
#undef PH_BEGIN_
#undef PH_END
}
constexpr int NPHASES = 1 + 2 * 11 + 2 * 12 + 1;

#ifndef MK_PER_PHASE
#define MK_PER_PHASE 0
#endif
#ifndef PROBE
#define PROBE 0
#endif
extern "C" void kernel_launch(void* const* d_in, const int* in_sizes, int n_in, void* d_out, int out_size, void* d_ws, size_t ws_size, hipStream_t stream) {
    static int grid = 0;
    if (grid == 0) {
        if (n_in != 28 || ws_size < WS_END || out_size != NLAT * D) { fprintf(stderr, "kernel_launch: unexpected problem shape (n_in %d, ws %zu, out %d)\n", n_in, ws_size, out_size); grid = -1; return; }
        int dev = 0, cus = 0;
        if (hipGetDevice(&dev) != hipSuccess || hipDeviceGetAttribute(&cus, hipDeviceAttributeMultiprocessorCount, dev) != hipSuccess) { grid = -1; return; }
        if (hipFuncSetAttribute((const void*)fwd_kernel, hipFuncAttributeMaxDynamicSharedMemorySize, LDS_BYTES) != hipSuccess) { fprintf(stderr, "kernel_launch: hipFuncSetAttribute failed\n"); grid = -1; return; }
        int per_cu = 0;
        if (hipOccupancyMaxActiveBlocksPerMultiprocessor(&per_cu, (const void*)fwd_kernel, NTHREADS, LDS_BYTES) != hipSuccess || per_cu < 1) { fprintf(stderr, "kernel_launch: occupancy query says %d\n", per_cu); }
        (void)hipGetLastError();
        grid = cus;
    }
    if (grid < 0) return;
    (void)hipMemsetAsync((char*)d_ws + WS_CTL, 0, CTL_ZERO_BYTES, stream);
    Args a{};
    for (int i = 0; i < 28; ++i) a.in[i] = (const float*)d_in[i];
    a.out = (float*)d_out; a.ws = (unsigned char*)d_ws;
#if MK_PER_PHASE
    for (int p = 0; p < NPHASES; ++p) { a.ph_lo = p; a.ph_hi = p + 1; hipLaunchKernelGGL(fwd_kernel, dim3(grid), dim3(NTHREADS), LDS_BYTES, stream, a);
        int l = -1, k = -1; const int base[4] = {1, 12, 24, 35}; for (int i = 0; i < 4; ++i) if (p >= base[i] && p < base[i] + (i & 1 ? 12 : 11)) { l = i; k = p - base[i]; }
        bool dup = false;
#if PROBE == 1
        dup = (k == 3);
#elif PROBE == 2
        dup = (k == 1) || (k == 9) || ((l & 1) && (k == 10 || k == 11));
#elif PROBE == 3
        dup = (p == 0) || (k == 2);
#elif PROBE == 4
        dup = (k == 6);
#endif
        if (dup) hipLaunchKernelGGL(fwd_kernel, dim3(grid), dim3(NTHREADS), LDS_BYTES, stream, a); }
#else
    a.ph_lo = 0; a.ph_hi = NPHASES; hipLaunchKernelGGL(fwd_kernel, dim3(grid), dim3(NTHREADS), LDS_BYTES, stream, a);
#endif
}
```

```cpp
#include <hip/hip_runtime.h>
#include <cstdio>
#include <cstdint>
#include <cmath>
#ifndef NB
#define NB 8
#endif
constexpr int D = 1024, NL = 2048, NC = 256, TK = NL + NC, DEPTH = 4, GRIDW = 64;
constexpr int NLAT = NB * NL, NCTX = NB * NC, NTOK = NLAT + NCTX;
constexpr int NP = 3840;
constexpr int DIN = 2912;
constexpr int C_QLAT = 0, C_KVLAT = 192, C_KPE = 320, C_HQ = 352, C_HZF = 608, C_HZB = 864, C_HI = 1120, C_HG = 1376;
constexpr int C_SQ = 1632, C_SK = 1888, C_SV = 2016, C_RQ = 2144, C_RK = 2272, C_RV = 2400, C_RG = 2656, C_QE = 2912, C_KVE = 3296;
constexpr int DFF = 2816, NEXP = 8, DFE = 3584;
constexpr float NORM_EPS = 1e-6f, LOG2E = 1.4426950408889634f;
typedef unsigned short bf16;

#ifdef HOST_TEST
#define HD static inline
#else
#define HD __host__ __device__ __forceinline__
#endif

HD float bf2f(bf16 b) { unsigned u = ((unsigned)b) << 16; float f; __builtin_memcpy(&f, &u, 4); return f; }
HD bf16 f2bf(float f) { unsigned u; __builtin_memcpy(&u, &f, 4); return (bf16)((u + 0x7fffu + ((u >> 16) & 1u)) >> 16); }
#define CBAR() asm volatile("" ::: "memory")
struct U4 { unsigned x, y, z, w; };
HD void ld8(const bf16* p, float (&f)[8]) {
    U4 u; __builtin_memcpy(&u, __builtin_assume_aligned(p, 16), 16);
    unsigned t;
    t = u.x << 16; __builtin_memcpy(&f[0], &t, 4); t = u.x & 0xffff0000u; __builtin_memcpy(&f[1], &t, 4);
    t = u.y << 16; __builtin_memcpy(&f[2], &t, 4); t = u.y & 0xffff0000u; __builtin_memcpy(&f[3], &t, 4);
    t = u.z << 16; __builtin_memcpy(&f[4], &t, 4); t = u.z & 0xffff0000u; __builtin_memcpy(&f[5], &t, 4);
    t = u.w << 16; __builtin_memcpy(&f[6], &t, 4); t = u.w & 0xffff0000u; __builtin_memcpy(&f[7], &t, 4);
}
HD void ld4f(const float* p, float (&f)[4]) { __builtin_memcpy(&f[0], __builtin_assume_aligned(p, 16), 16); }
HD float silu_f(float x) { return x / (1.0f + expf(-x)); }
HD int row_of(int b, int tq) { return tq < NC ? NLAT + b * NC + tq : b * NL + (tq - NC); }
HD void row_split(int row, int& b, int& tq) { if (row < NLAT) { b = row / NL; tq = NC + row % NL; } else { const int r = row - NLAT; b = r / NC; tq = r % NC; } }
HD float log_sigmoid_f(float x) { return fminf(x, 0.f) - log1pf(expf(-fabsf(x))); }

struct Mix {
    const bf16* P;
    bf16 *Qm, *Km, *Vm;
    bf16 *Qs, *Ks, *Vs;
    float* HF;
    float* HO;
    float *RQ, *RK;
    float* RO;
    bf16* OC;
    const float *loglb, *log1mlb;
    const float* hg_norm_g;
    const float* sink;
    const float* log_gamma;
    const float *gn_g, *gn_b;
    float *HU, *HDK, *HQC;
    float *RU, *RQC;
};
constexpr int CH = 72, NCH = TK / CH;
static_assert(NCH * CH == TK, "chunking");

HD void mla_prep_item(const Mix& M, int item) {
    const int row = item >> 2, h = item & 3; int b, tq; row_split(row, b, tq);
    const bf16* p = M.P + (size_t)row * NP;
    float sq = 0.f, skv = 0.f;
    for (int j = 0; j < 192; ++j) { const float v = bf2f(p[C_QLAT + j]); sq += v * v; }
    for (int j = 0; j < 128; ++j) { const float v = bf2f(p[C_KVLAT + j]); skv += v * v; }
    const float rq = 1.0f / sqrtf(sq * (1.0f / 192.0f) + NORM_EPS), rkv = 1.0f / sqrtf(skv * (1.0f / 128.0f) + NORM_EPS);
    const float qs = rq * 0.10206207261596575f * LOG2E;
    const size_t o96 = ((size_t)(b * 4 + h) * TK + tq) * 96;
    for (int j = 0; j < 64; ++j) {
        M.Qm[o96 + j] = f2bf(bf2f(p[C_QE + h * 96 + j]) * qs);
        M.Km[o96 + j] = f2bf(bf2f(p[C_KVE + h * 128 + j]) * rkv);
        M.Vm[((size_t)(b * 4 + h) * 64 + j) * TK + tq] = f2bf(bf2f(p[C_KVE + h * 128 + 64 + j]) * rkv);
    }
    const bool lat = tq >= NC; const int t = tq - NC;
    for (int j = 0; j < 16; ++j) {
        float c = 1.f, s = 0.f;
        if (lat) { const float inv = powf(10000.0f, -(float)(j & 7) / 8.0f); const float ang = (float)(j < 8 ? t / GRIDW : t % GRIDW) * inv; c = cosf(ang); s = sinf(ang); }
        const float q1 = bf2f(p[C_QE + h * 96 + 64 + j]), q2 = bf2f(p[C_QE + h * 96 + 80 + j]);
        M.Qm[o96 + 64 + j] = f2bf((q1 * c - q2 * s) * qs); M.Qm[o96 + 80 + j] = f2bf((q1 * s + q2 * c) * qs);
        const float k1 = bf2f(p[C_KPE + j]), k2 = bf2f(p[C_KPE + 16 + j]);
        M.Km[o96 + 64 + j] = f2bf(k1 * c - k2 * s); M.Km[o96 + 80 + j] = f2bf(k1 * s + k2 * c);
    }
}
HD void swa_prep_item(const Mix& M, int item) {
    const int row = item >> 3, s = item & 7; int b, tq; row_split(row, b, tq);
    const bf16* p = M.P + (size_t)row * NP;
    const bool lat = tq >= NC; const int t = tq - NC;
    if (s >= 6) { const int kh = s - 6; bf16* o = M.Vs + (size_t)(b * 2 + kh) * 64 * TK + tq; for (int j = 0; j < 64; ++j) o[(size_t)j * TK] = p[C_SV + kh * 64 + j]; return; }
    const bf16* src = s < 4 ? p + C_SQ + s * 64 : p + C_SK + (s - 4) * 64;
    bf16* o = s < 4 ? M.Qs + ((size_t)(b * 4 + s) * TK + tq) * 64 : M.Ks + ((size_t)(b * 2 + (s - 4)) * TK + tq) * 64;
    const float sc = s < 4 ? 0.125f * LOG2E : 1.0f;
    for (int j = 0; j < 32; ++j) {
        float c = 1.f, sn = 0.f;
        if (lat) { const float inv = powf(10000.0f, -(float)(j & 15) / 16.0f); const float ang = (float)(j < 16 ? t / GRIDW : t % GRIDW) * inv; c = cosf(ang); sn = sinf(ang); }
        const float x1 = bf2f(src[j]), x2 = bf2f(src[32 + j]);
        o[j] = f2bf((x1 * c - x2 * sn) * sc); o[32 + j] = f2bf((x1 * sn + x2 * c) * sc);
    }
}
HD void hg_prep_item(const Mix& M, int item) {
    const int row = item >> 8, c = item & 255;
    const bf16* p = M.P + (size_t)row * NP;
    for (int d = 0; d < 2; ++d) {
        const float z = bf2f(p[(d ? C_HZB : C_HZF) + c]);
        const float a = M.loglb[d * 256 + c], bb = M.log1mlb[d * 256 + c] + log_sigmoid_f(z);
        const float mx = fmaxf(a, bb), lf = mx + log1pf(expf(-fabsf(a - bb)));
        M.HF[((size_t)d * NTOK + row) * 256 + c] = expf(lf);
    }
}
HD void ret_prep_item(const Mix& M, int item) {
    const int row = item >> 3, w = (item >> 2) & 1, h = item & 3; int b, tq; row_split(row, b, tq);
    const bf16* src = M.P + (size_t)row * NP + (w ? C_RK : C_RQ) + h * 32;
    float* o = (w ? M.RK : M.RQ) + (size_t)row * 128 + h * 32;
    const float sc = w ? 1.0f : 0.17677669529663687f;
    for (int j = 0; j < 16; ++j) {
        const float inv = powf(10000.0f, -(float)j / 16.0f); const float ang = (float)tq * inv; const float c = cosf(ang), s = sinf(ang);
        const float x1 = bf2f(src[j]), x2 = bf2f(src[16 + j]);
        o[j] = (x1 * c - x2 * s) * sc; o[16 + j] = (x1 * s + x2 * c) * sc;
    }
}
HD void mla_attn_item(const Mix& M, int item) {
    const int tq = item % TK, bh = item / TK, b = bh >> 2, h = bh & 3;
    const bf16* qp = M.Qm + (size_t)item * 96;
    float q[96], o[64];
#pragma unroll
    for (int c8 = 0; c8 < 12; ++c8) { float t8[8]; ld8(qp + 8 * c8, t8);
#pragma unroll
        for (int j = 0; j < 8; ++j) q[8 * c8 + j] = t8[j]; }
#pragma unroll
    for (int j = 0; j < 64; ++j) o[j] = 0.f;
    float m = -1e30f, l = 0.f;
    const int nk = tq < NC ? NC : TK;
    const bf16* kb = M.Km + (size_t)bh * TK * 96; const bf16* vb = M.Vm + (size_t)bh * TK * 64;
    for (int k = 0; k < nk; ++k) {
        const bf16* kp = kb + (size_t)k * 96; float s = 0.f;
#pragma unroll
        for (int c8 = 0; c8 < 12; ++c8) { float t8[8]; ld8(kp + 8 * c8, t8);
#pragma unroll
            for (int j = 0; j < 8; ++j) s += q[8 * c8 + j] * t8[j];
            if ((c8 & 3) == 3) CBAR(); }
        const float mn = fmaxf(m, s), al = exp2f(m - mn), pr = exp2f(s - mn);
        l = l * al + pr; m = mn;
        const bf16* vp = vb + k;
#pragma unroll
        for (int j = 0; j < 64; ++j) o[j] = o[j] * al + pr * bf2f(vp[(size_t)j * TK]);
    }
    const float rl = 1.0f / l; bf16* op = M.OC + (size_t)row_of(b, tq) * D + h * 64;
#pragma unroll
    for (int j = 0; j < 64; ++j) op[j] = f2bf(o[j] * rl);
}
HD void swa_attn_item(const Mix& M, int item) {
    const int tq = item % TK, bh = item / TK, b = bh >> 2, hq = bh & 3, kh = hq >> 1;
    const bf16* qp = M.Qs + (size_t)item * 64;
    float q[64], o[64];
#pragma unroll
    for (int c8 = 0; c8 < 8; ++c8) { float t8[8]; ld8(qp + 8 * c8, t8);
#pragma unroll
        for (int j = 0; j < 8; ++j) { q[8 * c8 + j] = t8[j]; o[8 * c8 + j] = 0.f; } }
    float m = M.sink[hq] * LOG2E, l = 1.0f;
    const bf16* kb = M.Ks + (size_t)(b * 2 + kh) * TK * 64; const bf16* vb = M.Vs + (size_t)(b * 2 + kh) * TK * 64;
    const int t = tq - NC;
    const int lo2 = tq < NC ? 0 : (t - 128 < 0 ? 0 : t - 128), hi2 = tq < NC ? -1 : (t + 128 > NL - 1 ? NL - 1 : t + 128);
    const int n2 = hi2 - lo2 + 1;
    for (int i = 0; i < NC + n2; ++i) {
        const int k = i < NC ? i : NC + lo2 + (i - NC);
        const bf16* kp = kb + (size_t)k * 64; float s = 0.f;
#pragma unroll
        for (int c8 = 0; c8 < 8; ++c8) { float t8[8]; ld8(kp + 8 * c8, t8);
#pragma unroll
            for (int j = 0; j < 8; ++j) s += q[8 * c8 + j] * t8[j];
            if ((c8 & 3) == 3) CBAR(); }
        const float mn = fmaxf(m, s), al = exp2f(m - mn), pr = exp2f(s - mn);
        l = l * al + pr; m = mn;
        const bf16* vp = vb + k;
#pragma unroll
        for (int j = 0; j < 64; ++j) o[j] = o[j] * al + pr * bf2f(vp[(size_t)j * TK]);
    }
    const float rl = 1.0f / l; bf16* op = M.OC + (size_t)row_of(b, tq) * D + 512 + hq * 64;
#pragma unroll
    for (int j = 0; j < 64; ++j) op[j] = f2bf(o[j] * rl);
}
HD int dir_tq(int dir, int i) { return dir == 0 ? i : (i < NC ? NC - 1 - i : NC + (NL - 1 - (i - NC))); }
HD void hg_scan_item(const Mix& M, int item) {
    const int v = item & 63, h = (item >> 6) & 3, b = (item >> 8) % NB, dir = item / (256 * NB);
    float S[64];
#pragma unroll
    for (int k = 0; k < 64; ++k) S[k] = 0.f;
    for (int i = 0; i < TK; ++i) {
        const int row = row_of(b, dir_tq(dir, i));
        const bf16* p = M.P + (size_t)row * NP; const float* f = M.HF + ((size_t)dir * NTOK + row) * 256 + h * 64;
        const float vv = bf2f(p[C_HI + h * 64 + v]); float acc = 0.f;
#pragma unroll
        for (int c8 = 0; c8 < 8; ++c8) { float q8[8], fa[4], fb[4]; ld8(p + C_HQ + h * 64 + 8 * c8, q8); ld4f(f + 8 * c8, fa); ld4f(f + 8 * c8 + 4, fb);
#pragma unroll
            for (int j = 0; j < 8; ++j) { const int k = 8 * c8 + j; const float fk = j < 4 ? fa[j] : fb[j - 4]; S[k] = fk * S[k] + (1.0f - fk) * vv; acc += q8[j] * S[k]; }
            if ((c8 & 1) == 1) CBAR(); }
        M.HO[((size_t)dir * NTOK + row) * 256 + h * 64 + v] = acc * 0.125f;
    }
}
HD void ret_scan_item(const Mix& M, int item) {
    const int v = item & 63, h = (item >> 6) & 3, b = (item >> 8) % NB, dir = item / (256 * NB);
    const float g = expf(M.log_gamma[dir * 4 + h]);
    float S[32];
#pragma unroll
    for (int k = 0; k < 32; ++k) S[k] = 0.f;
    for (int i = 0; i < TK; ++i) {
        const int row = row_of(b, dir_tq(dir, i));
        const float vv = bf2f(M.P[(size_t)row * NP + C_RV + h * 64 + v]);
        const float* qk = M.RQ + (size_t)row * 128 + h * 32; const float* kk = M.RK + (size_t)row * 128 + h * 32; float acc = 0.f;
#pragma unroll
        for (int c4 = 0; c4 < 8; ++c4) { float qa[4], ka[4]; ld4f(qk + 4 * c4, qa); ld4f(kk + 4 * c4, ka);
#pragma unroll
            for (int j = 0; j < 4; ++j) { const int k = 4 * c4 + j; S[k] = g * S[k] + ka[j] * vv; acc += qa[j] * S[k]; }
            if ((c4 & 3) == 3) CBAR(); }
        M.RO[((size_t)dir * NTOK + row) * 256 + h * 64 + v] = acc;
    }
}
HD void hg_fin_item(const Mix& M, int item) {
    const int row = item >> 2, h = item & 3;
    const float* o0 = M.HO + (size_t)row * 256 + h * 64; const float* o1 = o0 + (size_t)NTOK * 256;
    float ss = 0.f;
    for (int v = 0; v < 64; ++v) { const float x = o0[v] + o1[v]; ss += x * x; }
    const float r = 1.0f / sqrtf(ss * (1.0f / 64.0f) + NORM_EPS);
    const bf16* gp = M.P + (size_t)row * NP + C_HG + h * 64; bf16* op = M.OC + (size_t)row * D + 256 + h * 64;
    for (int v = 0; v < 64; ++v) op[v] = f2bf((o0[v] + o1[v]) * r * M.hg_norm_g[h * 64 + v] * silu_f(bf2f(gp[v])));
}
HD void ret_fin_item(const Mix& M, int item) {
    const int row = item >> 2, h = item & 3;
    const float* o0 = M.RO + (size_t)row * 256 + h * 64; const float* o1 = o0 + (size_t)NTOK * 256;
    float s = 0.f;
    for (int v = 0; v < 64; ++v) s += o0[v] + o1[v];
    const float mu = s * (1.0f / 64.0f); float q = 0.f;
    for (int v = 0; v < 64; ++v) { const float d = o0[v] + o1[v] - mu; q += d * d; }
    const float r = 1.0f / sqrtf(q * (1.0f / 64.0f) + NORM_EPS);
    const bf16* gp = M.P + (size_t)row * NP + C_RG + h * 64; bf16* op = M.OC + (size_t)row * D + 768 + h * 64;
    for (int v = 0; v < 64; ++v) op[v] = f2bf(((o0[v] + o1[v] - mu) * r * M.gn_g[h * 64 + v] + M.gn_b[h * 64 + v]) * silu_f(bf2f(gp[v])));
}

HD void hg_local_item(const Mix& M, int item) {
    const int v = item & 63, c = (item >> 6) % NCH, seq = item / (64 * NCH), h = seq & 3, b = (seq >> 2) % NB, dir = seq / (4 * NB);
    float S[64];
#pragma unroll
    for (int k = 0; k < 64; ++k) S[k] = 0.f;
    float dk = 1.0f;
    for (int i = 0; i < CH; ++i) {
        const int row = row_of(b, dir_tq(dir, c * CH + i));
        const bf16* p = M.P + (size_t)row * NP; const float* f = M.HF + ((size_t)dir * NTOK + row) * 256 + h * 64;
        const float vv = bf2f(p[C_HI + h * 64 + v]); float acc = 0.f;
        dk *= f[v]; M.HQC[((size_t)dir * NTOK + row) * 256 + h * 64 + v] = bf2f(p[C_HQ + h * 64 + v]) * dk * 0.125f;
#pragma unroll
        for (int c8 = 0; c8 < 8; ++c8) { float q8[8], fa[4], fb[4]; ld8(p + C_HQ + h * 64 + 8 * c8, q8); ld4f(f + 8 * c8, fa); ld4f(f + 8 * c8 + 4, fb);
#pragma unroll
            for (int j = 0; j < 8; ++j) { const int k = 8 * c8 + j; const float fk = j < 4 ? fa[j] : fb[j - 4]; S[k] = fk * (S[k] - vv) + vv; acc += q8[j] * S[k]; }
            if ((c8 & 1) == 1) CBAR(); }
        M.HO[((size_t)dir * NTOK + row) * 256 + h * 64 + v] = acc * 0.125f;
    }
    float* u = M.HU + ((size_t)seq * NCH + c) * 4096 + v;
#pragma unroll
    for (int k = 0; k < 64; ++k) u[k * 64] = S[k];
    M.HDK[((size_t)seq * NCH + c) * 64 + v] = dk;
}
HD void hg_carry_item(const Mix& M, int item) {
    const int kv = item & 4095, seq = item >> 12, k = kv >> 6; float s = 0.f;
#pragma unroll 8
    for (int c = 0; c < NCH; ++c) { float* u = M.HU + ((size_t)seq * NCH + c) * 4096 + kv; const float uu = *u; *u = s; s = M.HDK[((size_t)seq * NCH + c) * 64 + k] * s + uu; }
}
HD void hg_fix_item(const Mix& M, int item) {
    const int v = item & 63, c = (item >> 6) % NCH, seq = item / (64 * NCH), h = seq & 3, b = (seq >> 2) % NB, dir = seq / (4 * NB);
    if (c == 0) return;
    float S[64]; const float* u = M.HU + ((size_t)seq * NCH + c) * 4096 + v;
#pragma unroll
    for (int k = 0; k < 64; ++k) S[k] = u[k * 64];
    for (int i = 0; i < CH; ++i) {
        const int row = row_of(b, dir_tq(dir, c * CH + i));
        const float* qc = M.HQC + ((size_t)dir * NTOK + row) * 256 + h * 64; float acc = 0.f;
#pragma unroll
        for (int c4 = 0; c4 < 16; ++c4) { float qa[4]; ld4f(qc + 4 * c4, qa);
#pragma unroll
            for (int j = 0; j < 4; ++j) acc += qa[j] * S[4 * c4 + j];
            if ((c4 & 3) == 3) CBAR(); }
        M.HO[((size_t)dir * NTOK + row) * 256 + h * 64 + v] += acc;
    }
}
HD void ret_local_item(const Mix& M, int item) {
    const int v = item & 63, c = (item >> 6) % NCH, seq = item / (64 * NCH), h = seq & 3, b = (seq >> 2) % NB, dir = seq / (4 * NB);
    const float g = expf(M.log_gamma[dir * 4 + h]);
    float S[32];
#pragma unroll
    for (int k = 0; k < 32; ++k) S[k] = 0.f;
    float gp = 1.0f;
    for (int i = 0; i < CH; ++i) {
        const int row = row_of(b, dir_tq(dir, c * CH + i));
        const float vv = bf2f(M.P[(size_t)row * NP + C_RV + h * 64 + v]);
        const float* qk = M.RQ + (size_t)row * 128 + h * 32; const float* kk = M.RK + (size_t)row * 128 + h * 32; float acc = 0.f;
        gp *= g; if (v < 32) M.RQC[((size_t)dir * NTOK + row) * 128 + h * 32 + v] = qk[v] * gp;
#pragma unroll
        for (int c4 = 0; c4 < 8; ++c4) { float qa[4], ka[4]; ld4f(qk + 4 * c4, qa); ld4f(kk + 4 * c4, ka);
#pragma unroll
            for (int j = 0; j < 4; ++j) { const int k = 4 * c4 + j; S[k] = g * S[k] + ka[j] * vv; acc += qa[j] * S[k]; }
            if ((c4 & 3) == 3) CBAR(); }
        M.RO[((size_t)dir * NTOK + row) * 256 + h * 64 + v] = acc;
    }
    float* u = M.RU + ((size_t)seq * NCH + c) * 2048 + v;
#pragma unroll
    for (int k = 0; k < 32; ++k) u[k * 64] = S[k];
}
HD void ret_carry_item(const Mix& M, int item) {
    const int kv = item & 2047, seq = item >> 11, h = seq & 3, dir = seq / (4 * NB); float s = 0.f;
    const float d = expf((float)CH * M.log_gamma[dir * 4 + h]);
#pragma unroll 8
    for (int c = 0; c < NCH; ++c) { float* u = M.RU + ((size_t)seq * NCH + c) * 2048 + kv; const float uu = *u; *u = s; s = d * s + uu; }
}
HD void ret_fix_item(const Mix& M, int item) {
    const int v = item & 63, c = (item >> 6) % NCH, seq = item / (64 * NCH), h = seq & 3, b = (seq >> 2) % NB, dir = seq / (4 * NB);
    if (c == 0) return;
    float S[32]; const float* u = M.RU + ((size_t)seq * NCH + c) * 2048 + v;
#pragma unroll
    for (int k = 0; k < 32; ++k) S[k] = u[k * 64];
    for (int i = 0; i < CH; ++i) {
        const int row = row_of(b, dir_tq(dir, c * CH + i));
        const float* qc = M.RQC + ((size_t)dir * NTOK + row) * 128 + h * 32; float acc = 0.f;
#pragma unroll
        for (int c4 = 0; c4 < 8; ++c4) { float qa[4]; ld4f(qc + 4 * c4, qa);
#pragma unroll
            for (int j = 0; j < 4; ++j) acc += qa[j] * S[4 * c4 + j];
            if ((c4 & 3) == 3) CBAR(); }
        M.RO[((size_t)dir * NTOK + row) * 256 + h * 64 + v] += acc;
    }
}
namespace pg8 {
#define PG8_LAS __attribute__((address_space(3)))
typedef unsigned short bf16_t;
typedef short bf16x8 __attribute__((ext_vector_type(8)));
typedef float f32x4 __attribute__((ext_vector_type(4)));
typedef unsigned u32x4 __attribute__((ext_vector_type(4)));
constexpr int BM = 256, BK = 64, HALF = 128, HTB = HALF * BK * 2  , STAGE_BYTES = 8 * HTB, NXCD = 8, WGM = 8;

__host__ __device__ __forceinline__ int lds_byte(int r, int c) { const int st = (r >> 4) * 2 + (c >> 5), rr = r & 15, cc = c & 31, ob = rr * 64 + cc * 2; return st * 1024 + (ob ^ (((ob >> 9) & 1) << 5)); }
__host__ __device__ __forceinline__ void stage_rc(int b, int& R, int& C) { const int st = b / 1024, sb = b % 1024, swz = sb ^ (((sb >> 9) & 1) << 5); R = (st >> 1) * 16 + swz / 64; C = (st & 1) * 32 + (swz % 64) / 2; }
__host__ __device__ __forceinline__ int perm32(int rho) { const int n = rho >> 4, i = rho & 15; return 8 * (i >> 2) + 4 * n + (i & 3); }

struct Unit { int pm, pn; };
struct Gemm { const bf16_t* A; const bf16_t* Bt; int M, N, K; };

struct StaticOrder {
    int nM, nN, nwg, G, c;
    __host__ __device__ void init(int M, int N, int G_, int c_) { nM = M / BM; nN = N / BM; nwg = nM * nN; G = G_; c = c_; }
    __host__ __device__ bool next(int i, Unit& u) const {
        const long L = (long)i * G + c; if (L >= nwg) return false;
        int wgid = (int)L; { const int q = nwg / NXCD, r = nwg % NXCD, xcd = wgid % NXCD, off = wgid / NXCD; wgid = (xcd < r ? xcd * (q + 1) : r * (q + 1) + (xcd - r) * q) + off; }
        const int nig = WGM * nN, gid = wgid / nig, fm = gid * WGM, gsz = (nM - fm) < WGM ? (nM - fm) : WGM;
        u.pm = fm + ((wgid % nig) % gsz); u.pn = (wgid % nig) / gsz; return true;
    }
    __device__ __forceinline__ void a_ready(const Unit&) const {}
    __device__ __forceinline__ void done(const Unit&) const {}
};

__device__ __forceinline__ unsigned cvt_pk_bf16(float lo, float hi) { unsigned r; asm volatile("v_cvt_pk_bf16_f32 %0, %1, %2" : "=v"(r) : "v"(lo), "v"(hi)); return r; }
typedef unsigned u32x2 __attribute__((ext_vector_type(2)));
struct EpiBf16P {
    static constexpr bool PERM = true, AFTER_DRAIN = false;
    bf16_t* O; int ldc; int nN;
    __device__ __forceinline__ void operator()(const f32x4 (&acc)[2][2][4][2], const Unit& u, int wr, int wc, int fr, int fq) const {
        const int row0 = u.pm * BM + wr * 64 + fr, col0 = (u.pn % nN) * BM + wc * 32 + 8 * fq;
#pragma unroll
        for (int ai = 0; ai < 2; ++ai)
#pragma unroll
            for (int m = 0; m < 4; ++m) { bf16_t* rowp = O + (size_t)(row0 + ai * HALF + m * 16) * ldc + col0;
#pragma unroll
                for (int bj = 0; bj < 2; ++bj) { const f32x4 v0 = acc[ai][bj][m][0], v1 = acc[ai][bj][m][1];
                    u32x4 w; w.x = cvt_pk_bf16(v0[0], v0[1]); w.y = cvt_pk_bf16(v0[2], v0[3]); w.z = cvt_pk_bf16(v1[0], v1[1]); w.w = cvt_pk_bf16(v1[2], v1[3]);
                    *(u32x4*)(rowp + bj * HALF) = w; } }
    }
};
struct EpiRes {
    static constexpr bool PERM = false, AFTER_DRAIN = false;
    float* H; const float* gate; int lat_tiles, tiles_per_batch, ctx_bidx;
    __device__ __forceinline__ void operator()(const f32x4 (&acc)[2][2][4][2], const Unit& u, int wr, int wc, int fr, int fq) const {
        const int bidx = u.pm < lat_tiles ? u.pm / tiles_per_batch : ctx_bidx;
        const float* g = gate + (size_t)bidx * 6144;
        const int row0 = u.pm * BM + wr * 64 + fr, col0 = u.pn * BM + wc * 32 + 4 * fq;
        f32x4 gv[2][2];
#pragma unroll
        for (int bj = 0; bj < 2; ++bj)
#pragma unroll
            for (int n = 0; n < 2; ++n) gv[bj][n] = *(const f32x4*)(g + col0 + bj * HALF + n * 16);
#pragma unroll
        for (int ai = 0; ai < 2; ++ai)
#pragma unroll
            for (int m = 0; m < 4; ++m) { float* rowp = H + (size_t)(row0 + ai * HALF + m * 16) * 1024 + col0;
#pragma unroll
                for (int bj = 0; bj < 2; ++bj)
#pragma unroll
                    for (int n = 0; n < 2; ++n) { f32x4* p = (f32x4*)(rowp + bj * HALF + n * 16); *p = *p + gv[bj][n] * acc[ai][bj][m][n]; } }
    }
};
struct EpiSwiglu {
    static constexpr bool PERM = true, AFTER_DRAIN = false;
    bf16_t* O; int ldo; int nN;
    __device__ __forceinline__ void operator()(const f32x4 (&acc)[2][2][4][2], const Unit& u, int wr, int wc, int fr, int fq) const {
        const int row0 = u.pm * BM + wr * 64 + fr, col0 = (u.pn % nN) * 128 + wc * 16 + 4 * fq;
#pragma unroll
        for (int ai = 0; ai < 2; ++ai)
#pragma unroll
            for (int m = 0; m < 4; ++m) { bf16_t* rowp = O + (size_t)(row0 + ai * HALF + m * 16) * ldo + col0;
#pragma unroll
                for (int bj = 0; bj < 2; ++bj) { const f32x4 gt = acc[ai][bj][m][0], up = acc[ai][bj][m][1]; float r[4];
#pragma unroll
                    for (int i = 0; i < 4; ++i) r[i] = gt[i] * __builtin_amdgcn_rcpf(1.0f + __builtin_amdgcn_exp2f(-1.4426950408889634f * gt[i])) * up[i];
                    u32x2 w; w.x = cvt_pk_bf16(r[0], r[1]); w.y = cvt_pk_bf16(r[2], r[3]);
                    *(u32x2*)(rowp + bj * 64) = w; } }
    }
};
struct MoeOrder {
    const unsigned* list; int nwg, G, c;
    __device__ __forceinline__ bool next(int i, Unit& u) const {
        const long L = (long)i * G + c; if (L >= nwg) return false;
        unsigned w; const unsigned* ptr = list + L;
        asm volatile("s_load_dword %0, %1, 0x0\n\ts_waitcnt lgkmcnt(0)" : "=s"(w) : "s"(ptr) : "memory");
        u.pm = (int)(w & 0xffffu); u.pn = (int)(w >> 16); return true;
    }
    __device__ __forceinline__ void a_ready(const Unit&) const {}
    __device__ __forceinline__ void done(const Unit&) const {}
};
template <class Epi, class Sched, bool ALIGN_EPI = false, bool SP2 = false>
__device__ __forceinline__ void gemm_phase(PG8_LAS unsigned char* lds, const Gemm g, const Sched& S, const Epi& E, const int tid_in) {
    const int tid = tid_in, wid = __builtin_amdgcn_readfirstlane(tid >> 6), lane = tid & 63, wr = wid >> 2, wc = wid & 3, fr = lane & 15, fq = lane >> 4;
    const int K = g.K, nt = K / BK;
    unsigned voffA[2], voffB[2];
#pragma unroll
    for (int i = 0; i < 2; ++i) { int R, C; stage_rc(tid * 16 + i * 8192, R, C); const int Rb = Epi::PERM ? ((R & ~31) + perm32(R & 31)) : R;
        voffA[i] = (unsigned)(R * K + C) * 2u; voffB[i] = (unsigned)(Rb * K + C) * 2u; }
    const size_t kstep = (size_t)(BK * 2);
    const size_t hstep = (size_t)HALF * K * 2;
    const size_t tstep = 2 * hstep;
    const unsigned ldsw = (unsigned)wid * 1024u;
    const int aoff = lds_byte(wr * 64 + fr, fq * 8), boff = lds_byte(wc * 32 + fr, fq * 8);
#define PG8_SA(b, h) (((b) * 2 + (h)) * HTB)
#define PG8_SB(b, h) ((4 + (b) * 2 + (h)) * HTB)
#define PG8_STAGE(bufoff, gbase, voff) do { _Pragma("unroll") for (int _i = 0; _i < 2; ++_i) \
        __builtin_amdgcn_global_load_lds((const unsigned*)((const char*)(gbase) + (voff)[_i]), (PG8_LAS unsigned*)(lds + (bufoff) + ldsw + _i * 8192), 16, 0, 0); } while (0)
#define PG8_LDA(dst, b, h) do { _Pragma("unroll") for (int m = 0; m < 4; ++m) _Pragma("unroll") for (int k = 0; k < 2; ++k) dst[m][k] = *(const PG8_LAS bf16x8*)(lds + PG8_SA(b, h) + aoff + m * 2048 + k * 1024); } while (0)
#define PG8_LDB(dst, b, h) do { _Pragma("unroll") for (int n = 0; n < 2; ++n) _Pragma("unroll") for (int k = 0; k < 2; ++k) dst[n][k] = *(const PG8_LAS bf16x8*)(lds + PG8_SB(b, h) + boff + n * 2048 + k * 1024); } while (0)
#define PG8_MMA(ai, bj, At, Bt) do { __builtin_amdgcn_s_setprio(1); _Pragma("unroll") for (int m = 0; m < 4; ++m) _Pragma("unroll") for (int n = 0; n < 2; ++n) _Pragma("unroll") for (int k = 0; k < 2; ++k) \
        acc[ai][bj][m][n] = __builtin_amdgcn_mfma_f32_16x16x32_bf16(Bt[n][k], At[m][k], acc[ai][bj][m][n], 0, 0, 0); __builtin_amdgcn_s_setprio(0); } while (0)
#define PG8_WAIT_V(n) asm volatile("s_waitcnt vmcnt(" #n ")" ::: "memory")
#define PG8_WAIT_L(n) asm volatile("s_waitcnt lgkmcnt(" #n ")" ::: "memory")
#define PG8_BAR __builtin_amdgcn_s_barrier()
#define PG8_SCHED __builtin_amdgcn_sched_barrier(0)
    Unit cur, nxt; int ui = 0;
    if (!S.next(0, cur)) return;
    f32x4 acc[2][2][4][2];
#pragma unroll
    for (int a = 0; a < 2; ++a)
#pragma unroll
        for (int b = 0; b < 2; ++b)
#pragma unroll
            for (int m = 0; m < 4; ++m)
#pragma unroll
                for (int n = 0; n < 2; ++n) acc[a][b][m][n] = (f32x4){0.f, 0.f, 0.f, 0.f};
    bf16x8 At[4][2], B0[2][2], B1[2][2];
    const char* cA = (const char*)g.A + (size_t)cur.pm * tstep; const char* cB = (const char*)g.Bt + (size_t)cur.pn * tstep;
    S.a_ready(cur);
    if constexpr (SP2) {
        PG8_STAGE(PG8_SB(0, 0), cB, voffB); PG8_STAGE(PG8_SB(0, 1), cB + hstep, voffB); PG8_STAGE(PG8_SA(0, 0), cA, voffA); PG8_STAGE(PG8_SA(0, 1), cA + hstep, voffA);
        if (wr == 1) PG8_BAR;
        PG8_WAIT_V(2); PG8_BAR;
        PG8_STAGE(PG8_SB(1, 0), cB + kstep, voffB); PG8_STAGE(PG8_SA(1, 0), cA + kstep, voffA); PG8_STAGE(PG8_SB(1, 1), cB + hstep + kstep, voffB);
        PG8_WAIT_V(6); PG8_BAR;
    } else {
        PG8_STAGE(PG8_SB(0, 0), cB, voffB); PG8_STAGE(PG8_SA(0, 0), cA, voffA); PG8_STAGE(PG8_SB(0, 1), cB + hstep, voffB); PG8_STAGE(PG8_SA(0, 1), cA + hstep, voffA);
        if (wr == 1) PG8_BAR;
        PG8_WAIT_V(4); PG8_BAR;
        PG8_STAGE(PG8_SB(1, 0), cB + kstep, voffB); PG8_STAGE(PG8_SA(1, 0), cA + kstep, voffA); PG8_STAGE(PG8_SB(1, 1), cB + hstep + kstep, voffB);
        PG8_WAIT_V(6); PG8_BAR;
    }
    for (;;) {
        const bool has_next = S.next(ui + 1, nxt);
        const char* nA = has_next ? (const char*)g.A + (size_t)nxt.pm * tstep : cA; const char* nB = has_next ? (const char*)g.Bt + (size_t)nxt.pn * tstep : cB;
        for (int t = 0; t < nt; t += 2) {
            const bool last = (t == nt - 2);
            const char* a1 = cA + (size_t)(t + 1) * kstep;
            const char* a2 = last ? nA : cA + (size_t)(t + 2) * kstep; const char* b2 = last ? nB : cB + (size_t)(t + 2) * kstep;
            const char* a3 = a2 + kstep; const char* b3 = b2 + kstep;
            if (last && has_next) S.a_ready(nxt);
            if constexpr (SP2) {
            PG8_LDB(B0, 0, 0); PG8_LDB(B1, 0, 1); PG8_SCHED; PG8_LDA(At, 0, 0); PG8_STAGE(PG8_SA(1, 1), a1 + hstep, voffA);
            PG8_WAIT_V(8); PG8_WAIT_L(0); PG8_BAR; PG8_MMA(0, 0, At, B0); PG8_MMA(0, 1, At, B1); PG8_BAR; PG8_SCHED;
            PG8_LDA(At, 0, 1); PG8_STAGE(PG8_SB(0, 0), b2, voffB); PG8_STAGE(PG8_SB(0, 1), b2 + hstep, voffB); PG8_STAGE(PG8_SA(0, 0), a2, voffA);
            PG8_WAIT_V(8); PG8_WAIT_L(0); PG8_BAR; PG8_MMA(1, 0, At, B0); PG8_MMA(1, 1, At, B1); PG8_BAR; PG8_SCHED;
            PG8_LDB(B0, 1, 0); PG8_LDB(B1, 1, 1); PG8_SCHED; PG8_LDA(At, 1, 0); PG8_STAGE(PG8_SA(0, 1), a2 + hstep, voffA);
            PG8_WAIT_V(8); PG8_WAIT_L(0); PG8_BAR; PG8_MMA(0, 0, At, B0); PG8_MMA(0, 1, At, B1); PG8_BAR; PG8_SCHED;
            PG8_LDA(At, 1, 1); PG8_STAGE(PG8_SB(1, 0), b3, voffB); PG8_STAGE(PG8_SB(1, 1), b3 + hstep, voffB); PG8_STAGE(PG8_SA(1, 0), a3, voffA);
            PG8_WAIT_V(8); PG8_WAIT_L(0); PG8_BAR; PG8_MMA(1, 0, At, B0); PG8_MMA(1, 1, At, B1); PG8_BAR; PG8_SCHED;
            } else {
            PG8_LDB(B0, 0, 0); PG8_SCHED; PG8_LDA(At, 0, 0); PG8_STAGE(PG8_SA(1, 1), a1 + hstep, voffA);
            PG8_WAIT_L(8); PG8_BAR; PG8_WAIT_L(0); PG8_MMA(0, 0, At, B0); PG8_BAR; PG8_SCHED;
            PG8_LDB(B1, 0, 1); PG8_STAGE(PG8_SB(0, 0), b2, voffB);
            PG8_BAR; PG8_WAIT_L(0); PG8_MMA(0, 1, At, B1); PG8_BAR;
            PG8_LDA(At, 0, 1); PG8_STAGE(PG8_SA(0, 0), a2, voffA);
            PG8_BAR; PG8_WAIT_L(0); PG8_MMA(1, 0, At, B0); PG8_BAR; PG8_SCHED;
            PG8_STAGE(PG8_SB(0, 1), b2 + hstep, voffB);
            PG8_WAIT_V(6); PG8_BAR; PG8_MMA(1, 1, At, B1); PG8_BAR;
            PG8_LDB(B0, 1, 0); PG8_SCHED; PG8_LDA(At, 1, 0); PG8_STAGE(PG8_SA(0, 1), a2 + hstep, voffA);
            PG8_WAIT_L(8); PG8_BAR; PG8_WAIT_L(0); PG8_MMA(0, 0, At, B0); PG8_BAR; PG8_SCHED;
            PG8_LDB(B1, 1, 1); PG8_STAGE(PG8_SB(1, 0), b3, voffB);
            PG8_BAR; PG8_WAIT_L(0); PG8_MMA(0, 1, At, B1); PG8_BAR;
            PG8_LDA(At, 1, 1); PG8_STAGE(PG8_SA(1, 0), a3, voffA);
            PG8_BAR; PG8_WAIT_L(0); PG8_MMA(1, 0, At, B0); PG8_BAR; PG8_SCHED;
            PG8_STAGE(PG8_SB(1, 1), b3 + hstep, voffB);
            PG8_WAIT_V(6); PG8_BAR; PG8_MMA(1, 1, At, B1); PG8_BAR;
            }
        }
        if constexpr (ALIGN_EPI) { if (wr == 0) PG8_BAR; }
        if constexpr (!Epi::AFTER_DRAIN) { unsigned z_ = 0u; asm volatile("" : "+v"(z_)); const int l2_ = (int)__builtin_amdgcn_mbcnt_hi(~0u, __builtin_amdgcn_mbcnt_lo(~0u, z_)); E(acc, cur, wr, wc, l2_ & 15, l2_ >> 4); S.done(cur); }
        if (!has_next) break;
#pragma unroll
        for (int a = 0; a < 2; ++a)
#pragma unroll
            for (int b = 0; b < 2; ++b)
#pragma unroll
                for (int m = 0; m < 4; ++m)
#pragma unroll
                    for (int n = 0; n < 2; ++n) acc[a][b][m][n] = (f32x4){0.f, 0.f, 0.f, 0.f};
        cur = nxt; cA = nA; cB = nB; ++ui;
        if constexpr (ALIGN_EPI) { if (wr == 1) PG8_BAR; }
    }
    PG8_WAIT_V(0);
    if constexpr (!ALIGN_EPI) { if (wr == 0) PG8_BAR; }
    PG8_BAR;
    if constexpr (Epi::AFTER_DRAIN) { E.fused(acc, cur, wr, wc, fr, fq, lds, wid, lane); S.done(cur); }
#undef PG8_SA
#undef PG8_SB
#undef PG8_STAGE
#undef PG8_LDA
#undef PG8_LDB
#undef PG8_MMA
#undef PG8_WAIT_V
#undef PG8_WAIT_L
#undef PG8_BAR
#undef PG8_SCHED
}
}
#ifndef LAS
#define LAS __attribute__((address_space(3)))
#endif
#define XB_TMO      128
#define XB_XCNT(j)  (256  + 64 * (j))
#define XB_XSUB(j)  (1280 + 64 * (j))
#define XB_XGEN(j)  (2304 + 64 * (j))
#define XB_TOP      3328
#define XB_TOPGEN   3392
#define XCD_BAR_WORDS 3456
#define XB_SPIN_CAP (1u << 24)

__device__ __forceinline__ unsigned xb_ld(unsigned* p)              { return __hip_atomic_load(p, __ATOMIC_RELAXED, __HIP_MEMORY_SCOPE_AGENT); }
__device__ __forceinline__ unsigned xb_add(unsigned* p, unsigned v) { return __hip_atomic_fetch_add(p, v, __ATOMIC_RELAXED, __HIP_MEMORY_SCOPE_AGENT); }
__device__ __forceinline__ unsigned xb_xcc_id() { return (unsigned)__builtin_amdgcn_s_getreg((3 << 11) | 20) & 0xFu; }
#define XB_SPIN(cond, bar) do { unsigned _sp = 0; while (cond) { __builtin_amdgcn_s_sleep(1); \
    if ((++_sp & 255u) == 0u) { if (xb_ld(&(bar)[XB_TMO])) break; if (_sp > XB_SPIN_CAP) { atomicAdd(&(bar)[XB_TMO], 1u); break; } } } } while (0)

struct XcdBarrier {
    int w;
    unsigned* bar; unsigned x;
    volatile LAS unsigned* st;
};

__device__ __forceinline__ bool xb_thread0(int w) { unsigned z = 0u; asm volatile("" : "+v"(z), "+s"(w)); return w == 0 && __builtin_amdgcn_mbcnt_hi(~0u, __builtin_amdgcn_mbcnt_lo(~0u, z)) == 0u; }
__device__ __forceinline__ XcdBarrier xcd_barrier_post(unsigned* bar, volatile LAS unsigned* st, int w) {
    XcdBarrier b; b.w = w; b.bar = bar; b.x = xb_xcc_id(); b.st = st;
    if (xb_thread0(w)) (void)xb_add(&bar[XB_XCNT(b.x)], 1u);
    return b;
}
__device__ __forceinline__ void xcd_barrier_complete(unsigned* bar, unsigned x, unsigned& nloc, unsigned& nx) {
    const unsigned G = gridDim.x * gridDim.y * gridDim.z;
    unsigned sum, cnt, mine, sp = 0u;
    for (;;) {
        sum = 0u; cnt = 0u; mine = 0u;
#pragma unroll
        for (unsigned j = 0; j < 16; ++j) { const unsigned c = xb_ld(&bar[XB_XCNT(j)]); sum += c; cnt += (c > 0u) ? 1u : 0u; mine = (j == x) ? c : mine; }
        if (sum == G) break;
        __builtin_amdgcn_s_sleep(1);
        if ((++sp & 255u) == 0u) { if (xb_ld(&bar[XB_TMO])) break; if (sp > XB_SPIN_CAP) { atomicAdd(&bar[XB_TMO], 1u); break; } }
    }
    nloc = mine > 0u ? mine : 1u; nx = cnt > 0u ? cnt : 1u;
}

__device__ __forceinline__ void xcd_barrier(const XcdBarrier& b) {
    asm volatile("s_waitcnt vmcnt(0)" ::: "memory");
    __syncthreads();
    if (xb_thread0(b.w)) {
        unsigned* bar = b.bar;
        __builtin_amdgcn_s_waitcnt(0);
        unsigned nloc = b.st[0], nx = b.st[1];
        if (nloc == 0u) { xcd_barrier_complete(bar, b.x, nloc, nx); b.st[0] = nloc; b.st[1] = nx; }
        const unsigned old = xb_add(&bar[XB_XSUB(b.x)], 1u);
        const unsigned gen = old / nloc;
        if (old + 1u == (gen + 1u) * nloc) {
            __builtin_amdgcn_fence(__ATOMIC_RELEASE, "agent");
            asm volatile("s_waitcnt vmcnt(0)" ::: "memory");
            const unsigned og = xb_add(&bar[XB_TOP], 1u);
            const unsigned tg = og / nx;
            if (og + 1u == (tg + 1u) * nx) xb_add(&bar[XB_TOPGEN], 1u);
            else XB_SPIN(xb_ld(&bar[XB_TOPGEN]) == tg, bar);
            __builtin_amdgcn_fence(__ATOMIC_ACQUIRE, "agent");
            xb_add(&bar[XB_XGEN(b.x)], 1u);
            asm volatile("s_waitcnt vmcnt(0)" ::: "memory");
        } else {
            XB_SPIN(xb_ld(&bar[XB_XGEN(b.x)]) == gen, bar);
            __builtin_amdgcn_fence(__ATOMIC_ACQUIRE, "agent");
            asm volatile("s_waitcnt vmcnt(0)" ::: "memory");
        }
    }
    __syncthreads();
}
constexpr int NWAVES = 8, NTHREADS = NWAVES * 64;
constexpr size_t MiB = 1u << 20;
constexpr size_t WS_CTL = 0, CTL_ZERO_BYTES = 1 * MiB;
constexpr size_t WS_SMALL = 1 * MiB, WS_TOKINFO = 2 * MiB, WS_LIST = 3 * MiB;
constexpr size_t WS_WIN = 4 * MiB, WS_WOUT = 34 * MiB, WS_WFGU = 42 * MiB, WS_WFD = 64 * MiB, WS_WMGU = 75 * MiB, WS_WMD = 187 * MiB;
constexpr size_t WS_H = 243 * MiB, WS_A = 315 * MiB, WS_OC = 351 * MiB, WS_Y = 387 * MiB, WS_AM = 463 * MiB, WS_BIG = 539 * MiB;
constexpr size_t WS_P = WS_BIG, WS_QM = 674 * MiB, WS_KM = WS_QM + 14155776, WS_VM = WS_KM + 14155776, WS_QS = 710 * MiB, WS_KS = WS_QS + 9437184, WS_VS = WS_KS + 4718592;
constexpr size_t WS_HF = 728 * MiB, WS_HO = 764 * MiB, WS_RQ = 800 * MiB, WS_RK = 809 * MiB, WS_RO = 818 * MiB, WS_HQC = 854 * MiB, WS_HU = 890 * MiB, WS_HDK = 922 * MiB, WS_RQC = 923 * MiB, WS_RU = 941 * MiB, WS_TAB = 957 * MiB, WS_END = 959 * MiB;
constexpr size_t WS_ACT = WS_BIG;
constexpr int MAXTILES = 152;
static_assert(WS_P + (size_t)NTOK * NP * 2 <= WS_QM && WS_VM + (size_t)NB * 4 * TK * 64 * 2 <= WS_QS && WS_VS + 4718592 <= WS_HF, "ws map 1");
static_assert(WS_HQC + (size_t)2 * NTOK * 256 * 4 <= WS_HU && WS_HU + (size_t)2 * NB * 4 * NCH * 4096 * 4 <= WS_HDK && WS_RQC + (size_t)2 * NTOK * 128 * 4 <= WS_RU && WS_RU + (size_t)2 * NB * 4 * NCH * 2048 * 4 <= WS_END, "ws map 3");
static_assert(WS_ACT + (size_t)MAXTILES * 256 * DFE * 2 <= WS_END && (size_t)MAXTILES * 256 * D * 2 <= 76 * MiB, "ws map 2");
constexpr int SM_MOD = 0;
constexpr int SM_LOGLB = 4 * 9 * 6144, SM_LOG1M = SM_LOGLB + 4 * 512, SM_LGAM = SM_LOG1M + 4 * 512, SM_META = SM_LGAM + 64, SM_ULIST = SM_META + 32;
constexpr int ULIST_GU = 0, ULIST_D = MAXTILES * 28;
static_assert((SM_ULIST + 2 * MAXTILES * 32) * 4 <= (int)MiB, "small region");
constexpr int CW_BAR = 4096, CW_CNT = 8192;
constexpr int LDS_BYTES = 147456, MISC_OFF = 131072 + 320;

#define GAS __attribute__((address_space(1)))
#define LAS __attribute__((address_space(3)))
typedef float f32x4 __attribute__((ext_vector_type(4)));
typedef unsigned v4u __attribute__((ext_vector_type(4)));
typedef unsigned v2u __attribute__((ext_vector_type(2)));
#define LDS_WAIT() asm volatile("s_waitcnt lgkmcnt(0)" ::: "memory")

struct Args { const float* in[28]; float* out; unsigned char* ws; int ph_lo, ph_hi; };
typedef __attribute__((address_space(4))) const unsigned long long ka_u64;
__device__ __forceinline__ const float* IN(int i) { ka_u64* ka = (ka_u64*)__builtin_amdgcn_kernarg_segment_ptr(); asm volatile("" : "+s"(ka)); return (const float*)ka[i]; }
__device__ __forceinline__ float* OUTP() { ka_u64* ka = (ka_u64*)__builtin_amdgcn_kernarg_segment_ptr(); asm volatile("" : "+s"(ka)); return (float*)ka[28]; }
__device__ __forceinline__ unsigned char* WSBASE() { ka_u64* ka = (ka_u64*)__builtin_amdgcn_kernarg_segment_ptr(); asm volatile("" : "+s"(ka)); return (unsigned char*)ka[29]; }
struct Frame {
    LAS unsigned char* lds;
    int tid, lane, wave, gtid, NT, gw, NGW;
    __device__ __forceinline__ unsigned char* base() const { return WSBASE(); }
};
#define WSP(T, off) ((T*)(ws + (off)))
#define F_ctl WSP(unsigned, WS_CTL)
#define F_sm WSP(float, WS_SMALL)
#define F_tokinfo WSP(int, WS_TOKINFO)
#define F_list WSP(int, WS_LIST)
#define F_H WSP(float, WS_H)
#define F_A WSP(bf16, WS_A)
#define F_OC WSP(bf16, WS_OC)
#define F_Y WSP(bf16, WS_Y)
#define F_AM WSP(bf16, WS_AM)
#define F_P WSP(bf16, WS_P)
#define F_ACT WSP(bf16, WS_ACT)
#define F_WIN WSP(bf16, WS_WIN)
#define F_WOUT WSP(bf16, WS_WOUT)
#define F_WFGU WSP(bf16, WS_WFGU)
#define F_WFD WSP(bf16, WS_WFD)
#define F_WMGU WSP(bf16, WS_WMGU)
#define F_WMD WSP(bf16, WS_WMD)
__device__ __forceinline__ float wave_sum(float v, int lane) {
#pragma unroll
    for (int o = 1; o < 64; o <<= 1) v += __int_as_float(__builtin_amdgcn_ds_bpermute((lane ^ o) << 2, __float_as_int(v)));
    return v;
}
__device__ __forceinline__ unsigned pk2(float lo, float hi) { return (unsigned)f2bf(lo) | ((unsigned)f2bf(hi) << 16); }

constexpr int TAB_MLA = 0, TAB_SWA = NL * 16 * 2, TAB_RET = TAB_SWA + NL * 32 * 2, TAB_FLOATS = TAB_RET + TK * 16 * 2;
__device__ __forceinline__ void build_tables(float* tab, int gtid, int NT) {
    for (int it = gtid; it < NL * 16; it += NT) { const int t = it >> 4, j = it & 15; const float inv = powf(10000.0f, -(float)(j & 7) / 8.0f), ang = (float)(j < 8 ? t / GRIDW : t % GRIDW) * inv;
        tab[TAB_MLA + 2 * it] = cosf(ang); tab[TAB_MLA + 2 * it + 1] = sinf(ang); }
    for (int it = gtid; it < NL * 32; it += NT) { const int t = it >> 5, j = it & 31; const float inv = powf(10000.0f, -(float)(j & 15) / 16.0f), ang = (float)(j < 16 ? t / GRIDW : t % GRIDW) * inv;
        tab[TAB_SWA + 2 * it] = cosf(ang); tab[TAB_SWA + 2 * it + 1] = sinf(ang); }
    for (int it = gtid; it < TK * 16; it += NT) { const int tq = it >> 4, j = it & 15; const float inv = powf(10000.0f, -(float)j / 16.0f), ang = (float)tq * inv;
        tab[TAB_RET + 2 * it] = cosf(ang); tab[TAB_RET + 2 * it + 1] = sinf(ang); }
}
static_assert((size_t)TAB_FLOATS * 4 <= 2 * MiB, "rope tables");
template <class SrcFn> __device__ __forceinline__ void transpose_item(const SrcFn& src, int K, int nblk, bf16* WT, LAS float* scr, int item, int lane) {
    const int kb = item / nblk, nb = item % nblk, k0 = 64 * kb, n0 = 32 * nb;
#pragma unroll 8
    for (int i = 0; i < 32; ++i) { const int kk = 2 * i + (lane >> 5); scr[kk * 33 + (lane & 31)] = src(k0 + kk, n0 + (lane & 31)); }
    LDS_WAIT(); asm volatile("" ::: "memory");
    const int c = lane & 7;
#pragma unroll
    for (int j = 0; j < 4; ++j) { const int n = (lane >> 3) + 8 * j; const LAS float* s = scr + (8 * c) * 33 + n;
        v4u o; o.x = pk2(s[0 * 33], s[1 * 33]); o.y = pk2(s[2 * 33], s[3 * 33]); o.z = pk2(s[4 * 33], s[5 * 33]); o.w = pk2(s[6 * 33], s[7 * 33]);
        *(v4u*)(WT + (size_t)(n0 + n) * K + k0 + 8 * c) = o; }
    LDS_WAIT(); asm volatile("" ::: "memory");
}
struct SrcPlain { const float* W; int N; __device__ __forceinline__ float operator()(int k, int n) const { return W[(size_t)k * N + n]; } };
struct SrcGU { const float* Wg; long du; int NF; __device__ __forceinline__ float operator()(int k, int c) const { const int j = c >> 3, w = c & 7; return Wg[(w < 4 ? 0l : du) + (long)k * NF + 4 * j + (w & 3)]; } };

__device__ __forceinline__ void convert_moe(Frame& F, int li) {
    unsigned char* ws = F.base();
    LAS float* scr = (LAS float*)(F.lds + 40960 + F.wave * 8704);
    constexpr int I_GU = 16 * 224, I_D = 56 * 32;
    for (int it = F.gw; it < 8 * (I_GU + I_D); it += F.NGW) {
        const int e = it / (I_GU + I_D); int r = it % (I_GU + I_D);
        if (r < I_GU) { SrcGU s{IN(24) + ((size_t)li * 8 + e) * D * DFE, (long)(IN(25) - IN(24)), DFE}; transpose_item(s, D, 224, F_WMGU + (size_t)e * 2 * DFE * D, scr, r, F.lane); }
        else { r -= I_GU; SrcPlain s{IN(26) + ((size_t)li * 8 + e) * DFE * D, D}; transpose_item(s, DFE, 32, F_WMD + (size_t)e * D * DFE, scr, r, F.lane); }
    }
}
__device__ __forceinline__ void prologue(Frame& F) {
    unsigned char* ws = F.base();
    LAS float* sil = (LAS float*)F.lds;
    for (int i = F.tid; i < 9 * 1024; i += NTHREADS) { const float cv = i < 8 * 1024 ? IN(1)[i] : IN(3)[i - 8 * 1024]; sil[i] = silu_f(cv); }
    __syncthreads();
    for (int it = F.gtid; it < DEPTH * 6144; it += F.NT) {
        const int l = it / 6144, j = it % 6144; const float* w = IN(4) + (size_t)l * D * 6144 + j;
        float acc[9];
#pragma unroll
        for (int b = 0; b < 9; ++b) acc[b] = IN(5)[l * 6144 + j];
        for (int k = 0; k < D; ++k) { const float wv = w[(size_t)k * 6144];
#pragma unroll
            for (int b = 0; b < 9; ++b) acc[b] += sil[b * 1024 + k] * wv; }
#pragma unroll
        for (int b = 0; b < 9; ++b) F_sm[SM_MOD + ((size_t)l * 9 + b) * 6144 + j] = acc[b];
    }
    for (int it = F.gtid; it < 512; it += F.NT) {
        float lg[DEPTH], mx = -1e30f, s = 0.f;
#pragma unroll
        for (int l = 0; l < DEPTH; ++l) { lg[l] = IN(14)[l * 512 + it]; mx = fmaxf(mx, lg[l]); }
#pragma unroll
        for (int l = 0; l < DEPTH; ++l) { lg[l] = expf(lg[l] - mx); s += lg[l]; }
        float cum = 0.f; const float p0 = lg[0] / s;
#pragma unroll
        for (int l = 0; l < DEPTH; ++l) { cum += lg[l] / s; const float lb = cum - p0; F_sm[SM_LOGLB + l * 512 + it] = logf(fmaxf(lb, 1e-30f)); F_sm[SM_LOG1M + l * 512 + it] = log1pf(-lb); }
    }
    for (int it = F.gtid; it < DEPTH * 8; it += F.NT) F_sm[SM_LGAM + it] = log_sigmoid_f(IN(17)[it]);
    build_tables(WSP(float, WS_TAB), F.gtid, F.NT);
    LAS float* scr = (LAS float*)(F.lds + 40960 + F.wave * 8704);
    constexpr int I_IN = 16 * 91, I_OUT = 16 * 32, I_FGU = 16 * 176, I_FD = 44 * 32;
    constexpr int N_IN = DEPTH * I_IN, N_OUT = DEPTH * I_OUT, N_FGU = 2 * I_FGU, N_FD = 2 * I_FD;
    for (int it = F.gw; it < N_IN + N_OUT + N_FGU + N_FD; it += F.NGW) {
        int r = it;
        if (r < N_IN) { const int l = r / I_IN; SrcPlain s{IN(8) + (size_t)l * D * DIN, DIN}; transpose_item(s, D, 91, F_WIN + (size_t)l * NP * D, scr, r % I_IN, F.lane); continue; } r -= N_IN;
        if (r < N_OUT) { const int l = r / I_OUT; SrcPlain s{IN(9) + (size_t)l * D * D, D}; transpose_item(s, D, 32, F_WOUT + (size_t)l * D * D, scr, r % I_OUT, F.lane); continue; } r -= N_OUT;
        if (r < N_FGU) { const int l = r / I_FGU; SrcGU s{IN(20) + (size_t)l * D * DFF, (long)(IN(21) - IN(20)), DFF}; transpose_item(s, D, 176, F_WFGU + (size_t)l * 2 * DFF * D, scr, r % I_FGU, F.lane); continue; } r -= N_FGU;
        { const int l = r / I_FD; SrcPlain s{IN(22) + (size_t)l * DFF * D, D}; transpose_item(s, DFF, 32, F_WFD + (size_t)l * D * DFF, scr, r % I_FD, F.lane); }
    }
    convert_moe(F, 0);
    for (int it = F.gtid; it < DEPTH * D * 928; it += F.NT) {
        const int n = it % 928, k = (it / 928) % D, l = it / (928 * D);
        const float* wi = IN(8) + ((size_t)l * D + k) * DIN; float acc = 0.f;
        if (n < 384) { const float* g = IN(10) + l * 192; const float* wu = IN(11) + (size_t)l * 192 * 384 + n; for (int j = 0; j < 192; ++j) acc += wi[j] * g[j] * wu[(size_t)j * 384]; }
        else if (n < 896) { const float* g = IN(12) + l * 128; const float* wu = IN(13) + (size_t)l * 128 * 512 + (n - 384); for (int j = 0; j < 128; ++j) acc += wi[192 + j] * g[j] * wu[(size_t)j * 512]; }
        F_WIN[((size_t)l * NP + DIN + n) * D + k] = f2bf(acc);
    }
}

typedef short bf16x8s __attribute__((ext_vector_type(8)));
typedef float f32x16 __attribute__((ext_vector_type(16)));
__device__ __forceinline__ int crow(int r, int hi) { return (r & 3) + 8 * (r >> 2) + 4 * hi; }
__device__ __forceinline__ float xlane32(float v, int lane) { return __int_as_float(__builtin_amdgcn_ds_bpermute((lane ^ 32) << 2, __float_as_int(v))); }
__device__ __forceinline__ unsigned cvtpk(float lo, float hi) { unsigned r; asm volatile("v_cvt_pk_bf16_f32 %0, %1, %2" : "=v"(r) : "v"(lo), "v"(hi)); return r; }

template <int DK, bool SWA>
__device__ __forceinline__ void attn_unit(LAS unsigned char* lds, const bf16* Qg, const bf16* Kg, const bf16* Vtg, bf16* OCp, int b, int hcol, int tq0,
                                          int t0a, int t1a, int t0b, int t1b, float sink2, int tid) {
    constexpr int KS = DK * 2 + 16, VS = 136, KT_BYTES = 64 * KS, STAGE = KT_BYTES + 64 * VS, KP = DK / 8, NKP = 64 * KP, NS = DK / 16;
    const int lane = tid & 63, wave = __builtin_amdgcn_readfirstlane(tid >> 6), q = lane & 31, hi = lane >> 5;
    LAS float* wsf = (LAS float*)(lds + 2 * STAGE) + wave * 64;
    const int tq = tq0 + wave * 32 + q;
    bf16x8s qf[NS];
#pragma unroll
    for (int s = 0; s < NS; ++s) qf[s] = *(const bf16x8s*)(Qg + (size_t)tq * DK + 16 * s + 8 * hi);
    f32x16 o0, o1;
#pragma unroll
    for (int r = 0; r < 16; ++r) { o0[r] = 0.f; o1[r] = 0.f; }
    float m = SWA ? sink2 : -1e30f, l = (SWA && hi == 0) ? 1.0f : 0.f;
    const int na = t1a - t0a, nt = na + (t1b - t0b);
    const int w0 = tq0 - NC + wave * 32;
    v4u kr0, kr1 = (v4u){0u, 0u, 0u, 0u}, vr;
    { const int t = na > 0 ? t0a : t0b; const v4u* kg = (const v4u*)(Kg + (size_t)t * 64 * DK); kr0 = kg[tid]; if (NKP > 512) { if (tid < NKP - 512) kr1 = kg[512 + tid]; }
      vr = *(const v4u*)(Vtg + (size_t)(tid >> 3) * TK + t * 64 + (tid & 7) * 8); }
    { LAS unsigned char* kb = lds; *(LAS v4u*)(kb + (tid / KP) * KS + (tid % KP) * 16) = kr0;
      if (NKP > 512) { if (tid < NKP - 512) { const int p = 512 + tid; *(LAS v4u*)(kb + (p / KP) * KS + (p % KP) * 16) = kr1; } }
      LAS unsigned char* vb = kb + KT_BYTES + (tid >> 3) * VS + (tid & 7) * 16; *(LAS v2u*)vb = (v2u){vr.x, vr.y}; *(LAS v2u*)(vb + 8) = (v2u){vr.z, vr.w}; }
    __syncthreads();
    for (int i = 0; i < nt; ++i) {
        const int t = i < na ? t0a + i : t0b + (i - na);
        if (i + 1 < nt) { const int tn = (i + 1) < na ? t0a + i + 1 : t0b + (i + 1 - na); const v4u* kg = (const v4u*)(Kg + (size_t)tn * 64 * DK); kr0 = kg[tid]; if (NKP > 512) { if (tid < NKP - 512) kr1 = kg[512 + tid]; }
            vr = *(const v4u*)(Vtg + (size_t)(tid >> 3) * TK + tn * 64 + (tid & 7) * 8); }
        LAS unsigned char* kb = lds + (i & 1) * STAGE; LAS unsigned char* vbs = kb + KT_BYTES;
        const int sb = 64 * t - NC;
        const bool band = SWA && t >= 4;
        const bool skip = band && (sb + 63 < w0 - 128 || sb > w0 + 31 + 128);
        if (!skip) {
            f32x16 p0, p1;
#pragma unroll
            for (int r = 0; r < 16; ++r) { p0[r] = 0.f; p1[r] = 0.f; }
#pragma unroll
            for (int s = 0; s < NS; ++s) {
                const bf16x8s k0 = *(const LAS bf16x8s*)(kb + q * KS + (16 * s + 8 * hi) * 2);
                const bf16x8s k1 = *(const LAS bf16x8s*)(kb + (32 + q) * KS + (16 * s + 8 * hi) * 2);
                p0 = __builtin_amdgcn_mfma_f32_32x32x16_bf16(k0, qf[s], p0, 0, 0, 0);
                p1 = __builtin_amdgcn_mfma_f32_32x32x16_bf16(k1, qf[s], p1, 0, 0, 0);
            }
            if (band) { const int tl = tq - NC;
#pragma unroll
                for (int r = 0; r < 16; ++r) { const int d0 = tl - (sb + crow(r, hi)), d1 = d0 - 32;
                    if (d0 > 128 || d0 < -128) p0[r] = -1e30f; if (d1 > 128 || d1 < -128) p1[r] = -1e30f; } }
            float mx = fmaxf(p0[0], p1[0]);
#pragma unroll
            for (int r = 1; r < 16; ++r) mx = fmaxf(mx, fmaxf(p0[r], p1[r]));
            mx = fmaxf(mx, xlane32(mx, lane));
            const float mn = fmaxf(m, mx), alpha = __builtin_amdgcn_exp2f(m - mn); m = mn;
            float ps = 0.f;
#pragma unroll
            for (int r = 0; r < 16; ++r) { p0[r] = __builtin_amdgcn_exp2f(p0[r] - mn); p1[r] = __builtin_amdgcn_exp2f(p1[r] - mn); ps += p0[r] + p1[r]; }
            l = l * alpha + ps;
            if (hi == 0) wsf[q] = alpha;
            bf16x8s pa[4];
            { v4u w;
              w.x = cvtpk(p0[0], p0[1]); w.y = cvtpk(p0[2], p0[3]); w.z = cvtpk(p0[4], p0[5]); w.w = cvtpk(p0[6], p0[7]); pa[0] = __builtin_bit_cast(bf16x8s, w);
              w.x = cvtpk(p0[8], p0[9]); w.y = cvtpk(p0[10], p0[11]); w.z = cvtpk(p0[12], p0[13]); w.w = cvtpk(p0[14], p0[15]); pa[1] = __builtin_bit_cast(bf16x8s, w);
              w.x = cvtpk(p1[0], p1[1]); w.y = cvtpk(p1[2], p1[3]); w.z = cvtpk(p1[4], p1[5]); w.w = cvtpk(p1[6], p1[7]); pa[2] = __builtin_bit_cast(bf16x8s, w);
              w.x = cvtpk(p1[8], p1[9]); w.y = cvtpk(p1[10], p1[11]); w.z = cvtpk(p1[12], p1[13]); w.w = cvtpk(p1[14], p1[15]); pa[3] = __builtin_bit_cast(bf16x8s, w); }
            asm volatile("s_waitcnt lgkmcnt(0)" ::: "memory");
#pragma unroll
            for (int r = 0; r < 16; ++r) { const float a = wsf[crow(r, hi)]; o0[r] *= a; o1[r] *= a; }
#pragma unroll
            for (int s4 = 0; s4 < 4; ++s4)
#pragma unroll
                for (int nb = 0; nb < 2; ++nb) {
                    const LAS unsigned char* vp = vbs + (32 * nb + q) * VS + (16 * s4 + 4 * hi) * 2;
                    const v2u lo = *(const LAS v2u*)vp, hh = *(const LAS v2u*)(vp + 16);
                    const bf16x8s vf = __builtin_bit_cast(bf16x8s, ((v4u){lo.x, lo.y, hh.x, hh.y}));
                    if (nb == 0) o0 = __builtin_amdgcn_mfma_f32_32x32x16_bf16(pa[s4], vf, o0, 0, 0, 0); else o1 = __builtin_amdgcn_mfma_f32_32x32x16_bf16(pa[s4], vf, o1, 0, 0, 0);
                }
        }
        if (i + 1 < nt) { LAS unsigned char* kn = lds + ((i + 1) & 1) * STAGE; *(LAS v4u*)(kn + (tid / KP) * KS + (tid % KP) * 16) = kr0;
            if (NKP > 512) { if (tid < NKP - 512) { const int p = 512 + tid; *(LAS v4u*)(kn + (p / KP) * KS + (p % KP) * 16) = kr1; } }
            LAS unsigned char* vb = kn + KT_BYTES + (tid >> 3) * VS + (tid & 7) * 16; *(LAS v2u*)vb = (v2u){vr.x, vr.y}; *(LAS v2u*)(vb + 8) = (v2u){vr.z, vr.w}; }
        __syncthreads();
    }
    const float lt = l + xlane32(l, lane);
    if (hi == 0) wsf[q] = 1.0f / lt;
    asm volatile("s_waitcnt lgkmcnt(0)" ::: "memory");
#pragma unroll
    for (int r = 0; r < 16; ++r) { const int qq = crow(r, hi); const float inv = wsf[qq];
        bf16* op = OCp + (size_t)row_of(b, tq0 + wave * 32 + qq) * D + hcol + q;
        op[0] = f2bf(o0[r] * inv); op[32] = f2bf(o1[r] * inv); }
    __syncthreads();
}
__device__ __forceinline__ void attn_phase(LAS unsigned char* lds, const Mix& M, const float* sink, bool with_ctx, int tid) {
    const int nunits = 512 + (with_ctx ? 64 : 0);
    for (int u = blockIdx.x; u < nunits; u += gridDim.x) {
        if (u < 512) {
            const int c = u & 255, bh = (c & 7) + 8 * (c >> 6), qb = (c >> 3) & 7, b = bh >> 2, h = bh & 3, tq0 = NC + 256 * qb;
            if (u < 256) attn_unit<96, false>(lds, M.Qm + (size_t)bh * TK * 96, M.Km + (size_t)bh * TK * 96, M.Vm + (size_t)bh * 64 * TK, M.OC, b, h * 64, tq0, 0, TK / 64, 0, 0, 0.f, tid);
            else { const int slo = 256 * qb - 128 < 0 ? 0 : 256 * qb - 128, shi = 256 * qb + 383 > NL - 1 ? NL - 1 : 256 * qb + 383;
                attn_unit<64, true>(lds, M.Qs + (size_t)bh * TK * 64, M.Ks + (size_t)(b * 2 + (h >> 1)) * TK * 64, M.Vs + (size_t)(b * 2 + (h >> 1)) * 64 * TK, M.OC, b, 512 + h * 64, tq0,
                                    0, NC / 64, (NC + slo) / 64, (NC + shi) / 64 + 1, sink[h] * LOG2E, tid); }
        } else {
            const int c = (u - 512) & 31, b = c >> 2, h = c & 3;
            if (u < 544) attn_unit<96, false>(lds, M.Qm + (size_t)c * TK * 96, M.Km + (size_t)c * TK * 96, M.Vm + (size_t)c * 64 * TK, M.OC, b, h * 64, 0, 0, NC / 64, 0, 0, 0.f, tid);
            else attn_unit<64, true>(lds, M.Qs + (size_t)c * TK * 64, M.Ks + (size_t)(b * 2 + (h >> 1)) * TK * 64, M.Vs + (size_t)(b * 2 + (h >> 1)) * 64 * TK, M.OC, b, 512 + h * 64, 0, 0, NC / 64, 0, 0, sink[h] * LOG2E, tid);
        }
    }
}
__device__ __forceinline__ float wsum(float v, int lane) {
#pragma unroll
    for (int o = 1; o < 64; o <<= 1) v += __int_as_float(__builtin_amdgcn_ds_bpermute((lane ^ o) << 2, __float_as_int(v)));
    return v;
}
__device__ __forceinline__ float bfl(unsigned w) { return __uint_as_float(w << 16); }
__device__ __forceinline__ float bfh(unsigned w) { return __uint_as_float(w & 0xffff0000u); }
__device__ __forceinline__ void prep_row(const Mix& M, const float* tab, int row, int lane) {
    int b, tq; row_split(row, b, tq); const bool lat = tq >= NC; const int t = lat ? tq - NC : 0;
    const bf16* p = M.P + (size_t)row * NP;
    float sq = 0.f, skv = 0.f;
    if (lane < 48) { const v2u w = *(const v2u*)(p + C_QLAT + 4 * lane); const float a = bfl(w.x), c = bfh(w.x), d = bfl(w.y), e = bfh(w.y); sq = (a * a + c * c) + (d * d + e * e); }
    if (lane < 32) { const v2u w = *(const v2u*)(p + C_KVLAT + 4 * lane); const float a = bfl(w.x), c = bfh(w.x), d = bfl(w.y), e = bfh(w.y); skv = (a * a + c * c) + (d * d + e * e); }
    sq = wsum(sq, lane); skv = wsum(skv, lane);
    const float rq = 1.0f / sqrtf(sq * (1.0f / 192.0f) + NORM_EPS), rkv = 1.0f / sqrtf(skv * (1.0f / 128.0f) + NORM_EPS), qs = rq * 0.10206207261596575f * LOG2E;
#pragma unroll
    for (int h = 0; h < 4; ++h) { const size_t o = ((size_t)(b * 4 + h) * TK + tq) * 96 + lane;
        M.Qm[o] = f2bf(bf2f(p[C_QE + h * 96 + lane]) * qs); M.Km[o] = f2bf(bf2f(p[C_KVE + h * 128 + lane]) * rkv); }
    { const int h = lane >> 4, j = lane & 15; float c = 1.f, s = 0.f; if (lat) { c = tab[TAB_MLA + (t * 16 + j) * 2]; s = tab[TAB_MLA + (t * 16 + j) * 2 + 1]; }
      const size_t o = ((size_t)(b * 4 + h) * TK + tq) * 96 + 64 + j;
      const float q1 = bf2f(p[C_QE + h * 96 + 64 + j]), q2 = bf2f(p[C_QE + h * 96 + 80 + j]); M.Qm[o] = f2bf((q1 * c - q2 * s) * qs); M.Qm[o + 16] = f2bf((q1 * s + q2 * c) * qs);
      const float k1 = bf2f(p[C_KPE + j]), k2 = bf2f(p[C_KPE + 16 + j]); M.Km[o] = f2bf(k1 * c - k2 * s); M.Km[o + 16] = f2bf(k1 * s + k2 * c); }
#pragma unroll
    for (int i = 0; i < 2; ++i) { const int e = lane + 64 * i, hq = e >> 5, j = e & 31; float c = 1.f, s = 0.f; if (lat) { c = tab[TAB_SWA + (t * 32 + j) * 2]; s = tab[TAB_SWA + (t * 32 + j) * 2 + 1]; }
        const float x1 = bf2f(p[C_SQ + hq * 64 + j]), x2 = bf2f(p[C_SQ + hq * 64 + 32 + j]); bf16* o = M.Qs + ((size_t)(b * 4 + hq) * TK + tq) * 64 + j;
        o[0] = f2bf((x1 * c - x2 * s) * (0.125f * LOG2E)); o[32] = f2bf((x1 * s + x2 * c) * (0.125f * LOG2E)); }
    { const int kh = lane >> 5, j = lane & 31; float c = 1.f, s = 0.f; if (lat) { c = tab[TAB_SWA + (t * 32 + j) * 2]; s = tab[TAB_SWA + (t * 32 + j) * 2 + 1]; }
      const float x1 = bf2f(p[C_SK + kh * 64 + j]), x2 = bf2f(p[C_SK + kh * 64 + 32 + j]); bf16* o = M.Ks + ((size_t)(b * 2 + kh) * TK + tq) * 64 + j;
      o[0] = f2bf(x1 * c - x2 * s); o[32] = f2bf(x1 * s + x2 * c); }
#pragma unroll
    for (int i = 0; i < 8; ++i) { const int d = i >> 2, c = (i & 3) * 64 + lane; const float z = bf2f(p[(d ? C_HZB : C_HZF) + c]);
        const float a = M.loglb[d * 256 + c], bb = M.log1mlb[d * 256 + c] + log_sigmoid_f(z), mx = fmaxf(a, bb), lf = mx + log1pf(expf(-fabsf(a - bb)));
        M.HF[((size_t)d * NTOK + row) * 256 + c] = expf(lf); }
#pragma unroll
    for (int w = 0; w < 2; ++w) { const int hh = lane >> 4, j = lane & 15; const float c = tab[TAB_RET + (tq * 16 + j) * 2], s = tab[TAB_RET + (tq * 16 + j) * 2 + 1];
        const bf16* src = p + (w ? C_RK : C_RQ) + hh * 32; float* o = (w ? M.RK : M.RQ) + (size_t)row * 128 + hh * 32 + j; const float sc = w ? 1.0f : 0.17677669529663687f;
        const float x1 = bf2f(src[j]), x2 = bf2f(src[16 + j]); o[0] = (x1 * c - x2 * s) * sc; o[16] = (x1 * s + x2 * c) * sc; }
}
__device__ __forceinline__ void prep_vt(const Mix& M, int g8, int lane) {
    const int row0 = g8 * 8; int b, tq0; row_split(row0, b, tq0);
    float rkv[8];
#pragma unroll
    for (int r = 0; r < 8; ++r) { float skv = 0.f; if (lane < 32) { const v2u w = *(const v2u*)(M.P + (size_t)(row0 + r) * NP + C_KVLAT + 4 * lane); const float a = bfl(w.x), c = bfh(w.x), d = bfl(w.y), e = bfh(w.y); skv = (a * a + c * c) + (d * d + e * e); }
        skv = wsum(skv, lane); rkv[r] = 1.0f / sqrtf(skv * (1.0f / 128.0f) + NORM_EPS); }
#pragma unroll
    for (int h = 0; h < 4; ++h) { float v[8];
#pragma unroll
        for (int r = 0; r < 8; ++r) v[r] = bf2f(M.P[(size_t)(row0 + r) * NP + C_KVE + h * 128 + 64 + lane]) * rkv[r];
        v4u o; o.x = pk2(v[0], v[1]); o.y = pk2(v[2], v[3]); o.z = pk2(v[4], v[5]); o.w = pk2(v[6], v[7]);
        *(v4u*)(M.Vm + ((size_t)(b * 4 + h) * 64 + lane) * TK + tq0) = o; }
#pragma unroll
    for (int kh = 0; kh < 2; ++kh) { unsigned short v[8];
#pragma unroll
        for (int r = 0; r < 8; ++r) v[r] = M.P[(size_t)(row0 + r) * NP + C_SV + kh * 64 + lane];
        v4u o; o.x = (unsigned)v[0] | ((unsigned)v[1] << 16); o.y = (unsigned)v[2] | ((unsigned)v[3] << 16); o.z = (unsigned)v[4] | ((unsigned)v[5] << 16); o.w = (unsigned)v[6] | ((unsigned)v[7] << 16);
        *(v4u*)(M.Vs + ((size_t)(b * 2 + kh) * 64 + lane) * TK + tq0) = o; }
}
constexpr int SBT = 12, NSB = CH / SBT;
__device__ __forceinline__ int scan_row(int b, int dir, int pos) { return row_of(b, dir_tq(dir, pos)); }
__device__ __forceinline__ void hg_local_wave(const Mix& M, LAS float* wl  , int unit, int lane) {
    const int c = unit % NCH, seq = unit / NCH, h = seq & 3, b = (seq >> 2) % NB, dir = seq / (4 * NB);
    float S[64];
#pragma unroll
    for (int k = 0; k < 64; ++k) S[k] = 0.f;
    float dk = 1.0f;
    LAS float* Fs = wl; LAS float* Qs = wl + 768; LAS float* Vs = wl + 1536;
    const int tt0 = lane >> 4, k4 = (lane & 15) * 4;
    for (int sb = 0; sb < NSB; ++sb) {
        const int pos0 = CH * c + SBT * sb;
        f32x4 fr[3]; v2u qr[3]; unsigned short vr[SBT];
#pragma unroll
        for (int j = 0; j < 3; ++j) { const int row = scan_row(b, dir, pos0 + 4 * j + tt0);
            fr[j] = *(const f32x4*)(M.HF + ((size_t)dir * NTOK + row) * 256 + h * 64 + k4); qr[j] = *(const v2u*)(M.P + (size_t)row * NP + C_HQ + h * 64 + k4); }
#pragma unroll
        for (int i = 0; i < SBT; ++i) vr[i] = M.P[(size_t)scan_row(b, dir, pos0 + i) * NP + C_HI + h * 64 + lane];
#pragma unroll
        for (int j = 0; j < 3; ++j) { *(LAS f32x4*)(Fs + (4 * j + tt0) * 64 + k4) = fr[j];
            *(LAS f32x4*)(Qs + (4 * j + tt0) * 64 + k4) = (f32x4){bfl(qr[j].x) * 0.125f, bfh(qr[j].x) * 0.125f, bfl(qr[j].y) * 0.125f, bfh(qr[j].y) * 0.125f}; }
#pragma unroll
        for (int i = 0; i < SBT; ++i) Vs[i * 64 + lane] = bf2f(vr[i]);
        asm volatile("s_waitcnt lgkmcnt(0)" ::: "memory");
#pragma unroll 2
        for (int i = 0; i < SBT; ++i) {
            const int row = scan_row(b, dir, pos0 + i); const float v = Vs[i * 64 + lane]; float acc = 0.f;
            dk *= Fs[i * 64 + lane]; M.HQC[((size_t)dir * NTOK + row) * 256 + h * 64 + lane] = Qs[i * 64 + lane] * dk;
#pragma unroll
            for (int kk = 0; kk < 16; ++kk) { const f32x4 f4 = *(const LAS f32x4*)(Fs + i * 64 + 4 * kk), q4 = *(const LAS f32x4*)(Qs + i * 64 + 4 * kk);
#pragma unroll
                for (int j = 0; j < 4; ++j) { S[4 * kk + j] = f4[j] * (S[4 * kk + j] - v) + v; acc += q4[j] * S[4 * kk + j]; } }
            M.HO[((size_t)dir * NTOK + row) * 256 + h * 64 + lane] = acc;
        }
        asm volatile("s_waitcnt lgkmcnt(0)" ::: "memory");
    }
    float* u = M.HU + ((size_t)seq * NCH + c) * 4096 + lane;
#pragma unroll
    for (int k = 0; k < 64; ++k) u[k * 64] = S[k];
    M.HDK[((size_t)seq * NCH + c) * 64 + lane] = dk;
}
__device__ __forceinline__ void ret_local_wave(const Mix& M, LAS float* wl, int unit, int lane) {
    const int c = unit % NCH, seq = unit / NCH, h = seq & 3, b = (seq >> 2) % NB, dir = seq / (4 * NB);
    const float g = expf(M.log_gamma[dir * 4 + h]);
    float S[32];
#pragma unroll
    for (int k = 0; k < 32; ++k) S[k] = 0.f;
    float gp = 1.0f;
    LAS float* Ks = wl; LAS float* Qs = wl + 768; LAS float* Vs = wl + 1536;
    const int tt0 = lane >> 3, k4 = (lane & 7) * 4;
    for (int sb = 0; sb < NSB; ++sb) {
        const int pos0 = CH * c + SBT * sb;
        f32x4 kr[2], qr[2]; unsigned short vr[SBT];
#pragma unroll
        for (int j = 0; j < 2; ++j) { const int tt = 8 * j + tt0; const int row = scan_row(b, dir, pos0 + (tt < SBT ? tt : 0));
            kr[j] = *(const f32x4*)(M.RK + (size_t)row * 128 + h * 32 + k4); qr[j] = *(const f32x4*)(M.RQ + (size_t)row * 128 + h * 32 + k4); }
#pragma unroll
        for (int i = 0; i < SBT; ++i) vr[i] = M.P[(size_t)scan_row(b, dir, pos0 + i) * NP + C_RV + h * 64 + lane];
#pragma unroll
        for (int j = 0; j < 2; ++j) { const int tt = 8 * j + tt0; if (tt < SBT) { *(LAS f32x4*)(Ks + tt * 32 + k4) = kr[j]; *(LAS f32x4*)(Qs + tt * 32 + k4) = qr[j]; } }
#pragma unroll
        for (int i = 0; i < SBT; ++i) Vs[i * 64 + lane] = bf2f(vr[i]);
        asm volatile("s_waitcnt lgkmcnt(0)" ::: "memory");
#pragma unroll 2
        for (int i = 0; i < SBT; ++i) {
            const int row = scan_row(b, dir, pos0 + i); const float v = Vs[i * 64 + lane]; float acc = 0.f;
            gp *= g; if (lane < 32) M.RQC[((size_t)dir * NTOK + row) * 128 + h * 32 + lane] = Qs[i * 32 + lane] * gp;
#pragma unroll
            for (int kk = 0; kk < 8; ++kk) { const f32x4 k4v = *(const LAS f32x4*)(Ks + i * 32 + 4 * kk), q4 = *(const LAS f32x4*)(Qs + i * 32 + 4 * kk);
#pragma unroll
                for (int j = 0; j < 4; ++j) { S[4 * kk + j] = g * S[4 * kk + j] + k4v[j] * v; acc += q4[j] * S[4 * kk + j]; } }
            M.RO[((size_t)dir * NTOK + row) * 256 + h * 64 + lane] = acc;
        }
        asm volatile("s_waitcnt lgkmcnt(0)" ::: "memory");
    }
    float* u = M.RU + ((size_t)seq * NCH + c) * 2048 + lane;
#pragma unroll
    for (int k = 0; k < 32; ++k) u[k * 64] = S[k];
}
__device__ __forceinline__ int bwd_chunk(int tq) { return (tq < NC ? NC - 1 - tq : NC + (NL - 1 - (tq - NC))) / CH; }
__device__ __forceinline__ void hg_fixfin_wave(const Mix& M, LAS float* wl, int unit, int lane) {
    const int c = unit % NCH, bh = unit / NCH, h = bh & 3, b = bh >> 2;
    const float* uf = M.HU + ((size_t)((0 * NB + b) * 4 + h) * NCH + c) * 4096 + lane;
    float Sf[64], Sb[64];
#pragma unroll
    for (int k = 0; k < 64; ++k) { Sf[k] = uf[k * 64]; Sb[k] = 0.f; }
    int cb = -1;
    const float ng = M.hg_norm_g[h * 64 + lane];
    const int tt0 = lane >> 4, k4 = (lane & 15) * 4;
    LAS float* Af = wl; LAS float* Ab = wl + 768;
    for (int sb = 0; sb < NSB; ++sb) {
        const int tq0 = CH * c + SBT * sb;
#pragma unroll
        for (int j = 0; j < 3; ++j) { const int row = row_of(b, tq0 + 4 * j + tt0);
            *(LAS f32x4*)(Af + (4 * j + tt0) * 64 + k4) = *(const f32x4*)(M.HQC + ((size_t)0 * NTOK + row) * 256 + h * 64 + k4);
            *(LAS f32x4*)(Ab + (4 * j + tt0) * 64 + k4) = *(const f32x4*)(M.HQC + ((size_t)1 * NTOK + row) * 256 + h * 64 + k4); }
        asm volatile("s_waitcnt lgkmcnt(0)" ::: "memory");
        for (int i = 0; i < SBT; ++i) {
            const int tq = tq0 + i, row = row_of(b, tq), cbn = bwd_chunk(tq);
            if (cbn != cb) { cb = cbn; const float* ub = M.HU + ((size_t)((1 * NB + b) * 4 + h) * NCH + cb) * 4096 + lane;
#pragma unroll
                for (int k = 0; k < 64; ++k) Sb[k] = ub[k * 64]; }
            float acc = M.HO[((size_t)0 * NTOK + row) * 256 + h * 64 + lane] + M.HO[((size_t)1 * NTOK + row) * 256 + h * 64 + lane];
            const float gate = bf2f(M.P[(size_t)row * NP + C_HG + h * 64 + lane]);
#pragma unroll
            for (int kk = 0; kk < 16; ++kk) { const f32x4 a4 = *(const LAS f32x4*)(Af + i * 64 + 4 * kk), b4 = *(const LAS f32x4*)(Ab + i * 64 + 4 * kk);
#pragma unroll
                for (int j = 0; j < 4; ++j) acc += a4[j] * Sf[4 * kk + j] + b4[j] * Sb[4 * kk + j]; }
            const float r = 1.0f / sqrtf(wsum(acc * acc, lane) * (1.0f / 64.0f) + NORM_EPS);
            M.OC[(size_t)row * D + 256 + h * 64 + lane] = f2bf(acc * r * ng * silu_f(gate));
        }
        asm volatile("s_waitcnt lgkmcnt(0)" ::: "memory");
    }
}
__device__ __forceinline__ void ret_fixfin_wave(const Mix& M, LAS float* wl, int unit, int lane) {
    const int c = unit % NCH, bh = unit / NCH, h = bh & 3, b = bh >> 2;
    const float* uf = M.RU + ((size_t)((0 * NB + b) * 4 + h) * NCH + c) * 2048 + lane;
    float Sf[32], Sb[32];
#pragma unroll
    for (int k = 0; k < 32; ++k) { Sf[k] = uf[k * 64]; Sb[k] = 0.f; }
    int cb = -1;
    const float gg = M.gn_g[h * 64 + lane], gb = M.gn_b[h * 64 + lane];
    const int tt0 = lane >> 3, k4 = (lane & 7) * 4;
    LAS float* Af = wl; LAS float* Ab = wl + 768;
    for (int sb = 0; sb < NSB; ++sb) {
        const int tq0 = CH * c + SBT * sb;
#pragma unroll
        for (int j = 0; j < 2; ++j) { const int tt = 8 * j + tt0; if (tt < SBT) { const int row = row_of(b, tq0 + tt);
            *(LAS f32x4*)(Af + tt * 32 + k4) = *(const f32x4*)(M.RQC + ((size_t)0 * NTOK + row) * 128 + h * 32 + k4);
            *(LAS f32x4*)(Ab + tt * 32 + k4) = *(const f32x4*)(M.RQC + ((size_t)1 * NTOK + row) * 128 + h * 32 + k4); } }
        asm volatile("s_waitcnt lgkmcnt(0)" ::: "memory");
        for (int i = 0; i < SBT; ++i) {
            const int tq = tq0 + i, row = row_of(b, tq), cbn = bwd_chunk(tq);
            if (cbn != cb) { cb = cbn; const float* ub = M.RU + ((size_t)((1 * NB + b) * 4 + h) * NCH + cb) * 2048 + lane;
#pragma unroll
                for (int k = 0; k < 32; ++k) Sb[k] = ub[k * 64]; }
            float acc = M.RO[((size_t)0 * NTOK + row) * 256 + h * 64 + lane] + M.RO[((size_t)1 * NTOK + row) * 256 + h * 64 + lane];
            const float gate = bf2f(M.P[(size_t)row * NP + C_RG + h * 64 + lane]);
#pragma unroll
            for (int kk = 0; kk < 8; ++kk) { const f32x4 a4 = *(const LAS f32x4*)(Af + i * 32 + 4 * kk), b4 = *(const LAS f32x4*)(Ab + i * 32 + 4 * kk);
#pragma unroll
                for (int j = 0; j < 4; ++j) acc += a4[j] * Sf[4 * kk + j] + b4[j] * Sb[4 * kk + j]; }
            const float mu = wsum(acc, lane) * (1.0f / 64.0f), dd = acc - mu, r = 1.0f / sqrtf(wsum(dd * dd, lane) * (1.0f / 64.0f) + NORM_EPS);
            M.OC[(size_t)row * D + 768 + h * 64 + lane] = f2bf((dd * r * gg + gb) * silu_f(gate));
        }
        asm volatile("s_waitcnt lgkmcnt(0)" ::: "memory");
    }
}
template <int KIND> __device__ __forceinline__ void norm_phase(Frame& F, int l) {
    unsigned char* ws = F.base();
    const bool combine = (KIND != 1) && l > 0 && ((l - 1) & 1);
    const bool first = (KIND == 0 && l == 0);
    const int nrows = (KIND == 2) ? NLAT : NTOK;
    const float* modl = F_sm + SM_MOD + (size_t)(KIND == 2 ? 0 : l) * 9 * 6144;
    const float* modp = F_sm + SM_MOD + (size_t)(l > 0 ? l - 1 : 0) * 9 * 6144;
    const int* offs = (const int*)(F_sm + SM_META) + ((l > 0 ? l - 1 : 0) >> 1) * 16;
    const float* gain = KIND == 0 ? IN(6) + l * D : (KIND == 1 ? IN(7) + l * D : IN(27));
    for (int row = F.gw; row < nrows; row += F.NGW) {
        const int bidx = row < NLAT ? row / NL : NB;
        const float* src = first ? (row < NLAT ? IN(0) + (size_t)row * D : IN(2) + (size_t)(row - NLAT) * D) : F_H + (size_t)row * D;
        f32x4 v[4];
#pragma unroll
        for (int j = 0; j < 4; ++j) v[j] = *(const f32x4*)(src + 4 * F.lane + 256 * j);
        if (combine) {
            const int* ti = F_tokinfo + (size_t)row * 8;
            const int e1 = ti[0], p1 = ti[1], e2 = ti[3], p2 = ti[4]; const float w1 = __int_as_float(ti[2]), w2 = __int_as_float(ti[5]);
            const bf16* y1 = F_Y + (size_t)(offs[e1] + p1) * D; const bf16* y2 = F_Y + (size_t)(offs[e2] + p2) * D;
#pragma unroll
            for (int j = 0; j < 4; ++j) { const int col = 4 * F.lane + 256 * j;
                const f32x4 gf = *(const f32x4*)(modp + (size_t)bidx * 6144 + 5 * 1024 + col);
                const v2u a = *(const v2u*)(y1 + col), b = *(const v2u*)(y2 + col);
                f32x4 ya, yb; ya[0] = bf2f((bf16)(a.x & 0xffff)); ya[1] = bf2f((bf16)(a.x >> 16)); ya[2] = bf2f((bf16)(a.y & 0xffff)); ya[3] = bf2f((bf16)(a.y >> 16));
                yb[0] = bf2f((bf16)(b.x & 0xffff)); yb[1] = bf2f((bf16)(b.x >> 16)); yb[2] = bf2f((bf16)(b.y & 0xffff)); yb[3] = bf2f((bf16)(b.y >> 16));
                v[j] = v[j] + gf * (ya * w1 + yb * w2); }
        }
        if (combine || first) {
#pragma unroll
            for (int j = 0; j < 4; ++j) *(f32x4*)(F_H + (size_t)row * D + 4 * F.lane + 256 * j) = v[j];
        }
        float ss = 0.f;
#pragma unroll
        for (int j = 0; j < 4; ++j) ss += (v[j][0] * v[j][0] + v[j][1] * v[j][1]) + (v[j][2] * v[j][2] + v[j][3] * v[j][3]);
        const float rstd = 1.0f / sqrtf(wave_sum(ss, F.lane) * (1.0f / D) + NORM_EPS);
        if (KIND == 2) {
#pragma unroll
            for (int j = 0; j < 4; ++j) { const int col = 4 * F.lane + 256 * j; const f32x4 g = *(const f32x4*)(gain + col); *(f32x4*)(OUTP() + (size_t)row * D + col) = v[j] * rstd * g; }
            continue;
        }
        const float* mrow = modl + (size_t)bidx * 6144 + (KIND == 0 ? 0 : 3 * 1024);
#pragma unroll
        for (int j = 0; j < 4; ++j) { const int col = 4 * F.lane + 256 * j;
            const f32x4 g = *(const f32x4*)(gain + col), sh = *(const f32x4*)(mrow + col), sc = *(const f32x4*)(mrow + 1024 + col);
            v[j] = v[j] * rstd * g * (sc + 1.0f) + sh;
            v2u o; o.x = pk2(v[j][0], v[j][1]); o.y = pk2(v[j][2], v[j][3]);
            *(v2u*)(F_A + (size_t)row * D + col) = o; }
        if (KIND == 1 && (l & 1)) {
            const int li = l >> 1; const float* wr = IN(23) + (size_t)li * D * 8;
            float lg[8];
#pragma unroll
            for (int e = 0; e < 8; ++e) lg[e] = 0.f;
#pragma unroll
            for (int j = 0; j < 4; ++j)
#pragma unroll
                for (int i = 0; i < 4; ++i) { const int col = 4 * F.lane + 256 * j + i; const f32x4 w0 = *(const f32x4*)(wr + (size_t)col * 8), w1 = *(const f32x4*)(wr + (size_t)col * 8 + 4);
#pragma unroll
                    for (int e = 0; e < 4; ++e) { lg[e] += v[j][i] * w0[e]; lg[4 + e] += v[j][i] * w1[e]; } }
#pragma unroll
            for (int e = 0; e < 8; ++e) lg[e] = wave_sum(lg[e], F.lane);
            int e1 = 0; float v1 = lg[0];
#pragma unroll
            for (int e = 1; e < 8; ++e) if (lg[e] > v1) { v1 = lg[e]; e1 = e; }
            int e2 = -1; float v2 = -3.0e38f;
#pragma unroll
            for (int e = 0; e < 8; ++e) if (e != e1 && lg[e] > v2) { v2 = lg[e]; e2 = e; }
            if (F.lane == 0) {
                const float w2 = 1.0f / (1.0f + expf(v1 - v2)), w1 = 1.0f - w2;
                const int p1 = (int)atomicAdd(F_ctl + CW_CNT + li * 8 + e1, 1u), p2 = (int)atomicAdd(F_ctl + CW_CNT + li * 8 + e2, 1u);
                F_list[(size_t)e1 * NTOK + p1] = row; F_list[(size_t)e2 * NTOK + p2] = row;
                int* ti = F_tokinfo + (size_t)row * 8; ti[0] = e1; ti[1] = p1; ti[2] = __float_as_int(w1); ti[3] = e2; ti[4] = p2; ti[5] = __float_as_int(w2);
            }
        }
    }
}
__device__ __forceinline__ void moe_tiles(Frame& F, int li, int (&tb)[9], int (&cnt)[8]) {
    unsigned char* ws = F.base();
    tb[0] = 0;
#pragma unroll
    for (int e = 0; e < 8; ++e) { cnt[e] = (int)__hip_atomic_load(F_ctl + CW_CNT + li * 8 + e, __ATOMIC_RELAXED, __HIP_MEMORY_SCOPE_AGENT); tb[e + 1] = tb[e] + ((cnt[e] + 255) >> 8); }
}
__device__ __forceinline__ void moe_gather(Frame& F, int li) {
    unsigned char* ws = F.base();
    int tb[9], cnt[8]; moe_tiles(F, li, tb, cnt);
    if (blockIdx.x == 0 && F.tid < 9) { int* meta = (int*)(F_sm + SM_META) + li * 16; int val = 0;
#pragma unroll
        for (int e = 0; e < 9; ++e) if (F.tid == e) val = tb[e] * 256;
        meta[F.tid] = val; }
    { const int T = tb[8]; unsigned* ul = (unsigned*)(F_sm + SM_ULIST) + li * (MAXTILES * 32);
      for (int L = F.gtid; L < T * 32; L += F.NT) {
          const bool gu = L < T * 28; const int nN = gu ? 28 : 4, nwg = T * nN; int wgid = gu ? L : L - T * 28;
          { const int q = nwg / 8, r = nwg % 8, xcd = wgid % 8, off = wgid / 8; wgid = (xcd < r ? xcd * (q + 1) : r * (q + 1) + (xcd - r) * q) + off; }
          const int nig = 8 * nN, gid = wgid / nig, fm = gid * 8, gsz = (T - fm) < 8 ? (T - fm) : 8;
          const int pm = fm + ((wgid % nig) % gsz), pnl = (wgid % nig) / gsz; int e = 0;
#pragma unroll
          for (int j = 1; j < 8; ++j) e += (pm >= tb[j]) ? 1 : 0;
          ul[(gu ? ULIST_GU : ULIST_D) + (gu ? L : L - T * 28)] = (unsigned)pm | ((unsigned)(e * nN + pnl) << 16);
      } }
    const int nslot = tb[8] * 256;
    for (int s = F.gw; s < nslot; s += F.NGW) {
        const int tile = s >> 8; int e = 0, base = 0, c = 0;
#pragma unroll
        for (int j = 0; j < 8; ++j) if (tile >= tb[j] && tile < tb[j + 1]) { e = j; base = tb[j] * 256; c = cnt[j]; }
        const int pos = s - base; const int tok = pos < c ? F_list[(size_t)e * NTOK + pos] : -1;
        v4u a = (v4u){0u, 0u, 0u, 0u}, b = a;
        if (tok >= 0) { const v4u* sp = (const v4u*)(F_A + (size_t)tok * D); a = sp[F.lane]; b = sp[64 + F.lane]; }
        v4u* dp = (v4u*)(F_AM + (size_t)s * D); dp[F.lane] = a; dp[64 + F.lane] = b;
    }
}

__device__ __forceinline__ void make_mix(Mix& M, unsigned char* ws, int l) {
    M.P = F_P; M.Qm = WSP(bf16, WS_QM); M.Km = WSP(bf16, WS_KM); M.Vm = WSP(bf16, WS_VM); M.Qs = WSP(bf16, WS_QS); M.Ks = WSP(bf16, WS_KS); M.Vs = WSP(bf16, WS_VS);
    M.HF = WSP(float, WS_HF); M.HO = WSP(float, WS_HO); M.RQ = WSP(float, WS_RQ); M.RK = WSP(float, WS_RK); M.RO = WSP(float, WS_RO); M.OC = F_OC;
    M.HU = WSP(float, WS_HU); M.HDK = WSP(float, WS_HDK); M.HQC = WSP(float, WS_HQC); M.RU = WSP(float, WS_RU); M.RQC = WSP(float, WS_RQC);
    M.loglb = F_sm + SM_LOGLB + l * 512; M.log1mlb = F_sm + SM_LOG1M + l * 512; M.hg_norm_g = IN(15) + l * 256; M.sink = IN(16) + l * 4; M.log_gamma = F_sm + SM_LGAM + l * 8;
    M.gn_g = IN(18) + l * 256; M.gn_b = IN(19) + l * 256;
}
__device__ __forceinline__ void frame_init(Frame& F, LAS unsigned char* lds, int wave_s) {
    unsigned z = 0u; asm volatile("" : "+v"(z)); int t = (int)__builtin_amdgcn_mbcnt_hi(~0u, __builtin_amdgcn_mbcnt_lo(~0u, z)); t += wave_s * 64;
    F.lds = lds; F.tid = t; F.lane = t & 63; F.wave = wave_s;
    F.gtid = blockIdx.x * NTHREADS + t; F.NT = gridDim.x * NTHREADS; { int gw_ = blockIdx.x * NWAVES + wave_s; asm volatile("" : "+s"(gw_)); F.gw = gw_; } F.NGW = gridDim.x * NWAVES;
}
__global__ void __launch_bounds__(NTHREADS, 2) fwd_kernel(Args args) {
    extern __shared__ __attribute__((aligned(16))) unsigned char lds[];
    const int wave_s = __builtin_amdgcn_readfirstlane((int)threadIdx.x >> 6);
    volatile LAS unsigned* MISC = (volatile LAS unsigned*)((LAS unsigned char*)lds + MISC_OFF);
    for (int u = threadIdx.x; u < (LDS_BYTES - 131072) / 4; u += NTHREADS) ((LAS unsigned*)((LAS unsigned char*)lds + 131072))[u] = 0u;
    __syncthreads();
    const int lo = args.ph_lo, hi = args.ph_hi;
    XcdBarrier bar; bar.w = wave_s; bar.bar = (unsigned*)(WSBASE() + WS_CTL) + CW_BAR; bar.x = 0; bar.st = nullptr;
    if (hi - lo > 1) bar = xcd_barrier_post((unsigned*)(WSBASE() + WS_CTL) + CW_BAR, MISC + 8, wave_s);
    int p = 0;
#ifndef PHMASK
#define PHMASK 0xffffffffu
#endif
#define PH_BEGIN_(k) if (((PHMASK >> (k)) & 1u) && p >= lo && p < hi) { Frame F; frame_init(F, (LAS unsigned char*)lds, wave_s); unsigned char* ws = F.base();
#define PH_END if (p + 1 < hi) xcd_barrier(bar); } ++p;

    PH_BEGIN_(0) (void)ws; prologue(F); PH_END

    for (int l = 0; l < DEPTH; ++l) {
        PH_BEGIN_(1) (void)ws; norm_phase<0>(F, l); if (l == 2) convert_moe(F, 1); PH_END
        PH_BEGIN_(2) { pg8::Gemm g{F_A, F_WIN + (size_t)l * NP * D, NTOK, NP, D}; pg8::StaticOrder S; S.init(NTOK, NP, gridDim.x, blockIdx.x);
                   pg8::EpiBf16P E{F_P, NP, NP / 256}; pg8::gemm_phase<pg8::EpiBf16P, pg8::StaticOrder, true, true>(F.lds, g, S, E, F.tid); } PH_END
#ifndef NO_MIX
        PH_BEGIN_(3) { Mix M; make_mix(M, ws, l); const float* tab = WSP(float, WS_TAB);
            for (int row = F.gw; row < NTOK; row += F.NGW) prep_row(M, tab, row, F.lane);
            for (int g8 = F.gw; g8 < NTOK / 8; g8 += F.NGW) prep_vt(M, g8, F.lane); }
        PH_END
        PH_BEGIN_(4) { Mix M; make_mix(M, ws, l);
            attn_phase(F.lds, M, M.sink, true, F.tid);
            LAS float* wl = (LAS float*)(F.lds + F.wave * 9216);
            for (int u = F.gw; u < 2 * NB * 4 * NCH; u += F.NGW) { hg_local_wave(M, wl, u, F.lane); ret_local_wave(M, wl, u, F.lane); } }
        PH_END
        PH_BEGIN_(14) { Mix M; make_mix(M, ws, l);
            for (int it = F.gtid; it < 2 * NB * 4 * 4096; it += F.NT) hg_carry_item(M, it);
            for (int it = F.gtid; it < 2 * NB * 4 * 2048; it += F.NT) ret_carry_item(M, it); }
        PH_END
        PH_BEGIN_(15) { Mix M; make_mix(M, ws, l);
            LAS float* wl = (LAS float*)(F.lds + F.wave * 9216);
            const int w = F.wave, isH = ((w & 1) == 0) != (w >= 4), idx = isH ? (w == 0 ? 0 : w == 2 ? 1 : w == 5 ? 2 : 3) : (w == 1 ? 0 : w == 3 ? 1 : w == 4 ? 2 : 3);
            for (int u = blockIdx.x * 4 + idx; u < NB * 4 * NCH; u += gridDim.x * 4) { if (isH) hg_fixfin_wave(M, wl, u, F.lane); else ret_fixfin_wave(M, wl, u, F.lane); } }
        PH_END
#endif
        PH_BEGIN_(6) { pg8::Gemm g{F_OC, F_WOUT + (size_t)l * D * D, NTOK, D, D}; pg8::StaticOrder S; S.init(NTOK, D, gridDim.x, blockIdx.x);
                   pg8::EpiRes E{F_H, F_sm + SM_MOD + (size_t)l * 9 * 6144 + 2 * 1024, NLAT / 256, NL / 256, NB}; pg8::gemm_phase<pg8::EpiRes, pg8::StaticOrder, true, true>(F.lds, g, S, E, F.tid); } PH_END
        PH_BEGIN_(7) (void)ws; norm_phase<1>(F, l); PH_END
        if ((l & 1) == 0) {
            const int li = l >> 1;
            PH_BEGIN_(8) { pg8::Gemm g{F_A, F_WFGU + (size_t)li * 2 * DFF * D, NTOK, 2 * DFF, D}; pg8::StaticOrder S; S.init(NTOK, 2 * DFF, gridDim.x, blockIdx.x);
                       pg8::EpiSwiglu E{F_ACT, DFF, 2 * DFF / 256}; pg8::gemm_phase<pg8::EpiSwiglu, pg8::StaticOrder, true, true>(F.lds, g, S, E, F.tid); } PH_END
            PH_BEGIN_(9) { pg8::Gemm g{F_ACT, F_WFD + (size_t)li * D * DFF, NTOK, D, DFF}; pg8::StaticOrder S; S.init(NTOK, D, gridDim.x, blockIdx.x);
                       pg8::EpiRes E{F_H, F_sm + SM_MOD + (size_t)l * 9 * 6144 + 5 * 1024, NLAT / 256, NL / 256, NB}; pg8::gemm_phase<pg8::EpiRes, pg8::StaticOrder, true, true>(F.lds, g, S, E, F.tid); } PH_END
        } else {
            const int li = l >> 1;
            PH_BEGIN_(10) (void)ws; moe_gather(F, li); PH_END
            PH_BEGIN_(11) { const int T = __builtin_amdgcn_readfirstlane((int)__hip_atomic_load((unsigned*)(F_sm + SM_META) + li * 16 + 8, __ATOMIC_RELAXED, __HIP_MEMORY_SCOPE_AGENT)) >> 8;
                       pg8::MoeOrder S; S.list = (const unsigned*)(F_sm + SM_ULIST) + li * (MAXTILES * 32) + ULIST_GU; S.nwg = T * (2 * DFE / 256); S.G = gridDim.x; S.c = blockIdx.x;
                       pg8::Gemm g{F_AM, F_WMGU, MAXTILES * 256, 8 * 2 * DFE, D};
                       pg8::EpiSwiglu E{F_ACT, DFE, 2 * DFE / 256}; pg8::gemm_phase<pg8::EpiSwiglu, pg8::MoeOrder, true, true>(F.lds, g, S, E, F.tid); } PH_END
            PH_BEGIN_(12) { const int T = __builtin_amdgcn_readfirstlane((int)__hip_atomic_load((unsigned*)(F_sm + SM_META) + li * 16 + 8, __ATOMIC_RELAXED, __HIP_MEMORY_SCOPE_AGENT)) >> 8;
                       pg8::MoeOrder S; S.list = (const unsigned*)(F_sm + SM_ULIST) + li * (MAXTILES * 32) + ULIST_D; S.nwg = T * (D / 256); S.G = gridDim.x; S.c = blockIdx.x;
                       pg8::Gemm g{F_ACT, F_WMD, MAXTILES * 256, 8 * D, DFE};
                       pg8::EpiBf16P E{F_Y, D, D / 256}; pg8::gemm_phase<pg8::EpiBf16P, pg8::MoeOrder, true, true>(F.lds, g, S, E, F.tid); } PH_END
        }
    }
    PH_BEGIN_(13) (void)ws; norm_phase<2>(F, DEPTH); PH_END
#undef PH_BEGIN_
#undef PH_END
}
constexpr int NPHASES = 1 + 2 * 10 + 2 * 11 + 1;

#ifndef MK_PER_PHASE
#define MK_PER_PHASE 0
#endif
#ifndef PROBE
#define PROBE 0
#endif
extern "C" void kernel_launch(void* const* d_in, const int* in_sizes, int n_in, void* d_out, int out_size, void* d_ws, size_t ws_size, hipStream_t stream) {
    static int grid = 0;
    if (grid == 0) {
        if (n_in != 28 || ws_size < WS_END || out_size != NLAT * D) { fprintf(stderr, "kernel_launch: unexpected problem shape (n_in %d, ws %zu, out %d)\n", n_in, ws_size, out_size); grid = -1; return; }
        int dev = 0, cus = 0;
        if (hipGetDevice(&dev) != hipSuccess || hipDeviceGetAttribute(&cus, hipDeviceAttributeMultiprocessorCount, dev) != hipSuccess) { grid = -1; return; }
        if (hipFuncSetAttribute((const void*)fwd_kernel, hipFuncAttributeMaxDynamicSharedMemorySize, LDS_BYTES) != hipSuccess) { fprintf(stderr, "kernel_launch: hipFuncSetAttribute failed\n"); grid = -1; return; }
        int per_cu = 0;
        if (hipOccupancyMaxActiveBlocksPerMultiprocessor(&per_cu, (const void*)fwd_kernel, NTHREADS, LDS_BYTES) != hipSuccess || per_cu < 1) { fprintf(stderr, "kernel_launch: occupancy query says %d\n", per_cu); }
        (void)hipGetLastError();
        grid = cus;
    }
    if (grid < 0) return;
    (void)hipMemsetAsync((char*)d_ws + WS_CTL, 0, CTL_ZERO_BYTES, stream);
    Args a{};
    for (int i = 0; i < 28; ++i) a.in[i] = (const float*)d_in[i];
    a.out = (float*)d_out; a.ws = (unsigned char*)d_ws;
#if MK_PER_PHASE
    for (int p = 0; p < NPHASES; ++p) { a.ph_lo = p; a.ph_hi = p + 1; hipLaunchKernelGGL(fwd_kernel, dim3(grid), dim3(NTHREADS), LDS_BYTES, stream, a);
        int l = -1, k = -1; const int base[4] = {1, 11, 22, 32}; for (int i = 0; i < 4; ++i) if (p >= base[i] && p < base[i] + (i & 1 ? 11 : 10)) { l = i; k = p - base[i]; }
        bool dup = false;
#if PROBE == 1
        dup = (p == 0);
#elif PROBE == 2
        dup = (k == 2);
#elif PROBE == 3
        dup = (k == 3);
#elif PROBE == 4
        dup = (k == 6);
#elif PROBE == 5
        dup = (k == 1);
#elif PROBE == 6
        dup = (k == 9) || ((l & 1) && (k == 10 || k == 11));
#elif PROBE == 7
        dup = (k == 8 && !(l & 1)) || (k == 0 && l == 0);
#endif
        if (dup) hipLaunchKernelGGL(fwd_kernel, dim3(grid), dim3(NTHREADS), LDS_BYTES, stream, a); }
#else
    a.ph_lo = 0; a.ph_hi = NPHASES; hipLaunchKernelGGL(fwd_kernel, dim3(grid), dim3(NTHREADS), LDS_BYTES, stream, a);
#endif
}
```

```cpp
#include <hip/hip_runtime.h>
#include <cstdio>
#include <cstdint>
#include <cmath>
#ifndef NB
#define NB 8
#endif
constexpr int D = 1024, NL = 2048, NC = 256, TK = NL + NC, DEPTH = 4, GRIDW = 64;
constexpr int NLAT = NB * NL, NCTX = NB * NC, NTOK = NLAT + NCTX;
constexpr int NP = 3840;
constexpr int DIN = 2912;
constexpr int C_QLAT = 0, C_KVLAT = 192, C_KPE = 320, C_HQ = 352, C_HZF = 608, C_HZB = 864, C_HI = 1120, C_HG = 1376;
constexpr int C_SQ = 1632, C_SK = 1888, C_SV = 2016, C_RQ = 2144, C_RK = 2272, C_RV = 2400, C_RG = 2656, C_QE = 2912, C_KVE = 3296;
constexpr int DFF = 2816, NEXP = 8, DFE = 3584;
constexpr float NORM_EPS = 1e-6f, LOG2E = 1.4426950408889634f;
typedef unsigned short bf16;

#ifdef HOST_TEST
#define HD static inline
#else
#define HD __host__ __device__ __forceinline__
#endif

HD float bf2f(bf16 b) { unsigned u = ((unsigned)b) << 16; float f; __builtin_memcpy(&f, &u, 4); return f; }
HD bf16 f2bf(float f) { unsigned u; __builtin_memcpy(&u, &f, 4); return (bf16)((u + 0x7fffu + ((u >> 16) & 1u)) >> 16); }
#define CBAR() asm volatile("" ::: "memory")
struct U4 { unsigned x, y, z, w; };
HD void ld8(const bf16* p, float (&f)[8]) {
    U4 u; __builtin_memcpy(&u, __builtin_assume_aligned(p, 16), 16);
    unsigned t;
    t = u.x << 16; __builtin_memcpy(&f[0], &t, 4); t = u.x & 0xffff0000u; __builtin_memcpy(&f[1], &t, 4);
    t = u.y << 16; __builtin_memcpy(&f[2], &t, 4); t = u.y & 0xffff0000u; __builtin_memcpy(&f[3], &t, 4);
    t = u.z << 16; __builtin_memcpy(&f[4], &t, 4); t = u.z & 0xffff0000u; __builtin_memcpy(&f[5], &t, 4);
    t = u.w << 16; __builtin_memcpy(&f[6], &t, 4); t = u.w & 0xffff0000u; __builtin_memcpy(&f[7], &t, 4);
}
HD void ld4f(const float* p, float (&f)[4]) { __builtin_memcpy(&f[0], __builtin_assume_aligned(p, 16), 16); }
HD float silu_f(float x) { return x / (1.0f + expf(-x)); }
HD int row_of(int b, int tq) { return tq < NC ? NLAT + b * NC + tq : b * NL + (tq - NC); }
HD void row_split(int row, int& b, int& tq) { if (row < NLAT) { b = row / NL; tq = NC + row % NL; } else { const int r = row - NLAT; b = r / NC; tq = r % NC; } }
HD float log_sigmoid_f(float x) { return fminf(x, 0.f) - log1pf(expf(-fabsf(x))); }

struct Mix {
    const bf16* P;
    bf16 *Qm, *Km, *Vm;
    bf16 *Qs, *Ks, *Vs;
    float* HF;
    float* HO;
    float *RQ, *RK;
    float* RO;
    bf16* OC;
    const float *loglb, *log1mlb;
    const float* hg_norm_g;
    const float* sink;
    const float* log_gamma;
    const float *gn_g, *gn_b;
    float *HU, *HDK, *HQC;
    float *RU, *RQC;
};
constexpr int CH = 72, NCH = TK / CH;
static_assert(NCH * CH == TK, "chunking");

HD void mla_prep_item(const Mix& M, int item) {
    const int row = item >> 2, h = item & 3; int b, tq; row_split(row, b, tq);
    const bf16* p = M.P + (size_t)row * NP;
    float sq = 0.f, skv = 0.f;
    for (int j = 0; j < 192; ++j) { const float v = bf2f(p[C_QLAT + j]); sq += v * v; }
    for (int j = 0; j < 128; ++j) { const float v = bf2f(p[C_KVLAT + j]); skv += v * v; }
    const float rq = 1.0f / sqrtf(sq * (1.0f / 192.0f) + NORM_EPS), rkv = 1.0f / sqrtf(skv * (1.0f / 128.0f) + NORM_EPS);
    const float qs = rq * 0.10206207261596575f * LOG2E;
    const size_t o96 = ((size_t)(b * 4 + h) * TK + tq) * 96;
    for (int j = 0; j < 64; ++j) {
        M.Qm[o96 + j] = f2bf(bf2f(p[C_QE + h * 96 + j]) * qs);
        M.Km[o96 + j] = f2bf(bf2f(p[C_KVE + h * 128 + j]) * rkv);
        M.Vm[((size_t)(b * 4 + h) * 64 + j) * TK + tq] = f2bf(bf2f(p[C_KVE + h * 128 + 64 + j]) * rkv);
    }
    const bool lat = tq >= NC; const int t = tq - NC;
    for (int j = 0; j < 16; ++j) {
        float c = 1.f, s = 0.f;
        if (lat) { const float inv = powf(10000.0f, -(float)(j & 7) / 8.0f); const float ang = (float)(j < 8 ? t / GRIDW : t % GRIDW) * inv; c = cosf(ang); s = sinf(ang); }
        const float q1 = bf2f(p[C_QE + h * 96 + 64 + j]), q2 = bf2f(p[C_QE + h * 96 + 80 + j]);
        M.Qm[o96 + 64 + j] = f2bf((q1 * c - q2 * s) * qs); M.Qm[o96 + 80 + j] = f2bf((q1 * s + q2 * c) * qs);
        const float k1 = bf2f(p[C_KPE + j]), k2 = bf2f(p[C_KPE + 16 + j]);
        M.Km[o96 + 64 + j] = f2bf(k1 * c - k2 * s); M.Km[o96 + 80 + j] = f2bf(k1 * s + k2 * c);
    }
}
HD void swa_prep_item(const Mix& M, int item) {
    const int row = item >> 3, s = item & 7; int b, tq; row_split(row, b, tq);
    const bf16* p = M.P + (size_t)row * NP;
    const bool lat = tq >= NC; const int t = tq - NC;
    if (s >= 6) { const int kh = s - 6; bf16* o = M.Vs + (size_t)(b * 2 + kh) * 64 * TK + tq; for (int j = 0; j < 64; ++j) o[(size_t)j * TK] = p[C_SV + kh * 64 + j]; return; }
    const bf16* src = s < 4 ? p + C_SQ + s * 64 : p + C_SK + (s - 4) * 64;
    bf16* o = s < 4 ? M.Qs + ((size_t)(b * 4 + s) * TK + tq) * 64 : M.Ks + ((size_t)(b * 2 + (s - 4)) * TK + tq) * 64;
    const float sc = s < 4 ? 0.125f * LOG2E : 1.0f;
    for (int j = 0; j < 32; ++j) {
        float c = 1.f, sn = 0.f;
        if (lat) { const float inv = powf(10000.0f, -(float)(j & 15) / 16.0f); const float ang = (float)(j < 16 ? t / GRIDW : t % GRIDW) * inv; c = cosf(ang); sn = sinf(ang); }
        const float x1 = bf2f(src[j]), x2 = bf2f(src[32 + j]);
        o[j] = f2bf((x1 * c - x2 * sn) * sc); o[32 + j] = f2bf((x1 * sn + x2 * c) * sc);
    }
}
HD void hg_prep_item(const Mix& M, int item) {
    const int row = item >> 8, c = item & 255;
    const bf16* p = M.P + (size_t)row * NP;
    for (int d = 0; d < 2; ++d) {
        const float z = bf2f(p[(d ? C_HZB : C_HZF) + c]);
        const float a = M.loglb[d * 256 + c], bb = M.log1mlb[d * 256 + c] + log_sigmoid_f(z);
        const float mx = fmaxf(a, bb), lf = mx + log1pf(expf(-fabsf(a - bb)));
        M.HF[((size_t)d * NTOK + row) * 256 + c] = expf(lf);
    }
}
HD void ret_prep_item(const Mix& M, int item) {
    const int row = item >> 3, w = (item >> 2) & 1, h = item & 3; int b, tq; row_split(row, b, tq);
    const bf16* src = M.P + (size_t)row * NP + (w ? C_RK : C_RQ) + h * 32;
    float* o = (w ? M.RK : M.RQ) + (size_t)row * 128 + h * 32;
    const float sc = w ? 1.0f : 0.17677669529663687f;
    for (int j = 0; j < 16; ++j) {
        const float inv = powf(10000.0f, -(float)j / 16.0f); const float ang = (float)tq * inv; const float c = cosf(ang), s = sinf(ang);
        const float x1 = bf2f(src[j]), x2 = bf2f(src[16 + j]);
        o[j] = (x1 * c - x2 * s) * sc; o[16 + j] = (x1 * s + x2 * c) * sc;
    }
}
HD void mla_attn_item(const Mix& M, int item) {
    const int tq = item % TK, bh = item / TK, b = bh >> 2, h = bh & 3;
    const bf16* qp = M.Qm + (size_t)item * 96;
    float q[96], o[64];
#pragma unroll
    for (int c8 = 0; c8 < 12; ++c8) { float t8[8]; ld8(qp + 8 * c8, t8);
#pragma unroll
        for (int j = 0; j < 8; ++j) q[8 * c8 + j] = t8[j]; }
#pragma unroll
    for (int j = 0; j < 64; ++j) o[j] = 0.f;
    float m = -1e30f, l = 0.f;
    const int nk = tq < NC ? NC : TK;
    const bf16* kb = M.Km + (size_t)bh * TK * 96; const bf16* vb = M.Vm + (size_t)bh * TK * 64;
    for (int k = 0; k < nk; ++k) {
        const bf16* kp = kb + (size_t)k * 96; float s = 0.f;
#pragma unroll
        for (int c8 = 0; c8 < 12; ++c8) { float t8[8]; ld8(kp + 8 * c8, t8);
#pragma unroll
            for (int j = 0; j < 8; ++j) s += q[8 * c8 + j] * t8[j];
            if ((c8 & 3) == 3) CBAR(); }
        const float mn = fmaxf(m, s), al = exp2f(m - mn), pr = exp2f(s - mn);
        l = l * al + pr; m = mn;
        const bf16* vp = vb + k;
#pragma unroll
        for (int j = 0; j < 64; ++j) o[j] = o[j] * al + pr * bf2f(vp[(size_t)j * TK]);
    }
    const float rl = 1.0f / l; bf16* op = M.OC + (size_t)row_of(b, tq) * D + h * 64;
#pragma unroll
    for (int j = 0; j < 64; ++j) op[j] = f2bf(o[j] * rl);
}
HD void swa_attn_item(const Mix& M, int item) {
    const int tq = item % TK, bh = item / TK, b = bh >> 2, hq = bh & 3, kh = hq >> 1;
    const bf16* qp = M.Qs + (size_t)item * 64;
    float q[64], o[64];
#pragma unroll
    for (int c8 = 0; c8 < 8; ++c8) { float t8[8]; ld8(qp + 8 * c8, t8);
#pragma unroll
        for (int j = 0; j < 8; ++j) { q[8 * c8 + j] = t8[j]; o[8 * c8 + j] = 0.f; } }
    float m = M.sink[hq] * LOG2E, l = 1.0f;
    const bf16* kb = M.Ks + (size_t)(b * 2 + kh) * TK * 64; const bf16* vb = M.Vs + (size_t)(b * 2 + kh) * TK * 64;
    const int t = tq - NC;
    const int lo2 = tq < NC ? 0 : (t - 128 < 0 ? 0 : t - 128), hi2 = tq < NC ? -1 : (t + 128 > NL - 1 ? NL - 1 : t + 128);
    const int n2 = hi2 - lo2 + 1;
    for (int i = 0; i < NC + n2; ++i) {
        const int k = i < NC ? i : NC + lo2 + (i - NC);
        const bf16* kp = kb + (size_t)k * 64; float s = 0.f;
#pragma unroll
        for (int c8 = 0; c8 < 8; ++c8) { float t8[8]; ld8(kp + 8 * c8, t8);
#pragma unroll
            for (int j = 0; j < 8; ++j) s += q[8 * c8 + j] * t8[j];
            if ((c8 & 3) == 3) CBAR(); }
        const float mn = fmaxf(m, s), al = exp2f(m - mn), pr = exp2f(s - mn);
        l = l * al + pr; m = mn;
        const bf16* vp = vb + k;
#pragma unroll
        for (int j = 0; j < 64; ++j) o[j] = o[j] * al + pr * bf2f(vp[(size_t)j * TK]);
    }
    const float rl = 1.0f / l; bf16* op = M.OC + (size_t)row_of(b, tq) * D + 512 + hq * 64;
#pragma unroll
    for (int j = 0; j < 64; ++j) op[j] = f2bf(o[j] * rl);
}
HD int dir_tq(int dir, int i) { return dir == 0 ? i : (i < NC ? NC - 1 - i : NC + (NL - 1 - (i - NC))); }
HD void hg_scan_item(const Mix& M, int item) {
    const int v = item & 63, h = (item >> 6) & 3, b = (item >> 8) % NB, dir = item / (256 * NB);
    float S[64];
#pragma unroll
    for (int k = 0; k < 64; ++k) S[k] = 0.f;
    for (int i = 0; i < TK; ++i) {
        const int row = row_of(b, dir_tq(dir, i));
        const bf16* p = M.P + (size_t)row * NP; const float* f = M.HF + ((size_t)dir * NTOK + row) * 256 + h * 64;
        const float vv = bf2f(p[C_HI + h * 64 + v]); float acc = 0.f;
#pragma unroll
        for (int c8 = 0; c8 < 8; ++c8) { float q8[8], fa[4], fb[4]; ld8(p + C_HQ + h * 64 + 8 * c8, q8); ld4f(f + 8 * c8, fa); ld4f(f + 8 * c8 + 4, fb);
#pragma unroll
            for (int j = 0; j < 8; ++j) { const int k = 8 * c8 + j; const float fk = j < 4 ? fa[j] : fb[j - 4]; S[k] = fk * S[k] + (1.0f - fk) * vv; acc += q8[j] * S[k]; }
            if ((c8 & 1) == 1) CBAR(); }
        M.HO[((size_t)dir * NTOK + row) * 256 + h * 64 + v] = acc * 0.125f;
    }
}
HD void ret_scan_item(const Mix& M, int item) {
    const int v = item & 63, h = (item >> 6) & 3, b = (item >> 8) % NB, dir = item / (256 * NB);
    const float g = expf(M.log_gamma[dir * 4 + h]);
    float S[32];
#pragma unroll
    for (int k = 0; k < 32; ++k) S[k] = 0.f;
    for (int i = 0; i < TK; ++i) {
        const int row = row_of(b, dir_tq(dir, i));
        const float vv = bf2f(M.P[(size_t)row * NP + C_RV + h * 64 + v]);
        const float* qk = M.RQ + (size_t)row * 128 + h * 32; const float* kk = M.RK + (size_t)row * 128 + h * 32; float acc = 0.f;
#pragma unroll
        for (int c4 = 0; c4 < 8; ++c4) { float qa[4], ka[4]; ld4f(qk + 4 * c4, qa); ld4f(kk + 4 * c4, ka);
#pragma unroll
            for (int j = 0; j < 4; ++j) { const int k = 4 * c4 + j; S[k] = g * S[k] + ka[j] * vv; acc += qa[j] * S[k]; }
            if ((c4 & 3) == 3) CBAR(); }
        M.RO[((size_t)dir * NTOK + row) * 256 + h * 64 + v] = acc;
    }
}
HD void hg_fin_item(const Mix& M, int item) {
    const int row = item >> 2, h = item & 3;
    const float* o0 = M.HO + (size_t)row * 256 + h * 64; const float* o1 = o0 + (size_t)NTOK * 256;
    float ss = 0.f;
    for (int v = 0; v < 64; ++v) { const float x = o0[v] + o1[v]; ss += x * x; }
    const float r = 1.0f / sqrtf(ss * (1.0f / 64.0f) + NORM_EPS);
    const bf16* gp = M.P + (size_t)row * NP + C_HG + h * 64; bf16* op = M.OC + (size_t)row * D + 256 + h * 64;
    for (int v = 0; v < 64; ++v) op[v] = f2bf((o0[v] + o1[v]) * r * M.hg_norm_g[h * 64 + v] * silu_f(bf2f(gp[v])));
}
HD void ret_fin_item(const Mix& M, int item) {
    const int row = item >> 2, h = item & 3;
    const float* o0 = M.RO + (size_t)row * 256 + h * 64; const float* o1 = o0 + (size_t)NTOK * 256;
    float s = 0.f;
    for (int v = 0; v < 64; ++v) s += o0[v] + o1[v];
    const float mu = s * (1.0f / 64.0f); float q = 0.f;
    for (int v = 0; v < 64; ++v) { const float d = o0[v] + o1[v] - mu; q += d * d; }
    const float r = 1.0f / sqrtf(q * (1.0f / 64.0f) + NORM_EPS);
    const bf16* gp = M.P + (size_t)row * NP + C_RG + h * 64; bf16* op = M.OC + (size_t)row * D + 768 + h * 64;
    for (int v = 0; v < 64; ++v) op[v] = f2bf(((o0[v] + o1[v] - mu) * r * M.gn_g[h * 64 + v] + M.gn_b[h * 64 + v]) * silu_f(bf2f(gp[v])));
}

HD void hg_local_item(const Mix& M, int item) {
    const int v = item & 63, c = (item >> 6) % NCH, seq = item / (64 * NCH), h = seq & 3, b = (seq >> 2) % NB, dir = seq / (4 * NB);
    float S[64];
#pragma unroll
    for (int k = 0; k < 64; ++k) S[k] = 0.f;
    float dk = 1.0f;
    for (int i = 0; i < CH; ++i) {
        const int row = row_of(b, dir_tq(dir, c * CH + i));
        const bf16* p = M.P + (size_t)row * NP; const float* f = M.HF + ((size_t)dir * NTOK + row) * 256 + h * 64;
        const float vv = bf2f(p[C_HI + h * 64 + v]); float acc = 0.f;
        dk *= f[v]; M.HQC[((size_t)dir * NTOK + row) * 256 + h * 64 + v] = bf2f(p[C_HQ + h * 64 + v]) * dk * 0.125f;
#pragma unroll
        for (int c8 = 0; c8 < 8; ++c8) { float q8[8], fa[4], fb[4]; ld8(p + C_HQ + h * 64 + 8 * c8, q8); ld4f(f + 8 * c8, fa); ld4f(f + 8 * c8 + 4, fb);
#pragma unroll
            for (int j = 0; j < 8; ++j) { const int k = 8 * c8 + j; const float fk = j < 4 ? fa[j] : fb[j - 4]; S[k] = fk * (S[k] - vv) + vv; acc += q8[j] * S[k]; }
            if ((c8 & 1) == 1) CBAR(); }
        M.HO[((size_t)dir * NTOK + row) * 256 + h * 64 + v] = acc * 0.125f;
    }
    float* u = M.HU + ((size_t)seq * NCH + c) * 4096 + v;
#pragma unroll
    for (int k = 0; k < 64; ++k) u[k * 64] = S[k];
    M.HDK[((size_t)seq * NCH + c) * 64 + v] = dk;
}
HD void hg_carry_item(const Mix& M, int item) {
    const int kv = item & 4095, seq = item >> 12, k = kv >> 6; float s = 0.f;
#pragma unroll 8
    for (int c = 0; c < NCH; ++c) { float* u = M.HU + ((size_t)seq * NCH + c) * 4096 + kv; const float uu = *u; *u = s; s = M.HDK[((size_t)seq * NCH + c) * 64 + k] * s + uu; }
}
HD void hg_fix_item(const Mix& M, int item) {
    const int v = item & 63, c = (item >> 6) % NCH, seq = item / (64 * NCH), h = seq & 3, b = (seq >> 2) % NB, dir = seq / (4 * NB);
    if (c == 0) return;
    float S[64]; const float* u = M.HU + ((size_t)seq * NCH + c) * 4096 + v;
#pragma unroll
    for (int k = 0; k < 64; ++k) S[k] = u[k * 64];
    for (int i = 0; i < CH; ++i) {
        const int row = row_of(b, dir_tq(dir, c * CH + i));
        const float* qc = M.HQC + ((size_t)dir * NTOK + row) * 256 + h * 64; float acc = 0.f;
#pragma unroll
        for (int c4 = 0; c4 < 16; ++c4) { float qa[4]; ld4f(qc + 4 * c4, qa);
#pragma unroll
            for (int j = 0; j < 4; ++j) acc += qa[j] * S[4 * c4 + j];
            if ((c4 & 3) == 3) CBAR(); }
        M.HO[((size_t)dir * NTOK + row) * 256 + h * 64 + v] += acc;
    }
}
HD void ret_local_item(const Mix& M, int item) {
    const int v = item & 63, c = (item >> 6) % NCH, seq = item / (64 * NCH), h = seq & 3, b = (seq >> 2) % NB, dir = seq / (4 * NB);
    const float g = expf(M.log_gamma[dir * 4 + h]);
    float S[32];
#pragma unroll
    for (int k = 0; k < 32; ++k) S[k] = 0.f;
    float gp = 1.0f;
    for (int i = 0; i < CH; ++i) {
        const int row = row_of(b, dir_tq(dir, c * CH + i));
        const float vv = bf2f(M.P[(size_t)row * NP + C_RV + h * 64 + v]);
        const float* qk = M.RQ + (size_t)row * 128 + h * 32; const float* kk = M.RK + (size_t)row * 128 + h * 32; float acc = 0.f;
        gp *= g; if (v < 32) M.RQC[((size_t)dir * NTOK + row) * 128 + h * 32 + v] = qk[v] * gp;
#pragma unroll
        for (int c4 = 0; c4 < 8; ++c4) { float qa[4], ka[4]; ld4f(qk + 4 * c4, qa); ld4f(kk + 4 * c4, ka);
#pragma unroll
            for (int j = 0; j < 4; ++j) { const int k = 4 * c4 + j; S[k] = g * S[k] + ka[j] * vv; acc += qa[j] * S[k]; }
            if ((c4 & 3) == 3) CBAR(); }
        M.RO[((size_t)dir * NTOK + row) * 256 + h * 64 + v] = acc;
    }
    float* u = M.RU + ((size_t)seq * NCH + c) * 2048 + v;
#pragma unroll
    for (int k = 0; k < 32; ++k) u[k * 64] = S[k];
}
HD void ret_carry_item(const Mix& M, int item) {
    const int kv = item & 2047, seq = item >> 11, h = seq & 3, dir = seq / (4 * NB); float s = 0.f;
    const float d = expf((float)CH * M.log_gamma[dir * 4 + h]);
#pragma unroll 8
    for (int c = 0; c < NCH; ++c) { float* u = M.RU + ((size_t)seq * NCH + c) * 2048 + kv; const float uu = *u; *u = s; s = d * s + uu; }
}
HD void ret_fix_item(const Mix& M, int item) {
    const int v = item & 63, c = (item >> 6) % NCH, seq = item / (64 * NCH), h = seq & 3, b = (seq >> 2) % NB, dir = seq / (4 * NB);
    if (c == 0) return;
    float S[32]; const float* u = M.RU + ((size_t)seq * NCH + c) * 2048 + v;
#pragma unroll
    for (int k = 0; k < 32; ++k) S[k] = u[k * 64];
    for (int i = 0; i < CH; ++i) {
        const int row = row_of(b, dir_tq(dir, c * CH + i));
        const float* qc = M.RQC + ((size_t)dir * NTOK + row) * 128 + h * 32; float acc = 0.f;
#pragma unroll
        for (int c4 = 0; c4 < 8; ++c4) { float qa[4]; ld4f(qc + 4 * c4, qa);
#pragma unroll
            for (int j = 0; j < 4; ++j) acc += qa[j] * S[4 * c4 + j];
            if ((c4 & 3) == 3) CBAR(); }
        M.RO[((size_t)dir * NTOK + row) * 256 + h * 64 + v] += acc;
    }
}
namespace pg8 {
#define PG8_LAS __attribute__((address_space(3)))
typedef unsigned short bf16_t;
typedef short bf16x8 __attribute__((ext_vector_type(8)));
typedef float f32x4 __attribute__((ext_vector_type(4)));
typedef unsigned u32x4 __attribute__((ext_vector_type(4)));
constexpr int BM = 256, BK = 64, HALF = 128, HTB = HALF * BK * 2  , STAGE_BYTES = 8 * HTB, NXCD = 8, WGM = 8;

__host__ __device__ __forceinline__ int lds_byte(int r, int c) { const int st = (r >> 4) * 2 + (c >> 5), rr = r & 15, cc = c & 31, ob = rr * 64 + cc * 2; return st * 1024 + (ob ^ (((ob >> 9) & 1) << 5)); }
__host__ __device__ __forceinline__ void stage_rc(int b, int& R, int& C) { const int st = b / 1024, sb = b % 1024, swz = sb ^ (((sb >> 9) & 1) << 5); R = (st >> 1) * 16 + swz / 64; C = (st & 1) * 32 + (swz % 64) / 2; }
__host__ __device__ __forceinline__ int perm32(int rho) { const int n = rho >> 4, i = rho & 15; return 8 * (i >> 2) + 4 * n + (i & 3); }

struct Unit { int pm, pn; };
struct Gemm { const bf16_t* A; const bf16_t* Bt; int M, N, K; };

struct StaticOrder {
    int nM, nN, nwg, G, c;
    __host__ __device__ void init(int M, int N, int G_, int c_) { nM = M / BM; nN = N / BM; nwg = nM * nN; G = G_; c = c_; }
    __host__ __device__ bool next(int i, Unit& u) const {
        const long L = (long)i * G + c; if (L >= nwg) return false;
        int wgid = (int)L; { const int q = nwg / NXCD, r = nwg % NXCD, xcd = wgid % NXCD, off = wgid / NXCD; wgid = (xcd < r ? xcd * (q + 1) : r * (q + 1) + (xcd - r) * q) + off; }
        const int nig = WGM * nN, gid = wgid / nig, fm = gid * WGM, gsz = (nM - fm) < WGM ? (nM - fm) : WGM;
        u.pm = fm + ((wgid % nig) % gsz); u.pn = (wgid % nig) / gsz; return true;
    }
    __device__ __forceinline__ void a_ready(const Unit&) const {}
    __device__ __forceinline__ void done(const Unit&) const {}
};

__device__ __forceinline__ unsigned cvt_pk_bf16(float lo, float hi) { unsigned r; asm volatile("v_cvt_pk_bf16_f32 %0, %1, %2" : "=v"(r) : "v"(lo), "v"(hi)); return r; }
typedef unsigned u32x2 __attribute__((ext_vector_type(2)));
struct EpiBf16P {
    static constexpr bool PERM = true, AFTER_DRAIN = false;
    bf16_t* O; int ldc; int nN;
    __device__ __forceinline__ void operator()(const f32x4 (&acc)[2][2][4][2], const Unit& u, int wr, int wc, int fr, int fq) const {
        const int row0 = u.pm * BM + wr * 64 + fr, col0 = (u.pn % nN) * BM + wc * 32 + 8 * fq;
#pragma unroll
        for (int ai = 0; ai < 2; ++ai)
#pragma unroll
            for (int m = 0; m < 4; ++m) { bf16_t* rowp = O + (size_t)(row0 + ai * HALF + m * 16) * ldc + col0;
#pragma unroll
                for (int bj = 0; bj < 2; ++bj) { const f32x4 v0 = acc[ai][bj][m][0], v1 = acc[ai][bj][m][1];
                    u32x4 w; w.x = cvt_pk_bf16(v0[0], v0[1]); w.y = cvt_pk_bf16(v0[2], v0[3]); w.z = cvt_pk_bf16(v1[0], v1[1]); w.w = cvt_pk_bf16(v1[2], v1[3]);
                    *(u32x4*)(rowp + bj * HALF) = w; } }
    }
};
struct EpiRes {
    static constexpr bool PERM = false, AFTER_DRAIN = false;
    float* H; const float* gate; int lat_tiles, tiles_per_batch, ctx_bidx;
    __device__ __forceinline__ void operator()(const f32x4 (&acc)[2][2][4][2], const Unit& u, int wr, int wc, int fr, int fq) const {
        const int bidx = u.pm < lat_tiles ? u.pm / tiles_per_batch : ctx_bidx;
        const float* g = gate + (size_t)bidx * 6144;
        const int row0 = u.pm * BM + wr * 64 + fr, col0 = u.pn * BM + wc * 32 + 4 * fq;
        f32x4 gv[2][2];
#pragma unroll
        for (int bj = 0; bj < 2; ++bj)
#pragma unroll
            for (int n = 0; n < 2; ++n) gv[bj][n] = *(const f32x4*)(g + col0 + bj * HALF + n * 16);
#pragma unroll
        for (int ai = 0; ai < 2; ++ai)
#pragma unroll
            for (int m = 0; m < 4; ++m) { float* rowp = H + (size_t)(row0 + ai * HALF + m * 16) * 1024 + col0;
#pragma unroll
                for (int bj = 0; bj < 2; ++bj)
#pragma unroll
                    for (int n = 0; n < 2; ++n) { f32x4* p = (f32x4*)(rowp + bj * HALF + n * 16); *p = *p + gv[bj][n] * acc[ai][bj][m][n]; } }
    }
};
struct EpiSwiglu {
    static constexpr bool PERM = true, AFTER_DRAIN = false;
    bf16_t* O; int ldo; int nN;
    __device__ __forceinline__ void operator()(const f32x4 (&acc)[2][2][4][2], const Unit& u, int wr, int wc, int fr, int fq) const {
        const int row0 = u.pm * BM + wr * 64 + fr, col0 = (u.pn % nN) * 128 + wc * 16 + 4 * fq;
#pragma unroll
        for (int ai = 0; ai < 2; ++ai)
#pragma unroll
            for (int m = 0; m < 4; ++m) { bf16_t* rowp = O + (size_t)(row0 + ai * HALF + m * 16) * ldo + col0;
#pragma unroll
                for (int bj = 0; bj < 2; ++bj) { const f32x4 gt = acc[ai][bj][m][0], up = acc[ai][bj][m][1]; float r[4];
#pragma unroll
                    for (int i = 0; i < 4; ++i) r[i] = gt[i] * __builtin_amdgcn_rcpf(1.0f + __builtin_amdgcn_exp2f(-1.4426950408889634f * gt[i])) * up[i];
                    u32x2 w; w.x = cvt_pk_bf16(r[0], r[1]); w.y = cvt_pk_bf16(r[2], r[3]);
                    *(u32x2*)(rowp + bj * 64) = w; } }
    }
};
struct MoeOrder {
    const unsigned* list; int nwg, G, c;
    __device__ __forceinline__ bool next(int i, Unit& u) const {
        const long L = (long)i * G + c; if (L >= nwg) return false;
        unsigned w; const unsigned* ptr = list + L;
        asm volatile("s_load_dword %0, %1, 0x0\n\ts_waitcnt lgkmcnt(0)" : "=s"(w) : "s"(ptr) : "memory");
        u.pm = (int)(w & 0xffffu); u.pn = (int)(w >> 16); return true;
    }
    __device__ __forceinline__ void a_ready(const Unit&) const {}
    __device__ __forceinline__ void done(const Unit&) const {}
};
template <class Epi, class Sched, bool ALIGN_EPI = false, bool SP2 = false>
__device__ __forceinline__ void gemm_phase(PG8_LAS unsigned char* lds, const Gemm g, const Sched& S, const Epi& E, const int tid_in) {
    const int tid = tid_in, wid = __builtin_amdgcn_readfirstlane(tid >> 6), lane = tid & 63, wr = wid >> 2, wc = wid & 3, fr = lane & 15, fq = lane >> 4;
    const int K = g.K, nt = K / BK;
    unsigned voffA[2], voffB[2];
#pragma unroll
    for (int i = 0; i < 2; ++i) { int R, C; stage_rc(tid * 16 + i * 8192, R, C); const int Rb = Epi::PERM ? ((R & ~31) + perm32(R & 31)) : R;
        voffA[i] = (unsigned)(R * K + C) * 2u; voffB[i] = (unsigned)(Rb * K + C) * 2u; }
    const size_t kstep = (size_t)(BK * 2);
    const size_t hstep = (size_t)HALF * K * 2;
    const size_t tstep = 2 * hstep;
    const unsigned ldsw = (unsigned)wid * 1024u;
    const int aoff = lds_byte(wr * 64 + fr, fq * 8), boff = lds_byte(wc * 32 + fr, fq * 8);
#define PG8_SA(b, h) (((b) * 2 + (h)) * HTB)
#define PG8_SB(b, h) ((4 + (b) * 2 + (h)) * HTB)
#define PG8_STAGE(bufoff, gbase, voff) do { _Pragma("unroll") for (int _i = 0; _i < 2; ++_i) \
        __builtin_amdgcn_global_load_lds((const unsigned*)((const char*)(gbase) + (voff)[_i]), (PG8_LAS unsigned*)(lds + (bufoff) + ldsw + _i * 8192), 16, 0, 0); } while (0)
#define PG8_LDA(dst, b, h) do { _Pragma("unroll") for (int m = 0; m < 4; ++m) _Pragma("unroll") for (int k = 0; k < 2; ++k) dst[m][k] = *(const PG8_LAS bf16x8*)(lds + PG8_SA(b, h) + aoff + m * 2048 + k * 1024); } while (0)
#define PG8_LDB(dst, b, h) do { _Pragma("unroll") for (int n = 0; n < 2; ++n) _Pragma("unroll") for (int k = 0; k < 2; ++k) dst[n][k] = *(const PG8_LAS bf16x8*)(lds + PG8_SB(b, h) + boff + n * 2048 + k * 1024); } while (0)
#define PG8_MMA(ai, bj, At, Bt) do { __builtin_amdgcn_s_setprio(1); _Pragma("unroll") for (int m = 0; m < 4; ++m) _Pragma("unroll") for (int n = 0; n < 2; ++n) _Pragma("unroll") for (int k = 0; k < 2; ++k) \
        acc[ai][bj][m][n] = __builtin_amdgcn_mfma_f32_16x16x32_bf16(Bt[n][k], At[m][k], acc[ai][bj][m][n], 0, 0, 0); __builtin_amdgcn_s_setprio(0); } while (0)
#define PG8_WAIT_V(n) asm volatile("s_waitcnt vmcnt(" #n ")" ::: "memory")
#define PG8_WAIT_L(n) asm volatile("s_waitcnt lgkmcnt(" #n ")" ::: "memory")
#define PG8_BAR __builtin_amdgcn_s_barrier()
#define PG8_SCHED __builtin_amdgcn_sched_barrier(0)
    Unit cur, nxt; int ui = 0;
    if (!S.next(0, cur)) return;
    f32x4 acc[2][2][4][2];
#pragma unroll
    for (int a = 0; a < 2; ++a)
#pragma unroll
        for (int b = 0; b < 2; ++b)
#pragma unroll
            for (int m = 0; m < 4; ++m)
#pragma unroll
                for (int n = 0; n < 2; ++n) acc[a][b][m][n] = (f32x4){0.f, 0.f, 0.f, 0.f};
    bf16x8 At[4][2], B0[2][2], B1[2][2];
    const char* cA = (const char*)g.A + (size_t)cur.pm * tstep; const char* cB = (const char*)g.Bt + (size_t)cur.pn * tstep;
    S.a_ready(cur);
    if constexpr (SP2) {
        PG8_STAGE(PG8_SB(0, 0), cB, voffB); PG8_STAGE(PG8_SB(0, 1), cB + hstep, voffB); PG8_STAGE(PG8_SA(0, 0), cA, voffA); PG8_STAGE(PG8_SA(0, 1), cA + hstep, voffA);
        if (wr == 1) PG8_BAR;
        PG8_WAIT_V(2); PG8_BAR;
        PG8_STAGE(PG8_SB(1, 0), cB + kstep, voffB); PG8_STAGE(PG8_SA(1, 0), cA + kstep, voffA); PG8_STAGE(PG8_SB(1, 1), cB + hstep + kstep, voffB);
        PG8_WAIT_V(6); PG8_BAR;
    } else {
        PG8_STAGE(PG8_SB(0, 0), cB, voffB); PG8_STAGE(PG8_SA(0, 0), cA, voffA); PG8_STAGE(PG8_SB(0, 1), cB + hstep, voffB); PG8_STAGE(PG8_SA(0, 1), cA + hstep, voffA);
        if (wr == 1) PG8_BAR;
        PG8_WAIT_V(4); PG8_BAR;
        PG8_STAGE(PG8_SB(1, 0), cB + kstep, voffB); PG8_STAGE(PG8_SA(1, 0), cA + kstep, voffA); PG8_STAGE(PG8_SB(1, 1), cB + hstep + kstep, voffB);
        PG8_WAIT_V(6); PG8_BAR;
    }
    for (;;) {
        const bool has_next = S.next(ui + 1, nxt);
        const char* nA = has_next ? (const char*)g.A + (size_t)nxt.pm * tstep : cA; const char* nB = has_next ? (const char*)g.Bt + (size_t)nxt.pn * tstep : cB;
        for (int t = 0; t < nt; t += 2) {
            const bool last = (t == nt - 2);
            const char* a1 = cA + (size_t)(t + 1) * kstep;
            const char* a2 = last ? nA : cA + (size_t)(t + 2) * kstep; const char* b2 = last ? nB : cB + (size_t)(t + 2) * kstep;
            const char* a3 = a2 + kstep; const char* b3 = b2 + kstep;
            if (last && has_next) S.a_ready(nxt);
            if constexpr (SP2) {
            PG8_LDB(B0, 0, 0); PG8_LDB(B1, 0, 1); PG8_SCHED; PG8_LDA(At, 0, 0); PG8_STAGE(PG8_SA(1, 1), a1 + hstep, voffA);
            PG8_WAIT_V(8); PG8_WAIT_L(0); PG8_BAR; PG8_MMA(0, 0, At, B0); PG8_MMA(0, 1, At, B1); PG8_BAR; PG8_SCHED;
            PG8_LDA(At, 0, 1); PG8_STAGE(PG8_SB(0, 0), b2, voffB); PG8_STAGE(PG8_SB(0, 1), b2 + hstep, voffB); PG8_STAGE(PG8_SA(0, 0), a2, voffA);
            PG8_WAIT_V(8); PG8_WAIT_L(0); PG8_BAR; PG8_MMA(1, 0, At, B0); PG8_MMA(1, 1, At, B1); PG8_BAR; PG8_SCHED;
            PG8_LDB(B0, 1, 0); PG8_LDB(B1, 1, 1); PG8_SCHED; PG8_LDA(At, 1, 0); PG8_STAGE(PG8_SA(0, 1), a2 + hstep, voffA);
            PG8_WAIT_V(8); PG8_WAIT_L(0); PG8_BAR; PG8_MMA(0, 0, At, B0); PG8_MMA(0, 1, At, B1); PG8_BAR; PG8_SCHED;
            PG8_LDA(At, 1, 1); PG8_STAGE(PG8_SB(1, 0), b3, voffB); PG8_STAGE(PG8_SB(1, 1), b3 + hstep, voffB); PG8_STAGE(PG8_SA(1, 0), a3, voffA);
            PG8_WAIT_V(8); PG8_WAIT_L(0); PG8_BAR; PG8_MMA(1, 0, At, B0); PG8_MMA(1, 1, At, B1); PG8_BAR; PG8_SCHED;
            } else {
            PG8_LDB(B0, 0, 0); PG8_SCHED; PG8_LDA(At, 0, 0); PG8_STAGE(PG8_SA(1, 1), a1 + hstep, voffA);
            PG8_WAIT_L(8); PG8_BAR; PG8_WAIT_L(0); PG8_MMA(0, 0, At, B0); PG8_BAR; PG8_SCHED;
            PG8_LDB(B1, 0, 1); PG8_STAGE(PG8_SB(0, 0), b2, voffB);
            PG8_BAR; PG8_WAIT_L(0); PG8_MMA(0, 1, At, B1); PG8_BAR;
            PG8_LDA(At, 0, 1); PG8_STAGE(PG8_SA(0, 0), a2, voffA);
            PG8_BAR; PG8_WAIT_L(0); PG8_MMA(1, 0, At, B0); PG8_BAR; PG8_SCHED;
            PG8_STAGE(PG8_SB(0, 1), b2 + hstep, voffB);
            PG8_WAIT_V(6); PG8_BAR; PG8_MMA(1, 1, At, B1); PG8_BAR;
            PG8_LDB(B0, 1, 0); PG8_SCHED; PG8_LDA(At, 1, 0); PG8_STAGE(PG8_SA(0, 1), a2 + hstep, voffA);
            PG8_WAIT_L(8); PG8_BAR; PG8_WAIT_L(0); PG8_MMA(0, 0, At, B0); PG8_BAR; PG8_SCHED;
            PG8_LDB(B1, 1, 1); PG8_STAGE(PG8_SB(1, 0), b3, voffB);
            PG8_BAR; PG8_WAIT_L(0); PG8_MMA(0, 1, At, B1); PG8_BAR;
            PG8_LDA(At, 1, 1); PG8_STAGE(PG8_SA(1, 0), a3, voffA);
            PG8_BAR; PG8_WAIT_L(0); PG8_MMA(1, 0, At, B0); PG8_BAR; PG8_SCHED;
            PG8_STAGE(PG8_SB(1, 1), b3 + hstep, voffB);
            PG8_WAIT_V(6); PG8_BAR; PG8_MMA(1, 1, At, B1); PG8_BAR;
            }
        }
        if constexpr (ALIGN_EPI) { if (wr == 0) PG8_BAR; }
        if constexpr (!Epi::AFTER_DRAIN) { unsigned z_ = 0u; asm volatile("" : "+v"(z_)); const int l2_ = (int)__builtin_amdgcn_mbcnt_hi(~0u, __builtin_amdgcn_mbcnt_lo(~0u, z_)); E(acc, cur, wr, wc, l2_ & 15, l2_ >> 4); S.done(cur); }
        if (!has_next) break;
#pragma unroll
        for (int a = 0; a < 2; ++a)
#pragma unroll
            for (int b = 0; b < 2; ++b)
#pragma unroll
                for (int m = 0; m < 4; ++m)
#pragma unroll
                    for (int n = 0; n < 2; ++n) acc[a][b][m][n] = (f32x4){0.f, 0.f, 0.f, 0.f};
        cur = nxt; cA = nA; cB = nB; ++ui;
        if constexpr (ALIGN_EPI) { if (wr == 1) PG8_BAR; }
    }
    PG8_WAIT_V(0);
    if constexpr (!ALIGN_EPI) { if (wr == 0) PG8_BAR; }
    PG8_BAR;
    if constexpr (Epi::AFTER_DRAIN) { E.fused(acc, cur, wr, wc, fr, fq, lds, wid, lane); S.done(cur); }
#undef PG8_SA
#undef PG8_SB
#undef PG8_STAGE
#undef PG8_LDA
#undef PG8_LDB
#undef PG8_MMA
#undef PG8_WAIT_V
#undef PG8_WAIT_L
#undef PG8_BAR
#undef PG8_SCHED
}
}
#ifndef LAS
#define LAS __attribute__((address_space(3)))
#endif
#define XB_TMO      128
#define XB_XCNT(j)  (256  + 64 * (j))
#define XB_XSUB(j)  (1280 + 64 * (j))
#define XB_XGEN(j)  (2304 + 64 * (j))
#define XB_TOP      3328
#define XB_TOPGEN   3392
#define XCD_BAR_WORDS 3456
#define XB_SPIN_CAP (1u << 24)

__device__ __forceinline__ unsigned xb_ld(unsigned* p)              { return __hip_atomic_load(p, __ATOMIC_RELAXED, __HIP_MEMORY_SCOPE_AGENT); }
__device__ __forceinline__ unsigned xb_add(unsigned* p, unsigned v) { return __hip_atomic_fetch_add(p, v, __ATOMIC_RELAXED, __HIP_MEMORY_SCOPE_AGENT); }
__device__ __forceinline__ unsigned xb_xcc_id() { return (unsigned)__builtin_amdgcn_s_getreg((3 << 11) | 20) & 0xFu; }
#define XB_SPIN(cond, bar) do { unsigned _sp = 0; while (cond) { __builtin_amdgcn_s_sleep(1); \
    if ((++_sp & 255u) == 0u) { if (xb_ld(&(bar)[XB_TMO])) break; if (_sp > XB_SPIN_CAP) { atomicAdd(&(bar)[XB_TMO], 1u); break; } } } } while (0)

struct XcdBarrier {
    int w;
    unsigned* bar; unsigned x;
    volatile LAS unsigned* st;
};

__device__ __forceinline__ bool xb_thread0(int w) { unsigned z = 0u; asm volatile("" : "+v"(z), "+s"(w)); return w == 0 && __builtin_amdgcn_mbcnt_hi(~0u, __builtin_amdgcn_mbcnt_lo(~0u, z)) == 0u; }
__device__ __forceinline__ XcdBarrier xcd_barrier_post(unsigned* bar, volatile LAS unsigned* st, int w) {
    XcdBarrier b; b.w = w; b.bar = bar; b.x = xb_xcc_id(); b.st = st;
    if (xb_thread0(w)) (void)xb_add(&bar[XB_XCNT(b.x)], 1u);
    return b;
}
__device__ __forceinline__ void xcd_barrier_complete(unsigned* bar, unsigned x, unsigned& nloc, unsigned& nx) {
    const unsigned G = gridDim.x * gridDim.y * gridDim.z;
    unsigned sum, cnt, mine, sp = 0u;
    for (;;) {
        sum = 0u; cnt = 0u; mine = 0u;
#pragma unroll
        for (unsigned j = 0; j < 16; ++j) { const unsigned c = xb_ld(&bar[XB_XCNT(j)]); sum += c; cnt += (c > 0u) ? 1u : 0u; mine = (j == x) ? c : mine; }
        if (sum == G) break;
        __builtin_amdgcn_s_sleep(1);
        if ((++sp & 255u) == 0u) { if (xb_ld(&bar[XB_TMO])) break; if (sp > XB_SPIN_CAP) { atomicAdd(&bar[XB_TMO], 1u); break; } }
    }
    nloc = mine > 0u ? mine : 1u; nx = cnt > 0u ? cnt : 1u;
}

__device__ __forceinline__ void xcd_barrier(const XcdBarrier& b) {
    asm volatile("s_waitcnt vmcnt(0)" ::: "memory");
    __syncthreads();
    if (xb_thread0(b.w)) {
        unsigned* bar = b.bar;
        __builtin_amdgcn_s_waitcnt(0);
        unsigned nloc = b.st[0], nx = b.st[1];
        if (nloc == 0u) { xcd_barrier_complete(bar, b.x, nloc, nx); b.st[0] = nloc; b.st[1] = nx; }
        const unsigned old = xb_add(&bar[XB_XSUB(b.x)], 1u);
        const unsigned gen = old / nloc;
        if (old + 1u == (gen + 1u) * nloc) {
            __builtin_amdgcn_fence(__ATOMIC_RELEASE, "agent");
            asm volatile("s_waitcnt vmcnt(0)" ::: "memory");
            const unsigned og = xb_add(&bar[XB_TOP], 1u);
            const unsigned tg = og / nx;
            if (og + 1u == (tg + 1u) * nx) xb_add(&bar[XB_TOPGEN], 1u);
            else XB_SPIN(xb_ld(&bar[XB_TOPGEN]) == tg, bar);
            __builtin_amdgcn_fence(__ATOMIC_ACQUIRE, "agent");
            xb_add(&bar[XB_XGEN(b.x)], 1u);
            asm volatile("s_waitcnt vmcnt(0)" ::: "memory");
        } else {
            XB_SPIN(xb_ld(&bar[XB_XGEN(b.x)]) == gen, bar);
            __builtin_amdgcn_fence(__ATOMIC_ACQUIRE, "agent");
            asm volatile("s_waitcnt vmcnt(0)" ::: "memory");
        }
    }
    __syncthreads();
}
constexpr int NWAVES = 8, NTHREADS = NWAVES * 64;
constexpr size_t MiB = 1u << 20;
constexpr size_t WS_CTL = 0, CTL_ZERO_BYTES = 1 * MiB;
constexpr size_t WS_SMALL = 1 * MiB, WS_TOKINFO = 2 * MiB, WS_LIST = 3 * MiB;
constexpr size_t WS_WIN = 4 * MiB, WS_WOUT = 34 * MiB, WS_WFGU = 42 * MiB, WS_WFD = 64 * MiB, WS_WMGU = 75 * MiB, WS_WMD = 187 * MiB;
constexpr size_t WS_H = 243 * MiB, WS_A = 315 * MiB, WS_OC = 351 * MiB, WS_Y = 387 * MiB, WS_AM = 463 * MiB, WS_BIG = 539 * MiB;
constexpr size_t WS_P = WS_BIG, WS_QM = 674 * MiB, WS_KM = WS_QM + 14155776, WS_VM = WS_KM + 14155776, WS_QS = 710 * MiB, WS_KS = WS_QS + 9437184, WS_VS = WS_KS + 4718592;
constexpr size_t WS_HF = 728 * MiB, WS_HO = 764 * MiB, WS_RQ = 800 * MiB, WS_RK = 809 * MiB, WS_RO = 818 * MiB, WS_HQC = 854 * MiB, WS_HU = 890 * MiB, WS_HDK = 922 * MiB, WS_RQC = 923 * MiB, WS_RU = 941 * MiB, WS_TAB = 957 * MiB, WS_END = 959 * MiB;
constexpr size_t WS_ACT = WS_BIG;
constexpr int MAXTILES = 152;
static_assert(WS_P + (size_t)NTOK * NP * 2 <= WS_QM && WS_VM + (size_t)NB * 4 * TK * 64 * 2 <= WS_QS && WS_VS + 4718592 <= WS_HF, "ws map 1");
static_assert(WS_HQC + (size_t)2 * NTOK * 256 * 4 <= WS_HU && WS_HU + (size_t)2 * NB * 4 * NCH * 4096 * 4 <= WS_HDK && WS_RQC + (size_t)2 * NTOK * 128 * 4 <= WS_RU && WS_RU + (size_t)2 * NB * 4 * NCH * 2048 * 4 <= WS_END, "ws map 3");
static_assert(WS_ACT + (size_t)MAXTILES * 256 * DFE * 2 <= WS_END && (size_t)MAXTILES * 256 * D * 2 <= 76 * MiB, "ws map 2");
constexpr int SM_MOD = 0;
constexpr int SM_LOGLB = 4 * 9 * 6144, SM_LOG1M = SM_LOGLB + 4 * 512, SM_LGAM = SM_LOG1M + 4 * 512, SM_META = SM_LGAM + 64, SM_ULIST = SM_META + 32;
constexpr int ULIST_GU = 0, ULIST_D = MAXTILES * 28;
static_assert((SM_ULIST + 2 * MAXTILES * 32) * 4 <= (int)MiB, "small region");
constexpr int CW_BAR = 4096, CW_CNT = 8192;
constexpr int LDS_BYTES = 147456, MISC_OFF = 131072 + 320;

#define GAS __attribute__((address_space(1)))
#define LAS __attribute__((address_space(3)))
typedef float f32x4 __attribute__((ext_vector_type(4)));
typedef unsigned v4u __attribute__((ext_vector_type(4)));
typedef unsigned v2u __attribute__((ext_vector_type(2)));
#define LDS_WAIT() asm volatile("s_waitcnt lgkmcnt(0)" ::: "memory")

struct Args { const float* in[28]; float* out; unsigned char* ws; int ph_lo, ph_hi; };
typedef __attribute__((address_space(4))) const unsigned long long ka_u64;
__device__ __forceinline__ const float* IN(int i) { ka_u64* ka = (ka_u64*)__builtin_amdgcn_kernarg_segment_ptr(); asm volatile("" : "+s"(ka)); return (const float*)ka[i]; }
__device__ __forceinline__ float* OUTP() { ka_u64* ka = (ka_u64*)__builtin_amdgcn_kernarg_segment_ptr(); asm volatile("" : "+s"(ka)); return (float*)ka[28]; }
__device__ __forceinline__ unsigned char* WSBASE() { ka_u64* ka = (ka_u64*)__builtin_amdgcn_kernarg_segment_ptr(); asm volatile("" : "+s"(ka)); return (unsigned char*)ka[29]; }
struct Frame {
    LAS unsigned char* lds;
    int tid, lane, wave, gtid, NT, gw, NGW;
    __device__ __forceinline__ unsigned char* base() const { return WSBASE(); }
};
#define WSP(T, off) ((T*)(ws + (off)))
#define F_ctl WSP(unsigned, WS_CTL)
#define F_sm WSP(float, WS_SMALL)
#define F_tokinfo WSP(int, WS_TOKINFO)
#define F_list WSP(int, WS_LIST)
#define F_H WSP(float, WS_H)
#define F_A WSP(bf16, WS_A)
#define F_OC WSP(bf16, WS_OC)
#define F_Y WSP(bf16, WS_Y)
#define F_AM WSP(bf16, WS_AM)
#define F_P WSP(bf16, WS_P)
#define F_ACT WSP(bf16, WS_ACT)
#define F_WIN WSP(bf16, WS_WIN)
#define F_WOUT WSP(bf16, WS_WOUT)
#define F_WFGU WSP(bf16, WS_WFGU)
#define F_WFD WSP(bf16, WS_WFD)
#define F_WMGU WSP(bf16, WS_WMGU)
#define F_WMD WSP(bf16, WS_WMD)
__device__ __forceinline__ float wave_sum(float v, int  ) {
    int x = __float_as_int(v);
    v += __int_as_float(__builtin_amdgcn_update_dpp(0, x, 0xB1, 0xF, 0xF, true)); x = __float_as_int(v);
    v += __int_as_float(__builtin_amdgcn_update_dpp(0, x, 0x4E, 0xF, 0xF, true)); x = __float_as_int(v);
    v += __int_as_float(__builtin_amdgcn_update_dpp(0, x, 0x141, 0xF, 0xF, true)); x = __float_as_int(v);
    v += __int_as_float(__builtin_amdgcn_update_dpp(0, x, 0x140, 0xF, 0xF, true)); x = __float_as_int(v);
    v += __int_as_float(__builtin_amdgcn_update_dpp(0, x, 0x142, 0xA, 0xF, false)); x = __float_as_int(v);
    v += __int_as_float(__builtin_amdgcn_update_dpp(0, x, 0x143, 0xC, 0xF, false));
    return __int_as_float(__builtin_amdgcn_readlane(__float_as_int(v), 63));
}
__device__ __forceinline__ unsigned pk2(float lo, float hi) { return (unsigned)f2bf(lo) | ((unsigned)f2bf(hi) << 16); }

constexpr int TAB_MLA = 0, TAB_SWA = NL * 16 * 2, TAB_RET = TAB_SWA + NL * 32 * 2, TAB_FLOATS = TAB_RET + TK * 16 * 2;
__device__ __forceinline__ void build_tables(float* tab, int gtid, int NT) {
    for (int it = gtid; it < NL * 16; it += NT) { const int t = it >> 4, j = it & 15; const float inv = powf(10000.0f, -(float)(j & 7) / 8.0f), ang = (float)(j < 8 ? t / GRIDW : t % GRIDW) * inv;
        tab[TAB_MLA + 2 * it] = cosf(ang); tab[TAB_MLA + 2 * it + 1] = sinf(ang); }
    for (int it = gtid; it < NL * 32; it += NT) { const int t = it >> 5, j = it & 31; const float inv = powf(10000.0f, -(float)(j & 15) / 16.0f), ang = (float)(j < 16 ? t / GRIDW : t % GRIDW) * inv;
        tab[TAB_SWA + 2 * it] = cosf(ang); tab[TAB_SWA + 2 * it + 1] = sinf(ang); }
    for (int it = gtid; it < TK * 16; it += NT) { const int tq = it >> 4, j = it & 15; const float inv = powf(10000.0f, -(float)j / 16.0f), ang = (float)tq * inv;
        tab[TAB_RET + 2 * it] = cosf(ang); tab[TAB_RET + 2 * it + 1] = sinf(ang); }
}
static_assert((size_t)TAB_FLOATS * 4 <= 2 * MiB, "rope tables");
template <class SrcFn> __device__ __forceinline__ void transpose_item(const SrcFn& src, int K, int nblk, bf16* WT, LAS float* scr, int item, int lane) {
    const int kb = item / nblk, nb = item % nblk, k0 = 64 * kb, n0 = 32 * nb;
    float tv[32];
#pragma unroll
    for (int i = 0; i < 32; ++i) tv[i] = src(k0 + 2 * i + (lane >> 5), n0 + (lane & 31));
#pragma unroll
    for (int i = 0; i < 32; ++i) scr[(2 * i + (lane >> 5)) * 33 + (lane & 31)] = tv[i];
    LDS_WAIT(); asm volatile("" ::: "memory");
    const int c = lane & 7;
#pragma unroll
    for (int j = 0; j < 4; ++j) { const int n = (lane >> 3) + 8 * j; const LAS float* s = scr + (8 * c) * 33 + n;
        v4u o; o.x = pk2(s[0 * 33], s[1 * 33]); o.y = pk2(s[2 * 33], s[3 * 33]); o.z = pk2(s[4 * 33], s[5 * 33]); o.w = pk2(s[6 * 33], s[7 * 33]);
        *(v4u*)(WT + (size_t)(n0 + n) * K + k0 + 8 * c) = o; }
    LDS_WAIT(); asm volatile("" ::: "memory");
}
struct SrcPlain { const float* W; int N; __device__ __forceinline__ float operator()(int k, int n) const { return W[(size_t)k * N + n]; } };
struct SrcGU { const float* Wg; long du; int NF; __device__ __forceinline__ float operator()(int k, int c) const { const int j = c >> 3, w = c & 7; return Wg[(w < 4 ? 0l : du) + (long)k * NF + 4 * j + (w & 3)]; } };

__device__ __forceinline__ void convert_moe(Frame& F, int li) {
    unsigned char* ws = F.base();
    LAS float* scr = (LAS float*)(F.lds + 40960 + F.wave * 8704);
    constexpr int I_GU = 16 * 224, I_D = 56 * 32;
    for (int it = F.gw; it < 8 * (I_GU + I_D); it += F.NGW) {
        const int e = it / (I_GU + I_D); int r = it % (I_GU + I_D);
        if (r < I_GU) { SrcGU s{IN(24) + ((size_t)li * 8 + e) * D * DFE, (long)(IN(25) - IN(24)), DFE}; transpose_item(s, D, 224, F_WMGU + (size_t)e * 2 * DFE * D, scr, r, F.lane); }
        else { r -= I_GU; SrcPlain s{IN(26) + ((size_t)li * 8 + e) * DFE * D, D}; transpose_item(s, DFE, 32, F_WMD + (size_t)e * D * DFE, scr, r, F.lane); }
    }
}
__device__ __forceinline__ void prologue(Frame& F) {
    unsigned char* ws = F.base();
    LAS float* sil = (LAS float*)F.lds;
    for (int i = F.tid; i < 9 * 1024; i += NTHREADS) { const float cv = i < 8 * 1024 ? IN(1)[i] : IN(3)[i - 8 * 1024]; sil[i] = silu_f(cv); }
    __syncthreads();
    { LAS float* red = (LAS float*)(F.lds + 36864);
      const int jc = F.tid & 63, kg = F.tid >> 6;
      for (int unit = blockIdx.x; unit < DEPTH * 96; unit += gridDim.x) {
          const int l = unit / 96, j0 = (unit % 96) * 64; const float* w = IN(4) + ((size_t)l * D + kg * 128) * 6144 + j0 + jc;
          float acc[9];
#pragma unroll
          for (int b = 0; b < 9; ++b) acc[b] = 0.f;
#pragma unroll 8
          for (int k = 0; k < 128; ++k) { const float wv = w[(size_t)k * 6144];
#pragma unroll
              for (int b = 0; b < 9; ++b) acc[b] += sil[b * 1024 + kg * 128 + k] * wv; }
#pragma unroll
          for (int b = 0; b < 9; ++b) red[(kg * 9 + b) * 64 + jc] = acc[b];
          __syncthreads();
          for (int o = F.tid; o < 9 * 64; o += NTHREADS) { float s = IN(5)[l * 6144 + j0 + (o & 63)];
#pragma unroll
              for (int g = 0; g < 8; ++g) s += red[(g * 9 + (o >> 6)) * 64 + (o & 63)];
              F_sm[SM_MOD + ((size_t)l * 9 + (o >> 6)) * 6144 + j0 + (o & 63)] = s; }
          __syncthreads();
      } }
    for (int it = F.gtid; it < 512; it += F.NT) {
        float lg[DEPTH], mx = -1e30f, s = 0.f;
#pragma unroll
        for (int l = 0; l < DEPTH; ++l) { lg[l] = IN(14)[l * 512 + it]; mx = fmaxf(mx, lg[l]); }
#pragma unroll
        for (int l = 0; l < DEPTH; ++l) { lg[l] = expf(lg[l] - mx); s += lg[l]; }
        float cum = 0.f; const float p0 = lg[0] / s;
#pragma unroll
        for (int l = 0; l < DEPTH; ++l) { cum += lg[l] / s; const float lb = cum - p0; F_sm[SM_LOGLB + l * 512 + it] = logf(fmaxf(lb, 1e-30f)); F_sm[SM_LOG1M + l * 512 + it] = log1pf(-lb); }
    }
    for (int it = F.gtid; it < DEPTH * 8; it += F.NT) F_sm[SM_LGAM + it] = log_sigmoid_f(IN(17)[it]);
    build_tables(WSP(float, WS_TAB), F.gtid, F.NT);
    LAS float* scr = (LAS float*)(F.lds + 40960 + F.wave * 8704);
    constexpr int I_IN = 16 * 91, I_OUT = 16 * 32, I_FGU = 16 * 176, I_FD = 44 * 32;
    constexpr int N_IN = DEPTH * I_IN, N_OUT = DEPTH * I_OUT, N_FGU = 2 * I_FGU, N_FD = 2 * I_FD;
    for (int it = F.gw; it < N_IN + N_OUT + N_FGU + N_FD; it += F.NGW) {
        int r = it;
        if (r < N_IN) { const int l = r / I_IN; SrcPlain s{IN(8) + (size_t)l * D * DIN, DIN}; transpose_item(s, D, 91, F_WIN + (size_t)l * NP * D, scr, r % I_IN, F.lane); continue; } r -= N_IN;
        if (r < N_OUT) { const int l = r / I_OUT; SrcPlain s{IN(9) + (size_t)l * D * D, D}; transpose_item(s, D, 32, F_WOUT + (size_t)l * D * D, scr, r % I_OUT, F.lane); continue; } r -= N_OUT;
        if (r < N_FGU) { const int l = r / I_FGU; SrcGU s{IN(20) + (size_t)l * D * DFF, (long)(IN(21) - IN(20)), DFF}; transpose_item(s, D, 176, F_WFGU + (size_t)l * 2 * DFF * D, scr, r % I_FGU, F.lane); continue; } r -= N_FGU;
        { const int l = r / I_FD; SrcPlain s{IN(22) + (size_t)l * DFF * D, D}; transpose_item(s, DFF, 32, F_WFD + (size_t)l * D * DFF, scr, r % I_FD, F.lane); }
    }
    convert_moe(F, 0);
    for (int it = F.gtid; it < DEPTH * (D / 8) * 928; it += F.NT) {
        const int n = it % 928, kg = (it / 928) % (D / 8), l = it / (928 * (D / 8));
        const float* wi = IN(8) + ((size_t)l * D + 8 * kg) * DIN; float acc[8];
#pragma unroll
        for (int r = 0; r < 8; ++r) acc[r] = 0.f;
        if (n < 384) { const float* g = IN(10) + l * 192; const float* wu = IN(11) + (size_t)l * 192 * 384 + n;
            for (int j = 0; j < 192; ++j) { const float w = g[j] * wu[(size_t)j * 384];
#pragma unroll
                for (int r = 0; r < 8; ++r) acc[r] += wi[(size_t)r * DIN + j] * w; } }
        else if (n < 896) { const float* g = IN(12) + l * 128; const float* wu = IN(13) + (size_t)l * 128 * 512 + (n - 384);
            for (int j = 0; j < 128; ++j) { const float w = g[j] * wu[(size_t)j * 512];
#pragma unroll
                for (int r = 0; r < 8; ++r) acc[r] += wi[(size_t)r * DIN + 192 + j] * w; } }
        v4u o; o.x = pk2(acc[0], acc[1]); o.y = pk2(acc[2], acc[3]); o.z = pk2(acc[4], acc[5]); o.w = pk2(acc[6], acc[7]);
        *(v4u*)(F_WIN + ((size_t)l * NP + DIN + n) * D + 8 * kg) = o;
    }
}

typedef short bf16x8s __attribute__((ext_vector_type(8)));
typedef float f32x16 __attribute__((ext_vector_type(16)));
__device__ __forceinline__ int crow(int r, int hi) { return (r & 3) + 8 * (r >> 2) + 4 * hi; }
__device__ __forceinline__ float xlane32(float v, int lane) { return __int_as_float(__builtin_amdgcn_ds_bpermute((lane ^ 32) << 2, __float_as_int(v))); }
__device__ __forceinline__ unsigned cvtpk(float lo, float hi) { unsigned r; asm volatile("v_cvt_pk_bf16_f32 %0, %1, %2" : "=v"(r) : "v"(lo), "v"(hi)); return r; }

template <int DK, bool SWA>
__device__ __forceinline__ void attn_unit(LAS unsigned char* lds, const bf16* Qg, const bf16* Kg, const bf16* Vtg, bf16* OCp, int b, int hcol, int tq0,
                                          int t0a, int t1a, int t0b, int t1b, float sink2, int tid) {
    constexpr int KS = DK * 2 + 16, VS = 136, KT_BYTES = 64 * KS, STAGE = KT_BYTES + 64 * VS, KP = DK / 8, NKP = 64 * KP, NS = DK / 16;
    const int lane = tid & 63, wave = __builtin_amdgcn_readfirstlane(tid >> 6), q = lane & 31, hi = lane >> 5;
    LAS float* wsf = (LAS float*)(lds + 2 * STAGE) + wave * 64;
    const int tq = tq0 + wave * 32 + q;
    bf16x8s qf[NS];
#pragma unroll
    for (int s = 0; s < NS; ++s) qf[s] = *(const bf16x8s*)(Qg + (size_t)tq * DK + 16 * s + 8 * hi);
    f32x16 o0, o1;
#pragma unroll
    for (int r = 0; r < 16; ++r) { o0[r] = 0.f; o1[r] = 0.f; }
    float m = SWA ? sink2 : -1e30f, l = (SWA && hi == 0) ? 1.0f : 0.f;
    const int na = t1a - t0a, nt = na + (t1b - t0b);
    const int w0 = tq0 - NC + wave * 32;
    v4u kr0, kr1 = (v4u){0u, 0u, 0u, 0u}, vr;
    { const int t = na > 0 ? t0a : t0b; const v4u* kg = (const v4u*)(Kg + (size_t)t * 64 * DK); kr0 = kg[tid]; if (NKP > 512) { if (tid < NKP - 512) kr1 = kg[512 + tid]; }
      vr = *(const v4u*)(Vtg + (size_t)(tid >> 3) * TK + t * 64 + (tid & 7) * 8); }
    { LAS unsigned char* kb = lds; *(LAS v4u*)(kb + (tid / KP) * KS + (tid % KP) * 16) = kr0;
      if (NKP > 512) { if (tid < NKP - 512) { const int p = 512 + tid; *(LAS v4u*)(kb + (p / KP) * KS + (p % KP) * 16) = kr1; } }
      LAS unsigned char* vb = kb + KT_BYTES + (tid >> 3) * VS + (tid & 7) * 16; *(LAS v2u*)vb = (v2u){vr.x, vr.y}; *(LAS v2u*)(vb + 8) = (v2u){vr.z, vr.w}; }
    __syncthreads();
    for (int i = 0; i < nt; ++i) {
        const int t = i < na ? t0a + i : t0b + (i - na);
        if (i + 1 < nt) { const int tn = (i + 1) < na ? t0a + i + 1 : t0b + (i + 1 - na); const v4u* kg = (const v4u*)(Kg + (size_t)tn * 64 * DK); kr0 = kg[tid]; if (NKP > 512) { if (tid < NKP - 512) kr1 = kg[512 + tid]; }
            vr = *(const v4u*)(Vtg + (size_t)(tid >> 3) * TK + tn * 64 + (tid & 7) * 8); }
        LAS unsigned char* kb = lds + (i & 1) * STAGE; LAS unsigned char* vbs = kb + KT_BYTES;
        const int sb = 64 * t - NC;
        const bool band = SWA && t >= 4;
        const bool skip = band && (sb + 63 < w0 - 128 || sb > w0 + 31 + 128);
        if (!skip) {
            f32x16 p0, p1;
#pragma unroll
            for (int r = 0; r < 16; ++r) { p0[r] = 0.f; p1[r] = 0.f; }
#pragma unroll
            for (int s = 0; s < NS; ++s) {
                const bf16x8s k0 = *(const LAS bf16x8s*)(kb + q * KS + (16 * s + 8 * hi) * 2);
                const bf16x8s k1 = *(const LAS bf16x8s*)(kb + (32 + q) * KS + (16 * s + 8 * hi) * 2);
                p0 = __builtin_amdgcn_mfma_f32_32x32x16_bf16(k0, qf[s], p0, 0, 0, 0);
                p1 = __builtin_amdgcn_mfma_f32_32x32x16_bf16(k1, qf[s], p1, 0, 0, 0);
            }
            if (band) { const int tl = tq - NC;
#pragma unroll
                for (int r = 0; r < 16; ++r) { const int d0 = tl - (sb + crow(r, hi)), d1 = d0 - 32;
                    if (d0 > 128 || d0 < -128) p0[r] = -1e30f; if (d1 > 128 || d1 < -128) p1[r] = -1e30f; } }
            float mx = fmaxf(p0[0], p1[0]);
#pragma unroll
            for (int r = 1; r < 16; ++r) mx = fmaxf(mx, fmaxf(p0[r], p1[r]));
            mx = fmaxf(mx, xlane32(mx, lane));
            const float mn = fmaxf(m, mx), alpha = __builtin_amdgcn_exp2f(m - mn); m = mn;
            float ps = 0.f;
#pragma unroll
            for (int r = 0; r < 16; ++r) { p0[r] = __builtin_amdgcn_exp2f(p0[r] - mn); p1[r] = __builtin_amdgcn_exp2f(p1[r] - mn); ps += p0[r] + p1[r]; }
            l = l * alpha + ps;
            if (hi == 0) wsf[q] = alpha;
            bf16x8s pa[4];
            { v4u w;
              w.x = cvtpk(p0[0], p0[1]); w.y = cvtpk(p0[2], p0[3]); w.z = cvtpk(p0[4], p0[5]); w.w = cvtpk(p0[6], p0[7]); pa[0] = __builtin_bit_cast(bf16x8s, w);
              w.x = cvtpk(p0[8], p0[9]); w.y = cvtpk(p0[10], p0[11]); w.z = cvtpk(p0[12], p0[13]); w.w = cvtpk(p0[14], p0[15]); pa[1] = __builtin_bit_cast(bf16x8s, w);
              w.x = cvtpk(p1[0], p1[1]); w.y = cvtpk(p1[2], p1[3]); w.z = cvtpk(p1[4], p1[5]); w.w = cvtpk(p1[6], p1[7]); pa[2] = __builtin_bit_cast(bf16x8s, w);
              w.x = cvtpk(p1[8], p1[9]); w.y = cvtpk(p1[10], p1[11]); w.z = cvtpk(p1[12], p1[13]); w.w = cvtpk(p1[14], p1[15]); pa[3] = __builtin_bit_cast(bf16x8s, w); }
            asm volatile("s_waitcnt lgkmcnt(0)" ::: "memory");
#pragma unroll
            for (int r = 0; r < 16; ++r) { const float a = wsf[crow(r, hi)]; o0[r] *= a; o1[r] *= a; }
#pragma unroll
            for (int s4 = 0; s4 < 4; ++s4)
#pragma unroll
                for (int nb = 0; nb < 2; ++nb) {
                    const LAS unsigned char* vp = vbs + (32 * nb + q) * VS + (16 * s4 + 4 * hi) * 2;
                    const v2u lo = *(const LAS v2u*)vp, hh = *(const LAS v2u*)(vp + 16);
                    const bf16x8s vf = __builtin_bit_cast(bf16x8s, ((v4u){lo.x, lo.y, hh.x, hh.y}));
                    if (nb == 0) o0 = __builtin_amdgcn_mfma_f32_32x32x16_bf16(pa[s4], vf, o0, 0, 0, 0); else o1 = __builtin_amdgcn_mfma_f32_32x32x16_bf16(pa[s4], vf, o1, 0, 0, 0);
                }
        }
        if (i + 1 < nt) { LAS unsigned char* kn = lds + ((i + 1) & 1) * STAGE; *(LAS v4u*)(kn + (tid / KP) * KS + (tid % KP) * 16) = kr0;
            if (NKP > 512) { if (tid < NKP - 512) { const int p = 512 + tid; *(LAS v4u*)(kn + (p / KP) * KS + (p % KP) * 16) = kr1; } }
            LAS unsigned char* vb = kn + KT_BYTES + (tid >> 3) * VS + (tid & 7) * 16; *(LAS v2u*)vb = (v2u){vr.x, vr.y}; *(LAS v2u*)(vb + 8) = (v2u){vr.z, vr.w}; }
        __syncthreads();
    }
    const float lt = l + xlane32(l, lane);
    if (hi == 0) wsf[q] = 1.0f / lt;
    asm volatile("s_waitcnt lgkmcnt(0)" ::: "memory");
#pragma unroll
    for (int r = 0; r < 16; ++r) { const int qq = crow(r, hi); const float inv = wsf[qq];
        bf16* op = OCp + (size_t)row_of(b, tq0 + wave * 32 + qq) * D + hcol + q;
        op[0] = f2bf(o0[r] * inv); op[32] = f2bf(o1[r] * inv); }
    __syncthreads();
}
__device__ __forceinline__ void attn_phase(LAS unsigned char* lds, const Mix& M, const float* sink, bool with_ctx, int tid) {
    const int nunits = 512 + (with_ctx ? 64 : 0);
    for (int u = blockIdx.x; u < nunits; u += gridDim.x) {
        if (u < 512) {
            const int c = u & 255, bh = (c & 7) + 8 * (c >> 6), qb = (c >> 3) & 7, b = bh >> 2, h = bh & 3, tq0 = NC + 256 * qb;
            if (u < 256) attn_unit<96, false>(lds, M.Qm + (size_t)bh * TK * 96, M.Km + (size_t)bh * TK * 96, M.Vm + (size_t)bh * 64 * TK, M.OC, b, h * 64, tq0, 0, TK / 64, 0, 0, 0.f, tid);
            else { const int slo = 256 * qb - 128 < 0 ? 0 : 256 * qb - 128, shi = 256 * qb + 383 > NL - 1 ? NL - 1 : 256 * qb + 383;
                attn_unit<64, true>(lds, M.Qs + (size_t)bh * TK * 64, M.Ks + (size_t)(b * 2 + (h >> 1)) * TK * 64, M.Vs + (size_t)(b * 2 + (h >> 1)) * 64 * TK, M.OC, b, 512 + h * 64, tq0,
                                    0, NC / 64, (NC + slo) / 64, (NC + shi) / 64 + 1, sink[h] * LOG2E, tid); }
        } else {
            const int c = (u - 512) & 31, b = c >> 2, h = c & 3;
            if (u < 544) attn_unit<96, false>(lds, M.Qm + (size_t)c * TK * 96, M.Km + (size_t)c * TK * 96, M.Vm + (size_t)c * 64 * TK, M.OC, b, h * 64, 0, 0, NC / 64, 0, 0, 0.f, tid);
            else attn_unit<64, true>(lds, M.Qs + (size_t)c * TK * 64, M.Ks + (size_t)(b * 2 + (h >> 1)) * TK * 64, M.Vs + (size_t)(b * 2 + (h >> 1)) * 64 * TK, M.OC, b, 512 + h * 64, 0, 0, NC / 64, 0, 0, sink[h] * LOG2E, tid);
        }
    }
}
__device__ __forceinline__ float wsum(float v, int  ) {
    int x = __float_as_int(v);
    v += __int_as_float(__builtin_amdgcn_update_dpp(0, x, 0xB1, 0xF, 0xF, true)); x = __float_as_int(v);
    v += __int_as_float(__builtin_amdgcn_update_dpp(0, x, 0x4E, 0xF, 0xF, true)); x = __float_as_int(v);
    v += __int_as_float(__builtin_amdgcn_update_dpp(0, x, 0x141, 0xF, 0xF, true)); x = __float_as_int(v);
    v += __int_as_float(__builtin_amdgcn_update_dpp(0, x, 0x140, 0xF, 0xF, true)); x = __float_as_int(v);
    v += __int_as_float(__builtin_amdgcn_update_dpp(0, x, 0x142, 0xA, 0xF, false)); x = __float_as_int(v);
    v += __int_as_float(__builtin_amdgcn_update_dpp(0, x, 0x143, 0xC, 0xF, false));
    return __int_as_float(__builtin_amdgcn_readlane(__float_as_int(v), 63));
}
__device__ __forceinline__ float bfl(unsigned w) { return __uint_as_float(w << 16); }
__device__ __forceinline__ float bfh(unsigned w) { return __uint_as_float(w & 0xffff0000u); }
__device__ __forceinline__ void prep_row(const Mix& M, const float* tab, int row, int lane) {
    int b, tq; row_split(row, b, tq); const bool lat = tq >= NC; const int t = lat ? tq - NC : 0;
    const bf16* p = M.P + (size_t)row * NP;
    float sq = 0.f, skv = 0.f;
    if (lane < 48) { const v2u w = *(const v2u*)(p + C_QLAT + 4 * lane); const float a = bfl(w.x), c = bfh(w.x), d = bfl(w.y), e = bfh(w.y); sq = (a * a + c * c) + (d * d + e * e); }
    if (lane < 32) { const v2u w = *(const v2u*)(p + C_KVLAT + 4 * lane); const float a = bfl(w.x), c = bfh(w.x), d = bfl(w.y), e = bfh(w.y); skv = (a * a + c * c) + (d * d + e * e); }
    sq = wsum(sq, lane); skv = wsum(skv, lane);
    const float rq = 1.0f / sqrtf(sq * (1.0f / 192.0f) + NORM_EPS), rkv = 1.0f / sqrtf(skv * (1.0f / 128.0f) + NORM_EPS), qs = rq * 0.10206207261596575f * LOG2E;
#pragma unroll
    for (int h = 0; h < 4; ++h) { const size_t o = ((size_t)(b * 4 + h) * TK + tq) * 96 + lane;
        M.Qm[o] = f2bf(bf2f(p[C_QE + h * 96 + lane]) * qs); M.Km[o] = f2bf(bf2f(p[C_KVE + h * 128 + lane]) * rkv); }
    { const int h = lane >> 4, j = lane & 15; float c = 1.f, s = 0.f; if (lat) { c = tab[TAB_MLA + (t * 16 + j) * 2]; s = tab[TAB_MLA + (t * 16 + j) * 2 + 1]; }
      const size_t o = ((size_t)(b * 4 + h) * TK + tq) * 96 + 64 + j;
      const float q1 = bf2f(p[C_QE + h * 96 + 64 + j]), q2 = bf2f(p[C_QE + h * 96 + 80 + j]); M.Qm[o] = f2bf((q1 * c - q2 * s) * qs); M.Qm[o + 16] = f2bf((q1 * s + q2 * c) * qs);
      const float k1 = bf2f(p[C_KPE + j]), k2 = bf2f(p[C_KPE + 16 + j]); M.Km[o] = f2bf(k1 * c - k2 * s); M.Km[o + 16] = f2bf(k1 * s + k2 * c); }
#pragma unroll
    for (int i = 0; i < 2; ++i) { const int e = lane + 64 * i, hq = e >> 5, j = e & 31; float c = 1.f, s = 0.f; if (lat) { c = tab[TAB_SWA + (t * 32 + j) * 2]; s = tab[TAB_SWA + (t * 32 + j) * 2 + 1]; }
        const float x1 = bf2f(p[C_SQ + hq * 64 + j]), x2 = bf2f(p[C_SQ + hq * 64 + 32 + j]); bf16* o = M.Qs + ((size_t)(b * 4 + hq) * TK + tq) * 64 + j;
        o[0] = f2bf((x1 * c - x2 * s) * (0.125f * LOG2E)); o[32] = f2bf((x1 * s + x2 * c) * (0.125f * LOG2E)); }
    { const int kh = lane >> 5, j = lane & 31; float c = 1.f, s = 0.f; if (lat) { c = tab[TAB_SWA + (t * 32 + j) * 2]; s = tab[TAB_SWA + (t * 32 + j) * 2 + 1]; }
      const float x1 = bf2f(p[C_SK + kh * 64 + j]), x2 = bf2f(p[C_SK + kh * 64 + 32 + j]); bf16* o = M.Ks + ((size_t)(b * 2 + kh) * TK + tq) * 64 + j;
      o[0] = f2bf(x1 * c - x2 * s); o[32] = f2bf(x1 * s + x2 * c); }
#pragma unroll
    for (int i = 0; i < 8; ++i) { const int d = i >> 2, c = (i & 3) * 64 + lane; const float z = bf2f(p[(d ? C_HZB : C_HZF) + c]);
        const float a = M.loglb[d * 256 + c], bb = M.log1mlb[d * 256 + c] + log_sigmoid_f(z), mx = fmaxf(a, bb), lf = mx + log1pf(expf(-fabsf(a - bb)));
        M.HF[((size_t)d * NTOK + row) * 256 + c] = expf(lf); }
#pragma unroll
    for (int w = 0; w < 2; ++w) { const int hh = lane >> 4, j = lane & 15; const float c = tab[TAB_RET + (tq * 16 + j) * 2], s = tab[TAB_RET + (tq * 16 + j) * 2 + 1];
        const bf16* src = p + (w ? C_RK : C_RQ) + hh * 32; float* o = (w ? M.RK : M.RQ) + (size_t)row * 128 + hh * 32 + j; const float sc = w ? 1.0f : 0.17677669529663687f;
        const float x1 = bf2f(src[j]), x2 = bf2f(src[16 + j]); o[0] = (x1 * c - x2 * s) * sc; o[16] = (x1 * s + x2 * c) * sc; }
}
__device__ __forceinline__ void prep_vt(const Mix& M, int g8, int lane) {
    const int row0 = g8 * 8; int b, tq0; row_split(row0, b, tq0);
    float rkv[8];
#pragma unroll
    for (int r = 0; r < 8; ++r) { float skv = 0.f; if (lane < 32) { const v2u w = *(const v2u*)(M.P + (size_t)(row0 + r) * NP + C_KVLAT + 4 * lane); const float a = bfl(w.x), c = bfh(w.x), d = bfl(w.y), e = bfh(w.y); skv = (a * a + c * c) + (d * d + e * e); }
        skv = wsum(skv, lane); rkv[r] = 1.0f / sqrtf(skv * (1.0f / 128.0f) + NORM_EPS); }
#pragma unroll
    for (int h = 0; h < 4; ++h) { float v[8];
#pragma unroll
        for (int r = 0; r < 8; ++r) v[r] = bf2f(M.P[(size_t)(row0 + r) * NP + C_KVE + h * 128 + 64 + lane]) * rkv[r];
        v4u o; o.x = pk2(v[0], v[1]); o.y = pk2(v[2], v[3]); o.z = pk2(v[4], v[5]); o.w = pk2(v[6], v[7]);
        *(v4u*)(M.Vm + ((size_t)(b * 4 + h) * 64 + lane) * TK + tq0) = o; }
#pragma unroll
    for (int kh = 0; kh < 2; ++kh) { unsigned short v[8];
#pragma unroll
        for (int r = 0; r < 8; ++r) v[r] = M.P[(size_t)(row0 + r) * NP + C_SV + kh * 64 + lane];
        v4u o; o.x = (unsigned)v[0] | ((unsigned)v[1] << 16); o.y = (unsigned)v[2] | ((unsigned)v[3] << 16); o.z = (unsigned)v[4] | ((unsigned)v[5] << 16); o.w = (unsigned)v[6] | ((unsigned)v[7] << 16);
        *(v4u*)(M.Vs + ((size_t)(b * 2 + kh) * 64 + lane) * TK + tq0) = o; }
}
constexpr int SBT = 12, NSB = CH / SBT;
__device__ __forceinline__ int scan_row(int b, int dir, int pos) { return row_of(b, dir_tq(dir, pos)); }
__device__ __forceinline__ void hg_local_wave(const Mix& M, LAS float* wl  , int unit, int lane) {
    const int c = unit % NCH, seq = unit / NCH, h = seq & 3, b = (seq >> 2) % NB, dir = seq / (4 * NB);
    float S[64];
#pragma unroll
    for (int k = 0; k < 64; ++k) S[k] = 0.f;
    float dk = 1.0f;
    LAS float* Fs = wl; LAS float* Qs = wl + 768; LAS float* Vs = wl + 1536;
    const int tt0 = lane >> 4, k4 = (lane & 15) * 4;
    for (int sb = 0; sb < NSB; ++sb) {
        const int pos0 = CH * c + SBT * sb;
        f32x4 fr[3]; v2u qr[3]; unsigned short vr[SBT];
#pragma unroll
        for (int j = 0; j < 3; ++j) { const int row = scan_row(b, dir, pos0 + 4 * j + tt0);
            fr[j] = *(const f32x4*)(M.HF + ((size_t)dir * NTOK + row) * 256 + h * 64 + k4); qr[j] = *(const v2u*)(M.P + (size_t)row * NP + C_HQ + h * 64 + k4); }
#pragma unroll
        for (int i = 0; i < SBT; ++i) vr[i] = M.P[(size_t)scan_row(b, dir, pos0 + i) * NP + C_HI + h * 64 + lane];
#pragma unroll
        for (int j = 0; j < 3; ++j) { *(LAS f32x4*)(Fs + (4 * j + tt0) * 64 + k4) = fr[j];
            *(LAS f32x4*)(Qs + (4 * j + tt0) * 64 + k4) = (f32x4){bfl(qr[j].x) * 0.125f, bfh(qr[j].x) * 0.125f, bfl(qr[j].y) * 0.125f, bfh(qr[j].y) * 0.125f}; }
#pragma unroll
        for (int i = 0; i < SBT; ++i) Vs[i * 64 + lane] = bf2f(vr[i]);
        asm volatile("s_waitcnt lgkmcnt(0)" ::: "memory");
#pragma unroll 2
        for (int i = 0; i < SBT; ++i) {
            const int row = scan_row(b, dir, pos0 + i); const float v = Vs[i * 64 + lane]; float ac[4] = {0.f, 0.f, 0.f, 0.f};
            dk *= Fs[i * 64 + lane]; M.HQC[((size_t)dir * NTOK + row) * 256 + h * 64 + lane] = Qs[i * 64 + lane] * dk;
#pragma unroll
            for (int kk = 0; kk < 16; ++kk) { const f32x4 f4 = *(const LAS f32x4*)(Fs + i * 64 + 4 * kk), q4 = *(const LAS f32x4*)(Qs + i * 64 + 4 * kk);
#pragma unroll
                for (int j = 0; j < 4; ++j) { S[4 * kk + j] = f4[j] * (S[4 * kk + j] - v) + v; ac[j] += q4[j] * S[4 * kk + j]; } }
            M.HO[((size_t)dir * NTOK + row) * 256 + h * 64 + lane] = (ac[0] + ac[1]) + (ac[2] + ac[3]);
        }
        asm volatile("s_waitcnt lgkmcnt(0)" ::: "memory");
    }
    float* u = M.HU + ((size_t)seq * NCH + c) * 4096 + lane;
#pragma unroll
    for (int k = 0; k < 64; ++k) u[k * 64] = S[k];
    M.HDK[((size_t)seq * NCH + c) * 64 + lane] = dk;
}
__device__ __forceinline__ void ret_local_wave(const Mix& M, LAS float* wl, int unit, int lane) {
    const int c = unit % NCH, seq = unit / NCH, h = seq & 3, b = (seq >> 2) % NB, dir = seq / (4 * NB);
    const float g = expf(M.log_gamma[dir * 4 + h]);
    float S[32];
#pragma unroll
    for (int k = 0; k < 32; ++k) S[k] = 0.f;
    float gp = 1.0f;
    LAS float* Ks = wl; LAS float* Qs = wl + 768; LAS float* Vs = wl + 1536;
    const int tt0 = lane >> 3, k4 = (lane & 7) * 4;
    for (int sb = 0; sb < NSB; ++sb) {
        const int pos0 = CH * c + SBT * sb;
        f32x4 kr[2], qr[2]; unsigned short vr[SBT];
#pragma unroll
        for (int j = 0; j < 2; ++j) { const int tt = 8 * j + tt0; const int row = scan_row(b, dir, pos0 + (tt < SBT ? tt : 0));
            kr[j] = *(const f32x4*)(M.RK + (size_t)row * 128 + h * 32 + k4); qr[j] = *(const f32x4*)(M.RQ + (size_t)row * 128 + h * 32 + k4); }
#pragma unroll
        for (int i = 0; i < SBT; ++i) vr[i] = M.P[(size_t)scan_row(b, dir, pos0 + i) * NP + C_RV + h * 64 + lane];
#pragma unroll
        for (int j = 0; j < 2; ++j) { const int tt = 8 * j + tt0; if (tt < SBT) { *(LAS f32x4*)(Ks + tt * 32 + k4) = kr[j]; *(LAS f32x4*)(Qs + tt * 32 + k4) = qr[j]; } }
#pragma unroll
        for (int i = 0; i < SBT; ++i) Vs[i * 64 + lane] = bf2f(vr[i]);
        asm volatile("s_waitcnt lgkmcnt(0)" ::: "memory");
#pragma unroll 2
        for (int i = 0; i < SBT; ++i) {
            const int row = scan_row(b, dir, pos0 + i); const float v = Vs[i * 64 + lane]; float ac[4] = {0.f, 0.f, 0.f, 0.f};
            gp *= g; if (lane < 32) M.RQC[((size_t)dir * NTOK + row) * 128 + h * 32 + lane] = Qs[i * 32 + lane] * gp;
#pragma unroll
            for (int kk = 0; kk < 8; ++kk) { const f32x4 k4v = *(const LAS f32x4*)(Ks + i * 32 + 4 * kk), q4 = *(const LAS f32x4*)(Qs + i * 32 + 4 * kk);
#pragma unroll
                for (int j = 0; j < 4; ++j) { S[4 * kk + j] = g * S[4 * kk + j] + k4v[j] * v; ac[j] += q4[j] * S[4 * kk + j]; } }
            M.RO[((size_t)dir * NTOK + row) * 256 + h * 64 + lane] = (ac[0] + ac[1]) + (ac[2] + ac[3]);
        }
        asm volatile("s_waitcnt lgkmcnt(0)" ::: "memory");
    }
    float* u = M.RU + ((size_t)seq * NCH + c) * 2048 + lane;
#pragma unroll
    for (int k = 0; k < 32; ++k) u[k * 64] = S[k];
}
__device__ __forceinline__ int bwd_chunk(int tq) { return (tq < NC ? NC - 1 - tq : NC + (NL - 1 - (tq - NC))) / CH; }
__device__ __forceinline__ void hg_fixfin_wave(const Mix& M, LAS float* wl, int unit, int lane, int tq_min) {
    const int c = unit % NCH, bh = unit / NCH, h = bh & 3, b = bh >> 2;
    if (CH * c + CH <= tq_min) return;
    const float* uf = M.HU + ((size_t)((0 * NB + b) * 4 + h) * NCH + c) * 4096 + lane;
    float Sf[64], Sb[64];
#pragma unroll
    for (int k = 0; k < 64; ++k) { Sf[k] = uf[k * 64]; Sb[k] = 0.f; }
    int cb = -1;
    const float ng = M.hg_norm_g[h * 64 + lane];
    const int tt0 = lane >> 4, k4 = (lane & 15) * 4;
    LAS float* Af = wl; LAS float* Ab = wl + 768;
    for (int sb = 0; sb < NSB; ++sb) {
        const int tq0 = CH * c + SBT * sb;
#pragma unroll
        for (int j = 0; j < 3; ++j) { const int row = row_of(b, tq0 + 4 * j + tt0);
            *(LAS f32x4*)(Af + (4 * j + tt0) * 64 + k4) = *(const f32x4*)(M.HQC + ((size_t)0 * NTOK + row) * 256 + h * 64 + k4);
            *(LAS f32x4*)(Ab + (4 * j + tt0) * 64 + k4) = *(const f32x4*)(M.HQC + ((size_t)1 * NTOK + row) * 256 + h * 64 + k4); }
        asm volatile("s_waitcnt lgkmcnt(0)" ::: "memory");
        for (int i = 0; i < SBT; ++i) {
            const int tq = tq0 + i, row = row_of(b, tq), cbn = bwd_chunk(tq);
            if (cbn != cb) { cb = cbn; const float* ub = M.HU + ((size_t)((1 * NB + b) * 4 + h) * NCH + cb) * 4096 + lane;
#pragma unroll
                for (int k = 0; k < 64; ++k) Sb[k] = ub[k * 64]; }
            float ac[4] = {M.HO[((size_t)0 * NTOK + row) * 256 + h * 64 + lane], M.HO[((size_t)1 * NTOK + row) * 256 + h * 64 + lane], 0.f, 0.f};
            const float gate = bf2f(M.P[(size_t)row * NP + C_HG + h * 64 + lane]);
#pragma unroll
            for (int kk = 0; kk < 16; ++kk) { const f32x4 a4 = *(const LAS f32x4*)(Af + i * 64 + 4 * kk), b4 = *(const LAS f32x4*)(Ab + i * 64 + 4 * kk);
#pragma unroll
                for (int j = 0; j < 4; ++j) { ac[j] += a4[j] * Sf[4 * kk + j]; ac[j] += b4[j] * Sb[4 * kk + j]; } }
            const float acc = (ac[0] + ac[1]) + (ac[2] + ac[3]);
            const float r = 1.0f / sqrtf(wsum(acc * acc, lane) * (1.0f / 64.0f) + NORM_EPS);
            M.OC[(size_t)row * D + 256 + h * 64 + lane] = f2bf(acc * r * ng * silu_f(gate));
        }
        asm volatile("s_waitcnt lgkmcnt(0)" ::: "memory");
    }
}
__device__ __forceinline__ void ret_fixfin_wave(const Mix& M, LAS float* wl, int unit, int lane, int tq_min) {
    const int c = unit % NCH, bh = unit / NCH, h = bh & 3, b = bh >> 2;
    if (CH * c + CH <= tq_min) return;
    const float* uf = M.RU + ((size_t)((0 * NB + b) * 4 + h) * NCH + c) * 2048 + lane;
    float Sf[32], Sb[32];
#pragma unroll
    for (int k = 0; k < 32; ++k) { Sf[k] = uf[k * 64]; Sb[k] = 0.f; }
    int cb = -1;
    const float gg = M.gn_g[h * 64 + lane], gb = M.gn_b[h * 64 + lane];
    const int tt0 = lane >> 3, k4 = (lane & 7) * 4;
    LAS float* Af = wl; LAS float* Ab = wl + 768;
    for (int sb = 0; sb < NSB; ++sb) {
        const int tq0 = CH * c + SBT * sb;
#pragma unroll
        for (int j = 0; j < 2; ++j) { const int tt = 8 * j + tt0; if (tt < SBT) { const int row = row_of(b, tq0 + tt);
            *(LAS f32x4*)(Af + tt * 32 + k4) = *(const f32x4*)(M.RQC + ((size_t)0 * NTOK + row) * 128 + h * 32 + k4);
            *(LAS f32x4*)(Ab + tt * 32 + k4) = *(const f32x4*)(M.RQC + ((size_t)1 * NTOK + row) * 128 + h * 32 + k4); } }
        asm volatile("s_waitcnt lgkmcnt(0)" ::: "memory");
        for (int i = 0; i < SBT; ++i) {
            const int tq = tq0 + i, row = row_of(b, tq), cbn = bwd_chunk(tq);
            if (cbn != cb) { cb = cbn; const float* ub = M.RU + ((size_t)((1 * NB + b) * 4 + h) * NCH + cb) * 2048 + lane;
#pragma unroll
                for (int k = 0; k < 32; ++k) Sb[k] = ub[k * 64]; }
            float ac[4] = {M.RO[((size_t)0 * NTOK + row) * 256 + h * 64 + lane], M.RO[((size_t)1 * NTOK + row) * 256 + h * 64 + lane], 0.f, 0.f};
            const float gate = bf2f(M.P[(size_t)row * NP + C_RG + h * 64 + lane]);
#pragma unroll
            for (int kk = 0; kk < 8; ++kk) { const f32x4 a4 = *(const LAS f32x4*)(Af + i * 32 + 4 * kk), b4 = *(const LAS f32x4*)(Ab + i * 32 + 4 * kk);
#pragma unroll
                for (int j = 0; j < 4; ++j) { ac[j] += a4[j] * Sf[4 * kk + j]; ac[j] += b4[j] * Sb[4 * kk + j]; } }
            const float acc = (ac[0] + ac[1]) + (ac[2] + ac[3]);
            const float mu = wsum(acc, lane) * (1.0f / 64.0f), dd = acc - mu, r = 1.0f / sqrtf(wsum(dd * dd, lane) * (1.0f / 64.0f) + NORM_EPS);
            M.OC[(size_t)row * D + 768 + h * 64 + lane] = f2bf((dd * r * gg + gb) * silu_f(gate));
        }
        asm volatile("s_waitcnt lgkmcnt(0)" ::: "memory");
    }
}
template <int KIND> __device__ __forceinline__ void norm_phase(Frame& F, int l) {
    unsigned char* ws = F.base();
    const bool combine = (KIND != 1) && l > 0 && ((l - 1) & 1);
    const bool first = (KIND == 0 && l == 0);
    const int nrows = (KIND == 2 || (KIND == 1 && l == DEPTH - 1)) ? NLAT : NTOK;
    const float* modl = F_sm + SM_MOD + (size_t)(KIND == 2 ? 0 : l) * 9 * 6144;
    const float* modp = F_sm + SM_MOD + (size_t)(l > 0 ? l - 1 : 0) * 9 * 6144;
    const int* offs = (const int*)(F_sm + SM_META) + ((l > 0 ? l - 1 : 0) >> 1) * 16;
    const float* gain = KIND == 0 ? IN(6) + l * D : (KIND == 1 ? IN(7) + l * D : IN(27));
    for (int row = F.gw; row < nrows; row += F.NGW) {
        const int bidx = row < NLAT ? row / NL : NB;
        const float* src = first ? (row < NLAT ? IN(0) + (size_t)row * D : IN(2) + (size_t)(row - NLAT) * D) : F_H + (size_t)row * D;
        f32x4 v[4];
#pragma unroll
        for (int j = 0; j < 4; ++j) v[j] = *(const f32x4*)(src + 4 * F.lane + 256 * j);
        if (combine) {
            const int* ti = F_tokinfo + (size_t)row * 8;
            const int e1 = ti[0], p1 = ti[1], e2 = ti[3], p2 = ti[4]; const float w1 = __int_as_float(ti[2]), w2 = __int_as_float(ti[5]);
            const bf16* y1 = F_Y + (size_t)(offs[e1] + p1) * D; const bf16* y2 = F_Y + (size_t)(offs[e2] + p2) * D;
#pragma unroll
            for (int j = 0; j < 4; ++j) { const int col = 4 * F.lane + 256 * j;
                const f32x4 gf = *(const f32x4*)(modp + (size_t)bidx * 6144 + 5 * 1024 + col);
                const v2u a = *(const v2u*)(y1 + col), b = *(const v2u*)(y2 + col);
                f32x4 ya, yb; ya[0] = bf2f((bf16)(a.x & 0xffff)); ya[1] = bf2f((bf16)(a.x >> 16)); ya[2] = bf2f((bf16)(a.y & 0xffff)); ya[3] = bf2f((bf16)(a.y >> 16));
                yb[0] = bf2f((bf16)(b.x & 0xffff)); yb[1] = bf2f((bf16)(b.x >> 16)); yb[2] = bf2f((bf16)(b.y & 0xffff)); yb[3] = bf2f((bf16)(b.y >> 16));
                v[j] = v[j] + gf * (ya * w1 + yb * w2); }
        }
        if (combine || first) {
#pragma unroll
            for (int j = 0; j < 4; ++j) *(f32x4*)(F_H + (size_t)row * D + 4 * F.lane + 256 * j) = v[j];
        }
        float ss = 0.f;
#pragma unroll
        for (int j = 0; j < 4; ++j) ss += (v[j][0] * v[j][0] + v[j][1] * v[j][1]) + (v[j][2] * v[j][2] + v[j][3] * v[j][3]);
        const float rstd = 1.0f / sqrtf(wave_sum(ss, F.lane) * (1.0f / D) + NORM_EPS);
        if (KIND == 2) {
#pragma unroll
            for (int j = 0; j < 4; ++j) { const int col = 4 * F.lane + 256 * j; const f32x4 g = *(const f32x4*)(gain + col); *(f32x4*)(OUTP() + (size_t)row * D + col) = v[j] * rstd * g; }
            continue;
        }
        const float* mrow = modl + (size_t)bidx * 6144 + (KIND == 0 ? 0 : 3 * 1024);
#pragma unroll
        for (int j = 0; j < 4; ++j) { const int col = 4 * F.lane + 256 * j;
            const f32x4 g = *(const f32x4*)(gain + col), sh = *(const f32x4*)(mrow + col), sc = *(const f32x4*)(mrow + 1024 + col);
            v[j] = v[j] * rstd * g * (sc + 1.0f) + sh;
            v2u o; o.x = pk2(v[j][0], v[j][1]); o.y = pk2(v[j][2], v[j][3]);
            *(v2u*)(F_A + (size_t)row * D + col) = o; }
        if (KIND == 1 && (l & 1)) {
            const int li = l >> 1; const float* wr = IN(23) + (size_t)li * D * 8;
            float lg[8];
#pragma unroll
            for (int e = 0; e < 8; ++e) lg[e] = 0.f;
#pragma unroll
            for (int j = 0; j < 4; ++j)
#pragma unroll
                for (int i = 0; i < 4; ++i) { const int col = 4 * F.lane + 256 * j + i; const f32x4 w0 = *(const f32x4*)(wr + (size_t)col * 8), w1 = *(const f32x4*)(wr + (size_t)col * 8 + 4);
#pragma unroll
                    for (int e = 0; e < 4; ++e) { lg[e] += v[j][i] * w0[e]; lg[4 + e] += v[j][i] * w1[e]; } }
#pragma unroll
            for (int e = 0; e < 8; ++e) lg[e] = wave_sum(lg[e], F.lane);
            int e1 = 0; float v1 = lg[0];
#pragma unroll
            for (int e = 1; e < 8; ++e) if (lg[e] > v1) { v1 = lg[e]; e1 = e; }
            int e2 = -1; float v2 = -3.0e38f;
#pragma unroll
            for (int e = 0; e < 8; ++e) if (e != e1 && lg[e] > v2) { v2 = lg[e]; e2 = e; }
            if (F.lane == 0) {
                const float w2 = 1.0f / (1.0f + expf(v1 - v2)), w1 = 1.0f - w2;
                const int p1 = (int)atomicAdd(F_ctl + CW_CNT + li * 8 + e1, 1u), p2 = (int)atomicAdd(F_ctl + CW_CNT + li * 8 + e2, 1u);
                F_list[(size_t)e1 * NTOK + p1] = row; F_list[(size_t)e2 * NTOK + p2] = row;
                int* ti = F_tokinfo + (size_t)row * 8; ti[0] = e1; ti[1] = p1; ti[2] = __float_as_int(w1); ti[3] = e2; ti[4] = p2; ti[5] = __float_as_int(w2);
            }
        }
    }
}
__device__ __forceinline__ void moe_tiles(Frame& F, int li, int (&tb)[9], int (&cnt)[8]) {
    unsigned char* ws = F.base();
    tb[0] = 0;
#pragma unroll
    for (int e = 0; e < 8; ++e) { cnt[e] = (int)__hip_atomic_load(F_ctl + CW_CNT + li * 8 + e, __ATOMIC_RELAXED, __HIP_MEMORY_SCOPE_AGENT); tb[e + 1] = tb[e] + ((cnt[e] + 255) >> 8); }
}
__device__ __forceinline__ void moe_gather(Frame& F, int li) {
    unsigned char* ws = F.base();
    int tb[9], cnt[8]; moe_tiles(F, li, tb, cnt);
    if (blockIdx.x == 0 && F.tid < 9) { int* meta = (int*)(F_sm + SM_META) + li * 16; int val = 0;
#pragma unroll
        for (int e = 0; e < 9; ++e) if (F.tid == e) val = tb[e] * 256;
        meta[F.tid] = val; }
    { const int T = tb[8]; unsigned* ul = (unsigned*)(F_sm + SM_ULIST) + li * (MAXTILES * 32);
      for (int L = F.gtid; L < T * 32; L += F.NT) {
          const bool gu = L < T * 28; const int nN = gu ? 28 : 4, nwg = T * nN; int wgid = gu ? L : L - T * 28;
          { const int q = nwg / 8, r = nwg % 8, xcd = wgid % 8, off = wgid / 8; wgid = (xcd < r ? xcd * (q + 1) : r * (q + 1) + (xcd - r) * q) + off; }
          const int nig = 8 * nN, gid = wgid / nig, fm = gid * 8, gsz = (T - fm) < 8 ? (T - fm) : 8;
          const int pm = fm + ((wgid % nig) % gsz), pnl = (wgid % nig) / gsz; int e = 0;
#pragma unroll
          for (int j = 1; j < 8; ++j) e += (pm >= tb[j]) ? 1 : 0;
          ul[(gu ? ULIST_GU : ULIST_D) + (gu ? L : L - T * 28)] = (unsigned)pm | ((unsigned)(e * nN + pnl) << 16);
      } }
    const int nslot = tb[8] * 256;
    for (int s = F.gw; s < nslot; s += F.NGW) {
        const int tile = s >> 8; int e = 0, base = 0, c = 0;
#pragma unroll
        for (int j = 0; j < 8; ++j) if (tile >= tb[j] && tile < tb[j + 1]) { e = j; base = tb[j] * 256; c = cnt[j]; }
        const int pos = s - base; const int tok = pos < c ? F_list[(size_t)e * NTOK + pos] : -1;
        v4u a = (v4u){0u, 0u, 0u, 0u}, b = a;
        if (tok >= 0) { const v4u* sp = (const v4u*)(F_A + (size_t)tok * D); a = sp[F.lane]; b = sp[64 + F.lane]; }
        v4u* dp = (v4u*)(F_AM + (size_t)s * D); dp[F.lane] = a; dp[64 + F.lane] = b;
    }
}

__device__ __forceinline__ void make_mix(Mix& M, unsigned char* ws, int l) {
    M.P = F_P; M.Qm = WSP(bf16, WS_QM); M.Km = WSP(bf16, WS_KM); M.Vm = WSP(bf16, WS_VM); M.Qs = WSP(bf16, WS_QS); M.Ks = WSP(bf16, WS_KS); M.Vs = WSP(bf16, WS_VS);
    M.HF = WSP(float, WS_HF); M.HO = WSP(float, WS_HO); M.RQ = WSP(float, WS_RQ); M.RK = WSP(float, WS_RK); M.RO = WSP(float, WS_RO); M.OC = F_OC;
    M.HU = WSP(float, WS_HU); M.HDK = WSP(float, WS_HDK); M.HQC = WSP(float, WS_HQC); M.RU = WSP(float, WS_RU); M.RQC = WSP(float, WS_RQC);
    M.loglb = F_sm + SM_LOGLB + l * 512; M.log1mlb = F_sm + SM_LOG1M + l * 512; M.hg_norm_g = IN(15) + l * 256; M.sink = IN(16) + l * 4; M.log_gamma = F_sm + SM_LGAM + l * 8;
    M.gn_g = IN(18) + l * 256; M.gn_b = IN(19) + l * 256;
}
__device__ __forceinline__ void frame_init(Frame& F, LAS unsigned char* lds, int wave_s) {
    unsigned z = 0u; asm volatile("" : "+v"(z)); int t = (int)__builtin_amdgcn_mbcnt_hi(~0u, __builtin_amdgcn_mbcnt_lo(~0u, z)); t += wave_s * 64;
    F.lds = lds; F.tid = t; F.lane = t & 63; F.wave = wave_s;
    F.gtid = blockIdx.x * NTHREADS + t; F.NT = gridDim.x * NTHREADS; { int gw_ = blockIdx.x * NWAVES + wave_s; asm volatile("" : "+s"(gw_)); F.gw = gw_; } F.NGW = gridDim.x * NWAVES;
}
__global__ void __launch_bounds__(NTHREADS, 2) fwd_kernel(Args args) {
    extern __shared__ __attribute__((aligned(16))) unsigned char lds[];
    const int wave_s = __builtin_amdgcn_readfirstlane((int)threadIdx.x >> 6);
    volatile LAS unsigned* MISC = (volatile LAS unsigned*)((LAS unsigned char*)lds + MISC_OFF);
    for (int u = threadIdx.x; u < (LDS_BYTES - 131072) / 4; u += NTHREADS) ((LAS unsigned*)((LAS unsigned char*)lds + 131072))[u] = 0u;
    __syncthreads();
    const int lo = args.ph_lo, hi = args.ph_hi;
    XcdBarrier bar; bar.w = wave_s; bar.bar = (unsigned*)(WSBASE() + WS_CTL) + CW_BAR; bar.x = 0; bar.st = nullptr;
    if (hi - lo > 1) bar = xcd_barrier_post((unsigned*)(WSBASE() + WS_CTL) + CW_BAR, MISC + 8, wave_s);
    int p = 0;
#ifndef PHMASK
#define PHMASK 0xffffffffu
#endif
#define PH_BEGIN_(k) if (((PHMASK >> (k)) & 1u) && p >= lo && p < hi) { Frame F; frame_init(F, (LAS unsigned char*)lds, wave_s); unsigned char* ws = F.base();
#define PH_END if (p + 1 < hi) xcd_barrier(bar); } ++p;

    PH_BEGIN_(0) (void)ws; prologue(F); PH_END

    for (int l = 0; l < DEPTH; ++l) {
        PH_BEGIN_(1) (void)ws; norm_phase<0>(F, l); if (l == 2) convert_moe(F, 1); PH_END
        PH_BEGIN_(2) { pg8::Gemm g{F_A, F_WIN + (size_t)l * NP * D, NTOK, NP, D}; pg8::StaticOrder S; S.init(NTOK, NP, gridDim.x, blockIdx.x);
                   pg8::EpiBf16P E{F_P, NP, NP / 256}; pg8::gemm_phase<pg8::EpiBf16P, pg8::StaticOrder, true, true>(F.lds, g, S, E, F.tid); } PH_END
#ifndef NO_MIX
        PH_BEGIN_(3) { Mix M; make_mix(M, ws, l); const float* tab = WSP(float, WS_TAB);
            for (int row = F.gw; row < NTOK; row += F.NGW) prep_row(M, tab, row, F.lane);
            for (int g8 = F.gw; g8 < NTOK / 8; g8 += F.NGW) prep_vt(M, g8, F.lane); }
        PH_END
        PH_BEGIN_(4) { Mix M; make_mix(M, ws, l);
            attn_phase(F.lds, M, M.sink, l < DEPTH - 1, F.tid);
            LAS float* wl = (LAS float*)(F.lds + F.wave * 9216);
            for (int u = F.gw; u < 2 * NB * 4 * NCH; u += F.NGW) { hg_local_wave(M, wl, u, F.lane); ret_local_wave(M, wl, u, F.lane); } }
        PH_END
        PH_BEGIN_(14) { Mix M; make_mix(M, ws, l);
            for (int it = F.gtid; it < 2 * NB * 4 * 4096; it += F.NT) hg_carry_item(M, it);
            for (int it = F.gtid; it < 2 * NB * 4 * 2048; it += F.NT) ret_carry_item(M, it); }
        PH_END
        PH_BEGIN_(15) { Mix M; make_mix(M, ws, l);
            LAS float* wl = (LAS float*)(F.lds + F.wave * 9216);
            const int w = F.wave, isH = ((w & 1) == 0) != (w >= 4), idx = isH ? (w == 0 ? 0 : w == 2 ? 1 : w == 5 ? 2 : 3) : (w == 1 ? 0 : w == 3 ? 1 : w == 4 ? 2 : 3);
            for (int u = blockIdx.x * 4 + idx; u < NB * 4 * NCH; u += gridDim.x * 4) { if (isH) hg_fixfin_wave(M, wl, u, F.lane, l < DEPTH - 1 ? 0 : NC); else ret_fixfin_wave(M, wl, u, F.lane, l < DEPTH - 1 ? 0 : NC); } }
        PH_END
#endif
        PH_BEGIN_(6) { const int Mr = l < DEPTH - 1 ? NTOK : NLAT; pg8::Gemm g{F_OC, F_WOUT + (size_t)l * D * D, Mr, D, D}; pg8::StaticOrder S; S.init(Mr, D, gridDim.x, blockIdx.x);
                   pg8::EpiRes E{F_H, F_sm + SM_MOD + (size_t)l * 9 * 6144 + 2 * 1024, NLAT / 256, NL / 256, NB}; pg8::gemm_phase<pg8::EpiRes, pg8::StaticOrder, true, true>(F.lds, g, S, E, F.tid); } PH_END
        PH_BEGIN_(7) (void)ws; norm_phase<1>(F, l); PH_END
        if ((l & 1) == 0) {
            const int li = l >> 1;
            PH_BEGIN_(8) { pg8::Gemm g{F_A, F_WFGU + (size_t)li * 2 * DFF * D, NTOK, 2 * DFF, D}; pg8::StaticOrder S; S.init(NTOK, 2 * DFF, gridDim.x, blockIdx.x);
                       pg8::EpiSwiglu E{F_ACT, DFF, 2 * DFF / 256}; pg8::gemm_phase<pg8::EpiSwiglu, pg8::StaticOrder, true, true>(F.lds, g, S, E, F.tid); } PH_END
            PH_BEGIN_(9) { pg8::Gemm g{F_ACT, F_WFD + (size_t)li * D * DFF, NTOK, D, DFF}; pg8::StaticOrder S; S.init(NTOK, D, gridDim.x, blockIdx.x);
                       pg8::EpiRes E{F_H, F_sm + SM_MOD + (size_t)l * 9 * 6144 + 5 * 1024, NLAT / 256, NL / 256, NB}; pg8::gemm_phase<pg8::EpiRes, pg8::StaticOrder, true, true>(F.lds, g, S, E, F.tid); } PH_END
        } else {
            const int li = l >> 1;
            PH_BEGIN_(10) (void)ws; moe_gather(F, li); PH_END
            PH_BEGIN_(11) { const int T = __builtin_amdgcn_readfirstlane((int)__hip_atomic_load((unsigned*)(F_sm + SM_META) + li * 16 + 8, __ATOMIC_RELAXED, __HIP_MEMORY_SCOPE_AGENT)) >> 8;
                       pg8::MoeOrder S; S.list = (const unsigned*)(F_sm + SM_ULIST) + li * (MAXTILES * 32) + ULIST_GU; S.nwg = T * (2 * DFE / 256); S.G = gridDim.x; S.c = blockIdx.x;
                       pg8::Gemm g{F_AM, F_WMGU, MAXTILES * 256, 8 * 2 * DFE, D};
                       pg8::EpiSwiglu E{F_ACT, DFE, 2 * DFE / 256}; pg8::gemm_phase<pg8::EpiSwiglu, pg8::MoeOrder, true, true>(F.lds, g, S, E, F.tid); } PH_END
            PH_BEGIN_(12) { const int T = __builtin_amdgcn_readfirstlane((int)__hip_atomic_load((unsigned*)(F_sm + SM_META) + li * 16 + 8, __ATOMIC_RELAXED, __HIP_MEMORY_SCOPE_AGENT)) >> 8;
                       pg8::MoeOrder S; S.list = (const unsigned*)(F_sm + SM_ULIST) + li * (MAXTILES * 32) + ULIST_D; S.nwg = T * (D / 256); S.G = gridDim.x; S.c = blockIdx.x;
                       pg8::Gemm g{F_ACT, F_WMD, MAXTILES * 256, 8 * D, DFE};
                       pg8::EpiBf16P E{F_Y, D, D / 256}; pg8::gemm_phase<pg8::EpiBf16P, pg8::MoeOrder, true, true>(F.lds, g, S, E, F.tid); } PH_END
        }
    }
    PH_BEGIN_(13) (void)ws; norm_phase<2>(F, DEPTH); PH_END
#undef PH_BEGIN_
#undef PH_END
}
constexpr int NPHASES = 1 + 2 * 10 + 2 * 11 + 1;

#ifndef MK_PER_PHASE
#define MK_PER_PHASE 0
#endif
#ifndef PROBE
#define PROBE 0
#endif
extern "C" void kernel_launch(void* const* d_in, const int* in_sizes, int n_in, void* d_out, int out_size, void* d_ws, size_t ws_size, hipStream_t stream) {
    static int grid = 0;
    if (grid == 0) {
        if (n_in != 28 || ws_size < WS_END || out_size != NLAT * D) { fprintf(stderr, "kernel_launch: unexpected problem shape (n_in %d, ws %zu, out %d)\n", n_in, ws_size, out_size); grid = -1; return; }
        int dev = 0, cus = 0;
        if (hipGetDevice(&dev) != hipSuccess || hipDeviceGetAttribute(&cus, hipDeviceAttributeMultiprocessorCount, dev) != hipSuccess) { grid = -1; return; }
        if (hipFuncSetAttribute((const void*)fwd_kernel, hipFuncAttributeMaxDynamicSharedMemorySize, LDS_BYTES) != hipSuccess) { fprintf(stderr, "kernel_launch: hipFuncSetAttribute failed\n"); grid = -1; return; }
        int per_cu = 0;
        if (hipOccupancyMaxActiveBlocksPerMultiprocessor(&per_cu, (const void*)fwd_kernel, NTHREADS, LDS_BYTES) != hipSuccess || per_cu < 1) { fprintf(stderr, "kernel_launch: occupancy query says %d\n", per_cu); }
        (void)hipGetLastError();
        grid = cus;
    }
    if (grid < 0) return;
    (void)hipMemsetAsync((char*)d_ws + WS_CTL, 0, CTL_ZERO_BYTES, stream);
    Args a{};
    for (int i = 0; i < 28; ++i) a.in[i] = (const float*)d_in[i];
    a.out = (float*)d_out; a.ws = (unsigned char*)d_ws;
#if MK_PER_PHASE
    for (int p = 0; p < NPHASES; ++p) { a.ph_lo = p; a.ph_hi = p + 1; hipLaunchKernelGGL(fwd_kernel, dim3(grid), dim3(NTHREADS), LDS_BYTES, stream, a);
        int l = -1, k = -1; const int base[4] = {1, 11, 22, 32}; for (int i = 0; i < 4; ++i) if (p >= base[i] && p < base[i] + (i & 1 ? 11 : 10)) { l = i; k = p - base[i]; }
        bool dup = false;
#if PROBE == 1
        dup = (p == 0);
#elif PROBE == 2
        dup = (k == 2);
#elif PROBE == 3
        dup = (k == 3);
#elif PROBE == 4
        dup = (k == 5);
#elif PROBE == 5
        dup = (k == 1);
#elif PROBE == 6
        dup = (k == 8) || ((l & 1) && (k == 9 || k == 10));
#endif
        if (dup) hipLaunchKernelGGL(fwd_kernel, dim3(grid), dim3(NTHREADS), LDS_BYTES, stream, a); }
#else
    a.ph_lo = 0; a.ph_hi = NPHASES; hipLaunchKernelGGL(fwd_kernel, dim3(grid), dim3(NTHREADS), LDS_BYTES, stream, a);
#endif
}
```

```cpp
#include <hip/hip_runtime.h>
#include <cstdio>
#include <cstdint>
#include <cmath>
#ifndef NB
#define NB 8
#endif
constexpr int D = 1024, NL = 2048, NC = 256, TK = NL + NC, DEPTH = 4, GRIDW = 64;
constexpr int NLAT = NB * NL, NCTX = NB * NC, NTOK = NLAT + NCTX;
constexpr int NP = 3840;
constexpr int DIN = 2912;
constexpr int C_QLAT = 0, C_KVLAT = 192, C_KPE = 320, C_HQ = 352, C_HZF = 608, C_HZB = 864, C_HI = 1120, C_HG = 1376;
constexpr int C_SQ = 1632, C_SK = 1888, C_SV = 2016, C_RQ = 2144, C_RK = 2272, C_RV = 2400, C_RG = 2656, C_QE = 2912, C_KVE = 3296;
constexpr int DFF = 2816, NEXP = 8, DFE = 3584;
constexpr float NORM_EPS = 1e-6f, LOG2E = 1.4426950408889634f;
typedef unsigned short bf16;

#ifdef HOST_TEST
#define HD static inline
#else
#define HD __host__ __device__ __forceinline__
#endif

HD float bf2f(bf16 b) { unsigned u = ((unsigned)b) << 16; float f; __builtin_memcpy(&f, &u, 4); return f; }
HD bf16 f2bf(float f) { unsigned u; __builtin_memcpy(&u, &f, 4); return (bf16)((u + 0x7fffu + ((u >> 16) & 1u)) >> 16); }
#define CBAR() asm volatile("" ::: "memory")
struct U4 { unsigned x, y, z, w; };
HD void ld8(const bf16* p, float (&f)[8]) {
    U4 u; __builtin_memcpy(&u, __builtin_assume_aligned(p, 16), 16);
    unsigned t;
    t = u.x << 16; __builtin_memcpy(&f[0], &t, 4); t = u.x & 0xffff0000u; __builtin_memcpy(&f[1], &t, 4);
    t = u.y << 16; __builtin_memcpy(&f[2], &t, 4); t = u.y & 0xffff0000u; __builtin_memcpy(&f[3], &t, 4);
    t = u.z << 16; __builtin_memcpy(&f[4], &t, 4); t = u.z & 0xffff0000u; __builtin_memcpy(&f[5], &t, 4);
    t = u.w << 16; __builtin_memcpy(&f[6], &t, 4); t = u.w & 0xffff0000u; __builtin_memcpy(&f[7], &t, 4);
}
HD void ld4f(const float* p, float (&f)[4]) { __builtin_memcpy(&f[0], __builtin_assume_aligned(p, 16), 16); }
HD float silu_f(float x) { return x / (1.0f + expf(-x)); }
HD int row_of(int b, int tq) { return tq < NC ? NLAT + b * NC + tq : b * NL + (tq - NC); }
HD void row_split(int row, int& b, int& tq) { if (row < NLAT) { b = row / NL; tq = NC + row % NL; } else { const int r = row - NLAT; b = r / NC; tq = r % NC; } }
HD float log_sigmoid_f(float x) { return fminf(x, 0.f) - log1pf(expf(-fabsf(x))); }

struct Mix {
    const bf16* P;
    bf16 *Qm, *Km, *Vm;
    bf16 *Qs, *Ks, *Vs;
    float* HF;
    float* HO;
    float *RQ, *RK;
    float* RO;
    bf16* OC;
    const float *loglb, *log1mlb;
    const float* hg_norm_g;
    const float* sink;
    const float* log_gamma;
    const float *gn_g, *gn_b;
    float *HU, *HDK, *HQC;
    float *RU, *RQC;
};
constexpr int CH = 72, NCH = TK / CH;
static_assert(NCH * CH == TK, "chunking");

HD void mla_prep_item(const Mix& M, int item) {
    const int row = item >> 2, h = item & 3; int b, tq; row_split(row, b, tq);
    const bf16* p = M.P + (size_t)row * NP;
    float sq = 0.f, skv = 0.f;
    for (int j = 0; j < 192; ++j) { const float v = bf2f(p[C_QLAT + j]); sq += v * v; }
    for (int j = 0; j < 128; ++j) { const float v = bf2f(p[C_KVLAT + j]); skv += v * v; }
    const float rq = 1.0f / sqrtf(sq * (1.0f / 192.0f) + NORM_EPS), rkv = 1.0f / sqrtf(skv * (1.0f / 128.0f) + NORM_EPS);
    const float qs = rq * 0.10206207261596575f * LOG2E;
    const size_t o96 = ((size_t)(b * 4 + h) * TK + tq) * 96;
    for (int j = 0; j < 64; ++j) {
        M.Qm[o96 + j] = f2bf(bf2f(p[C_QE + h * 96 + j]) * qs);
        M.Km[o96 + j] = f2bf(bf2f(p[C_KVE + h * 128 + j]) * rkv);
        M.Vm[((size_t)(b * 4 + h) * 64 + j) * TK + tq] = f2bf(bf2f(p[C_KVE + h * 128 + 64 + j]) * rkv);
    }
    const bool lat = tq >= NC; const int t = tq - NC;
    for (int j = 0; j < 16; ++j) {
        float c = 1.f, s = 0.f;
        if (lat) { const float inv = powf(10000.0f, -(float)(j & 7) / 8.0f); const float ang = (float)(j < 8 ? t / GRIDW : t % GRIDW) * inv; c = cosf(ang); s = sinf(ang); }
        const float q1 = bf2f(p[C_QE + h * 96 + 64 + j]), q2 = bf2f(p[C_QE + h * 96 + 80 + j]);
        M.Qm[o96 + 64 + j] = f2bf((q1 * c - q2 * s) * qs); M.Qm[o96 + 80 + j] = f2bf((q1 * s + q2 * c) * qs);
        const float k1 = bf2f(p[C_KPE + j]), k2 = bf2f(p[C_KPE + 16 + j]);
        M.Km[o96 + 64 + j] = f2bf(k1 * c - k2 * s); M.Km[o96 + 80 + j] = f2bf(k1 * s + k2 * c);
    }
}
HD void swa_prep_item(const Mix& M, int item) {
    const int row = item >> 3, s = item & 7; int b, tq; row_split(row, b, tq);
    const bf16* p = M.P + (size_t)row * NP;
    const bool lat = tq >= NC; const int t = tq - NC;
    if (s >= 6) { const int kh = s - 6; bf16* o = M.Vs + (size_t)(b * 2 + kh) * 64 * TK + tq; for (int j = 0; j < 64; ++j) o[(size_t)j * TK] = p[C_SV + kh * 64 + j]; return; }
    const bf16* src = s < 4 ? p + C_SQ + s * 64 : p + C_SK + (s - 4) * 64;
    bf16* o = s < 4 ? M.Qs + ((size_t)(b * 4 + s) * TK + tq) * 64 : M.Ks + ((size_t)(b * 2 + (s - 4)) * TK + tq) * 64;
    const float sc = s < 4 ? 0.125f * LOG2E : 1.0f;
    for (int j = 0; j < 32; ++j) {
        float c = 1.f, sn = 0.f;
        if (lat) { const float inv = powf(10000.0f, -(float)(j & 15) / 16.0f); const float ang = (float)(j < 16 ? t / GRIDW : t % GRIDW) * inv; c = cosf(ang); sn = sinf(ang); }
        const float x1 = bf2f(src[j]), x2 = bf2f(src[32 + j]);
        o[j] = f2bf((x1 * c - x2 * sn) * sc); o[32 + j] = f2bf((x1 * sn + x2 * c) * sc);
    }
}
HD void hg_prep_item(const Mix& M, int item) {
    const int row = item >> 8, c = item & 255;
    const bf16* p = M.P + (size_t)row * NP;
    for (int d = 0; d < 2; ++d) {
        const float z = bf2f(p[(d ? C_HZB : C_HZF) + c]);
        const float a = M.loglb[d * 256 + c], bb = M.log1mlb[d * 256 + c] + log_sigmoid_f(z);
        const float mx = fmaxf(a, bb), lf = mx + log1pf(expf(-fabsf(a - bb)));
        M.HF[((size_t)d * NTOK + row) * 256 + c] = expf(lf);
    }
}
HD void ret_prep_item(const Mix& M, int item) {
    const int row = item >> 3, w = (item >> 2) & 1, h = item & 3; int b, tq; row_split(row, b, tq);
    const bf16* src = M.P + (size_t)row * NP + (w ? C_RK : C_RQ) + h * 32;
    float* o = (w ? M.RK : M.RQ) + (size_t)row * 128 + h * 32;
    const float sc = w ? 1.0f : 0.17677669529663687f;
    for (int j = 0; j < 16; ++j) {
        const float inv = powf(10000.0f, -(float)j / 16.0f); const float ang = (float)tq * inv; const float c = cosf(ang), s = sinf(ang);
        const float x1 = bf2f(src[j]), x2 = bf2f(src[16 + j]);
        o[j] = (x1 * c - x2 * s) * sc; o[16 + j] = (x1 * s + x2 * c) * sc;
    }
}
HD void mla_attn_item(const Mix& M, int item) {
    const int tq = item % TK, bh = item / TK, b = bh >> 2, h = bh & 3;
    const bf16* qp = M.Qm + (size_t)item * 96;
    float q[96], o[64];
#pragma unroll
    for (int c8 = 0; c8 < 12; ++c8) { float t8[8]; ld8(qp + 8 * c8, t8);
#pragma unroll
        for (int j = 0; j < 8; ++j) q[8 * c8 + j] = t8[j]; }
#pragma unroll
    for (int j = 0; j < 64; ++j) o[j] = 0.f;
    float m = -1e30f, l = 0.f;
    const int nk = tq < NC ? NC : TK;
    const bf16* kb = M.Km + (size_t)bh * TK * 96; const bf16* vb = M.Vm + (size_t)bh * TK * 64;
    for (int k = 0; k < nk; ++k) {
        const bf16* kp = kb + (size_t)k * 96; float s = 0.f;
#pragma unroll
        for (int c8 = 0; c8 < 12; ++c8) { float t8[8]; ld8(kp + 8 * c8, t8);
#pragma unroll
            for (int j = 0; j < 8; ++j) s += q[8 * c8 + j] * t8[j];
            if ((c8 & 3) == 3) CBAR(); }
        const float mn = fmaxf(m, s), al = exp2f(m - mn), pr = exp2f(s - mn);
        l = l * al + pr; m = mn;
        const bf16* vp = vb + k;
#pragma unroll
        for (int j = 0; j < 64; ++j) o[j] = o[j] * al + pr * bf2f(vp[(size_t)j * TK]);
    }
    const float rl = 1.0f / l; bf16* op = M.OC + (size_t)row_of(b, tq) * D + h * 64;
#pragma unroll
    for (int j = 0; j < 64; ++j) op[j] = f2bf(o[j] * rl);
}
HD void swa_attn_item(const Mix& M, int item) {
    const int tq = item % TK, bh = item / TK, b = bh >> 2, hq = bh & 3, kh = hq >> 1;
    const bf16* qp = M.Qs + (size_t)item * 64;
    float q[64], o[64];
#pragma unroll
    for (int c8 = 0; c8 < 8; ++c8) { float t8[8]; ld8(qp + 8 * c8, t8);
#pragma unroll
        for (int j = 0; j < 8; ++j) { q[8 * c8 + j] = t8[j]; o[8 * c8 + j] = 0.f; } }
    float m = M.sink[hq] * LOG2E, l = 1.0f;
    const bf16* kb = M.Ks + (size_t)(b * 2 + kh) * TK * 64; const bf16* vb = M.Vs + (size_t)(b * 2 + kh) * TK * 64;
    const int t = tq - NC;
    const int lo2 = tq < NC ? 0 : (t - 128 < 0 ? 0 : t - 128), hi2 = tq < NC ? -1 : (t + 128 > NL - 1 ? NL - 1 : t + 128);
    const int n2 = hi2 - lo2 + 1;
    for (int i = 0; i < NC + n2; ++i) {
        const int k = i < NC ? i : NC + lo2 + (i - NC);
        const bf16* kp = kb + (size_t)k * 64; float s = 0.f;
#pragma unroll
        for (int c8 = 0; c8 < 8; ++c8) { float t8[8]; ld8(kp + 8 * c8, t8);
#pragma unroll
            for (int j = 0; j < 8; ++j) s += q[8 * c8 + j] * t8[j];
            if ((c8 & 3) == 3) CBAR(); }
        const float mn = fmaxf(m, s), al = exp2f(m - mn), pr = exp2f(s - mn);
        l = l * al + pr; m = mn;
        const bf16* vp = vb + k;
#pragma unroll
        for (int j = 0; j < 64; ++j) o[j] = o[j] * al + pr * bf2f(vp[(size_t)j * TK]);
    }
    const float rl = 1.0f / l; bf16* op = M.OC + (size_t)row_of(b, tq) * D + 512 + hq * 64;
#pragma unroll
    for (int j = 0; j < 64; ++j) op[j] = f2bf(o[j] * rl);
}
HD int dir_tq(int dir, int i) { return dir == 0 ? i : (i < NC ? NC - 1 - i : NC + (NL - 1 - (i - NC))); }
HD void hg_scan_item(const Mix& M, int item) {
    const int v = item & 63, h = (item >> 6) & 3, b = (item >> 8) % NB, dir = item / (256 * NB);
    float S[64];
#pragma unroll
    for (int k = 0; k < 64; ++k) S[k] = 0.f;
    for (int i = 0; i < TK; ++i) {
        const int row = row_of(b, dir_tq(dir, i));
        const bf16* p = M.P + (size_t)row * NP; const float* f = M.HF + ((size_t)dir * NTOK + row) * 256 + h * 64;
        const float vv = bf2f(p[C_HI + h * 64 + v]); float acc = 0.f;
#pragma unroll
        for (int c8 = 0; c8 < 8; ++c8) { float q8[8], fa[4], fb[4]; ld8(p + C_HQ + h * 64 + 8 * c8, q8); ld4f(f + 8 * c8, fa); ld4f(f + 8 * c8 + 4, fb);
#pragma unroll
            for (int j = 0; j < 8; ++j) { const int k = 8 * c8 + j; const float fk = j < 4 ? fa[j] : fb[j - 4]; S[k] = fk * S[k] + (1.0f - fk) * vv; acc += q8[j] * S[k]; }
            if ((c8 & 1) == 1) CBAR(); }
        M.HO[((size_t)dir * NTOK + row) * 256 + h * 64 + v] = acc * 0.125f;
    }
}
HD void ret_scan_item(const Mix& M, int item) {
    const int v = item & 63, h = (item >> 6) & 3, b = (item >> 8) % NB, dir = item / (256 * NB);
    const float g = expf(M.log_gamma[dir * 4 + h]);
    float S[32];
#pragma unroll
    for (int k = 0; k < 32; ++k) S[k] = 0.f;
    for (int i = 0; i < TK; ++i) {
        const int row = row_of(b, dir_tq(dir, i));
        const float vv = bf2f(M.P[(size_t)row * NP + C_RV + h * 64 + v]);
        const float* qk = M.RQ + (size_t)row * 128 + h * 32; const float* kk = M.RK + (size_t)row * 128 + h * 32; float acc = 0.f;
#pragma unroll
        for (int c4 = 0; c4 < 8; ++c4) { float qa[4], ka[4]; ld4f(qk + 4 * c4, qa); ld4f(kk + 4 * c4, ka);
#pragma unroll
            for (int j = 0; j < 4; ++j) { const int k = 4 * c4 + j; S[k] = g * S[k] + ka[j] * vv; acc += qa[j] * S[k]; }
            if ((c4 & 3) == 3) CBAR(); }
        M.RO[((size_t)dir * NTOK + row) * 256 + h * 64 + v] = acc;
    }
}
HD void hg_fin_item(const Mix& M, int item) {
    const int row = item >> 2, h = item & 3;
    const float* o0 = M.HO + (size_t)row * 256 + h * 64; const float* o1 = o0 + (size_t)NTOK * 256;
    float ss = 0.f;
    for (int v = 0; v < 64; ++v) { const float x = o0[v] + o1[v]; ss += x * x; }
    const float r = 1.0f / sqrtf(ss * (1.0f / 64.0f) + NORM_EPS);
    const bf16* gp = M.P + (size_t)row * NP + C_HG + h * 64; bf16* op = M.OC + (size_t)row * D + 256 + h * 64;
    for (int v = 0; v < 64; ++v) op[v] = f2bf((o0[v] + o1[v]) * r * M.hg_norm_g[h * 64 + v] * silu_f(bf2f(gp[v])));
}
HD void ret_fin_item(const Mix& M, int item) {
    const int row = item >> 2, h = item & 3;
    const float* o0 = M.RO + (size_t)row * 256 + h * 64; const float* o1 = o0 + (size_t)NTOK * 256;
    float s = 0.f;
    for (int v = 0; v < 64; ++v) s += o0[v] + o1[v];
    const float mu = s * (1.0f / 64.0f); float q = 0.f;
    for (int v = 0; v < 64; ++v) { const float d = o0[v] + o1[v] - mu; q += d * d; }
    const float r = 1.0f / sqrtf(q * (1.0f / 64.0f) + NORM_EPS);
    const bf16* gp = M.P + (size_t)row * NP + C_RG + h * 64; bf16* op = M.OC + (size_t)row * D + 768 + h * 64;
    for (int v = 0; v < 64; ++v) op[v] = f2bf(((o0[v] + o1[v] - mu) * r * M.gn_g[h * 64 + v] + M.gn_b[h * 64 + v]) * silu_f(bf2f(gp[v])));
}

HD void hg_local_item(const Mix& M, int item) {
    const int v = item & 63, c = (item >> 6) % NCH, seq = item / (64 * NCH), h = seq & 3, b = (seq >> 2) % NB, dir = seq / (4 * NB);
    float S[64];
#pragma unroll
    for (int k = 0; k < 64; ++k) S[k] = 0.f;
    float dk = 1.0f;
    for (int i = 0; i < CH; ++i) {
        const int row = row_of(b, dir_tq(dir, c * CH + i));
        const bf16* p = M.P + (size_t)row * NP; const float* f = M.HF + ((size_t)dir * NTOK + row) * 256 + h * 64;
        const float vv = bf2f(p[C_HI + h * 64 + v]); float acc = 0.f;
        dk *= f[v]; M.HQC[((size_t)dir * NTOK + row) * 256 + h * 64 + v] = bf2f(p[C_HQ + h * 64 + v]) * dk * 0.125f;
#pragma unroll
        for (int c8 = 0; c8 < 8; ++c8) { float q8[8], fa[4], fb[4]; ld8(p + C_HQ + h * 64 + 8 * c8, q8); ld4f(f + 8 * c8, fa); ld4f(f + 8 * c8 + 4, fb);
#pragma unroll
            for (int j = 0; j < 8; ++j) { const int k = 8 * c8 + j; const float fk = j < 4 ? fa[j] : fb[j - 4]; S[k] = fk * (S[k] - vv) + vv; acc += q8[j] * S[k]; }
            if ((c8 & 1) == 1) CBAR(); }
        M.HO[((size_t)dir * NTOK + row) * 256 + h * 64 + v] = acc * 0.125f;
    }
    float* u = M.HU + ((size_t)seq * NCH + c) * 4096 + v;
#pragma unroll
    for (int k = 0; k < 64; ++k) u[k * 64] = S[k];
    M.HDK[((size_t)seq * NCH + c) * 64 + v] = dk;
}
HD void hg_carry_item(const Mix& M, int item) {
    const int kv = item & 4095, seq = item >> 12, k = kv >> 6; float s = 0.f;
#pragma unroll 8
    for (int c = 0; c < NCH; ++c) { float* u = M.HU + ((size_t)seq * NCH + c) * 4096 + kv; const float uu = *u; *u = s; s = M.HDK[((size_t)seq * NCH + c) * 64 + k] * s + uu; }
}
HD void hg_fix_item(const Mix& M, int item) {
    const int v = item & 63, c = (item >> 6) % NCH, seq = item / (64 * NCH), h = seq & 3, b = (seq >> 2) % NB, dir = seq / (4 * NB);
    if (c == 0) return;
    float S[64]; const float* u = M.HU + ((size_t)seq * NCH + c) * 4096 + v;
#pragma unroll
    for (int k = 0; k < 64; ++k) S[k] = u[k * 64];
    for (int i = 0; i < CH; ++i) {
        const int row = row_of(b, dir_tq(dir, c * CH + i));
        const float* qc = M.HQC + ((size_t)dir * NTOK + row) * 256 + h * 64; float acc = 0.f;
#pragma unroll
        for (int c4 = 0; c4 < 16; ++c4) { float qa[4]; ld4f(qc + 4 * c4, qa);
#pragma unroll
            for (int j = 0; j < 4; ++j) acc += qa[j] * S[4 * c4 + j];
            if ((c4 & 3) == 3) CBAR(); }
        M.HO[((size_t)dir * NTOK + row) * 256 + h * 64 + v] += acc;
    }
}
HD void ret_local_item(const Mix& M, int item) {
    const int v = item & 63, c = (item >> 6) % NCH, seq = item / (64 * NCH), h = seq & 3, b = (seq >> 2) % NB, dir = seq / (4 * NB);
    const float g = expf(M.log_gamma[dir * 4 + h]);
    float S[32];
#pragma unroll
    for (int k = 0; k < 32; ++k) S[k] = 0.f;
    float gp = 1.0f;
    for (int i = 0; i < CH; ++i) {
        const int row = row_of(b, dir_tq(dir, c * CH + i));
        const float vv = bf2f(M.P[(size_t)row * NP + C_RV + h * 64 + v]);
        const float* qk = M.RQ + (size_t)row * 128 + h * 32; const float* kk = M.RK + (size_t)row * 128 + h * 32; float acc = 0.f;
        gp *= g; if (v < 32) M.RQC[((size_t)dir * NTOK + row) * 128 + h * 32 + v] = qk[v] * gp;
#pragma unroll
        for (int c4 = 0; c4 < 8; ++c4) { float qa[4], ka[4]; ld4f(qk + 4 * c4, qa); ld4f(kk + 4 * c4, ka);
#pragma unroll
            for (int j = 0; j < 4; ++j) { const int k = 4 * c4 + j; S[k] = g * S[k] + ka[j] * vv; acc += qa[j] * S[k]; }
            if ((c4 & 3) == 3) CBAR(); }
        M.RO[((size_t)dir * NTOK + row) * 256 + h * 64 + v] = acc;
    }
    float* u = M.RU + ((size_t)seq * NCH + c) * 2048 + v;
#pragma unroll
    for (int k = 0; k < 32; ++k) u[k * 64] = S[k];
}
HD void ret_carry_item(const Mix& M, int item) {
    const int kv = item & 2047, seq = item >> 11, h = seq & 3, dir = seq / (4 * NB); float s = 0.f;
    const float d = expf((float)CH * M.log_gamma[dir * 4 + h]);
#pragma unroll 8
    for (int c = 0; c < NCH; ++c) { float* u = M.RU + ((size_t)seq * NCH + c) * 2048 + kv; const float uu = *u; *u = s; s = d * s + uu; }
}
HD void ret_fix_item(const Mix& M, int item) {
    const int v = item & 63, c = (item >> 6) % NCH, seq = item / (64 * NCH), h = seq & 3, b = (seq >> 2) % NB, dir = seq / (4 * NB);
    if (c == 0) return;
    float S[32]; const float* u = M.RU + ((size_t)seq * NCH + c) * 2048 + v;
#pragma unroll
    for (int k = 0; k < 32; ++k) S[k] = u[k * 64];
    for (int i = 0; i < CH; ++i) {
        const int row = row_of(b, dir_tq(dir, c * CH + i));
        const float* qc = M.RQC + ((size_t)dir * NTOK + row) * 128 + h * 32; float acc = 0.f;
#pragma unroll
        for (int c4 = 0; c4 < 8; ++c4) { float qa[4]; ld4f(qc + 4 * c4, qa);
#pragma unroll
            for (int j = 0; j < 4; ++j) acc += qa[j] * S[4 * c4 + j];
            if ((c4 & 3) == 3) CBAR(); }
        M.RO[((size_t)dir * NTOK + row) * 256 + h * 64 + v] += acc;
    }
}
namespace pg8 {
#define PG8_LAS __attribute__((address_space(3)))
typedef unsigned short bf16_t;
typedef short bf16x8 __attribute__((ext_vector_type(8)));
typedef float f32x4 __attribute__((ext_vector_type(4)));
typedef unsigned u32x4 __attribute__((ext_vector_type(4)));
constexpr int BM = 256, BK = 64, HALF = 128, HTB = HALF * BK * 2  , STAGE_BYTES = 8 * HTB, NXCD = 8, WGM = 8;

__host__ __device__ __forceinline__ int lds_byte(int r, int c) { const int st = (r >> 4) * 2 + (c >> 5), rr = r & 15, cc = c & 31, ob = rr * 64 + cc * 2; return st * 1024 + (ob ^ (((ob >> 9) & 1) << 5)); }
__host__ __device__ __forceinline__ void stage_rc(int b, int& R, int& C) { const int st = b / 1024, sb = b % 1024, swz = sb ^ (((sb >> 9) & 1) << 5); R = (st >> 1) * 16 + swz / 64; C = (st & 1) * 32 + (swz % 64) / 2; }
__host__ __device__ __forceinline__ int perm32(int rho) { const int n = rho >> 4, i = rho & 15; return 8 * (i >> 2) + 4 * n + (i & 3); }

struct Unit { int pm, pn; };
struct Gemm { const bf16_t* A; const bf16_t* Bt; int M, N, K; };

struct StaticOrder {
    int nM, nN, nwg, G, c;
    __host__ __device__ void init(int M, int N, int G_, int c_) { nM = M / BM; nN = N / BM; nwg = nM * nN; G = G_; c = c_; }
    __host__ __device__ bool next(int i, Unit& u) const {
        const long L = (long)i * G + c; if (L >= nwg) return false;
        int wgid = (int)L; { const int q = nwg / NXCD, r = nwg % NXCD, xcd = wgid % NXCD, off = wgid / NXCD; wgid = (xcd < r ? xcd * (q + 1) : r * (q + 1) + (xcd - r) * q) + off; }
        const int nig = WGM * nN, gid = wgid / nig, fm = gid * WGM, gsz = (nM - fm) < WGM ? (nM - fm) : WGM;
        u.pm = fm + ((wgid % nig) % gsz); u.pn = (wgid % nig) / gsz; return true;
    }
    __device__ __forceinline__ void a_ready(const Unit&) const {}
    __device__ __forceinline__ void done(const Unit&) const {}
};

__device__ __forceinline__ unsigned cvt_pk_bf16(float lo, float hi) { unsigned r; asm volatile("v_cvt_pk_bf16_f32 %0, %1, %2" : "=v"(r) : "v"(lo), "v"(hi)); return r; }
typedef unsigned u32x2 __attribute__((ext_vector_type(2)));
struct EpiBf16P {
    static constexpr bool PERM = true, AFTER_DRAIN = false;
    bf16_t* O; int ldc; int nN;
    __device__ __forceinline__ void operator()(const f32x4 (&acc)[2][2][4][2], const Unit& u, int wr, int wc, int fr, int fq) const {
        const int row0 = u.pm * BM + wr * 64 + fr, col0 = (u.pn % nN) * BM + wc * 32 + 8 * fq;
#pragma unroll
        for (int ai = 0; ai < 2; ++ai)
#pragma unroll
            for (int m = 0; m < 4; ++m) { bf16_t* rowp = O + (size_t)(row0 + ai * HALF + m * 16) * ldc + col0;
#pragma unroll
                for (int bj = 0; bj < 2; ++bj) { const f32x4 v0 = acc[ai][bj][m][0], v1 = acc[ai][bj][m][1];
                    u32x4 w; w.x = cvt_pk_bf16(v0[0], v0[1]); w.y = cvt_pk_bf16(v0[2], v0[3]); w.z = cvt_pk_bf16(v1[0], v1[1]); w.w = cvt_pk_bf16(v1[2], v1[3]);
                    *(u32x4*)(rowp + bj * HALF) = w; } }
    }
};
struct EpiRes {
    static constexpr bool PERM = false, AFTER_DRAIN = false;
    float* H; const float* gate; int lat_tiles, tiles_per_batch, ctx_bidx;
    __device__ __forceinline__ void operator()(const f32x4 (&acc)[2][2][4][2], const Unit& u, int wr, int wc, int fr, int fq) const {
        const int bidx = u.pm < lat_tiles ? u.pm / tiles_per_batch : ctx_bidx;
        const float* g = gate + (size_t)bidx * 6144;
        const int row0 = u.pm * BM + wr * 64 + fr, col0 = u.pn * BM + wc * 32 + 4 * fq;
        f32x4 gv[2][2];
#pragma unroll
        for (int bj = 0; bj < 2; ++bj)
#pragma unroll
            for (int n = 0; n < 2; ++n) gv[bj][n] = *(const f32x4*)(g + col0 + bj * HALF + n * 16);
#pragma unroll
        for (int ai = 0; ai < 2; ++ai)
#pragma unroll
            for (int m = 0; m < 4; ++m) { float* rowp = H + (size_t)(row0 + ai * HALF + m * 16) * 1024 + col0;
#pragma unroll
                for (int bj = 0; bj < 2; ++bj)
#pragma unroll
                    for (int n = 0; n < 2; ++n) { f32x4* p = (f32x4*)(rowp + bj * HALF + n * 16); *p = *p + gv[bj][n] * acc[ai][bj][m][n]; } }
    }
};
struct EpiSwiglu {
    static constexpr bool PERM = true, AFTER_DRAIN = false;
    bf16_t* O; int ldo; int nN;
    __device__ __forceinline__ void operator()(const f32x4 (&acc)[2][2][4][2], const Unit& u, int wr, int wc, int fr, int fq) const {
        const int row0 = u.pm * BM + wr * 64 + fr, col0 = (u.pn % nN) * 128 + wc * 16 + 4 * fq;
#pragma unroll
        for (int ai = 0; ai < 2; ++ai)
#pragma unroll
            for (int m = 0; m < 4; ++m) { bf16_t* rowp = O + (size_t)(row0 + ai * HALF + m * 16) * ldo + col0;
#pragma unroll
                for (int bj = 0; bj < 2; ++bj) { const f32x4 gt = acc[ai][bj][m][0], up = acc[ai][bj][m][1]; float r[4];
#pragma unroll
                    for (int i = 0; i < 4; ++i) r[i] = gt[i] * __builtin_amdgcn_rcpf(1.0f + __builtin_amdgcn_exp2f(-1.4426950408889634f * gt[i])) * up[i];
                    u32x2 w; w.x = cvt_pk_bf16(r[0], r[1]); w.y = cvt_pk_bf16(r[2], r[3]);
                    *(u32x2*)(rowp + bj * 64) = w; } }
    }
};
struct MoeOrder {
    const unsigned* list; int nwg, G, c;
    __device__ __forceinline__ bool next(int i, Unit& u) const {
        const long L = (long)i * G + c; if (L >= nwg) return false;
        unsigned w; const unsigned* ptr = list + L;
        asm volatile("s_load_dword %0, %1, 0x0\n\ts_waitcnt lgkmcnt(0)" : "=s"(w) : "s"(ptr) : "memory");
        u.pm = (int)(w & 0xffffu); u.pn = (int)(w >> 16); return true;
    }
    __device__ __forceinline__ void a_ready(const Unit&) const {}
    __device__ __forceinline__ void done(const Unit&) const {}
};
template <class Epi, class Sched, bool ALIGN_EPI = false, bool SP2 = false>
__device__ __forceinline__ void gemm_phase(PG8_LAS unsigned char* lds, const Gemm g, const Sched& S, const Epi& E, const int tid_in) {
    const int tid = tid_in, wid = __builtin_amdgcn_readfirstlane(tid >> 6), lane = tid & 63, wr = wid >> 2, wc = wid & 3, fr = lane & 15, fq = lane >> 4;
    const int K = g.K, nt = K / BK;
    unsigned voffA[2], voffB[2];
#pragma unroll
    for (int i = 0; i < 2; ++i) { int R, C; stage_rc(tid * 16 + i * 8192, R, C); const int Rb = Epi::PERM ? ((R & ~31) + perm32(R & 31)) : R;
        voffA[i] = (unsigned)(R * K + C) * 2u; voffB[i] = (unsigned)(Rb * K + C) * 2u; }
    const size_t kstep = (size_t)(BK * 2);
    const size_t hstep = (size_t)HALF * K * 2;
    const size_t tstep = 2 * hstep;
    const unsigned ldsw = (unsigned)wid * 1024u;
    const int aoff = lds_byte(wr * 64 + fr, fq * 8), boff = lds_byte(wc * 32 + fr, fq * 8);
#define PG8_SA(b, h) (((b) * 2 + (h)) * HTB)
#define PG8_SB(b, h) ((4 + (b) * 2 + (h)) * HTB)
#define PG8_STAGE(bufoff, gbase, voff) do { _Pragma("unroll") for (int _i = 0; _i < 2; ++_i) \
        __builtin_amdgcn_global_load_lds((const unsigned*)((const char*)(gbase) + (voff)[_i]), (PG8_LAS unsigned*)(lds + (bufoff) + ldsw + _i * 8192), 16, 0, 0); } while (0)
#define PG8_LDA(dst, b, h) do { _Pragma("unroll") for (int m = 0; m < 4; ++m) _Pragma("unroll") for (int k = 0; k < 2; ++k) dst[m][k] = *(const PG8_LAS bf16x8*)(lds + PG8_SA(b, h) + aoff + m * 2048 + k * 1024); } while (0)
#define PG8_LDB(dst, b, h) do { _Pragma("unroll") for (int n = 0; n < 2; ++n) _Pragma("unroll") for (int k = 0; k < 2; ++k) dst[n][k] = *(const PG8_LAS bf16x8*)(lds + PG8_SB(b, h) + boff + n * 2048 + k * 1024); } while (0)
#define PG8_MMA(ai, bj, At, Bt) do { __builtin_amdgcn_s_setprio(1); _Pragma("unroll") for (int m = 0; m < 4; ++m) _Pragma("unroll") for (int n = 0; n < 2; ++n) _Pragma("unroll") for (int k = 0; k < 2; ++k) \
        acc[ai][bj][m][n] = __builtin_amdgcn_mfma_f32_16x16x32_bf16(Bt[n][k], At[m][k], acc[ai][bj][m][n], 0, 0, 0); __builtin_amdgcn_s_setprio(0); } while (0)
#define PG8_WAIT_V(n) asm volatile("s_waitcnt vmcnt(" #n ")" ::: "memory")
#define PG8_WAIT_L(n) asm volatile("s_waitcnt lgkmcnt(" #n ")" ::: "memory")
#define PG8_BAR __builtin_amdgcn_s_barrier()
#define PG8_SCHED __builtin_amdgcn_sched_barrier(0)
    Unit cur, nxt; int ui = 0;
    if (!S.next(0, cur)) return;
    f32x4 acc[2][2][4][2];
#pragma unroll
    for (int a = 0; a < 2; ++a)
#pragma unroll
        for (int b = 0; b < 2; ++b)
#pragma unroll
            for (int m = 0; m < 4; ++m)
#pragma unroll
                for (int n = 0; n < 2; ++n) acc[a][b][m][n] = (f32x4){0.f, 0.f, 0.f, 0.f};
    bf16x8 At[4][2], B0[2][2], B1[2][2];
    const char* cA = (const char*)g.A + (size_t)cur.pm * tstep; const char* cB = (const char*)g.Bt + (size_t)cur.pn * tstep;
    S.a_ready(cur);
    if constexpr (SP2) {
        PG8_STAGE(PG8_SB(0, 0), cB, voffB); PG8_STAGE(PG8_SB(0, 1), cB + hstep, voffB); PG8_STAGE(PG8_SA(0, 0), cA, voffA); PG8_STAGE(PG8_SA(0, 1), cA + hstep, voffA);
        if (wr == 1) PG8_BAR;
        PG8_WAIT_V(2); PG8_BAR;
        PG8_STAGE(PG8_SB(1, 0), cB + kstep, voffB); PG8_STAGE(PG8_SA(1, 0), cA + kstep, voffA); PG8_STAGE(PG8_SB(1, 1), cB + hstep + kstep, voffB);
        PG8_WAIT_V(6); PG8_BAR;
    } else {
        PG8_STAGE(PG8_SB(0, 0), cB, voffB); PG8_STAGE(PG8_SA(0, 0), cA, voffA); PG8_STAGE(PG8_SB(0, 1), cB + hstep, voffB); PG8_STAGE(PG8_SA(0, 1), cA + hstep, voffA);
        if (wr == 1) PG8_BAR;
        PG8_WAIT_V(4); PG8_BAR;
        PG8_STAGE(PG8_SB(1, 0), cB + kstep, voffB); PG8_STAGE(PG8_SA(1, 0), cA + kstep, voffA); PG8_STAGE(PG8_SB(1, 1), cB + hstep + kstep, voffB);
        PG8_WAIT_V(6); PG8_BAR;
    }
    for (;;) {
        const bool has_next = S.next(ui + 1, nxt);
        const char* nA = has_next ? (const char*)g.A + (size_t)nxt.pm * tstep : cA; const char* nB = has_next ? (const char*)g.Bt + (size_t)nxt.pn * tstep : cB;
        for (int t = 0; t < nt; t += 2) {
            const bool last = (t == nt - 2);
            const char* a1 = cA + (size_t)(t + 1) * kstep;
            const char* a2 = last ? nA : cA + (size_t)(t + 2) * kstep; const char* b2 = last ? nB : cB + (size_t)(t + 2) * kstep;
            const char* a3 = a2 + kstep; const char* b3 = b2 + kstep;
            if (last && has_next) S.a_ready(nxt);
            if constexpr (SP2) {
            PG8_LDB(B0, 0, 0); PG8_LDB(B1, 0, 1); PG8_SCHED; PG8_LDA(At, 0, 0); PG8_STAGE(PG8_SA(1, 1), a1 + hstep, voffA);
            PG8_WAIT_V(8); PG8_WAIT_L(0); PG8_BAR; PG8_MMA(0, 0, At, B0); PG8_MMA(0, 1, At, B1); PG8_BAR; PG8_SCHED;
            PG8_LDA(At, 0, 1); PG8_STAGE(PG8_SB(0, 0), b2, voffB); PG8_STAGE(PG8_SB(0, 1), b2 + hstep, voffB); PG8_STAGE(PG8_SA(0, 0), a2, voffA);
            PG8_WAIT_V(8); PG8_WAIT_L(0); PG8_BAR; PG8_MMA(1, 0, At, B0); PG8_MMA(1, 1, At, B1); PG8_BAR; PG8_SCHED;
            PG8_LDB(B0, 1, 0); PG8_LDB(B1, 1, 1); PG8_SCHED; PG8_LDA(At, 1, 0); PG8_STAGE(PG8_SA(0, 1), a2 + hstep, voffA);
            PG8_WAIT_V(8); PG8_WAIT_L(0); PG8_BAR; PG8_MMA(0, 0, At, B0); PG8_MMA(0, 1, At, B1); PG8_BAR; PG8_SCHED;
            PG8_LDA(At, 1, 1); PG8_STAGE(PG8_SB(1, 0), b3, voffB); PG8_STAGE(PG8_SB(1, 1), b3 + hstep, voffB); PG8_STAGE(PG8_SA(1, 0), a3, voffA);
            PG8_WAIT_V(8); PG8_WAIT_L(0); PG8_BAR; PG8_MMA(1, 0, At, B0); PG8_MMA(1, 1, At, B1); PG8_BAR; PG8_SCHED;
            } else {
            PG8_LDB(B0, 0, 0); PG8_SCHED; PG8_LDA(At, 0, 0); PG8_STAGE(PG8_SA(1, 1), a1 + hstep, voffA);
            PG8_WAIT_L(8); PG8_BAR; PG8_WAIT_L(0); PG8_MMA(0, 0, At, B0); PG8_BAR; PG8_SCHED;
            PG8_LDB(B1, 0, 1); PG8_STAGE(PG8_SB(0, 0), b2, voffB);
            PG8_BAR; PG8_WAIT_L(0); PG8_MMA(0, 1, At, B1); PG8_BAR;
            PG8_LDA(At, 0, 1); PG8_STAGE(PG8_SA(0, 0), a2, voffA);
            PG8_BAR; PG8_WAIT_L(0); PG8_MMA(1, 0, At, B0); PG8_BAR; PG8_SCHED;
            PG8_STAGE(PG8_SB(0, 1), b2 + hstep, voffB);
            PG8_WAIT_V(6); PG8_BAR; PG8_MMA(1, 1, At, B1); PG8_BAR;
            PG8_LDB(B0, 1, 0); PG8_SCHED; PG8_LDA(At, 1, 0); PG8_STAGE(PG8_SA(0, 1), a2 + hstep, voffA);
            PG8_WAIT_L(8); PG8_BAR; PG8_WAIT_L(0); PG8_MMA(0, 0, At, B0); PG8_BAR; PG8_SCHED;
            PG8_LDB(B1, 1, 1); PG8_STAGE(PG8_SB(1, 0), b3, voffB);
            PG8_BAR; PG8_WAIT_L(0); PG8_MMA(0, 1, At, B1); PG8_BAR;
            PG8_LDA(At, 1, 1); PG8_STAGE(PG8_SA(1, 0), a3, voffA);
            PG8_BAR; PG8_WAIT_L(0); PG8_MMA(1, 0, At, B0); PG8_BAR; PG8_SCHED;
            PG8_STAGE(PG8_SB(1, 1), b3 + hstep, voffB);
            PG8_WAIT_V(6); PG8_BAR; PG8_MMA(1, 1, At, B1); PG8_BAR;
            }
        }
        if constexpr (ALIGN_EPI) { if (wr == 0) PG8_BAR; }
        if constexpr (!Epi::AFTER_DRAIN) { unsigned z_ = 0u; asm volatile("" : "+v"(z_)); const int l2_ = (int)__builtin_amdgcn_mbcnt_hi(~0u, __builtin_amdgcn_mbcnt_lo(~0u, z_)); E(acc, cur, wr, wc, l2_ & 15, l2_ >> 4); S.done(cur); }
        if (!has_next) break;
#pragma unroll
        for (int a = 0; a < 2; ++a)
#pragma unroll
            for (int b = 0; b < 2; ++b)
#pragma unroll
                for (int m = 0; m < 4; ++m)
#pragma unroll
                    for (int n = 0; n < 2; ++n) acc[a][b][m][n] = (f32x4){0.f, 0.f, 0.f, 0.f};
        cur = nxt; cA = nA; cB = nB; ++ui;
        if constexpr (ALIGN_EPI) { if (wr == 1) PG8_BAR; }
    }
    PG8_WAIT_V(0);
    if constexpr (!ALIGN_EPI) { if (wr == 0) PG8_BAR; }
    PG8_BAR;
    if constexpr (Epi::AFTER_DRAIN) { E.fused(acc, cur, wr, wc, fr, fq, lds, wid, lane); S.done(cur); }
#undef PG8_SA
#undef PG8_SB
#undef PG8_STAGE
#undef PG8_LDA
#undef PG8_LDB
#undef PG8_MMA
#undef PG8_WAIT_V
#undef PG8_WAIT_L
#undef PG8_BAR
#undef PG8_SCHED
}
}
#ifndef LAS
#define LAS __attribute__((address_space(3)))
#endif
#define XB_TMO      128
#define XB_XCNT(j)  (256  + 64 * (j))
#define XB_XSUB(j)  (1280 + 64 * (j))
#define XB_XGEN(j)  (2304 + 64 * (j))
#define XB_TOP      3328
#define XB_TOPGEN   3392
#define XCD_BAR_WORDS 3456
#define XB_SPIN_CAP (1u << 24)

__device__ __forceinline__ unsigned xb_ld(unsigned* p)              { return __hip_atomic_load(p, __ATOMIC_RELAXED, __HIP_MEMORY_SCOPE_AGENT); }
__device__ __forceinline__ unsigned xb_add(unsigned* p, unsigned v) { return __hip_atomic_fetch_add(p, v, __ATOMIC_RELAXED, __HIP_MEMORY_SCOPE_AGENT); }
__device__ __forceinline__ unsigned xb_xcc_id() { return (unsigned)__builtin_amdgcn_s_getreg((3 << 11) | 20) & 0xFu; }
#define XB_SPIN(cond, bar) do { unsigned _sp = 0; while (cond) { __builtin_amdgcn_s_sleep(1); \
    if ((++_sp & 255u) == 0u) { if (xb_ld(&(bar)[XB_TMO])) break; if (_sp > XB_SPIN_CAP) { atomicAdd(&(bar)[XB_TMO], 1u); break; } } } } while (0)

struct XcdBarrier {
    int w;
    unsigned* bar; unsigned x;
    volatile LAS unsigned* st;
};

__device__ __forceinline__ bool xb_thread0(int w) { unsigned z = 0u; asm volatile("" : "+v"(z), "+s"(w)); return w == 0 && __builtin_amdgcn_mbcnt_hi(~0u, __builtin_amdgcn_mbcnt_lo(~0u, z)) == 0u; }
__device__ __forceinline__ XcdBarrier xcd_barrier_post(unsigned* bar, volatile LAS unsigned* st, int w) {
    XcdBarrier b; b.w = w; b.bar = bar; b.x = xb_xcc_id(); b.st = st;
    if (xb_thread0(w)) (void)xb_add(&bar[XB_XCNT(b.x)], 1u);
    return b;
}
__device__ __forceinline__ void xcd_barrier_complete(unsigned* bar, unsigned x, unsigned& nloc, unsigned& nx) {
    const unsigned G = gridDim.x * gridDim.y * gridDim.z;
    unsigned sum, cnt, mine, sp = 0u;
    for (;;) {
        sum = 0u; cnt = 0u; mine = 0u;
#pragma unroll
        for (unsigned j = 0; j < 16; ++j) { const unsigned c = xb_ld(&bar[XB_XCNT(j)]); sum += c; cnt += (c > 0u) ? 1u : 0u; mine = (j == x) ? c : mine; }
        if (sum == G) break;
        __builtin_amdgcn_s_sleep(1);
        if ((++sp & 255u) == 0u) { if (xb_ld(&bar[XB_TMO])) break; if (sp > XB_SPIN_CAP) { atomicAdd(&bar[XB_TMO], 1u); break; } }
    }
    nloc = mine > 0u ? mine : 1u; nx = cnt > 0u ? cnt : 1u;
}

__device__ __forceinline__ void xcd_barrier(const XcdBarrier& b) {
    asm volatile("s_waitcnt vmcnt(0)" ::: "memory");
    __syncthreads();
    if (xb_thread0(b.w)) {
        unsigned* bar = b.bar;
        __builtin_amdgcn_s_waitcnt(0);
        unsigned nloc = b.st[0], nx = b.st[1];
        if (nloc == 0u) { xcd_barrier_complete(bar, b.x, nloc, nx); b.st[0] = nloc; b.st[1] = nx; }
        const unsigned old = xb_add(&bar[XB_XSUB(b.x)], 1u);
        const unsigned gen = old / nloc;
        if (old + 1u == (gen + 1u) * nloc) {
            __builtin_amdgcn_fence(__ATOMIC_RELEASE, "agent");
            asm volatile("s_waitcnt vmcnt(0)" ::: "memory");
            const unsigned og = xb_add(&bar[XB_TOP], 1u);
            const unsigned tg = og / nx;
            if (og + 1u == (tg + 1u) * nx) xb_add(&bar[XB_TOPGEN], 1u);
            else XB_SPIN(xb_ld(&bar[XB_TOPGEN]) == tg, bar);
            __builtin_amdgcn_fence(__ATOMIC_ACQUIRE, "agent");
            xb_add(&bar[XB_XGEN(b.x)], 1u);
            asm volatile("s_waitcnt vmcnt(0)" ::: "memory");
        } else {
            XB_SPIN(xb_ld(&bar[XB_XGEN(b.x)]) == gen, bar);
            __builtin_amdgcn_fence(__ATOMIC_ACQUIRE, "agent");
            asm volatile("s_waitcnt vmcnt(0)" ::: "memory");
        }
    }
    __syncthreads();
}
#define GAS __attribute__((address_space(1)))
constexpr int NWAVES = 8, NTHREADS = NWAVES * 64;
constexpr size_t MiB = 1u << 20;
constexpr size_t WS_CTL = 0, CTL_ZERO_BYTES = 1 * MiB;
constexpr size_t WS_SMALL = 1 * MiB, WS_TOKINFO = 2 * MiB, WS_LIST = 3 * MiB;
constexpr size_t WS_WIN = 4 * MiB, WS_WOUT = 34 * MiB, WS_WFGU = 42 * MiB, WS_WFD = 64 * MiB, WS_WMGU = 75 * MiB, WS_WMD = 187 * MiB;
constexpr size_t WS_H = 243 * MiB, WS_A = 315 * MiB, WS_OC = 351 * MiB, WS_Y = 387 * MiB, WS_AM = 463 * MiB, WS_BIG = 539 * MiB;
constexpr size_t WS_P = WS_BIG, WS_QM = 674 * MiB, WS_KM = WS_QM + 14155776, WS_VM = WS_KM + 14155776, WS_QS = 710 * MiB, WS_KS = WS_QS + 9437184, WS_VS = WS_KS + 4718592;
constexpr size_t WS_HF = 728 * MiB, WS_HO = 764 * MiB, WS_RQ = 800 * MiB, WS_RK = 809 * MiB, WS_RO = 818 * MiB, WS_HQC = 854 * MiB, WS_HU = 890 * MiB, WS_HDK = 922 * MiB, WS_RQC = 923 * MiB, WS_RU = 941 * MiB, WS_TAB = 957 * MiB, WS_END = 959 * MiB;
constexpr size_t WS_ACT = WS_BIG;
constexpr int MAXTILES = 152;
static_assert(WS_P + (size_t)NTOK * NP * 2 <= WS_QM && WS_VM + (size_t)NB * 4 * TK * 64 * 2 <= WS_QS && WS_VS + 4718592 <= WS_HF, "ws map 1");
static_assert(WS_HQC + (size_t)2 * NTOK * 256 * 4 <= WS_HU && WS_HU + (size_t)2 * NB * 4 * NCH * 4096 * 4 <= WS_HDK && WS_RQC + (size_t)2 * NTOK * 128 * 4 <= WS_RU && WS_RU + (size_t)2 * NB * 4 * NCH * 2048 * 4 <= WS_END, "ws map 3");
static_assert(WS_ACT + (size_t)MAXTILES * 256 * DFE * 2 <= WS_END && (size_t)MAXTILES * 256 * D * 2 <= 76 * MiB, "ws map 2");
constexpr int SM_MOD = 0;
constexpr int SM_LOGLB = 4 * 9 * 6144, SM_LOG1M = SM_LOGLB + 4 * 512, SM_LGAM = SM_LOG1M + 4 * 512, SM_META = SM_LGAM + 64, SM_ULIST = SM_META + 32;
constexpr int ULIST_GU = 0, ULIST_D = MAXTILES * 28;
static_assert((SM_ULIST + 2 * MAXTILES * 32) * 4 <= (int)MiB, "small region");
constexpr int CW_BAR = 4096, CW_CNT = 8192;
constexpr int LDS_BYTES = 147456, MISC_OFF = 131072 + 320;

#define LAS __attribute__((address_space(3)))
typedef float f32x4 __attribute__((ext_vector_type(4)));
typedef unsigned v4u __attribute__((ext_vector_type(4)));
typedef unsigned v2u __attribute__((ext_vector_type(2)));
#define LDS_WAIT() asm volatile("s_waitcnt lgkmcnt(0)" ::: "memory")

struct Args { const float* in[28]; float* out; unsigned char* ws; int ph_lo, ph_hi; };
typedef __attribute__((address_space(4))) const unsigned long long ka_u64;
__device__ __forceinline__ const float* IN(int i) { ka_u64* ka = (ka_u64*)__builtin_amdgcn_kernarg_segment_ptr(); asm volatile("" : "+s"(ka)); return (const float*)(GAS const float*)ka[i]; }
__device__ __forceinline__ float* OUTP() { ka_u64* ka = (ka_u64*)__builtin_amdgcn_kernarg_segment_ptr(); asm volatile("" : "+s"(ka)); return (float*)(GAS float*)ka[28]; }
__device__ __forceinline__ unsigned char* WSBASE() { ka_u64* ka = (ka_u64*)__builtin_amdgcn_kernarg_segment_ptr(); asm volatile("" : "+s"(ka)); return (unsigned char*)(GAS unsigned char*)ka[29]; }
struct Frame {
    LAS unsigned char* lds;
    int tid, lane, wave, gtid, NT, gw, NGW;
    __device__ __forceinline__ unsigned char* base() const { return WSBASE(); }
};
#define WSP(T, off) ((T*)(ws + (off)))
#define F_ctl WSP(unsigned, WS_CTL)
#define F_sm WSP(float, WS_SMALL)
#define F_tokinfo WSP(int, WS_TOKINFO)
#define F_list WSP(int, WS_LIST)
#define F_H WSP(float, WS_H)
#define F_A WSP(bf16, WS_A)
#define F_OC WSP(bf16, WS_OC)
#define F_Y WSP(bf16, WS_Y)
#define F_AM WSP(bf16, WS_AM)
#define F_P WSP(bf16, WS_P)
#define F_ACT WSP(bf16, WS_ACT)
#define F_WIN WSP(bf16, WS_WIN)
#define F_WOUT WSP(bf16, WS_WOUT)
#define F_WFGU WSP(bf16, WS_WFGU)
#define F_WFD WSP(bf16, WS_WFD)
#define F_WMGU WSP(bf16, WS_WMGU)
#define F_WMD WSP(bf16, WS_WMD)
__device__ __forceinline__ float wave_sum(float v, int  ) {
    int x = __float_as_int(v);
    v += __int_as_float(__builtin_amdgcn_update_dpp(0, x, 0xB1, 0xF, 0xF, true)); x = __float_as_int(v);
    v += __int_as_float(__builtin_amdgcn_update_dpp(0, x, 0x4E, 0xF, 0xF, true)); x = __float_as_int(v);
    v += __int_as_float(__builtin_amdgcn_update_dpp(0, x, 0x141, 0xF, 0xF, true)); x = __float_as_int(v);
    v += __int_as_float(__builtin_amdgcn_update_dpp(0, x, 0x140, 0xF, 0xF, true)); x = __float_as_int(v);
    v += __int_as_float(__builtin_amdgcn_update_dpp(0, x, 0x142, 0xA, 0xF, false)); x = __float_as_int(v);
    v += __int_as_float(__builtin_amdgcn_update_dpp(0, x, 0x143, 0xC, 0xF, false));
    return __int_as_float(__builtin_amdgcn_readlane(__float_as_int(v), 63));
}
__device__ __forceinline__ unsigned pk2(float lo, float hi) { return (unsigned)f2bf(lo) | ((unsigned)f2bf(hi) << 16); }

constexpr int TAB_MLA = 0, TAB_SWA = NL * 16 * 2, TAB_RET = TAB_SWA + NL * 32 * 2, TAB_FLOATS = TAB_RET + TK * 16 * 2;
__device__ __forceinline__ void build_tables(float* tab, int gtid, int NT) {
    for (int it = gtid; it < NL * 16; it += NT) { const int t = it >> 4, j = it & 15; const float inv = powf(10000.0f, -(float)(j & 7) / 8.0f), ang = (float)(j < 8 ? t / GRIDW : t % GRIDW) * inv;
        tab[TAB_MLA + 2 * it] = cosf(ang); tab[TAB_MLA + 2 * it + 1] = sinf(ang); }
    for (int it = gtid; it < NL * 32; it += NT) { const int t = it >> 5, j = it & 31; const float inv = powf(10000.0f, -(float)(j & 15) / 16.0f), ang = (float)(j < 16 ? t / GRIDW : t % GRIDW) * inv;
        tab[TAB_SWA + 2 * it] = cosf(ang); tab[TAB_SWA + 2 * it + 1] = sinf(ang); }
    for (int it = gtid; it < TK * 16; it += NT) { const int tq = it >> 4, j = it & 15; const float inv = powf(10000.0f, -(float)j / 16.0f), ang = (float)tq * inv;
        tab[TAB_RET + 2 * it] = cosf(ang); tab[TAB_RET + 2 * it + 1] = sinf(ang); }
}
static_assert((size_t)TAB_FLOATS * 4 <= 2 * MiB, "rope tables");
template <class SrcFn> __device__ __forceinline__ void transpose_item(const SrcFn& src, int K, int nblk, bf16* WT, LAS float* scr, int item, int lane) {
    const int kb = item / nblk, nb = item % nblk, k0 = 64 * kb, n0 = 32 * nb;
    float tv[32];
#pragma unroll
    for (int i = 0; i < 32; ++i) tv[i] = src(k0 + 2 * i + (lane >> 5), n0 + (lane & 31));
#pragma unroll
    for (int i = 0; i < 32; ++i) scr[(2 * i + (lane >> 5)) * 33 + (lane & 31)] = tv[i];
    LDS_WAIT(); asm volatile("" ::: "memory");
    const int c = lane & 7;
#pragma unroll
    for (int j = 0; j < 4; ++j) { const int n = (lane >> 3) + 8 * j; const LAS float* s = scr + (8 * c) * 33 + n;
        v4u o; o.x = pk2(s[0 * 33], s[1 * 33]); o.y = pk2(s[2 * 33], s[3 * 33]); o.z = pk2(s[4 * 33], s[5 * 33]); o.w = pk2(s[6 * 33], s[7 * 33]);
        *(v4u*)(WT + (size_t)(n0 + n) * K + k0 + 8 * c) = o; }
    LDS_WAIT(); asm volatile("" ::: "memory");
}
struct SrcPlain { const float* W; int N; __device__ __forceinline__ float operator()(int k, int n) const { return W[(size_t)k * N + n]; } };
struct SrcGU { const float* Wg; long du; int NF; __device__ __forceinline__ float operator()(int k, int c) const { const int j = c >> 3, w = c & 7; return Wg[(w < 4 ? 0l : du) + (long)k * NF + 4 * j + (w & 3)]; } };

__device__ __forceinline__ void convert_moe(Frame& F, int li) {
    unsigned char* ws = F.base();
    LAS float* scr = (LAS float*)(F.lds + 40960 + F.wave * 8704);
    constexpr int I_GU = 16 * 224, I_D = 56 * 32;
    for (int it = F.gw; it < 8 * (I_GU + I_D); it += F.NGW) {
        const int e = it / (I_GU + I_D); int r = it % (I_GU + I_D);
        if (r < I_GU) { SrcGU s{IN(24) + ((size_t)li * 8 + e) * D * DFE, (long)(IN(25) - IN(24)), DFE}; transpose_item(s, D, 224, F_WMGU + (size_t)e * 2 * DFE * D, scr, r, F.lane); }
        else { r -= I_GU; SrcPlain s{IN(26) + ((size_t)li * 8 + e) * DFE * D, D}; transpose_item(s, DFE, 32, F_WMD + (size_t)e * D * DFE, scr, r, F.lane); }
    }
}
__device__ __forceinline__ void prologue(Frame& F) {
    unsigned char* ws = F.base();
    LAS float* sil = (LAS float*)F.lds;
    for (int i = F.tid; i < 9 * 1024; i += NTHREADS) { const float cv = i < 8 * 1024 ? IN(1)[i] : IN(3)[i - 8 * 1024]; sil[i] = silu_f(cv); }
    __syncthreads();
    { LAS float* red = (LAS float*)(F.lds + 36864);
      const int jc = F.tid & 63, kg = F.tid >> 6;
      for (int unit = blockIdx.x; unit < DEPTH * 96; unit += gridDim.x) {
          const int l = unit / 96, j0 = (unit % 96) * 64; const float* w = IN(4) + ((size_t)l * D + kg * 128) * 6144 + j0 + jc;
          float acc[9];
#pragma unroll
          for (int b = 0; b < 9; ++b) acc[b] = 0.f;
#pragma unroll 8
          for (int k = 0; k < 128; ++k) { const float wv = w[(size_t)k * 6144];
#pragma unroll
              for (int b = 0; b < 9; ++b) acc[b] += sil[b * 1024 + kg * 128 + k] * wv; }
#pragma unroll
          for (int b = 0; b < 9; ++b) red[(kg * 9 + b) * 64 + jc] = acc[b];
          __syncthreads();
          for (int o = F.tid; o < 9 * 64; o += NTHREADS) { float s = IN(5)[l * 6144 + j0 + (o & 63)];
#pragma unroll
              for (int g = 0; g < 8; ++g) s += red[(g * 9 + (o >> 6)) * 64 + (o & 63)];
              F_sm[SM_MOD + ((size_t)l * 9 + (o >> 6)) * 6144 + j0 + (o & 63)] = s; }
          __syncthreads();
      } }
    for (int it = F.gtid; it < 512; it += F.NT) {
        float lg[DEPTH], mx = -1e30f, s = 0.f;
#pragma unroll
        for (int l = 0; l < DEPTH; ++l) { lg[l] = IN(14)[l * 512 + it]; mx = fmaxf(mx, lg[l]); }
#pragma unroll
        for (int l = 0; l < DEPTH; ++l) { lg[l] = expf(lg[l] - mx); s += lg[l]; }
        float cum = 0.f; const float p0 = lg[0] / s;
#pragma unroll
        for (int l = 0; l < DEPTH; ++l) { cum += lg[l] / s; const float lb = cum - p0; F_sm[SM_LOGLB + l * 512 + it] = logf(fmaxf(lb, 1e-30f)); F_sm[SM_LOG1M + l * 512 + it] = log1pf(-lb); }
    }
    for (int it = F.gtid; it < DEPTH * 8; it += F.NT) F_sm[SM_LGAM + it] = log_sigmoid_f(IN(17)[it]);
    build_tables(WSP(float, WS_TAB), F.gtid, F.NT);
    LAS float* scr = (LAS float*)(F.lds + 40960 + F.wave * 8704);
    constexpr int I_IN = 16 * 91, I_OUT = 16 * 32, I_FGU = 16 * 176, I_FD = 44 * 32;
    constexpr int N_IN = DEPTH * I_IN, N_OUT = DEPTH * I_OUT, N_FGU = 2 * I_FGU, N_FD = 2 * I_FD;
    for (int it = F.gw; it < N_IN + N_OUT + N_FGU + N_FD; it += F.NGW) {
        int r = it;
        if (r < N_IN) { const int l = r / I_IN; SrcPlain s{IN(8) + (size_t)l * D * DIN, DIN}; transpose_item(s, D, 91, F_WIN + (size_t)l * NP * D, scr, r % I_IN, F.lane); continue; } r -= N_IN;
        if (r < N_OUT) { const int l = r / I_OUT; SrcPlain s{IN(9) + (size_t)l * D * D, D}; transpose_item(s, D, 32, F_WOUT + (size_t)l * D * D, scr, r % I_OUT, F.lane); continue; } r -= N_OUT;
        if (r < N_FGU) { const int l = r / I_FGU; SrcGU s{IN(20) + (size_t)l * D * DFF, (long)(IN(21) - IN(20)), DFF}; transpose_item(s, D, 176, F_WFGU + (size_t)l * 2 * DFF * D, scr, r % I_FGU, F.lane); continue; } r -= N_FGU;
        { const int l = r / I_FD; SrcPlain s{IN(22) + (size_t)l * DFF * D, D}; transpose_item(s, DFF, 32, F_WFD + (size_t)l * D * DFF, scr, r % I_FD, F.lane); }
    }
    convert_moe(F, 0);
    for (int it = F.gtid; it < DEPTH * (D / 8) * 928; it += F.NT) {
        const int n = it % 928, kg = (it / 928) % (D / 8), l = it / (928 * (D / 8));
        const float* wi = IN(8) + ((size_t)l * D + 8 * kg) * DIN; float acc[8];
#pragma unroll
        for (int r = 0; r < 8; ++r) acc[r] = 0.f;
        if (n < 384) { const float* g = IN(10) + l * 192; const float* wu = IN(11) + (size_t)l * 192 * 384 + n;
            for (int j = 0; j < 192; ++j) { const float w = g[j] * wu[(size_t)j * 384];
#pragma unroll
                for (int r = 0; r < 8; ++r) acc[r] += wi[(size_t)r * DIN + j] * w; } }
        else if (n < 896) { const float* g = IN(12) + l * 128; const float* wu = IN(13) + (size_t)l * 128 * 512 + (n - 384);
            for (int j = 0; j < 128; ++j) { const float w = g[j] * wu[(size_t)j * 512];
#pragma unroll
                for (int r = 0; r < 8; ++r) acc[r] += wi[(size_t)r * DIN + 192 + j] * w; } }
        v4u o; o.x = pk2(acc[0], acc[1]); o.y = pk2(acc[2], acc[3]); o.z = pk2(acc[4], acc[5]); o.w = pk2(acc[6], acc[7]);
        *(v4u*)(F_WIN + ((size_t)l * NP + DIN + n) * D + 8 * kg) = o;
    }
}

typedef short bf16x8s __attribute__((ext_vector_type(8)));
typedef float f32x16 __attribute__((ext_vector_type(16)));
__device__ __forceinline__ int crow(int r, int hi) { return (r & 3) + 8 * (r >> 2) + 4 * hi; }
__device__ __forceinline__ float xlane32(float v, int lane) { return __int_as_float(__builtin_amdgcn_ds_bpermute((lane ^ 32) << 2, __float_as_int(v))); }
__device__ __forceinline__ unsigned cvtpk(float lo, float hi) { unsigned r; asm volatile("v_cvt_pk_bf16_f32 %0, %1, %2" : "=v"(r) : "v"(lo), "v"(hi)); return r; }

template <int DK, bool SWA>
__device__ __forceinline__ void attn_unit(LAS unsigned char* lds, const bf16* Qg, const bf16* Kg, const bf16* Vtg, bf16* OCp, int b, int hcol, int tq0,
                                          int t0a, int t1a, int t0b, int t1b, float sink2, int tid) {
    constexpr int KS = DK * 2 + 16, VS = 136, KT_BYTES = 64 * KS, STAGE = KT_BYTES + 64 * VS, KP = DK / 8, NKP = 64 * KP, NS = DK / 16;
    const int lane = tid & 63, wave = __builtin_amdgcn_readfirstlane(tid >> 6), q = lane & 31, hi = lane >> 5;
    LAS float* wsf = (LAS float*)(lds + 2 * STAGE) + wave * 64;
    const int tq = tq0 + wave * 32 + q;
    bf16x8s qf[NS];
#pragma unroll
    for (int s = 0; s < NS; ++s) qf[s] = *(const bf16x8s*)(Qg + (size_t)tq * DK + 16 * s + 8 * hi);
    f32x16 o0, o1;
#pragma unroll
    for (int r = 0; r < 16; ++r) { o0[r] = 0.f; o1[r] = 0.f; }
    float m = SWA ? sink2 : -1e30f, l = (SWA && hi == 0) ? 1.0f : 0.f;
    const int na = t1a - t0a, nt = na + (t1b - t0b);
    const int w0 = tq0 - NC + wave * 32;
    v4u kr0, kr1 = (v4u){0u, 0u, 0u, 0u}, vr;
    { const int t = na > 0 ? t0a : t0b; const v4u* kg = (const v4u*)(Kg + (size_t)t * 64 * DK); kr0 = kg[tid]; if (NKP > 512) { if (tid < NKP - 512) kr1 = kg[512 + tid]; }
      vr = *(const v4u*)(Vtg + (size_t)(tid >> 3) * TK + t * 64 + (tid & 7) * 8); }
    { LAS unsigned char* kb = lds; *(LAS v4u*)(kb + (tid / KP) * KS + (tid % KP) * 16) = kr0;
      if (NKP > 512) { if (tid < NKP - 512) { const int p = 512 + tid; *(LAS v4u*)(kb + (p / KP) * KS + (p % KP) * 16) = kr1; } }
      LAS unsigned char* vb = kb + KT_BYTES + (tid >> 3) * VS + (tid & 7) * 16; *(LAS v2u*)vb = (v2u){vr.x, vr.y}; *(LAS v2u*)(vb + 8) = (v2u){vr.z, vr.w}; }
    __syncthreads();
    for (int i = 0; i < nt; ++i) {
        const int t = i < na ? t0a + i : t0b + (i - na);
        if (i + 1 < nt) { const int tn = (i + 1) < na ? t0a + i + 1 : t0b + (i + 1 - na); const v4u* kg = (const v4u*)(Kg + (size_t)tn * 64 * DK); kr0 = kg[tid]; if (NKP > 512) { if (tid < NKP - 512) kr1 = kg[512 + tid]; }
            vr = *(const v4u*)(Vtg + (size_t)(tid >> 3) * TK + tn * 64 + (tid & 7) * 8); }
        LAS unsigned char* kb = lds + (i & 1) * STAGE; LAS unsigned char* vbs = kb + KT_BYTES;
        const int sb = 64 * t - NC;
        const bool band = SWA && t >= 4;
        const bool skip = band && (sb + 63 < w0 - 128 || sb > w0 + 31 + 128);
        if (!skip) {
            f32x16 p0, p1;
#pragma unroll
            for (int r = 0; r < 16; ++r) { p0[r] = 0.f; p1[r] = 0.f; }
#pragma unroll
            for (int s = 0; s < NS; ++s) {
                const bf16x8s k0 = *(const LAS bf16x8s*)(kb + q * KS + (16 * s + 8 * hi) * 2);
                const bf16x8s k1 = *(const LAS bf16x8s*)(kb + (32 + q) * KS + (16 * s + 8 * hi) * 2);
                p0 = __builtin_amdgcn_mfma_f32_32x32x16_bf16(k0, qf[s], p0, 0, 0, 0);
                p1 = __builtin_amdgcn_mfma_f32_32x32x16_bf16(k1, qf[s], p1, 0, 0, 0);
            }
            if (band) { const int tl = tq - NC;
#pragma unroll
                for (int r = 0; r < 16; ++r) { const int d0 = tl - (sb + crow(r, hi)), d1 = d0 - 32;
                    if (d0 > 128 || d0 < -128) p0[r] = -1e30f; if (d1 > 128 || d1 < -128) p1[r] = -1e30f; } }
            float mx = fmaxf(p0[0], p1[0]);
#pragma unroll
            for (int r = 1; r < 16; ++r) mx = fmaxf(mx, fmaxf(p0[r], p1[r]));
            mx = fmaxf(mx, xlane32(mx, lane));
            const float mn = fmaxf(m, mx), alpha = __builtin_amdgcn_exp2f(m - mn); m = mn;
            float ps = 0.f;
#pragma unroll
            for (int r = 0; r < 16; ++r) { p0[r] = __builtin_amdgcn_exp2f(p0[r] - mn); p1[r] = __builtin_amdgcn_exp2f(p1[r] - mn); ps += p0[r] + p1[r]; }
            l = l * alpha + ps;
            if (hi == 0) wsf[q] = alpha;
            bf16x8s pa[4];
            { v4u w;
              w.x = cvtpk(p0[0], p0[1]); w.y = cvtpk(p0[2], p0[3]); w.z = cvtpk(p0[4], p0[5]); w.w = cvtpk(p0[6], p0[7]); pa[0] = __builtin_bit_cast(bf16x8s, w);
              w.x = cvtpk(p0[8], p0[9]); w.y = cvtpk(p0[10], p0[11]); w.z = cvtpk(p0[12], p0[13]); w.w = cvtpk(p0[14], p0[15]); pa[1] = __builtin_bit_cast(bf16x8s, w);
              w.x = cvtpk(p1[0], p1[1]); w.y = cvtpk(p1[2], p1[3]); w.z = cvtpk(p1[4], p1[5]); w.w = cvtpk(p1[6], p1[7]); pa[2] = __builtin_bit_cast(bf16x8s, w);
              w.x = cvtpk(p1[8], p1[9]); w.y = cvtpk(p1[10], p1[11]); w.z = cvtpk(p1[12], p1[13]); w.w = cvtpk(p1[14], p1[15]); pa[3] = __builtin_bit_cast(bf16x8s, w); }
            asm volatile("s_waitcnt lgkmcnt(0)" ::: "memory");
#pragma unroll
            for (int r = 0; r < 16; ++r) { const float a = wsf[crow(r, hi)]; o0[r] *= a; o1[r] *= a; }
#pragma unroll
            for (int s4 = 0; s4 < 4; ++s4)
#pragma unroll
                for (int nb = 0; nb < 2; ++nb) {
                    const LAS unsigned char* vp = vbs + (32 * nb + q) * VS + (16 * s4 + 4 * hi) * 2;
                    const v2u lo = *(const LAS v2u*)vp, hh = *(const LAS v2u*)(vp + 16);
                    const bf16x8s vf = __builtin_bit_cast(bf16x8s, ((v4u){lo.x, lo.y, hh.x, hh.y}));
                    if (nb == 0) o0 = __builtin_amdgcn_mfma_f32_32x32x16_bf16(pa[s4], vf, o0, 0, 0, 0); else o1 = __builtin_amdgcn_mfma_f32_32x32x16_bf16(pa[s4], vf, o1, 0, 0, 0);
                }
        }
        if (i + 1 < nt) { LAS unsigned char* kn = lds + ((i + 1) & 1) * STAGE; *(LAS v4u*)(kn + (tid / KP) * KS + (tid % KP) * 16) = kr0;
            if (NKP > 512) { if (tid < NKP - 512) { const int p = 512 + tid; *(LAS v4u*)(kn + (p / KP) * KS + (p % KP) * 16) = kr1; } }
            LAS unsigned char* vb = kn + KT_BYTES + (tid >> 3) * VS + (tid & 7) * 16; *(LAS v2u*)vb = (v2u){vr.x, vr.y}; *(LAS v2u*)(vb + 8) = (v2u){vr.z, vr.w}; }
        __syncthreads();
    }
    const float lt = l + xlane32(l, lane);
    if (hi == 0) wsf[q] = 1.0f / lt;
    asm volatile("s_waitcnt lgkmcnt(0)" ::: "memory");
#pragma unroll
    for (int r = 0; r < 16; ++r) { const int qq = crow(r, hi); const float inv = wsf[qq];
        bf16* op = OCp + (size_t)row_of(b, tq0 + wave * 32 + qq) * D + hcol + q;
        op[0] = f2bf(o0[r] * inv); op[32] = f2bf(o1[r] * inv); }
    __syncthreads();
}
__device__ __forceinline__ void attn_phase(LAS unsigned char* lds, const Mix& M, const float* sink, bool with_ctx, int tid) {
    const int nunits = 512 + (with_ctx ? 64 : 0);
    for (int u = blockIdx.x; u < nunits; u += gridDim.x) {
        if (u < 512) {
            const int c = u & 255, bh = (c & 7) + 8 * (c >> 6), qb = (c >> 3) & 7, b = bh >> 2, h = bh & 3, tq0 = NC + 256 * qb;
            if (u < 256) attn_unit<96, false>(lds, M.Qm + (size_t)bh * TK * 96, M.Km + (size_t)bh * TK * 96, M.Vm + (size_t)bh * 64 * TK, M.OC, b, h * 64, tq0, 0, TK / 64, 0, 0, 0.f, tid);
            else { const int slo = 256 * qb - 128 < 0 ? 0 : 256 * qb - 128, shi = 256 * qb + 383 > NL - 1 ? NL - 1 : 256 * qb + 383;
                attn_unit<64, true>(lds, M.Qs + (size_t)bh * TK * 64, M.Ks + (size_t)(b * 2 + (h >> 1)) * TK * 64, M.Vs + (size_t)(b * 2 + (h >> 1)) * 64 * TK, M.OC, b, 512 + h * 64, tq0,
                                    0, NC / 64, (NC + slo) / 64, (NC + shi) / 64 + 1, sink[h] * LOG2E, tid); }
        } else {
            const int c = (u - 512) & 31, b = c >> 2, h = c & 3;
            if (u < 544) attn_unit<96, false>(lds, M.Qm + (size_t)c * TK * 96, M.Km + (size_t)c * TK * 96, M.Vm + (size_t)c * 64 * TK, M.OC, b, h * 64, 0, 0, NC / 64, 0, 0, 0.f, tid);
            else attn_unit<64, true>(lds, M.Qs + (size_t)c * TK * 64, M.Ks + (size_t)(b * 2 + (h >> 1)) * TK * 64, M.Vs + (size_t)(b * 2 + (h >> 1)) * 64 * TK, M.OC, b, 512 + h * 64, 0, 0, NC / 64, 0, 0, sink[h] * LOG2E, tid);
        }
    }
}
__device__ __forceinline__ float wsum(float v, int  ) {
    int x = __float_as_int(v);
    v += __int_as_float(__builtin_amdgcn_update_dpp(0, x, 0xB1, 0xF, 0xF, true)); x = __float_as_int(v);
    v += __int_as_float(__builtin_amdgcn_update_dpp(0, x, 0x4E, 0xF, 0xF, true)); x = __float_as_int(v);
    v += __int_as_float(__builtin_amdgcn_update_dpp(0, x, 0x141, 0xF, 0xF, true)); x = __float_as_int(v);
    v += __int_as_float(__builtin_amdgcn_update_dpp(0, x, 0x140, 0xF, 0xF, true)); x = __float_as_int(v);
    v += __int_as_float(__builtin_amdgcn_update_dpp(0, x, 0x142, 0xA, 0xF, false)); x = __float_as_int(v);
    v += __int_as_float(__builtin_amdgcn_update_dpp(0, x, 0x143, 0xC, 0xF, false));
    return __int_as_float(__builtin_amdgcn_readlane(__float_as_int(v), 63));
}
__device__ __forceinline__ float fma_s(float a, float b, float c) { float d; asm("v_fma_f32 %0, %1, %2, %3" : "=v"(d) : "v"(a), "v"(b), "v"(c)); return d; }
__device__ __forceinline__ float sub_s(float a, float b) { float d; asm("v_sub_f32_e32 %0, %1, %2" : "=v"(d) : "v"(a), "v"(b)); return d; }
__device__ __forceinline__ float bfl(unsigned w) { return __uint_as_float(w << 16); }
__device__ __forceinline__ float bfh(unsigned w) { return __uint_as_float(w & 0xffff0000u); }
struct PrepRegs { v2u ql, kvl; unsigned qe[4], kve[4], qp1, qp2, kp1, kp2, sq1[2], sq2[2], sk1, sk2, hz[8], r1[2], r2[2]; };
__device__ __forceinline__ void prep_load(PrepRegs& R, const bf16* p, int lane) {
    R.ql = (lane < 48) ? *(const v2u*)(p + C_QLAT + 4 * (lane < 48 ? lane : 0)) : (v2u){0u, 0u};
    R.kvl = (lane < 32) ? *(const v2u*)(p + C_KVLAT + 4 * (lane < 32 ? lane : 0)) : (v2u){0u, 0u};
#pragma unroll
    for (int h = 0; h < 4; ++h) { R.qe[h] = p[C_QE + h * 96 + lane]; R.kve[h] = p[C_KVE + h * 128 + lane]; }
    { const int h = lane >> 4, j = lane & 15; R.qp1 = p[C_QE + h * 96 + 64 + j]; R.qp2 = p[C_QE + h * 96 + 80 + j]; R.kp1 = p[C_KPE + j]; R.kp2 = p[C_KPE + 16 + j]; }
#pragma unroll
    for (int i = 0; i < 2; ++i) { const int e = lane + 64 * i, hq = e >> 5, j = e & 31; R.sq1[i] = p[C_SQ + hq * 64 + j]; R.sq2[i] = p[C_SQ + hq * 64 + 32 + j]; }
    { const int kh = lane >> 5, j = lane & 31; R.sk1 = p[C_SK + kh * 64 + j]; R.sk2 = p[C_SK + kh * 64 + 32 + j]; }
#pragma unroll
    for (int i = 0; i < 8; ++i) R.hz[i] = p[((i >> 2) ? C_HZB : C_HZF) + (i & 3) * 64 + lane];
#pragma unroll
    for (int w = 0; w < 2; ++w) { const int hh = lane >> 4, j = lane & 15; R.r1[w] = p[(w ? C_RK : C_RQ) + hh * 32 + j]; R.r2[w] = p[(w ? C_RK : C_RQ) + hh * 32 + 16 + j]; }
}
__device__ __forceinline__ void prep_compute(const Mix& M, const float* tab, const PrepRegs& R, int row, int lane) {
    int b, tq; row_split(row, b, tq); const bool lat = tq >= NC; const int t = lat ? tq - NC : 0;
    float sq, skv;
    { const float a = bfl(R.ql.x), c = bfh(R.ql.x), d = bfl(R.ql.y), e = bfh(R.ql.y); sq = (a * a + c * c) + (d * d + e * e); }
    { const float a = bfl(R.kvl.x), c = bfh(R.kvl.x), d = bfl(R.kvl.y), e = bfh(R.kvl.y); skv = (a * a + c * c) + (d * d + e * e); }
    sq = wsum(sq, lane); skv = wsum(skv, lane);
    const float rq = 1.0f / sqrtf(sq * (1.0f / 192.0f) + NORM_EPS), rkv = 1.0f / sqrtf(skv * (1.0f / 128.0f) + NORM_EPS), qs = rq * 0.10206207261596575f * LOG2E;
#pragma unroll
    for (int h = 0; h < 4; ++h) { const size_t o = ((size_t)(b * 4 + h) * TK + tq) * 96 + lane; M.Qm[o] = f2bf(bf2f((bf16)R.qe[h]) * qs); M.Km[o] = f2bf(bf2f((bf16)R.kve[h]) * rkv); }
    { const int h = lane >> 4, j = lane & 15; float c = 1.f, s = 0.f; if (lat) { c = tab[TAB_MLA + (t * 16 + j) * 2]; s = tab[TAB_MLA + (t * 16 + j) * 2 + 1]; }
      const size_t o = ((size_t)(b * 4 + h) * TK + tq) * 96 + 64 + j;
      const float q1 = bf2f((bf16)R.qp1), q2 = bf2f((bf16)R.qp2); M.Qm[o] = f2bf((q1 * c - q2 * s) * qs); M.Qm[o + 16] = f2bf((q1 * s + q2 * c) * qs);
      const float k1 = bf2f((bf16)R.kp1), k2 = bf2f((bf16)R.kp2); M.Km[o] = f2bf(k1 * c - k2 * s); M.Km[o + 16] = f2bf(k1 * s + k2 * c); }
#pragma unroll
    for (int i = 0; i < 2; ++i) { const int e = lane + 64 * i, hq = e >> 5, j = e & 31; float c = 1.f, s = 0.f; if (lat) { c = tab[TAB_SWA + (t * 32 + j) * 2]; s = tab[TAB_SWA + (t * 32 + j) * 2 + 1]; }
        const float x1 = bf2f((bf16)R.sq1[i]), x2 = bf2f((bf16)R.sq2[i]); bf16* o = M.Qs + ((size_t)(b * 4 + hq) * TK + tq) * 64 + j;
        o[0] = f2bf((x1 * c - x2 * s) * (0.125f * LOG2E)); o[32] = f2bf((x1 * s + x2 * c) * (0.125f * LOG2E)); }
    { const int kh = lane >> 5, j = lane & 31; float c = 1.f, s = 0.f; if (lat) { c = tab[TAB_SWA + (t * 32 + j) * 2]; s = tab[TAB_SWA + (t * 32 + j) * 2 + 1]; }
      const float x1 = bf2f((bf16)R.sk1), x2 = bf2f((bf16)R.sk2); bf16* o = M.Ks + ((size_t)(b * 2 + kh) * TK + tq) * 64 + j;
      o[0] = f2bf(x1 * c - x2 * s); o[32] = f2bf(x1 * s + x2 * c); }
#pragma unroll
    for (int i = 0; i < 8; ++i) { const int d = i >> 2, c = (i & 3) * 64 + lane; const float z = bf2f((bf16)R.hz[i]);
        const float a = M.loglb[d * 256 + c], bb = M.log1mlb[d * 256 + c] + log_sigmoid_f(z), mx = fmaxf(a, bb), lf = mx + log1pf(expf(-fabsf(a - bb)));
        M.HF[((size_t)d * NTOK + row) * 256 + c] = expf(lf); }
#pragma unroll
    for (int w = 0; w < 2; ++w) { const int hh = lane >> 4, j = lane & 15; const float c = tab[TAB_RET + (tq * 16 + j) * 2], s = tab[TAB_RET + (tq * 16 + j) * 2 + 1];
        float* o = (w ? M.RK : M.RQ) + (size_t)row * 128 + hh * 32 + j; const float sc = w ? 1.0f : 0.17677669529663687f;
        const float x1 = bf2f((bf16)R.r1[w]), x2 = bf2f((bf16)R.r2[w]); o[0] = (x1 * c - x2 * s) * sc; o[16] = (x1 * s + x2 * c) * sc; }
}
__device__ __forceinline__ void prep_vt(const Mix& M, int g8, int lane) {
    const int row0 = g8 * 8; int b, tq0; row_split(row0, b, tq0);
    float rkv[8];
#pragma unroll
    for (int r = 0; r < 8; ++r) { float skv = 0.f; if (lane < 32) { const v2u w = *(const v2u*)(M.P + (size_t)(row0 + r) * NP + C_KVLAT + 4 * lane); const float a = bfl(w.x), c = bfh(w.x), d = bfl(w.y), e = bfh(w.y); skv = (a * a + c * c) + (d * d + e * e); }
        skv = wsum(skv, lane); rkv[r] = 1.0f / sqrtf(skv * (1.0f / 128.0f) + NORM_EPS); }
#pragma unroll
    for (int h = 0; h < 4; ++h) { float v[8];
#pragma unroll
        for (int r = 0; r < 8; ++r) v[r] = bf2f(M.P[(size_t)(row0 + r) * NP + C_KVE + h * 128 + 64 + lane]) * rkv[r];
        v4u o; o.x = pk2(v[0], v[1]); o.y = pk2(v[2], v[3]); o.z = pk2(v[4], v[5]); o.w = pk2(v[6], v[7]);
        *(v4u*)(M.Vm + ((size_t)(b * 4 + h) * 64 + lane) * TK + tq0) = o; }
#pragma unroll
    for (int kh = 0; kh < 2; ++kh) { unsigned short v[8];
#pragma unroll
        for (int r = 0; r < 8; ++r) v[r] = M.P[(size_t)(row0 + r) * NP + C_SV + kh * 64 + lane];
        v4u o; o.x = (unsigned)v[0] | ((unsigned)v[1] << 16); o.y = (unsigned)v[2] | ((unsigned)v[3] << 16); o.z = (unsigned)v[4] | ((unsigned)v[5] << 16); o.w = (unsigned)v[6] | ((unsigned)v[7] << 16);
        *(v4u*)(M.Vs + ((size_t)(b * 2 + kh) * 64 + lane) * TK + tq0) = o; }
}
constexpr int SBT = 12, NSB = CH / SBT;
__device__ __forceinline__ int scan_row(int b, int dir, int pos) { return row_of(b, dir_tq(dir, pos)); }
__device__ __forceinline__ void scan_local_wave(const Mix& M, LAS float* wl  , int unit, int lane) {
    const int c = unit % NCH, seq = unit / NCH, h = seq & 3, b = (seq >> 2) % NB, dir = seq / (4 * NB);
    const float g = expf(M.log_gamma[dir * 4 + h]);
    float S[64], R[32];
#pragma unroll
    for (int k = 0; k < 64; ++k) S[k] = 0.f;
#pragma unroll
    for (int k = 0; k < 32; ++k) R[k] = 0.f;
    float dk = 1.0f, gp = 1.0f;
    LAS float* Fs = wl; LAS float* Qs = wl + 768; LAS float* Vs = wl + 1536; LAS float* Ks = wl + 2304; LAS float* Qr = wl + 2688; LAS float* Vr = wl + 3072;
    const int tt0 = lane >> 4, k4 = (lane & 15) * 4, tr0 = lane >> 3, r4 = (lane & 7) * 4;
    for (int sb = 0; sb < NSB; ++sb) {
        const int pos0 = CH * c + SBT * sb;
        f32x4 fr[3], kr[2], qq[2]; v2u qr[3]; unsigned short vr[SBT], wr[SBT];
#pragma unroll
        for (int j = 0; j < 3; ++j) { const int row = scan_row(b, dir, pos0 + 4 * j + tt0);
            fr[j] = *(const f32x4*)(M.HF + ((size_t)dir * NTOK + row) * 256 + h * 64 + k4); qr[j] = *(const v2u*)(M.P + (size_t)row * NP + C_HQ + h * 64 + k4); }
#pragma unroll
        for (int j = 0; j < 2; ++j) { const int tt = 8 * j + tr0; const int row = scan_row(b, dir, pos0 + (tt < SBT ? tt : 0));
            kr[j] = *(const f32x4*)(M.RK + (size_t)row * 128 + h * 32 + r4); qq[j] = *(const f32x4*)(M.RQ + (size_t)row * 128 + h * 32 + r4); }
#pragma unroll
        for (int i = 0; i < SBT; ++i) { const bf16* p = M.P + (size_t)scan_row(b, dir, pos0 + i) * NP; vr[i] = p[C_HI + h * 64 + lane]; wr[i] = p[C_RV + h * 64 + lane]; }
#pragma unroll
        for (int j = 0; j < 3; ++j) { *(LAS f32x4*)(Fs + (4 * j + tt0) * 64 + k4) = fr[j];
            *(LAS f32x4*)(Qs + (4 * j + tt0) * 64 + k4) = (f32x4){bfl(qr[j].x) * 0.125f, bfh(qr[j].x) * 0.125f, bfl(qr[j].y) * 0.125f, bfh(qr[j].y) * 0.125f}; }
#pragma unroll
        for (int j = 0; j < 2; ++j) { const int tt = 8 * j + tr0; if (tt < SBT) { *(LAS f32x4*)(Ks + tt * 32 + r4) = kr[j]; *(LAS f32x4*)(Qr + tt * 32 + r4) = qq[j]; } }
#pragma unroll
        for (int i = 0; i < SBT; ++i) { Vs[i * 64 + lane] = bf2f(vr[i]); Vr[i * 64 + lane] = bf2f(wr[i]); }
        asm volatile("s_waitcnt lgkmcnt(0)" ::: "memory");
        for (int i = 0; i < SBT; ++i) {
            const int row = scan_row(b, dir, pos0 + i); const float v = Vs[i * 64 + lane], w = Vr[i * 64 + lane]; float ac[4] = {0.f, 0.f, 0.f, 0.f}, ar[4] = {0.f, 0.f, 0.f, 0.f};
            dk *= Fs[i * 64 + lane]; M.HQC[((size_t)dir * NTOK + row) * 256 + h * 64 + lane] = Qs[i * 64 + lane] * dk;
            gp *= g; if (lane < 32) M.RQC[((size_t)dir * NTOK + row) * 128 + h * 32 + lane] = Qr[i * 32 + lane] * gp;
#pragma unroll
            for (int kk = 0; kk < 16; ++kk) { const f32x4 f4 = *(const LAS f32x4*)(Fs + i * 64 + 4 * kk), q4 = *(const LAS f32x4*)(Qs + i * 64 + 4 * kk);
#pragma unroll
                for (int j = 0; j < 4; ++j) { S[4 * kk + j] = f4[j] * (S[4 * kk + j] - v) + v; ac[j] += q4[j] * S[4 * kk + j]; }
                if (kk & 1) { const int k2 = kk >> 1; const f32x4 k4v = *(const LAS f32x4*)(Ks + i * 32 + 4 * k2), p4 = *(const LAS f32x4*)(Qr + i * 32 + 4 * k2);
#pragma unroll
                    for (int j = 0; j < 4; ++j) { R[4 * k2 + j] = g * R[4 * k2 + j] + k4v[j] * w; ar[j] += p4[j] * R[4 * k2 + j]; } } }
            M.HO[((size_t)dir * NTOK + row) * 256 + h * 64 + lane] = (ac[0] + ac[1]) + (ac[2] + ac[3]);
            M.RO[((size_t)dir * NTOK + row) * 256 + h * 64 + lane] = (ar[0] + ar[1]) + (ar[2] + ar[3]);
        }
        asm volatile("s_waitcnt lgkmcnt(0)" ::: "memory");
    }
    float* u = M.HU + ((size_t)seq * NCH + c) * 4096 + lane; float* ur = M.RU + ((size_t)seq * NCH + c) * 2048 + lane;
#pragma unroll
    for (int k = 0; k < 64; ++k) u[k * 64] = S[k];
#pragma unroll
    for (int k = 0; k < 32; ++k) ur[k * 64] = R[k];
    M.HDK[((size_t)seq * NCH + c) * 64 + lane] = dk;
}
__device__ __forceinline__ int bwd_chunk(int tq) { return (tq < NC ? NC - 1 - tq : NC + (NL - 1 - (tq - NC))) / CH; }
__device__ __forceinline__ void hg_fixfin_wave(const Mix& M, LAS float* wl, int unit, int lane, int tq_min) {
    const int c = unit % NCH, bh = unit / NCH, h = bh & 3, b = bh >> 2;
    if (CH * c + CH <= tq_min) return;
    const float* uf = M.HU + ((size_t)((0 * NB + b) * 4 + h) * NCH + c) * 4096 + lane;
    float Sf[64], Sb[64];
#pragma unroll
    for (int k = 0; k < 64; ++k) { Sf[k] = uf[k * 64]; Sb[k] = 0.f; }
    int cb = -1;
    const float ng = M.hg_norm_g[h * 64 + lane];
    const int tt0 = lane >> 4, k4 = (lane & 15) * 4;
    LAS float* Af = wl; LAS float* Ab = wl + 768;
    for (int sb = 0; sb < NSB; ++sb) {
        const int tq0 = CH * c + SBT * sb;
#pragma unroll
        for (int j = 0; j < 3; ++j) { const int row = row_of(b, tq0 + 4 * j + tt0);
            *(LAS f32x4*)(Af + (4 * j + tt0) * 64 + k4) = *(const f32x4*)(M.HQC + ((size_t)0 * NTOK + row) * 256 + h * 64 + k4);
            *(LAS f32x4*)(Ab + (4 * j + tt0) * 64 + k4) = *(const f32x4*)(M.HQC + ((size_t)1 * NTOK + row) * 256 + h * 64 + k4); }
        asm volatile("s_waitcnt lgkmcnt(0)" ::: "memory");
        for (int i = 0; i < SBT; ++i) {
            const int tq = tq0 + i, row = row_of(b, tq), cbn = bwd_chunk(tq);
            if (cbn != cb) { cb = cbn; const float* ub = M.HU + ((size_t)((1 * NB + b) * 4 + h) * NCH + cb) * 4096 + lane;
#pragma unroll
                for (int k = 0; k < 64; ++k) Sb[k] = ub[k * 64]; }
            float ac[4] = {M.HO[((size_t)0 * NTOK + row) * 256 + h * 64 + lane], M.HO[((size_t)1 * NTOK + row) * 256 + h * 64 + lane], 0.f, 0.f};
            const float gate = bf2f(M.P[(size_t)row * NP + C_HG + h * 64 + lane]);
#pragma unroll
            for (int kk = 0; kk < 16; ++kk) { const f32x4 a4 = *(const LAS f32x4*)(Af + i * 64 + 4 * kk), b4 = *(const LAS f32x4*)(Ab + i * 64 + 4 * kk);
#pragma unroll
                for (int j = 0; j < 4; ++j) { ac[j] += a4[j] * Sf[4 * kk + j]; ac[j] += b4[j] * Sb[4 * kk + j]; } }
            const float acc = (ac[0] + ac[1]) + (ac[2] + ac[3]);
            const float r = 1.0f / sqrtf(wsum(acc * acc, lane) * (1.0f / 64.0f) + NORM_EPS);
            M.OC[(size_t)row * D + 256 + h * 64 + lane] = f2bf(acc * r * ng * silu_f(gate));
        }
        asm volatile("s_waitcnt lgkmcnt(0)" ::: "memory");
    }
}
__device__ __forceinline__ void ret_fixfin_wave(const Mix& M, LAS float* wl, int unit, int lane, int tq_min) {
    const int c = unit % NCH, bh = unit / NCH, h = bh & 3, b = bh >> 2;
    if (CH * c + CH <= tq_min) return;
    const float* uf = M.RU + ((size_t)((0 * NB + b) * 4 + h) * NCH + c) * 2048 + lane;
    float Sf[32], Sb[32];
#pragma unroll
    for (int k = 0; k < 32; ++k) { Sf[k] = uf[k * 64]; Sb[k] = 0.f; }
    int cb = -1;
    const float gg = M.gn_g[h * 64 + lane], gb = M.gn_b[h * 64 + lane];
    const int tt0 = lane >> 3, k4 = (lane & 7) * 4;
    LAS float* Af = wl; LAS float* Ab = wl + 768;
    for (int sb = 0; sb < NSB; ++sb) {
        const int tq0 = CH * c + SBT * sb;
#pragma unroll
        for (int j = 0; j < 2; ++j) { const int tt = 8 * j + tt0; if (tt < SBT) { const int row = row_of(b, tq0 + tt);
            *(LAS f32x4*)(Af + tt * 32 + k4) = *(const f32x4*)(M.RQC + ((size_t)0 * NTOK + row) * 128 + h * 32 + k4);
            *(LAS f32x4*)(Ab + tt * 32 + k4) = *(const f32x4*)(M.RQC + ((size_t)1 * NTOK + row) * 128 + h * 32 + k4); } }
        asm volatile("s_waitcnt lgkmcnt(0)" ::: "memory");
        for (int i = 0; i < SBT; ++i) {
            const int tq = tq0 + i, row = row_of(b, tq), cbn = bwd_chunk(tq);
            if (cbn != cb) { cb = cbn; const float* ub = M.RU + ((size_t)((1 * NB + b) * 4 + h) * NCH + cb) * 2048 + lane;
#pragma unroll
                for (int k = 0; k < 32; ++k) Sb[k] = ub[k * 64]; }
            float ac[4] = {M.RO[((size_t)0 * NTOK + row) * 256 + h * 64 + lane], M.RO[((size_t)1 * NTOK + row) * 256 + h * 64 + lane], 0.f, 0.f};
            const float gate = bf2f(M.P[(size_t)row * NP + C_RG + h * 64 + lane]);
#pragma unroll
            for (int kk = 0; kk < 8; ++kk) { const f32x4 a4 = *(const LAS f32x4*)(Af + i * 32 + 4 * kk), b4 = *(const LAS f32x4*)(Ab + i * 32 + 4 * kk);
#pragma unroll
                for (int j = 0; j < 4; ++j) { ac[j] += a4[j] * Sf[4 * kk + j]; ac[j] += b4[j] * Sb[4 * kk + j]; } }
            const float acc = (ac[0] + ac[1]) + (ac[2] + ac[3]);
            const float mu = wsum(acc, lane) * (1.0f / 64.0f), dd = acc - mu, r = 1.0f / sqrtf(wsum(dd * dd, lane) * (1.0f / 64.0f) + NORM_EPS);
            M.OC[(size_t)row * D + 768 + h * 64 + lane] = f2bf((dd * r * gg + gb) * silu_f(gate));
        }
        asm volatile("s_waitcnt lgkmcnt(0)" ::: "memory");
    }
}
template <int KIND> __device__ __forceinline__ void norm_phase(Frame& F, int l) {
    unsigned char* ws = F.base();
    const bool combine = (KIND != 1) && l > 0 && ((l - 1) & 1);
    const bool first = (KIND == 0 && l == 0);
    const int nrows = (KIND == 2 || (KIND == 1 && l == DEPTH - 1)) ? NLAT : NTOK;
    const float* modl = F_sm + SM_MOD + (size_t)(KIND == 2 ? 0 : l) * 9 * 6144;
    const float* modp = F_sm + SM_MOD + (size_t)(l > 0 ? l - 1 : 0) * 9 * 6144;
    const int* offs = (const int*)(F_sm + SM_META) + ((l > 0 ? l - 1 : 0) >> 1) * 16;
    const float* gain = KIND == 0 ? IN(6) + l * D : (KIND == 1 ? IN(7) + l * D : IN(27));
    for (int row = F.gw; row < nrows; row += F.NGW) {
        const int bidx = row < NLAT ? row / NL : NB;
        const float* src = first ? (row < NLAT ? IN(0) + (size_t)row * D : IN(2) + (size_t)(row - NLAT) * D) : F_H + (size_t)row * D;
        f32x4 v[4];
#pragma unroll
        for (int j = 0; j < 4; ++j) v[j] = *(const f32x4*)(src + 4 * F.lane + 256 * j);
        if (combine) {
            const int* ti = F_tokinfo + (size_t)row * 8;
            const int e1 = ti[0], p1 = ti[1], e2 = ti[3], p2 = ti[4]; const float w1 = __int_as_float(ti[2]), w2 = __int_as_float(ti[5]);
            const bf16* y1 = F_Y + (size_t)(offs[e1] + p1) * D; const bf16* y2 = F_Y + (size_t)(offs[e2] + p2) * D;
#pragma unroll
            for (int j = 0; j < 4; ++j) { const int col = 4 * F.lane + 256 * j;
                const f32x4 gf = *(const f32x4*)(modp + (size_t)bidx * 6144 + 5 * 1024 + col);
                const v2u a = *(const v2u*)(y1 + col), b = *(const v2u*)(y2 + col);
                f32x4 ya, yb; ya[0] = bf2f((bf16)(a.x & 0xffff)); ya[1] = bf2f((bf16)(a.x >> 16)); ya[2] = bf2f((bf16)(a.y & 0xffff)); ya[3] = bf2f((bf16)(a.y >> 16));
                yb[0] = bf2f((bf16)(b.x & 0xffff)); yb[1] = bf2f((bf16)(b.x >> 16)); yb[2] = bf2f((bf16)(b.y & 0xffff)); yb[3] = bf2f((bf16)(b.y >> 16));
                v[j] = v[j] + gf * (ya * w1 + yb * w2); }
        }
        if (combine || first) {
#pragma unroll
            for (int j = 0; j < 4; ++j) *(f32x4*)(F_H + (size_t)row * D + 4 * F.lane + 256 * j) = v[j];
        }
        float ss = 0.f;
#pragma unroll
        for (int j = 0; j < 4; ++j) ss += (v[j][0] * v[j][0] + v[j][1] * v[j][1]) + (v[j][2] * v[j][2] + v[j][3] * v[j][3]);
        const float rstd = 1.0f / sqrtf(wave_sum(ss, F.lane) * (1.0f / D) + NORM_EPS);
        if (KIND == 2) {
#pragma unroll
            for (int j = 0; j < 4; ++j) { const int col = 4 * F.lane + 256 * j; const f32x4 g = *(const f32x4*)(gain + col); *(f32x4*)(OUTP() + (size_t)row * D + col) = v[j] * rstd * g; }
            continue;
        }
        const float* mrow = modl + (size_t)bidx * 6144 + (KIND == 0 ? 0 : 3 * 1024);
#pragma unroll
        for (int j = 0; j < 4; ++j) { const int col = 4 * F.lane + 256 * j;
            const f32x4 g = *(const f32x4*)(gain + col), sh = *(const f32x4*)(mrow + col), sc = *(const f32x4*)(mrow + 1024 + col);
            v[j] = v[j] * rstd * g * (sc + 1.0f) + sh;
            v2u o; o.x = pk2(v[j][0], v[j][1]); o.y = pk2(v[j][2], v[j][3]);
            *(v2u*)(F_A + (size_t)row * D + col) = o; }
        if (KIND == 1 && (l & 1)) {
            const int li = l >> 1; const float* wr = IN(23) + (size_t)li * D * 8;
            float lg[8];
#pragma unroll
            for (int e = 0; e < 8; ++e) lg[e] = 0.f;
#pragma unroll
            for (int j = 0; j < 4; ++j)
#pragma unroll
                for (int i = 0; i < 4; ++i) { const int col = 4 * F.lane + 256 * j + i; const f32x4 w0 = *(const f32x4*)(wr + (size_t)col * 8), w1 = *(const f32x4*)(wr + (size_t)col * 8 + 4);
#pragma unroll
                    for (int e = 0; e < 4; ++e) { lg[e] += v[j][i] * w0[e]; lg[4 + e] += v[j][i] * w1[e]; } }
#pragma unroll
            for (int e = 0; e < 8; ++e) lg[e] = wave_sum(lg[e], F.lane);
            int e1 = 0; float v1 = lg[0];
#pragma unroll
            for (int e = 1; e < 8; ++e) if (lg[e] > v1) { v1 = lg[e]; e1 = e; }
            int e2 = -1; float v2 = -3.0e38f;
#pragma unroll
            for (int e = 0; e < 8; ++e) if (e != e1 && lg[e] > v2) { v2 = lg[e]; e2 = e; }
            if (F.lane == 0) {
                const float w2 = 1.0f / (1.0f + expf(v1 - v2)), w1 = 1.0f - w2;
                const int p1 = (int)atomicAdd(F_ctl + CW_CNT + li * 8 + e1, 1u), p2 = (int)atomicAdd(F_ctl + CW_CNT + li * 8 + e2, 1u);
                F_list[(size_t)e1 * NTOK + p1] = row; F_list[(size_t)e2 * NTOK + p2] = row;
                int* ti = F_tokinfo + (size_t)row * 8; ti[0] = e1; ti[1] = p1; ti[2] = __float_as_int(w1); ti[3] = e2; ti[4] = p2; ti[5] = __float_as_int(w2);
            }
        }
    }
}
__device__ __forceinline__ void moe_tiles(Frame& F, int li, int (&tb)[9], int (&cnt)[8]) {
    unsigned char* ws = F.base();
    tb[0] = 0;
#pragma unroll
    for (int e = 0; e < 8; ++e) { cnt[e] = (int)__hip_atomic_load(F_ctl + CW_CNT + li * 8 + e, __ATOMIC_RELAXED, __HIP_MEMORY_SCOPE_AGENT); tb[e + 1] = tb[e] + ((cnt[e] + 255) >> 8); }
}
__device__ __forceinline__ void moe_gather(Frame& F, int li) {
    unsigned char* ws = F.base();
    int tb[9], cnt[8]; moe_tiles(F, li, tb, cnt);
    if (blockIdx.x == 0 && F.tid < 9) { int* meta = (int*)(F_sm + SM_META) + li * 16; int val = 0;
#pragma unroll
        for (int e = 0; e < 9; ++e) if (F.tid == e) val = tb[e] * 256;
        meta[F.tid] = val; }
    { const int T = tb[8]; unsigned* ul = (unsigned*)(F_sm + SM_ULIST) + li * (MAXTILES * 32);
      for (int L = F.gtid; L < T * 32; L += F.NT) {
          const bool gu = L < T * 28; const int nN = gu ? 28 : 4, nwg = T * nN; int wgid = gu ? L : L - T * 28;
          { const int q = nwg / 8, r = nwg % 8, xcd = wgid % 8, off = wgid / 8; wgid = (xcd < r ? xcd * (q + 1) : r * (q + 1) + (xcd - r) * q) + off; }
          const int nig = 8 * nN, gid = wgid / nig, fm = gid * 8, gsz = (T - fm) < 8 ? (T - fm) : 8;
          const int pm = fm + ((wgid % nig) % gsz), pnl = (wgid % nig) / gsz; int e = 0;
#pragma unroll
          for (int j = 1; j < 8; ++j) e += (pm >= tb[j]) ? 1 : 0;
          ul[(gu ? ULIST_GU : ULIST_D) + (gu ? L : L - T * 28)] = (unsigned)pm | ((unsigned)(e * nN + pnl) << 16);
      } }
    const int nslot = tb[8] * 256;
    for (int s = F.gw; s < nslot; s += F.NGW) {
        const int tile = s >> 8; int e = 0, base = 0, c = 0;
#pragma unroll
        for (int j = 0; j < 8; ++j) if (tile >= tb[j] && tile < tb[j + 1]) { e = j; base = tb[j] * 256; c = cnt[j]; }
        const int pos = s - base; const int tok = pos < c ? F_list[(size_t)e * NTOK + pos] : -1;
        v4u a = (v4u){0u, 0u, 0u, 0u}, b = a;
        if (tok >= 0) { const v4u* sp = (const v4u*)(F_A + (size_t)tok * D); a = sp[F.lane]; b = sp[64 + F.lane]; }
        v4u* dp = (v4u*)(F_AM + (size_t)s * D); dp[F.lane] = a; dp[64 + F.lane] = b;
    }
}

#ifndef MK_PER_PHASE
#define MK_PER_PHASE 0
#endif
#ifndef PROBE
#define PROBE 0
#endif
__device__ __forceinline__ void make_mix(Mix& M, unsigned char* ws, int l) {
    M.P = F_P; M.Qm = WSP(bf16, WS_QM); M.Km = WSP(bf16, WS_KM); M.Vm = WSP(bf16, WS_VM); M.Qs = WSP(bf16, WS_QS); M.Ks = WSP(bf16, WS_KS); M.Vs = WSP(bf16, WS_VS);
    M.HF = WSP(float, WS_HF); M.HO = WSP(float, WS_HO); M.RQ = WSP(float, WS_RQ); M.RK = WSP(float, WS_RK); M.RO = WSP(float, WS_RO); M.OC = F_OC;
    M.HU = WSP(float, WS_HU); M.HDK = WSP(float, WS_HDK); M.HQC = WSP(float, WS_HQC); M.RU = WSP(float, WS_RU); M.RQC = WSP(float, WS_RQC);
    M.loglb = F_sm + SM_LOGLB + l * 512; M.log1mlb = F_sm + SM_LOG1M + l * 512; M.hg_norm_g = IN(15) + l * 256; M.sink = IN(16) + l * 4; M.log_gamma = F_sm + SM_LGAM + l * 8;
    M.gn_g = IN(18) + l * 256; M.gn_b = IN(19) + l * 256;
}
__device__ __forceinline__ void frame_init(Frame& F, LAS unsigned char* lds, int wave_s) {
    unsigned z = 0u; asm volatile("" : "+v"(z)); int t = (int)__builtin_amdgcn_mbcnt_hi(~0u, __builtin_amdgcn_mbcnt_lo(~0u, z)); t += wave_s * 64;
    F.lds = lds; F.tid = t; F.lane = t & 63; F.wave = wave_s;
    F.gtid = blockIdx.x * NTHREADS + t; F.NT = gridDim.x * NTHREADS; { int gw_ = blockIdx.x * NWAVES + wave_s; asm volatile("" : "+s"(gw_)); F.gw = gw_; } F.NGW = gridDim.x * NWAVES;
}
__global__ void __launch_bounds__(NTHREADS, 2) fwd_kernel(Args args) {
    extern __shared__ __attribute__((aligned(16))) unsigned char lds[];
    const int wave_s = __builtin_amdgcn_readfirstlane((int)threadIdx.x >> 6);
    volatile LAS unsigned* MISC = (volatile LAS unsigned*)((LAS unsigned char*)lds + MISC_OFF);
    for (int u = threadIdx.x; u < (LDS_BYTES - 131072) / 4; u += NTHREADS) ((LAS unsigned*)((LAS unsigned char*)lds + 131072))[u] = 0u;
    __syncthreads();
    const int lo = args.ph_lo, hi = args.ph_hi;
    XcdBarrier bar; bar.w = wave_s; bar.bar = (unsigned*)(WSBASE() + WS_CTL) + CW_BAR; bar.x = 0; bar.st = nullptr;
    if (hi - lo > 1) bar = xcd_barrier_post((unsigned*)(WSBASE() + WS_CTL) + CW_BAR, MISC + 8, wave_s);
    int p = 0;
#ifndef PHMASK
#define PHMASK 0xffffffffu
#endif
#define PH_BEGIN_(k) if (((PHMASK >> (k)) & 1u) && p >= lo && p < hi) { Frame F; frame_init(F, (LAS unsigned char*)lds, wave_s); unsigned char* ws = F.base();
#define PH_END if (p + 1 < hi) xcd_barrier(bar); } ++p;

    PH_BEGIN_(0) (void)ws; prologue(F); PH_END

    for (int l = 0; l < DEPTH; ++l) {
        PH_BEGIN_(1) (void)ws; norm_phase<0>(F, l); if (l == 2) convert_moe(F, 1); PH_END
        PH_BEGIN_(2) { pg8::Gemm g{F_A, F_WIN + (size_t)l * NP * D, NTOK, NP, D}; pg8::StaticOrder S; S.init(NTOK, NP, gridDim.x, blockIdx.x);
                   pg8::EpiBf16P E{F_P, NP, NP / 256}; pg8::gemm_phase<pg8::EpiBf16P, pg8::StaticOrder, true, true>(F.lds, g, S, E, F.tid); } PH_END
#ifndef NO_MIX
        PH_BEGIN_(3) { Mix M; make_mix(M, ws, l); const float* tab = WSP(float, WS_TAB);
            for (int row = F.gw; row < NTOK; row += 2 * F.NGW) {
                PrepRegs Ra, Rb; const int r2 = row + F.NGW, r2c = r2 < NTOK ? r2 : row;
                prep_load(Ra, M.P + (size_t)row * NP, F.lane); prep_load(Rb, M.P + (size_t)r2c * NP, F.lane);
                prep_compute(M, tab, Ra, row, F.lane);
                if (r2 < NTOK) prep_compute(M, tab, Rb, r2, F.lane);
            }
            for (int g8 = F.gw; g8 < NTOK / 8; g8 += F.NGW) prep_vt(M, g8, F.lane); }
        PH_END
        PH_BEGIN_(4) { Mix M; make_mix(M, ws, l);
            attn_phase(F.lds, M, M.sink, l < DEPTH - 1, F.tid);
#if PROBE == 7
            attn_phase(F.lds, M, M.sink, l < DEPTH - 1, F.tid);
#endif
            LAS float* wl = (LAS float*)(F.lds + F.wave * 15360);
            for (int u = F.gw; u < 2 * NB * 4 * NCH; u += F.NGW) scan_local_wave(M, wl, u, F.lane);
#if PROBE == 8
            for (int u = F.gw; u < 2 * NB * 4 * NCH; u += F.NGW) scan_local_wave(M, wl, u, F.lane);
#endif
            }
        PH_END
        PH_BEGIN_(14) { Mix M; make_mix(M, ws, l);
            for (int it = F.gtid; it < 2 * NB * 4 * 4096; it += F.NT) hg_carry_item(M, it);
            for (int it = F.gtid; it < 2 * NB * 4 * 2048; it += F.NT) ret_carry_item(M, it); }
        PH_END
        PH_BEGIN_(15) { Mix M; make_mix(M, ws, l);
            LAS float* wl = (LAS float*)(F.lds + F.wave * 9216);
            const int w = F.wave, isH = ((w & 1) == 0) != (w >= 4), idx = isH ? (w == 0 ? 0 : w == 2 ? 1 : w == 5 ? 2 : 3) : (w == 1 ? 0 : w == 3 ? 1 : w == 4 ? 2 : 3);
            for (int u = blockIdx.x * 4 + idx; u < NB * 4 * NCH; u += gridDim.x * 4) { if (isH) hg_fixfin_wave(M, wl, u, F.lane, l < DEPTH - 1 ? 0 : NC); else ret_fixfin_wave(M, wl, u, F.lane, l < DEPTH - 1 ? 0 : NC); } }
        PH_END
#endif
        PH_BEGIN_(6) { const int Mr = l < DEPTH - 1 ? NTOK : NLAT; pg8::Gemm g{F_OC, F_WOUT + (size_t)l * D * D, Mr, D, D}; pg8::StaticOrder S; S.init(Mr, D, gridDim.x, blockIdx.x);
                   pg8::EpiRes E{F_H, F_sm + SM_MOD + (size_t)l * 9 * 6144 + 2 * 1024, NLAT / 256, NL / 256, NB}; pg8::gemm_phase<pg8::EpiRes, pg8::StaticOrder, true, true>(F.lds, g, S, E, F.tid); } PH_END
        PH_BEGIN_(7) (void)ws; norm_phase<1>(F, l); PH_END
        if ((l & 1) == 0) {
            const int li = l >> 1;
            PH_BEGIN_(8) { pg8::Gemm g{F_A, F_WFGU + (size_t)li * 2 * DFF * D, NTOK, 2 * DFF, D}; pg8::StaticOrder S; S.init(NTOK, 2 * DFF, gridDim.x, blockIdx.x);
                       pg8::EpiSwiglu E{F_ACT, DFF, 2 * DFF / 256}; pg8::gemm_phase<pg8::EpiSwiglu, pg8::StaticOrder, true, true>(F.lds, g, S, E, F.tid); } PH_END
            PH_BEGIN_(9) { pg8::Gemm g{F_ACT, F_WFD + (size_t)li * D * DFF, NTOK, D, DFF}; pg8::StaticOrder S; S.init(NTOK, D, gridDim.x, blockIdx.x);
                       pg8::EpiRes E{F_H, F_sm + SM_MOD + (size_t)l * 9 * 6144 + 5 * 1024, NLAT / 256, NL / 256, NB}; pg8::gemm_phase<pg8::EpiRes, pg8::StaticOrder, true, true>(F.lds, g, S, E, F.tid); } PH_END
        } else {
            const int li = l >> 1;
            PH_BEGIN_(10) (void)ws; moe_gather(F, li); PH_END
            PH_BEGIN_(11) { const int T = __builtin_amdgcn_readfirstlane((int)__hip_atomic_load((unsigned*)(F_sm + SM_META) + li * 16 + 8, __ATOMIC_RELAXED, __HIP_MEMORY_SCOPE_AGENT)) >> 8;
                       pg8::MoeOrder S; S.list = (const unsigned*)(F_sm + SM_ULIST) + li * (MAXTILES * 32) + ULIST_GU; S.nwg = T * (2 * DFE / 256); S.G = gridDim.x; S.c = blockIdx.x;
                       pg8::Gemm g{F_AM, F_WMGU, MAXTILES * 256, 8 * 2 * DFE, D};
                       pg8::EpiSwiglu E{F_ACT, DFE, 2 * DFE / 256}; pg8::gemm_phase<pg8::EpiSwiglu, pg8::MoeOrder, true, true>(F.lds, g, S, E, F.tid); } PH_END
            PH_BEGIN_(12) { const int T = __builtin_amdgcn_readfirstlane((int)__hip_atomic_load((unsigned*)(F_sm + SM_META) + li * 16 + 8, __ATOMIC_RELAXED, __HIP_MEMORY_SCOPE_AGENT)) >> 8;
                       pg8::MoeOrder S; S.list = (const unsigned*)(F_sm + SM_ULIST) + li * (MAXTILES * 32) + ULIST_D; S.nwg = T * (D / 256); S.G = gridDim.x; S.c = blockIdx.x;
                       pg8::Gemm g{F_ACT, F_WMD, MAXTILES * 256, 8 * D, DFE};
                       pg8::EpiBf16P E{F_Y, D, D / 256}; pg8::gemm_phase<pg8::EpiBf16P, pg8::MoeOrder, true, true>(F.lds, g, S, E, F.tid); } PH_END
        }
    }
    PH_BEGIN_(13) (void)ws; norm_phase<2>(F, DEPTH); PH_END
#undef PH_BEGIN_
#undef PH_END
}
constexpr int NPHASES = 1 + 2 * 10 + 2 * 11 + 1;


extern "C" void kernel_launch(void* const* d_in, const int* in_sizes, int n_in, void* d_out, int out_size, void* d_ws, size_t ws_size, hipStream_t stream) {
    static int grid = 0;
    if (grid == 0) {
        if (n_in != 28 || ws_size < WS_END || out_size != NLAT * D) { fprintf(stderr, "kernel_launch: unexpected problem shape (n_in %d, ws %zu, out %d)\n", n_in, ws_size, out_size); grid = -1; return; }
        int dev = 0, cus = 0;
        if (hipGetDevice(&dev) != hipSuccess || hipDeviceGetAttribute(&cus, hipDeviceAttributeMultiprocessorCount, dev) != hipSuccess) { grid = -1; return; }
        if (hipFuncSetAttribute((const void*)fwd_kernel, hipFuncAttributeMaxDynamicSharedMemorySize, LDS_BYTES) != hipSuccess) { fprintf(stderr, "kernel_launch: hipFuncSetAttribute failed\n"); grid = -1; return; }
        int per_cu = 0;
        if (hipOccupancyMaxActiveBlocksPerMultiprocessor(&per_cu, (const void*)fwd_kernel, NTHREADS, LDS_BYTES) != hipSuccess || per_cu < 1) { fprintf(stderr, "kernel_launch: occupancy query says %d\n", per_cu); }
        (void)hipGetLastError();
        grid = cus;
    }
    if (grid < 0) return;
    (void)hipMemsetAsync((char*)d_ws + WS_CTL, 0, CTL_ZERO_BYTES, stream);
    Args a{};
    for (int i = 0; i < 28; ++i) a.in[i] = (const float*)d_in[i];
    a.out = (float*)d_out; a.ws = (unsigned char*)d_ws;
#if MK_PER_PHASE
    for (int p = 0; p < NPHASES; ++p) { a.ph_lo = p; a.ph_hi = p + 1; hipLaunchKernelGGL(fwd_kernel, dim3(grid), dim3(NTHREADS), LDS_BYTES, stream, a);
        int l = -1, k = -1; const int base[4] = {1, 11, 22, 32}; for (int i = 0; i < 4; ++i) if (p >= base[i] && p < base[i] + (i & 1 ? 11 : 10)) { l = i; k = p - base[i]; }
        bool dup = false;
#if PROBE == 1
        dup = (p == 0);
#elif PROBE == 2
        dup = (k == 2);
#elif PROBE == 3
        dup = (k == 3);
#elif PROBE == 4
        dup = (k == 5);
#elif PROBE == 5
        dup = (k == 1);
#elif PROBE == 6
        dup = (k == 8) || ((l & 1) && (k == 9 || k == 10));
#endif
        if (dup) hipLaunchKernelGGL(fwd_kernel, dim3(grid), dim3(NTHREADS), LDS_BYTES, stream, a); }
#else
    a.ph_lo = 0; a.ph_hi = NPHASES; hipLaunchKernelGGL(fwd_kernel, dim3(grid), dim3(NTHREADS), LDS_BYTES, stream, a);
#endif
}
```

```cpp
#include <hip/hip_runtime.h>
#include <cstdio>
#include <cstdint>
#include <cmath>
#ifndef NB
#define NB 8
#endif
constexpr int D = 1024, NL = 2048, NC = 256, TK = NL + NC, DEPTH = 4, GRIDW = 64;
constexpr int NLAT = NB * NL, NCTX = NB * NC, NTOK = NLAT + NCTX;
constexpr int NP = 3840;
constexpr int DIN = 2912;
constexpr int C_QLAT = 0, C_KVLAT = 192, C_KPE = 320, C_HQ = 352, C_HZF = 608, C_HZB = 864, C_HI = 1120, C_HG = 1376;
constexpr int C_SQ = 1632, C_SK = 1888, C_SV = 2016, C_RQ = 2144, C_RK = 2272, C_RV = 2400, C_RG = 2656, C_QE = 2912, C_KVE = 3296;
constexpr int DFF = 2816, NEXP = 8, DFE = 3584;
constexpr float NORM_EPS = 1e-6f, LOG2E = 1.4426950408889634f;
typedef unsigned short bf16;

#ifdef HOST_TEST
#define HD static inline
#else
#define HD __host__ __device__ __forceinline__
#endif

HD float bf2f(bf16 b) { unsigned u = ((unsigned)b) << 16; float f; __builtin_memcpy(&f, &u, 4); return f; }
HD bf16 f2bf(float f) { unsigned u; __builtin_memcpy(&u, &f, 4); return (bf16)((u + 0x7fffu + ((u >> 16) & 1u)) >> 16); }
#define CBAR() asm volatile("" ::: "memory")
struct U4 { unsigned x, y, z, w; };
HD void ld8(const bf16* p, float (&f)[8]) {
    U4 u; __builtin_memcpy(&u, __builtin_assume_aligned(p, 16), 16);
    unsigned t;
    t = u.x << 16; __builtin_memcpy(&f[0], &t, 4); t = u.x & 0xffff0000u; __builtin_memcpy(&f[1], &t, 4);
    t = u.y << 16; __builtin_memcpy(&f[2], &t, 4); t = u.y & 0xffff0000u; __builtin_memcpy(&f[3], &t, 4);
    t = u.z << 16; __builtin_memcpy(&f[4], &t, 4); t = u.z & 0xffff0000u; __builtin_memcpy(&f[5], &t, 4);
    t = u.w << 16; __builtin_memcpy(&f[6], &t, 4); t = u.w & 0xffff0000u; __builtin_memcpy(&f[7], &t, 4);
}
HD void ld4f(const float* p, float (&f)[4]) { __builtin_memcpy(&f[0], __builtin_assume_aligned(p, 16), 16); }
HD float silu_f(float x) { return x / (1.0f + expf(-x)); }
HD int row_of(int b, int tq) { return tq < NC ? NLAT + b * NC + tq : b * NL + (tq - NC); }
HD void row_split(int row, int& b, int& tq) { if (row < NLAT) { b = row / NL; tq = NC + row % NL; } else { const int r = row - NLAT; b = r / NC; tq = r % NC; } }
HD float log_sigmoid_f(float x) { return fminf(x, 0.f) - log1pf(expf(-fabsf(x))); }

struct Mix {
    const bf16* P;
    bf16 *Qm, *Km, *Vm;
    bf16 *Qs, *Ks, *Vs;
    float* HF;
    float* HO;
    float *RQ, *RK;
    float* RO;
    bf16* OC;
    const float *loglb, *log1mlb;
    const float* hg_norm_g;
    const float* sink;
    const float* log_gamma;
    const float *gn_g, *gn_b;
    float *HU, *HDK, *HQC;
    float *RU, *RQC;
    bf16 *HQCb, *RQCb;
};
constexpr int CH = 72, NCH = TK / CH;
static_assert(NCH * CH == TK, "chunking");

HD void mla_prep_item(const Mix& M, int item) {
    const int row = item >> 2, h = item & 3; int b, tq; row_split(row, b, tq);
    const bf16* p = M.P + (size_t)row * NP;
    float sq = 0.f, skv = 0.f;
    for (int j = 0; j < 192; ++j) { const float v = bf2f(p[C_QLAT + j]); sq += v * v; }
    for (int j = 0; j < 128; ++j) { const float v = bf2f(p[C_KVLAT + j]); skv += v * v; }
    const float rq = 1.0f / sqrtf(sq * (1.0f / 192.0f) + NORM_EPS), rkv = 1.0f / sqrtf(skv * (1.0f / 128.0f) + NORM_EPS);
    const float qs = rq * 0.10206207261596575f * LOG2E;
    const size_t o96 = ((size_t)(b * 4 + h) * TK + tq) * 96;
    for (int j = 0; j < 64; ++j) {
        M.Qm[o96 + j] = f2bf(bf2f(p[C_QE + h * 96 + j]) * qs);
        M.Km[o96 + j] = f2bf(bf2f(p[C_KVE + h * 128 + j]) * rkv);
        M.Vm[((size_t)(b * 4 + h) * 64 + j) * TK + tq] = f2bf(bf2f(p[C_KVE + h * 128 + 64 + j]) * rkv);
    }
    const bool lat = tq >= NC; const int t = tq - NC;
    for (int j = 0; j < 16; ++j) {
        float c = 1.f, s = 0.f;
        if (lat) { const float inv = powf(10000.0f, -(float)(j & 7) / 8.0f); const float ang = (float)(j < 8 ? t / GRIDW : t % GRIDW) * inv; c = cosf(ang); s = sinf(ang); }
        const float q1 = bf2f(p[C_QE + h * 96 + 64 + j]), q2 = bf2f(p[C_QE + h * 96 + 80 + j]);
        M.Qm[o96 + 64 + j] = f2bf((q1 * c - q2 * s) * qs); M.Qm[o96 + 80 + j] = f2bf((q1 * s + q2 * c) * qs);
        const float k1 = bf2f(p[C_KPE + j]), k2 = bf2f(p[C_KPE + 16 + j]);
        M.Km[o96 + 64 + j] = f2bf(k1 * c - k2 * s); M.Km[o96 + 80 + j] = f2bf(k1 * s + k2 * c);
    }
}
HD void swa_prep_item(const Mix& M, int item) {
    const int row = item >> 3, s = item & 7; int b, tq; row_split(row, b, tq);
    const bf16* p = M.P + (size_t)row * NP;
    const bool lat = tq >= NC; const int t = tq - NC;
    if (s >= 6) { const int kh = s - 6; bf16* o = M.Vs + (size_t)(b * 2 + kh) * 64 * TK + tq; for (int j = 0; j < 64; ++j) o[(size_t)j * TK] = p[C_SV + kh * 64 + j]; return; }
    const bf16* src = s < 4 ? p + C_SQ + s * 64 : p + C_SK + (s - 4) * 64;
    bf16* o = s < 4 ? M.Qs + ((size_t)(b * 4 + s) * TK + tq) * 64 : M.Ks + ((size_t)(b * 2 + (s - 4)) * TK + tq) * 64;
    const float sc = s < 4 ? 0.125f * LOG2E : 1.0f;
    for (int j = 0; j < 32; ++j) {
        float c = 1.f, sn = 0.f;
        if (lat) { const float inv = powf(10000.0f, -(float)(j & 15) / 16.0f); const float ang = (float)(j < 16 ? t / GRIDW : t % GRIDW) * inv; c = cosf(ang); sn = sinf(ang); }
        const float x1 = bf2f(src[j]), x2 = bf2f(src[32 + j]);
        o[j] = f2bf((x1 * c - x2 * sn) * sc); o[32 + j] = f2bf((x1 * sn + x2 * c) * sc);
    }
}
HD void hg_prep_item(const Mix& M, int item) {
    const int row = item >> 8, c = item & 255;
    const bf16* p = M.P + (size_t)row * NP;
    for (int d = 0; d < 2; ++d) {
        const float z = bf2f(p[(d ? C_HZB : C_HZF) + c]);
        const float a = M.loglb[d * 256 + c], bb = M.log1mlb[d * 256 + c] + log_sigmoid_f(z);
        const float mx = fmaxf(a, bb), lf = mx + log1pf(expf(-fabsf(a - bb)));
        M.HF[((size_t)d * NTOK + row) * 256 + c] = expf(lf);
    }
}
HD void ret_prep_item(const Mix& M, int item) {
    const int row = item >> 3, w = (item >> 2) & 1, h = item & 3; int b, tq; row_split(row, b, tq);
    const bf16* src = M.P + (size_t)row * NP + (w ? C_RK : C_RQ) + h * 32;
    float* o = (w ? M.RK : M.RQ) + (size_t)row * 128 + h * 32;
    const float sc = w ? 1.0f : 0.17677669529663687f;
    for (int j = 0; j < 16; ++j) {
        const float inv = powf(10000.0f, -(float)j / 16.0f); const float ang = (float)tq * inv; const float c = cosf(ang), s = sinf(ang);
        const float x1 = bf2f(src[j]), x2 = bf2f(src[16 + j]);
        o[j] = (x1 * c - x2 * s) * sc; o[16 + j] = (x1 * s + x2 * c) * sc;
    }
}
HD void mla_attn_item(const Mix& M, int item) {
    const int tq = item % TK, bh = item / TK, b = bh >> 2, h = bh & 3;
    const bf16* qp = M.Qm + (size_t)item * 96;
    float q[96], o[64];
#pragma unroll
    for (int c8 = 0; c8 < 12; ++c8) { float t8[8]; ld8(qp + 8 * c8, t8);
#pragma unroll
        for (int j = 0; j < 8; ++j) q[8 * c8 + j] = t8[j]; }
#pragma unroll
    for (int j = 0; j < 64; ++j) o[j] = 0.f;
    float m = -1e30f, l = 0.f;
    const int nk = tq < NC ? NC : TK;
    const bf16* kb = M.Km + (size_t)bh * TK * 96; const bf16* vb = M.Vm + (size_t)bh * TK * 64;
    for (int k = 0; k < nk; ++k) {
        const bf16* kp = kb + (size_t)k * 96; float s = 0.f;
#pragma unroll
        for (int c8 = 0; c8 < 12; ++c8) { float t8[8]; ld8(kp + 8 * c8, t8);
#pragma unroll
            for (int j = 0; j < 8; ++j) s += q[8 * c8 + j] * t8[j];
            if ((c8 & 3) == 3) CBAR(); }
        const float mn = fmaxf(m, s), al = exp2f(m - mn), pr = exp2f(s - mn);
        l = l * al + pr; m = mn;
        const bf16* vp = vb + k;
#pragma unroll
        for (int j = 0; j < 64; ++j) o[j] = o[j] * al + pr * bf2f(vp[(size_t)j * TK]);
    }
    const float rl = 1.0f / l; bf16* op = M.OC + (size_t)row_of(b, tq) * D + h * 64;
#pragma unroll
    for (int j = 0; j < 64; ++j) op[j] = f2bf(o[j] * rl);
}
HD void swa_attn_item(const Mix& M, int item) {
    const int tq = item % TK, bh = item / TK, b = bh >> 2, hq = bh & 3, kh = hq >> 1;
    const bf16* qp = M.Qs + (size_t)item * 64;
    float q[64], o[64];
#pragma unroll
    for (int c8 = 0; c8 < 8; ++c8) { float t8[8]; ld8(qp + 8 * c8, t8);
#pragma unroll
        for (int j = 0; j < 8; ++j) { q[8 * c8 + j] = t8[j]; o[8 * c8 + j] = 0.f; } }
    float m = M.sink[hq] * LOG2E, l = 1.0f;
    const bf16* kb = M.Ks + (size_t)(b * 2 + kh) * TK * 64; const bf16* vb = M.Vs + (size_t)(b * 2 + kh) * TK * 64;
    const int t = tq - NC;
    const int lo2 = tq < NC ? 0 : (t - 128 < 0 ? 0 : t - 128), hi2 = tq < NC ? -1 : (t + 128 > NL - 1 ? NL - 1 : t + 128);
    const int n2 = hi2 - lo2 + 1;
    for (int i = 0; i < NC + n2; ++i) {
        const int k = i < NC ? i : NC + lo2 + (i - NC);
        const bf16* kp = kb + (size_t)k * 64; float s = 0.f;
#pragma unroll
        for (int c8 = 0; c8 < 8; ++c8) { float t8[8]; ld8(kp + 8 * c8, t8);
#pragma unroll
            for (int j = 0; j < 8; ++j) s += q[8 * c8 + j] * t8[j];
            if ((c8 & 3) == 3) CBAR(); }
        const float mn = fmaxf(m, s), al = exp2f(m - mn), pr = exp2f(s - mn);
        l = l * al + pr; m = mn;
        const bf16* vp = vb + k;
#pragma unroll
        for (int j = 0; j < 64; ++j) o[j] = o[j] * al + pr * bf2f(vp[(size_t)j * TK]);
    }
    const float rl = 1.0f / l; bf16* op = M.OC + (size_t)row_of(b, tq) * D + 512 + hq * 64;
#pragma unroll
    for (int j = 0; j < 64; ++j) op[j] = f2bf(o[j] * rl);
}
HD int dir_tq(int dir, int i) { return dir == 0 ? i : (i < NC ? NC - 1 - i : NC + (NL - 1 - (i - NC))); }
HD void hg_scan_item(const Mix& M, int item) {
    const int v = item & 63, h = (item >> 6) & 3, b = (item >> 8) % NB, dir = item / (256 * NB);
    float S[64];
#pragma unroll
    for (int k = 0; k < 64; ++k) S[k] = 0.f;
    for (int i = 0; i < TK; ++i) {
        const int row = row_of(b, dir_tq(dir, i));
        const bf16* p = M.P + (size_t)row * NP; const float* f = M.HF + ((size_t)dir * NTOK + row) * 256 + h * 64;
        const float vv = bf2f(p[C_HI + h * 64 + v]); float acc = 0.f;
#pragma unroll
        for (int c8 = 0; c8 < 8; ++c8) { float q8[8], fa[4], fb[4]; ld8(p + C_HQ + h * 64 + 8 * c8, q8); ld4f(f + 8 * c8, fa); ld4f(f + 8 * c8 + 4, fb);
#pragma unroll
            for (int j = 0; j < 8; ++j) { const int k = 8 * c8 + j; const float fk = j < 4 ? fa[j] : fb[j - 4]; S[k] = fk * S[k] + (1.0f - fk) * vv; acc += q8[j] * S[k]; }
            if ((c8 & 1) == 1) CBAR(); }
        M.HO[((size_t)dir * NTOK + row) * 256 + h * 64 + v] = acc * 0.125f;
    }
}
HD void ret_scan_item(const Mix& M, int item) {
    const int v = item & 63, h = (item >> 6) & 3, b = (item >> 8) % NB, dir = item / (256 * NB);
    const float g = expf(M.log_gamma[dir * 4 + h]);
    float S[32];
#pragma unroll
    for (int k = 0; k < 32; ++k) S[k] = 0.f;
    for (int i = 0; i < TK; ++i) {
        const int row = row_of(b, dir_tq(dir, i));
        const float vv = bf2f(M.P[(size_t)row * NP + C_RV + h * 64 + v]);
        const float* qk = M.RQ + (size_t)row * 128 + h * 32; const float* kk = M.RK + (size_t)row * 128 + h * 32; float acc = 0.f;
#pragma unroll
        for (int c4 = 0; c4 < 8; ++c4) { float qa[4], ka[4]; ld4f(qk + 4 * c4, qa); ld4f(kk + 4 * c4, ka);
#pragma unroll
            for (int j = 0; j < 4; ++j) { const int k = 4 * c4 + j; S[k] = g * S[k] + ka[j] * vv; acc += qa[j] * S[k]; }
            if ((c4 & 3) == 3) CBAR(); }
        M.RO[((size_t)dir * NTOK + row) * 256 + h * 64 + v] = acc;
    }
}
HD void hg_fin_item(const Mix& M, int item) {
    const int row = item >> 2, h = item & 3;
    const float* o0 = M.HO + (size_t)row * 256 + h * 64; const float* o1 = o0 + (size_t)NTOK * 256;
    float ss = 0.f;
    for (int v = 0; v < 64; ++v) { const float x = o0[v] + o1[v]; ss += x * x; }
    const float r = 1.0f / sqrtf(ss * (1.0f / 64.0f) + NORM_EPS);
    const bf16* gp = M.P + (size_t)row * NP + C_HG + h * 64; bf16* op = M.OC + (size_t)row * D + 256 + h * 64;
    for (int v = 0; v < 64; ++v) op[v] = f2bf((o0[v] + o1[v]) * r * M.hg_norm_g[h * 64 + v] * silu_f(bf2f(gp[v])));
}
HD void ret_fin_item(const Mix& M, int item) {
    const int row = item >> 2, h = item & 3;
    const float* o0 = M.RO + (size_t)row * 256 + h * 64; const float* o1 = o0 + (size_t)NTOK * 256;
    float s = 0.f;
    for (int v = 0; v < 64; ++v) s += o0[v] + o1[v];
    const float mu = s * (1.0f / 64.0f); float q = 0.f;
    for (int v = 0; v < 64; ++v) { const float d = o0[v] + o1[v] - mu; q += d * d; }
    const float r = 1.0f / sqrtf(q * (1.0f / 64.0f) + NORM_EPS);
    const bf16* gp = M.P + (size_t)row * NP + C_RG + h * 64; bf16* op = M.OC + (size_t)row * D + 768 + h * 64;
    for (int v = 0; v < 64; ++v) op[v] = f2bf(((o0[v] + o1[v] - mu) * r * M.gn_g[h * 64 + v] + M.gn_b[h * 64 + v]) * silu_f(bf2f(gp[v])));
}

HD void hg_local_item(const Mix& M, int item) {
    const int v = item & 63, c = (item >> 6) % NCH, seq = item / (64 * NCH), h = seq & 3, b = (seq >> 2) % NB, dir = seq / (4 * NB);
    float S[64];
#pragma unroll
    for (int k = 0; k < 64; ++k) S[k] = 0.f;
    float dk = 1.0f;
    for (int i = 0; i < CH; ++i) {
        const int row = row_of(b, dir_tq(dir, c * CH + i));
        const bf16* p = M.P + (size_t)row * NP; const float* f = M.HF + ((size_t)dir * NTOK + row) * 256 + h * 64;
        const float vv = bf2f(p[C_HI + h * 64 + v]); float acc = 0.f;
        dk *= f[v]; M.HQC[((size_t)dir * NTOK + row) * 256 + h * 64 + v] = bf2f(p[C_HQ + h * 64 + v]) * dk * 0.125f;
#pragma unroll
        for (int c8 = 0; c8 < 8; ++c8) { float q8[8], fa[4], fb[4]; ld8(p + C_HQ + h * 64 + 8 * c8, q8); ld4f(f + 8 * c8, fa); ld4f(f + 8 * c8 + 4, fb);
#pragma unroll
            for (int j = 0; j < 8; ++j) { const int k = 8 * c8 + j; const float fk = j < 4 ? fa[j] : fb[j - 4]; S[k] = fk * (S[k] - vv) + vv; acc += q8[j] * S[k]; }
            if ((c8 & 1) == 1) CBAR(); }
        M.HO[((size_t)dir * NTOK + row) * 256 + h * 64 + v] = acc * 0.125f;
    }
    float* u = M.HU + ((size_t)seq * NCH + c) * 4096 + v;
#pragma unroll
    for (int k = 0; k < 64; ++k) u[k * 64] = S[k];
    M.HDK[((size_t)seq * NCH + c) * 64 + v] = dk;
}
HD void hg_carry_item(const Mix& M, int item) {
    const int kv = item & 4095, seq = item >> 12, k = kv >> 6; float s = 0.f;
#pragma unroll 8
    for (int c = 0; c < NCH; ++c) { float* u = M.HU + ((size_t)seq * NCH + c) * 4096 + kv; const float uu = *u; *u = s; s = M.HDK[((size_t)seq * NCH + c) * 64 + k] * s + uu; }
}
HD void hg_fix_item(const Mix& M, int item) {
    const int v = item & 63, c = (item >> 6) % NCH, seq = item / (64 * NCH), h = seq & 3, b = (seq >> 2) % NB, dir = seq / (4 * NB);
    if (c == 0) return;
    float S[64]; const float* u = M.HU + ((size_t)seq * NCH + c) * 4096 + v;
#pragma unroll
    for (int k = 0; k < 64; ++k) S[k] = u[k * 64];
    for (int i = 0; i < CH; ++i) {
        const int row = row_of(b, dir_tq(dir, c * CH + i));
        const float* qc = M.HQC + ((size_t)dir * NTOK + row) * 256 + h * 64; float acc = 0.f;
#pragma unroll
        for (int c4 = 0; c4 < 16; ++c4) { float qa[4]; ld4f(qc + 4 * c4, qa);
#pragma unroll
            for (int j = 0; j < 4; ++j) acc += qa[j] * S[4 * c4 + j];
            if ((c4 & 3) == 3) CBAR(); }
        M.HO[((size_t)dir * NTOK + row) * 256 + h * 64 + v] += acc;
    }
}
HD void ret_local_item(const Mix& M, int item) {
    const int v = item & 63, c = (item >> 6) % NCH, seq = item / (64 * NCH), h = seq & 3, b = (seq >> 2) % NB, dir = seq / (4 * NB);
    const float g = expf(M.log_gamma[dir * 4 + h]);
    float S[32];
#pragma unroll
    for (int k = 0; k < 32; ++k) S[k] = 0.f;
    float gp = 1.0f;
    for (int i = 0; i < CH; ++i) {
        const int row = row_of(b, dir_tq(dir, c * CH + i));
        const float vv = bf2f(M.P[(size_t)row * NP + C_RV + h * 64 + v]);
        const float* qk = M.RQ + (size_t)row * 128 + h * 32; const float* kk = M.RK + (size_t)row * 128 + h * 32; float acc = 0.f;
        gp *= g; if (v < 32) M.RQC[((size_t)dir * NTOK + row) * 128 + h * 32 + v] = qk[v] * gp;
#pragma unroll
        for (int c4 = 0; c4 < 8; ++c4) { float qa[4], ka[4]; ld4f(qk + 4 * c4, qa); ld4f(kk + 4 * c4, ka);
#pragma unroll
            for (int j = 0; j < 4; ++j) { const int k = 4 * c4 + j; S[k] = g * S[k] + ka[j] * vv; acc += qa[j] * S[k]; }
            if ((c4 & 3) == 3) CBAR(); }
        M.RO[((size_t)dir * NTOK + row) * 256 + h * 64 + v] = acc;
    }
    float* u = M.RU + ((size_t)seq * NCH + c) * 2048 + v;
#pragma unroll
    for (int k = 0; k < 32; ++k) u[k * 64] = S[k];
}
HD void ret_carry_item(const Mix& M, int item) {
    const int kv = item & 2047, seq = item >> 11, h = seq & 3, dir = seq / (4 * NB); float s = 0.f;
    const float d = expf((float)CH * M.log_gamma[dir * 4 + h]);
#pragma unroll 8
    for (int c = 0; c < NCH; ++c) { float* u = M.RU + ((size_t)seq * NCH + c) * 2048 + kv; const float uu = *u; *u = s; s = d * s + uu; }
}
HD void ret_fix_item(const Mix& M, int item) {
    const int v = item & 63, c = (item >> 6) % NCH, seq = item / (64 * NCH), h = seq & 3, b = (seq >> 2) % NB, dir = seq / (4 * NB);
    if (c == 0) return;
    float S[32]; const float* u = M.RU + ((size_t)seq * NCH + c) * 2048 + v;
#pragma unroll
    for (int k = 0; k < 32; ++k) S[k] = u[k * 64];
    for (int i = 0; i < CH; ++i) {
        const int row = row_of(b, dir_tq(dir, c * CH + i));
        const float* qc = M.RQC + ((size_t)dir * NTOK + row) * 128 + h * 32; float acc = 0.f;
#pragma unroll
        for (int c4 = 0; c4 < 8; ++c4) { float qa[4]; ld4f(qc + 4 * c4, qa);
#pragma unroll
            for (int j = 0; j < 4; ++j) acc += qa[j] * S[4 * c4 + j];
            if ((c4 & 3) == 3) CBAR(); }
        M.RO[((size_t)dir * NTOK + row) * 256 + h * 64 + v] += acc;
    }
}
namespace pg8 {
#define PG8_LAS __attribute__((address_space(3)))
typedef unsigned short bf16_t;
typedef short bf16x8 __attribute__((ext_vector_type(8)));
typedef float f32x4 __attribute__((ext_vector_type(4)));
typedef unsigned u32x4 __attribute__((ext_vector_type(4)));
constexpr int BM = 256, BK = 64, HALF = 128, HTB = HALF * BK * 2  , STAGE_BYTES = 8 * HTB, NXCD = 8, WGM = 8;

__host__ __device__ __forceinline__ int lds_byte(int r, int c) { const int st = (r >> 4) * 2 + (c >> 5), rr = r & 15, cc = c & 31, ob = rr * 64 + cc * 2; return st * 1024 + (ob ^ (((ob >> 9) & 1) << 5)); }
__host__ __device__ __forceinline__ void stage_rc(int b, int& R, int& C) { const int st = b / 1024, sb = b % 1024, swz = sb ^ (((sb >> 9) & 1) << 5); R = (st >> 1) * 16 + swz / 64; C = (st & 1) * 32 + (swz % 64) / 2; }
__host__ __device__ __forceinline__ int perm32(int rho) { const int n = rho >> 4, i = rho & 15; return 8 * (i >> 2) + 4 * n + (i & 3); }

struct Unit { int pm, pn; };
struct Gemm { const bf16_t* A; const bf16_t* Bt; int M, N, K; };

struct StaticOrder {
    int nM, nN, nwg, G, c;
    __host__ __device__ void init(int M, int N, int G_, int c_) { nM = M / BM; nN = N / BM; nwg = nM * nN; G = G_; c = c_; }
    __host__ __device__ bool next(int i, Unit& u) const {
        const long L = (long)i * G + c; if (L >= nwg) return false;
        int wgid = (int)L; { const int q = nwg / NXCD, r = nwg % NXCD, xcd = wgid % NXCD, off = wgid / NXCD; wgid = (xcd < r ? xcd * (q + 1) : r * (q + 1) + (xcd - r) * q) + off; }
        const int nig = WGM * nN, gid = wgid / nig, fm = gid * WGM, gsz = (nM - fm) < WGM ? (nM - fm) : WGM;
        u.pm = fm + ((wgid % nig) % gsz); u.pn = (wgid % nig) / gsz; return true;
    }
    __device__ __forceinline__ void a_ready(const Unit&) const {}
    __device__ __forceinline__ void done(const Unit&) const {}
};

__device__ __forceinline__ unsigned cvt_pk_bf16(float lo, float hi) { unsigned r; asm volatile("v_cvt_pk_bf16_f32 %0, %1, %2" : "=v"(r) : "v"(lo), "v"(hi)); return r; }
typedef unsigned u32x2 __attribute__((ext_vector_type(2)));
struct EpiBf16P {
    static constexpr bool PERM = true, AFTER_DRAIN = false;
    bf16_t* O; int ldc; int nN;
    __device__ __forceinline__ void operator()(const f32x4 (&acc)[2][2][4][2], const Unit& u, int wr, int wc, int fr, int fq) const {
        const int row0 = u.pm * BM + wr * 64 + fr, col0 = (u.pn % nN) * BM + wc * 32 + 8 * fq;
#pragma unroll
        for (int ai = 0; ai < 2; ++ai)
#pragma unroll
            for (int m = 0; m < 4; ++m) { bf16_t* rowp = O + (size_t)(row0 + ai * HALF + m * 16) * ldc + col0;
#pragma unroll
                for (int bj = 0; bj < 2; ++bj) { const f32x4 v0 = acc[ai][bj][m][0], v1 = acc[ai][bj][m][1];
                    u32x4 w; w.x = cvt_pk_bf16(v0[0], v0[1]); w.y = cvt_pk_bf16(v0[2], v0[3]); w.z = cvt_pk_bf16(v1[0], v1[1]); w.w = cvt_pk_bf16(v1[2], v1[3]);
                    *(u32x4*)(rowp + bj * HALF) = w; } }
    }
};
struct EpiRes {
    static constexpr bool PERM = false, AFTER_DRAIN = false;
    float* H; const float* gate; int lat_tiles, tiles_per_batch, ctx_bidx;
    __device__ __forceinline__ void operator()(const f32x4 (&acc)[2][2][4][2], const Unit& u, int wr, int wc, int fr, int fq) const {
        const int bidx = u.pm < lat_tiles ? u.pm / tiles_per_batch : ctx_bidx;
        const float* g = gate + (size_t)bidx * 6144;
        const int row0 = u.pm * BM + wr * 64 + fr, col0 = u.pn * BM + wc * 32 + 4 * fq;
        f32x4 gv[2][2];
#pragma unroll
        for (int bj = 0; bj < 2; ++bj)
#pragma unroll
            for (int n = 0; n < 2; ++n) gv[bj][n] = *(const f32x4*)(g + col0 + bj * HALF + n * 16);
#pragma unroll
        for (int ai = 0; ai < 2; ++ai)
#pragma unroll
            for (int m = 0; m < 4; ++m) { float* rowp = H + (size_t)(row0 + ai * HALF + m * 16) * 1024 + col0;
#pragma unroll
                for (int bj = 0; bj < 2; ++bj)
#pragma unroll
                    for (int n = 0; n < 2; ++n) { f32x4* p = (f32x4*)(rowp + bj * HALF + n * 16); *p = *p + gv[bj][n] * acc[ai][bj][m][n]; } }
    }
};
struct EpiSwiglu {
    static constexpr bool PERM = true, AFTER_DRAIN = false;
    bf16_t* O; int ldo; int nN;
    __device__ __forceinline__ void operator()(const f32x4 (&acc)[2][2][4][2], const Unit& u, int wr, int wc, int fr, int fq) const {
        const int row0 = u.pm * BM + wr * 64 + fr, col0 = (u.pn % nN) * 128 + wc * 16 + 4 * fq;
#pragma unroll
        for (int ai = 0; ai < 2; ++ai)
#pragma unroll
            for (int m = 0; m < 4; ++m) { bf16_t* rowp = O + (size_t)(row0 + ai * HALF + m * 16) * ldo + col0;
#pragma unroll
                for (int bj = 0; bj < 2; ++bj) { const f32x4 gt = acc[ai][bj][m][0], up = acc[ai][bj][m][1]; float r[4];
#pragma unroll
                    for (int i = 0; i < 4; ++i) r[i] = gt[i] * __builtin_amdgcn_rcpf(1.0f + __builtin_amdgcn_exp2f(-1.4426950408889634f * gt[i])) * up[i];
                    u32x2 w; w.x = cvt_pk_bf16(r[0], r[1]); w.y = cvt_pk_bf16(r[2], r[3]);
                    *(u32x2*)(rowp + bj * 64) = w; } }
    }
};
struct MoeOrder {
    const unsigned* list; int nwg, G, c;
    __device__ __forceinline__ bool next(int i, Unit& u) const {
        const long L = (long)i * G + c; if (L >= nwg) return false;
        unsigned w; const unsigned* ptr = list + L;
        asm volatile("s_load_dword %0, %1, 0x0\n\ts_waitcnt lgkmcnt(0)" : "=s"(w) : "s"(ptr) : "memory");
        u.pm = (int)(w & 0xffffu); u.pn = (int)(w >> 16); return true;
    }
    __device__ __forceinline__ void a_ready(const Unit&) const {}
    __device__ __forceinline__ void done(const Unit&) const {}
};
template <class Epi, class Sched, bool ALIGN_EPI = false, bool SP2 = false>
__device__ __forceinline__ void gemm_phase(PG8_LAS unsigned char* lds, const Gemm g, const Sched& S, const Epi& E, const int tid_in) {
    const int tid = tid_in, wid = __builtin_amdgcn_readfirstlane(tid >> 6), lane = tid & 63, wr = wid >> 2, wc = wid & 3, fr = lane & 15, fq = lane >> 4;
    const int K = g.K, nt = K / BK;
    unsigned voffA[2], voffB[2];
#pragma unroll
    for (int i = 0; i < 2; ++i) { int R, C; stage_rc(tid * 16 + i * 8192, R, C); const int Rb = Epi::PERM ? ((R & ~31) + perm32(R & 31)) : R;
        voffA[i] = (unsigned)(R * K + C) * 2u; voffB[i] = (unsigned)(Rb * K + C) * 2u; }
    const size_t kstep = (size_t)(BK * 2);
    const size_t hstep = (size_t)HALF * K * 2;
    const size_t tstep = 2 * hstep;
    const unsigned ldsw = (unsigned)wid * 1024u;
    const int aoff = lds_byte(wr * 64 + fr, fq * 8), boff = lds_byte(wc * 32 + fr, fq * 8);
#define PG8_SA(b, h) (((b) * 2 + (h)) * HTB)
#define PG8_SB(b, h) ((4 + (b) * 2 + (h)) * HTB)
#define PG8_STAGE(bufoff, gbase, voff) do { _Pragma("unroll") for (int _i = 0; _i < 2; ++_i) \
        __builtin_amdgcn_global_load_lds((const unsigned*)((const char*)(gbase) + (voff)[_i]), (PG8_LAS unsigned*)(lds + (bufoff) + ldsw + _i * 8192), 16, 0, 0); } while (0)
#define PG8_LDA(dst, b, h) do { _Pragma("unroll") for (int m = 0; m < 4; ++m) _Pragma("unroll") for (int k = 0; k < 2; ++k) dst[m][k] = *(const PG8_LAS bf16x8*)(lds + PG8_SA(b, h) + aoff + m * 2048 + k * 1024); } while (0)
#define PG8_LDB(dst, b, h) do { _Pragma("unroll") for (int n = 0; n < 2; ++n) _Pragma("unroll") for (int k = 0; k < 2; ++k) dst[n][k] = *(const PG8_LAS bf16x8*)(lds + PG8_SB(b, h) + boff + n * 2048 + k * 1024); } while (0)
#define PG8_MMA(ai, bj, At, Bt) do { __builtin_amdgcn_s_setprio(1); _Pragma("unroll") for (int m = 0; m < 4; ++m) _Pragma("unroll") for (int n = 0; n < 2; ++n) _Pragma("unroll") for (int k = 0; k < 2; ++k) \
        acc[ai][bj][m][n] = __builtin_amdgcn_mfma_f32_16x16x32_bf16(Bt[n][k], At[m][k], acc[ai][bj][m][n], 0, 0, 0); __builtin_amdgcn_s_setprio(0); } while (0)
#define PG8_WAIT_V(n) asm volatile("s_waitcnt vmcnt(" #n ")" ::: "memory")
#define PG8_WAIT_L(n) asm volatile("s_waitcnt lgkmcnt(" #n ")" ::: "memory")
#define PG8_BAR __builtin_amdgcn_s_barrier()
#define PG8_SCHED __builtin_amdgcn_sched_barrier(0)
    Unit cur, nxt; int ui = 0;
    if (!S.next(0, cur)) return;
    f32x4 acc[2][2][4][2];
#pragma unroll
    for (int a = 0; a < 2; ++a)
#pragma unroll
        for (int b = 0; b < 2; ++b)
#pragma unroll
            for (int m = 0; m < 4; ++m)
#pragma unroll
                for (int n = 0; n < 2; ++n) acc[a][b][m][n] = (f32x4){0.f, 0.f, 0.f, 0.f};
    bf16x8 At[4][2], B0[2][2], B1[2][2];
    const char* cA = (const char*)g.A + (size_t)cur.pm * tstep; const char* cB = (const char*)g.Bt + (size_t)cur.pn * tstep;
    S.a_ready(cur);
    if constexpr (SP2) {
        PG8_STAGE(PG8_SB(0, 0), cB, voffB); PG8_STAGE(PG8_SB(0, 1), cB + hstep, voffB); PG8_STAGE(PG8_SA(0, 0), cA, voffA); PG8_STAGE(PG8_SA(0, 1), cA + hstep, voffA);
        if (wr == 1) PG8_BAR;
        PG8_WAIT_V(2); PG8_BAR;
        PG8_STAGE(PG8_SB(1, 0), cB + kstep, voffB); PG8_STAGE(PG8_SA(1, 0), cA + kstep, voffA); PG8_STAGE(PG8_SB(1, 1), cB + hstep + kstep, voffB);
        PG8_WAIT_V(6); PG8_BAR;
    } else {
        PG8_STAGE(PG8_SB(0, 0), cB, voffB); PG8_STAGE(PG8_SA(0, 0), cA, voffA); PG8_STAGE(PG8_SB(0, 1), cB + hstep, voffB); PG8_STAGE(PG8_SA(0, 1), cA + hstep, voffA);
        if (wr == 1) PG8_BAR;
        PG8_WAIT_V(4); PG8_BAR;
        PG8_STAGE(PG8_SB(1, 0), cB + kstep, voffB); PG8_STAGE(PG8_SA(1, 0), cA + kstep, voffA); PG8_STAGE(PG8_SB(1, 1), cB + hstep + kstep, voffB);
        PG8_WAIT_V(6); PG8_BAR;
    }
    for (;;) {
        const bool has_next = S.next(ui + 1, nxt);
        const char* nA = has_next ? (const char*)g.A + (size_t)nxt.pm * tstep : cA; const char* nB = has_next ? (const char*)g.Bt + (size_t)nxt.pn * tstep : cB;
        for (int t = 0; t < nt; t += 2) {
            const bool last = (t == nt - 2);
            const char* a1 = cA + (size_t)(t + 1) * kstep;
            const char* a2 = last ? nA : cA + (size_t)(t + 2) * kstep; const char* b2 = last ? nB : cB + (size_t)(t + 2) * kstep;
            const char* a3 = a2 + kstep; const char* b3 = b2 + kstep;
            if (last && has_next) S.a_ready(nxt);
            if constexpr (SP2) {
            PG8_LDB(B0, 0, 0); PG8_LDB(B1, 0, 1); PG8_SCHED; PG8_LDA(At, 0, 0); PG8_STAGE(PG8_SA(1, 1), a1 + hstep, voffA);
            PG8_WAIT_V(8); PG8_WAIT_L(0); PG8_BAR; PG8_MMA(0, 0, At, B0); PG8_MMA(0, 1, At, B1); PG8_BAR; PG8_SCHED;
            PG8_LDA(At, 0, 1); PG8_STAGE(PG8_SB(0, 0), b2, voffB); PG8_STAGE(PG8_SB(0, 1), b2 + hstep, voffB); PG8_STAGE(PG8_SA(0, 0), a2, voffA);
            PG8_WAIT_V(8); PG8_WAIT_L(0); PG8_BAR; PG8_MMA(1, 0, At, B0); PG8_MMA(1, 1, At, B1); PG8_BAR; PG8_SCHED;
            PG8_LDB(B0, 1, 0); PG8_LDB(B1, 1, 1); PG8_SCHED; PG8_LDA(At, 1, 0); PG8_STAGE(PG8_SA(0, 1), a2 + hstep, voffA);
            PG8_WAIT_V(8); PG8_WAIT_L(0); PG8_BAR; PG8_MMA(0, 0, At, B0); PG8_MMA(0, 1, At, B1); PG8_BAR; PG8_SCHED;
            PG8_LDA(At, 1, 1); PG8_STAGE(PG8_SB(1, 0), b3, voffB); PG8_STAGE(PG8_SB(1, 1), b3 + hstep, voffB); PG8_STAGE(PG8_SA(1, 0), a3, voffA);
            PG8_WAIT_V(8); PG8_WAIT_L(0); PG8_BAR; PG8_MMA(1, 0, At, B0); PG8_MMA(1, 1, At, B1); PG8_BAR; PG8_SCHED;
            } else {
            PG8_LDB(B0, 0, 0); PG8_SCHED; PG8_LDA(At, 0, 0); PG8_STAGE(PG8_SA(1, 1), a1 + hstep, voffA);
            PG8_WAIT_L(8); PG8_BAR; PG8_WAIT_L(0); PG8_MMA(0, 0, At, B0); PG8_BAR; PG8_SCHED;
            PG8_LDB(B1, 0, 1); PG8_STAGE(PG8_SB(0, 0), b2, voffB);
            PG8_BAR; PG8_WAIT_L(0); PG8_MMA(0, 1, At, B1); PG8_BAR;
            PG8_LDA(At, 0, 1); PG8_STAGE(PG8_SA(0, 0), a2, voffA);
            PG8_BAR; PG8_WAIT_L(0); PG8_MMA(1, 0, At, B0); PG8_BAR; PG8_SCHED;
            PG8_STAGE(PG8_SB(0, 1), b2 + hstep, voffB);
            PG8_WAIT_V(6); PG8_BAR; PG8_MMA(1, 1, At, B1); PG8_BAR;
            PG8_LDB(B0, 1, 0); PG8_SCHED; PG8_LDA(At, 1, 0); PG8_STAGE(PG8_SA(0, 1), a2 + hstep, voffA);
            PG8_WAIT_L(8); PG8_BAR; PG8_WAIT_L(0); PG8_MMA(0, 0, At, B0); PG8_BAR; PG8_SCHED;
            PG8_LDB(B1, 1, 1); PG8_STAGE(PG8_SB(1, 0), b3, voffB);
            PG8_BAR; PG8_WAIT_L(0); PG8_MMA(0, 1, At, B1); PG8_BAR;
            PG8_LDA(At, 1, 1); PG8_STAGE(PG8_SA(1, 0), a3, voffA);
            PG8_BAR; PG8_WAIT_L(0); PG8_MMA(1, 0, At, B0); PG8_BAR; PG8_SCHED;
            PG8_STAGE(PG8_SB(1, 1), b3 + hstep, voffB);
            PG8_WAIT_V(6); PG8_BAR; PG8_MMA(1, 1, At, B1); PG8_BAR;
            }
        }
        if constexpr (ALIGN_EPI) { if (wr == 0) PG8_BAR; }
        if constexpr (!Epi::AFTER_DRAIN) { unsigned z_ = 0u; asm volatile("" : "+v"(z_)); const int l2_ = (int)__builtin_amdgcn_mbcnt_hi(~0u, __builtin_amdgcn_mbcnt_lo(~0u, z_)); E(acc, cur, wr, wc, l2_ & 15, l2_ >> 4); S.done(cur); }
        if (!has_next) break;
#pragma unroll
        for (int a = 0; a < 2; ++a)
#pragma unroll
            for (int b = 0; b < 2; ++b)
#pragma unroll
                for (int m = 0; m < 4; ++m)
#pragma unroll
                    for (int n = 0; n < 2; ++n) acc[a][b][m][n] = (f32x4){0.f, 0.f, 0.f, 0.f};
        cur = nxt; cA = nA; cB = nB; ++ui;
        if constexpr (ALIGN_EPI) { if (wr == 1) PG8_BAR; }
    }
    PG8_WAIT_V(0);
    if constexpr (!ALIGN_EPI) { if (wr == 0) PG8_BAR; }
    PG8_BAR;
    if constexpr (Epi::AFTER_DRAIN) { E.fused(acc, cur, wr, wc, fr, fq, lds, wid, lane); S.done(cur); }
#undef PG8_SA
#undef PG8_SB
#undef PG8_STAGE
#undef PG8_LDA
#undef PG8_LDB
#undef PG8_MMA
#undef PG8_WAIT_V
#undef PG8_WAIT_L
#undef PG8_BAR
#undef PG8_SCHED
}
}
#ifndef LAS
#define LAS __attribute__((address_space(3)))
#endif
#define XB_TMO      128
#define XB_XCNT(j)  (256  + 64 * (j))
#define XB_XSUB(j)  (1280 + 64 * (j))
#define XB_XGEN(j)  (2304 + 64 * (j))
#define XB_TOP      3328
#define XB_TOPGEN   3392
#define XCD_BAR_WORDS 3456
#define XB_SPIN_CAP (1u << 24)

__device__ __forceinline__ unsigned xb_ld(unsigned* p)              { return __hip_atomic_load(p, __ATOMIC_RELAXED, __HIP_MEMORY_SCOPE_AGENT); }
__device__ __forceinline__ unsigned xb_add(unsigned* p, unsigned v) { return __hip_atomic_fetch_add(p, v, __ATOMIC_RELAXED, __HIP_MEMORY_SCOPE_AGENT); }
__device__ __forceinline__ unsigned xb_xcc_id() { return (unsigned)__builtin_amdgcn_s_getreg((3 << 11) | 20) & 0xFu; }
#define XB_SPIN(cond, bar) do { unsigned _sp = 0; while (cond) { __builtin_amdgcn_s_sleep(1); \
    if ((++_sp & 255u) == 0u) { if (xb_ld(&(bar)[XB_TMO])) break; if (_sp > XB_SPIN_CAP) { atomicAdd(&(bar)[XB_TMO], 1u); break; } } } } while (0)

struct XcdBarrier {
    int w;
    unsigned* bar; unsigned x;
    volatile LAS unsigned* st;
};

__device__ __forceinline__ bool xb_thread0(int w) { unsigned z = 0u; asm volatile("" : "+v"(z), "+s"(w)); return w == 0 && __builtin_amdgcn_mbcnt_hi(~0u, __builtin_amdgcn_mbcnt_lo(~0u, z)) == 0u; }
__device__ __forceinline__ XcdBarrier xcd_barrier_post(unsigned* bar, volatile LAS unsigned* st, int w) {
    XcdBarrier b; b.w = w; b.bar = bar; b.x = xb_xcc_id(); b.st = st;
    if (xb_thread0(w)) (void)xb_add(&bar[XB_XCNT(b.x)], 1u);
    return b;
}
__device__ __forceinline__ void xcd_barrier_complete(unsigned* bar, unsigned x, unsigned& nloc, unsigned& nx) {
    const unsigned G = gridDim.x * gridDim.y * gridDim.z;
    unsigned sum, cnt, mine, sp = 0u;
    for (;;) {
        sum = 0u; cnt = 0u; mine = 0u;
#pragma unroll
        for (unsigned j = 0; j < 16; ++j) { const unsigned c = xb_ld(&bar[XB_XCNT(j)]); sum += c; cnt += (c > 0u) ? 1u : 0u; mine = (j == x) ? c : mine; }
        if (sum == G) break;
        __builtin_amdgcn_s_sleep(1);
        if ((++sp & 255u) == 0u) { if (xb_ld(&bar[XB_TMO])) break; if (sp > XB_SPIN_CAP) { atomicAdd(&bar[XB_TMO], 1u); break; } }
    }
    nloc = mine > 0u ? mine : 1u; nx = cnt > 0u ? cnt : 1u;
}

__device__ __forceinline__ void xcd_barrier(const XcdBarrier& b) {
    asm volatile("s_waitcnt vmcnt(0)" ::: "memory");
    __syncthreads();
    if (xb_thread0(b.w)) {
        unsigned* bar = b.bar;
        __builtin_amdgcn_s_waitcnt(0);
        unsigned nloc = b.st[0], nx = b.st[1];
        if (nloc == 0u) { xcd_barrier_complete(bar, b.x, nloc, nx); b.st[0] = nloc; b.st[1] = nx; }
        const unsigned old = xb_add(&bar[XB_XSUB(b.x)], 1u);
        const unsigned gen = old / nloc;
        if (old + 1u == (gen + 1u) * nloc) {
            __builtin_amdgcn_fence(__ATOMIC_RELEASE, "agent");
            asm volatile("s_waitcnt vmcnt(0)" ::: "memory");
            const unsigned og = xb_add(&bar[XB_TOP], 1u);
            const unsigned tg = og / nx;
            if (og + 1u == (tg + 1u) * nx) xb_add(&bar[XB_TOPGEN], 1u);
            else XB_SPIN(xb_ld(&bar[XB_TOPGEN]) == tg, bar);
            __builtin_amdgcn_fence(__ATOMIC_ACQUIRE, "agent");
            xb_add(&bar[XB_XGEN(b.x)], 1u);
            asm volatile("s_waitcnt vmcnt(0)" ::: "memory");
        } else {
            XB_SPIN(xb_ld(&bar[XB_XGEN(b.x)]) == gen, bar);
            __builtin_amdgcn_fence(__ATOMIC_ACQUIRE, "agent");
            asm volatile("s_waitcnt vmcnt(0)" ::: "memory");
        }
    }
    __syncthreads();
}
#define GAS __attribute__((address_space(1)))
constexpr int NWAVES = 8, NTHREADS = NWAVES * 64;
constexpr size_t MiB = 1u << 20;
constexpr size_t WS_CTL = 0, CTL_ZERO_BYTES = 1 * MiB;
constexpr size_t WS_SMALL = 1 * MiB, WS_TOKINFO = 2 * MiB, WS_LIST = 3 * MiB;
constexpr size_t WS_WIN = 4 * MiB, WS_WOUT = 34 * MiB, WS_WFGU = 42 * MiB, WS_WFD = 64 * MiB, WS_WMGU = 75 * MiB, WS_WMD = 187 * MiB;
constexpr size_t WS_H = 243 * MiB, WS_A = 315 * MiB, WS_OC = 351 * MiB, WS_Y = 387 * MiB, WS_AM = 463 * MiB, WS_BIG = 539 * MiB;
constexpr size_t WS_P = WS_BIG, WS_QM = 674 * MiB, WS_KM = WS_QM + 14155776, WS_VM = WS_KM + 14155776, WS_QS = 710 * MiB, WS_KS = WS_QS + 9437184, WS_VS = WS_KS + 4718592;
constexpr size_t WS_HF = 728 * MiB, WS_HO = 764 * MiB, WS_RQ = 800 * MiB, WS_RK = 809 * MiB, WS_RO = 818 * MiB, WS_HQC = 854 * MiB, WS_HU = 872 * MiB, WS_HDK = 908 * MiB, WS_RQC = 909 * MiB, WS_RU = 927 * MiB, WS_TAB = 945 * MiB, WS_END = 947 * MiB;
constexpr size_t WS_ACT = WS_BIG;
constexpr int MAXTILES = 152;
static_assert(WS_P + (size_t)NTOK * NP * 2 <= WS_QM && WS_VM + (size_t)NB * 4 * TK * 64 * 2 <= WS_QS && WS_VS + 4718592 <= WS_HF, "ws map 1");
static_assert(WS_HQC + (size_t)2 * NTOK * 256 * 2 <= WS_HU && WS_HU + (size_t)2 * NB * 4 * 36 * 4096 * 4 <= WS_HDK && WS_RQC + (size_t)2 * NTOK * 256 * 2 <= WS_RU && WS_RU + (size_t)2 * NB * 4 * 36 * 2048 * 4 <= WS_TAB, "ws map 3");
static_assert(WS_ACT + (size_t)MAXTILES * 256 * DFE * 2 <= WS_END && (size_t)MAXTILES * 256 * D * 2 <= 76 * MiB, "ws map 2");
constexpr int SM_MOD = 0;
constexpr int SM_LOGLB = 4 * 9 * 6144, SM_LOG1M = SM_LOGLB + 4 * 512, SM_LGAM = SM_LOG1M + 4 * 512, SM_META = SM_LGAM + 64, SM_ULIST = SM_META + 32;
constexpr int ULIST_GU = 0, ULIST_D = MAXTILES * 28;
static_assert((SM_ULIST + 2 * MAXTILES * 32) * 4 <= (int)MiB, "small region");
constexpr int CW_BAR = 4096, CW_CNT = 8192;
constexpr int LDS_BYTES = 147456, MISC_OFF = 131072 + 320;

#define LAS __attribute__((address_space(3)))
typedef float f32x4 __attribute__((ext_vector_type(4)));
typedef unsigned v4u __attribute__((ext_vector_type(4)));
typedef unsigned v2u __attribute__((ext_vector_type(2)));
#define LDS_WAIT() asm volatile("s_waitcnt lgkmcnt(0)" ::: "memory")

struct Args { const float* in[28]; float* out; unsigned char* ws; int ph_lo, ph_hi; };
typedef __attribute__((address_space(4))) const unsigned long long ka_u64;
__device__ __forceinline__ const float* IN(int i) { ka_u64* ka = (ka_u64*)__builtin_amdgcn_kernarg_segment_ptr(); asm volatile("" : "+s"(ka)); return (const float*)(GAS const float*)ka[i]; }
__device__ __forceinline__ float* OUTP() { ka_u64* ka = (ka_u64*)__builtin_amdgcn_kernarg_segment_ptr(); asm volatile("" : "+s"(ka)); return (float*)(GAS float*)ka[28]; }
__device__ __forceinline__ unsigned char* WSBASE() { ka_u64* ka = (ka_u64*)__builtin_amdgcn_kernarg_segment_ptr(); asm volatile("" : "+s"(ka)); return (unsigned char*)(GAS unsigned char*)ka[29]; }
struct Frame {
    LAS unsigned char* lds;
    int tid, lane, wave, gtid, NT, gw, NGW;
    __device__ __forceinline__ unsigned char* base() const { return WSBASE(); }
};
#define WSP(T, off) ((T*)(ws + (off)))
#define F_ctl WSP(unsigned, WS_CTL)
#define F_sm WSP(float, WS_SMALL)
#define F_tokinfo WSP(int, WS_TOKINFO)
#define F_list WSP(int, WS_LIST)
#define F_H WSP(float, WS_H)
#define F_A WSP(bf16, WS_A)
#define F_OC WSP(bf16, WS_OC)
#define F_Y WSP(bf16, WS_Y)
#define F_AM WSP(bf16, WS_AM)
#define F_P WSP(bf16, WS_P)
#define F_ACT WSP(bf16, WS_ACT)
#define F_WIN WSP(bf16, WS_WIN)
#define F_WOUT WSP(bf16, WS_WOUT)
#define F_WFGU WSP(bf16, WS_WFGU)
#define F_WFD WSP(bf16, WS_WFD)
#define F_WMGU WSP(bf16, WS_WMGU)
#define F_WMD WSP(bf16, WS_WMD)
__device__ __forceinline__ float wave_sum(float v, int  ) {
    int x = __float_as_int(v);
    v += __int_as_float(__builtin_amdgcn_update_dpp(0, x, 0xB1, 0xF, 0xF, true)); x = __float_as_int(v);
    v += __int_as_float(__builtin_amdgcn_update_dpp(0, x, 0x4E, 0xF, 0xF, true)); x = __float_as_int(v);
    v += __int_as_float(__builtin_amdgcn_update_dpp(0, x, 0x141, 0xF, 0xF, true)); x = __float_as_int(v);
    v += __int_as_float(__builtin_amdgcn_update_dpp(0, x, 0x140, 0xF, 0xF, true)); x = __float_as_int(v);
    v += __int_as_float(__builtin_amdgcn_update_dpp(0, x, 0x142, 0xA, 0xF, false)); x = __float_as_int(v);
    v += __int_as_float(__builtin_amdgcn_update_dpp(0, x, 0x143, 0xC, 0xF, false));
    return __int_as_float(__builtin_amdgcn_readlane(__float_as_int(v), 63));
}
__device__ __forceinline__ unsigned pk2(float lo, float hi) { return (unsigned)f2bf(lo) | ((unsigned)f2bf(hi) << 16); }

constexpr int TAB_MLA = 0, TAB_SWA = NL * 16 * 2, TAB_RET = TAB_SWA + NL * 32 * 2, TAB_FLOATS = TAB_RET + TK * 16 * 2;
__device__ __forceinline__ void build_tables(float* tab, int gtid, int NT) {
    for (int it = gtid; it < NL * 16; it += NT) { const int t = it >> 4, j = it & 15; const float inv = powf(10000.0f, -(float)(j & 7) / 8.0f), ang = (float)(j < 8 ? t / GRIDW : t % GRIDW) * inv;
        tab[TAB_MLA + 2 * it] = cosf(ang); tab[TAB_MLA + 2 * it + 1] = sinf(ang); }
    for (int it = gtid; it < NL * 32; it += NT) { const int t = it >> 5, j = it & 31; const float inv = powf(10000.0f, -(float)(j & 15) / 16.0f), ang = (float)(j < 16 ? t / GRIDW : t % GRIDW) * inv;
        tab[TAB_SWA + 2 * it] = cosf(ang); tab[TAB_SWA + 2 * it + 1] = sinf(ang); }
    for (int it = gtid; it < TK * 16; it += NT) { const int tq = it >> 4, j = it & 15; const float inv = powf(10000.0f, -(float)j / 16.0f), ang = (float)tq * inv;
        tab[TAB_RET + 2 * it] = cosf(ang); tab[TAB_RET + 2 * it + 1] = sinf(ang); }
}
static_assert((size_t)TAB_FLOATS * 4 <= 2 * MiB, "rope tables");
template <class SrcFn> __device__ __forceinline__ void transpose_item(const SrcFn& src, int K, int nblk, bf16* WT, LAS float* scr, int item, int lane) {
    const int kb = item / nblk, nb = item % nblk, k0 = 64 * kb, n0 = 32 * nb;
    float tv[32];
#pragma unroll
    for (int i = 0; i < 32; ++i) tv[i] = src(k0 + 2 * i + (lane >> 5), n0 + (lane & 31));
#pragma unroll
    for (int i = 0; i < 32; ++i) scr[(2 * i + (lane >> 5)) * 33 + (lane & 31)] = tv[i];
    LDS_WAIT(); asm volatile("" ::: "memory");
    const int c = lane & 7;
#pragma unroll
    for (int j = 0; j < 4; ++j) { const int n = (lane >> 3) + 8 * j; const LAS float* s = scr + (8 * c) * 33 + n;
        v4u o; o.x = pk2(s[0 * 33], s[1 * 33]); o.y = pk2(s[2 * 33], s[3 * 33]); o.z = pk2(s[4 * 33], s[5 * 33]); o.w = pk2(s[6 * 33], s[7 * 33]);
        *(v4u*)(WT + (size_t)(n0 + n) * K + k0 + 8 * c) = o; }
    LDS_WAIT(); asm volatile("" ::: "memory");
}
struct SrcPlain { const float* W; int N; __device__ __forceinline__ float operator()(int k, int n) const { return W[(size_t)k * N + n]; } };
struct SrcGU { const float* Wg; long du; int NF; __device__ __forceinline__ float operator()(int k, int c) const { const int j = c >> 3, w = c & 7; return Wg[(w < 4 ? 0l : du) + (long)k * NF + 4 * j + (w & 3)]; } };

__device__ __forceinline__ void convert_moe(Frame& F, int li) {
    unsigned char* ws = F.base();
    LAS float* scr = (LAS float*)(F.lds + 40960 + F.wave * 8704);
    constexpr int I_GU = 16 * 224, I_D = 56 * 32;
    for (int it = F.gw; it < 8 * (I_GU + I_D); it += F.NGW) {
        const int e = it / (I_GU + I_D); int r = it % (I_GU + I_D);
        if (r < I_GU) { SrcGU s{IN(24) + ((size_t)li * 8 + e) * D * DFE, (long)(IN(25) - IN(24)), DFE}; transpose_item(s, D, 224, F_WMGU + (size_t)e * 2 * DFE * D, scr, r, F.lane); }
        else { r -= I_GU; SrcPlain s{IN(26) + ((size_t)li * 8 + e) * DFE * D, D}; transpose_item(s, DFE, 32, F_WMD + (size_t)e * D * DFE, scr, r, F.lane); }
    }
}
__device__ __forceinline__ void prologue(Frame& F) {
    unsigned char* ws = F.base();
    LAS float* sil = (LAS float*)F.lds;
    for (int i = F.tid; i < 9 * 1024; i += NTHREADS) { const float cv = i < 8 * 1024 ? IN(1)[i] : IN(3)[i - 8 * 1024]; sil[i] = silu_f(cv); }
    __syncthreads();
    { LAS float* red = (LAS float*)(F.lds + 36864);
      const int jc = F.tid & 63, kg = F.tid >> 6;
      for (int unit = blockIdx.x; unit < DEPTH * 96; unit += gridDim.x) {
          const int l = unit / 96, j0 = (unit % 96) * 64; const float* w = IN(4) + ((size_t)l * D + kg * 128) * 6144 + j0 + jc;
          float acc[9];
#pragma unroll
          for (int b = 0; b < 9; ++b) acc[b] = 0.f;
#pragma unroll 8
          for (int k = 0; k < 128; ++k) { const float wv = w[(size_t)k * 6144];
#pragma unroll
              for (int b = 0; b < 9; ++b) acc[b] += sil[b * 1024 + kg * 128 + k] * wv; }
#pragma unroll
          for (int b = 0; b < 9; ++b) red[(kg * 9 + b) * 64 + jc] = acc[b];
          __syncthreads();
          for (int o = F.tid; o < 9 * 64; o += NTHREADS) { float s = IN(5)[l * 6144 + j0 + (o & 63)];
#pragma unroll
              for (int g = 0; g < 8; ++g) s += red[(g * 9 + (o >> 6)) * 64 + (o & 63)];
              F_sm[SM_MOD + ((size_t)l * 9 + (o >> 6)) * 6144 + j0 + (o & 63)] = s; }
          __syncthreads();
      } }
    for (int it = F.gtid; it < 512; it += F.NT) {
        float lg[DEPTH], mx = -1e30f, s = 0.f;
#pragma unroll
        for (int l = 0; l < DEPTH; ++l) { lg[l] = IN(14)[l * 512 + it]; mx = fmaxf(mx, lg[l]); }
#pragma unroll
        for (int l = 0; l < DEPTH; ++l) { lg[l] = expf(lg[l] - mx); s += lg[l]; }
        float cum = 0.f; const float p0 = lg[0] / s;
#pragma unroll
        for (int l = 0; l < DEPTH; ++l) { cum += lg[l] / s; const float lb = cum - p0; F_sm[SM_LOGLB + l * 512 + it] = logf(fmaxf(lb, 1e-30f)); F_sm[SM_LOG1M + l * 512 + it] = log1pf(-lb); }
    }
    for (int it = F.gtid; it < DEPTH * 8; it += F.NT) F_sm[SM_LGAM + it] = log_sigmoid_f(IN(17)[it]);
    build_tables(WSP(float, WS_TAB), F.gtid, F.NT);
    LAS float* scr = (LAS float*)(F.lds + 40960 + F.wave * 8704);
    constexpr int I_IN = 16 * 91, I_OUT = 16 * 32, I_FGU = 16 * 176, I_FD = 44 * 32;
    constexpr int N_IN = DEPTH * I_IN, N_OUT = DEPTH * I_OUT, N_FGU = 2 * I_FGU, N_FD = 2 * I_FD;
    for (int it = F.gw; it < N_IN + N_OUT + N_FGU + N_FD; it += F.NGW) {
        int r = it;
        if (r < N_IN) { const int l = r / I_IN; SrcPlain s{IN(8) + (size_t)l * D * DIN, DIN}; transpose_item(s, D, 91, F_WIN + (size_t)l * NP * D, scr, r % I_IN, F.lane); continue; } r -= N_IN;
        if (r < N_OUT) { const int l = r / I_OUT; SrcPlain s{IN(9) + (size_t)l * D * D, D}; transpose_item(s, D, 32, F_WOUT + (size_t)l * D * D, scr, r % I_OUT, F.lane); continue; } r -= N_OUT;
        if (r < N_FGU) { const int l = r / I_FGU; SrcGU s{IN(20) + (size_t)l * D * DFF, (long)(IN(21) - IN(20)), DFF}; transpose_item(s, D, 176, F_WFGU + (size_t)l * 2 * DFF * D, scr, r % I_FGU, F.lane); continue; } r -= N_FGU;
        { const int l = r / I_FD; SrcPlain s{IN(22) + (size_t)l * DFF * D, D}; transpose_item(s, DFF, 32, F_WFD + (size_t)l * D * DFF, scr, r % I_FD, F.lane); }
    }
    convert_moe(F, 0);
    for (int it = F.gtid; it < DEPTH * (D / 8) * 928; it += F.NT) {
        const int n = it % 928, kg = (it / 928) % (D / 8), l = it / (928 * (D / 8));
        const float* wi = IN(8) + ((size_t)l * D + 8 * kg) * DIN; float acc[8];
#pragma unroll
        for (int r = 0; r < 8; ++r) acc[r] = 0.f;
        if (n < 384) { const float* g = IN(10) + l * 192; const float* wu = IN(11) + (size_t)l * 192 * 384 + n;
            for (int j = 0; j < 192; ++j) { const float w = g[j] * wu[(size_t)j * 384];
#pragma unroll
                for (int r = 0; r < 8; ++r) acc[r] += wi[(size_t)r * DIN + j] * w; } }
        else if (n < 896) { const float* g = IN(12) + l * 128; const float* wu = IN(13) + (size_t)l * 128 * 512 + (n - 384);
            for (int j = 0; j < 128; ++j) { const float w = g[j] * wu[(size_t)j * 512];
#pragma unroll
                for (int r = 0; r < 8; ++r) acc[r] += wi[(size_t)r * DIN + 192 + j] * w; } }
        v4u o; o.x = pk2(acc[0], acc[1]); o.y = pk2(acc[2], acc[3]); o.z = pk2(acc[4], acc[5]); o.w = pk2(acc[6], acc[7]);
        *(v4u*)(F_WIN + ((size_t)l * NP + DIN + n) * D + 8 * kg) = o;
    }
}

typedef short bf16x8s __attribute__((ext_vector_type(8)));
typedef float f32x16 __attribute__((ext_vector_type(16)));
__device__ __forceinline__ int crow(int r, int hi) { return (r & 3) + 8 * (r >> 2) + 4 * hi; }
__device__ __forceinline__ float xlane32(float v, int lane) { return __int_as_float(__builtin_amdgcn_ds_bpermute((lane ^ 32) << 2, __float_as_int(v))); }
__device__ __forceinline__ unsigned cvtpk(float lo, float hi) { unsigned r; asm volatile("v_cvt_pk_bf16_f32 %0, %1, %2" : "=v"(r) : "v"(lo), "v"(hi)); return r; }

template <int DK, bool SWA>
__device__ __forceinline__ void attn_unit(LAS unsigned char* lds, const bf16* Qg, const bf16* Kg, const bf16* Vtg, bf16* OCp, int b, int hcol, int tq0,
                                          int t0a, int t1a, int t0b, int t1b, float sink2, int tid) {
    constexpr int KS = DK * 2 + 16, VS = 136, KT_BYTES = 64 * KS, STAGE = KT_BYTES + 64 * VS, KP = DK / 8, NKP = 64 * KP, NS = DK / 16;
    const int lane = tid & 63, wave = __builtin_amdgcn_readfirstlane(tid >> 6), q = lane & 31, hi = lane >> 5;
    LAS float* wsf = (LAS float*)(lds + 2 * STAGE) + wave * 64;
    const int tq = tq0 + wave * 32 + q;
    bf16x8s qf[NS];
#pragma unroll
    for (int s = 0; s < NS; ++s) qf[s] = *(const bf16x8s*)(Qg + (size_t)tq * DK + 16 * s + 8 * hi);
    f32x16 o0, o1;
#pragma unroll
    for (int r = 0; r < 16; ++r) { o0[r] = 0.f; o1[r] = 0.f; }
    float m = SWA ? sink2 : -1e30f, l = (SWA && hi == 0) ? 1.0f : 0.f;
    const int na = t1a - t0a, nt = na + (t1b - t0b);
    const int w0 = tq0 - NC + wave * 32;
    v4u kr0, kr1 = (v4u){0u, 0u, 0u, 0u}, vr;
    { const int t = na > 0 ? t0a : t0b; const v4u* kg = (const v4u*)(Kg + (size_t)t * 64 * DK); kr0 = kg[tid]; if (NKP > 512) { if (tid < NKP - 512) kr1 = kg[512 + tid]; }
      vr = *(const v4u*)(Vtg + (size_t)(tid >> 3) * TK + t * 64 + (tid & 7) * 8); }
    { LAS unsigned char* kb = lds; *(LAS v4u*)(kb + (tid / KP) * KS + (tid % KP) * 16) = kr0;
      if (NKP > 512) { if (tid < NKP - 512) { const int p = 512 + tid; *(LAS v4u*)(kb + (p / KP) * KS + (p % KP) * 16) = kr1; } }
      LAS unsigned char* vb = kb + KT_BYTES + (tid >> 3) * VS + (tid & 7) * 16; *(LAS v2u*)vb = (v2u){vr.x, vr.y}; *(LAS v2u*)(vb + 8) = (v2u){vr.z, vr.w}; }
    __syncthreads();
    for (int i = 0; i < nt; ++i) {
        const int t = i < na ? t0a + i : t0b + (i - na);
        if (i + 1 < nt) { const int tn = (i + 1) < na ? t0a + i + 1 : t0b + (i + 1 - na); const v4u* kg = (const v4u*)(Kg + (size_t)tn * 64 * DK); kr0 = kg[tid]; if (NKP > 512) { if (tid < NKP - 512) kr1 = kg[512 + tid]; }
            vr = *(const v4u*)(Vtg + (size_t)(tid >> 3) * TK + tn * 64 + (tid & 7) * 8); }
        LAS unsigned char* kb = lds + (i & 1) * STAGE; LAS unsigned char* vbs = kb + KT_BYTES;
        const int sb = 64 * t - NC;
        const bool band = SWA && t >= 4;
        const bool skip = band && (sb + 63 < w0 - 128 || sb > w0 + 31 + 128);
        if (!skip) {
            f32x16 p0, p1;
#pragma unroll
            for (int r = 0; r < 16; ++r) { p0[r] = 0.f; p1[r] = 0.f; }
#pragma unroll
            for (int s = 0; s < NS; ++s) {
                const bf16x8s k0 = *(const LAS bf16x8s*)(kb + q * KS + (16 * s + 8 * hi) * 2);
                const bf16x8s k1 = *(const LAS bf16x8s*)(kb + (32 + q) * KS + (16 * s + 8 * hi) * 2);
                p0 = __builtin_amdgcn_mfma_f32_32x32x16_bf16(k0, qf[s], p0, 0, 0, 0);
                p1 = __builtin_amdgcn_mfma_f32_32x32x16_bf16(k1, qf[s], p1, 0, 0, 0);
            }
            if (band) { const int tl = tq - NC;
#pragma unroll
                for (int r = 0; r < 16; ++r) { const int d0 = tl - (sb + crow(r, hi)), d1 = d0 - 32;
                    if (d0 > 128 || d0 < -128) p0[r] = -1e30f; if (d1 > 128 || d1 < -128) p1[r] = -1e30f; } }
            float mx = fmaxf(p0[0], p1[0]);
#pragma unroll
            for (int r = 1; r < 16; ++r) mx = fmaxf(mx, fmaxf(p0[r], p1[r]));
            mx = fmaxf(mx, xlane32(mx, lane));
            const float mn = fmaxf(m, mx), alpha = __builtin_amdgcn_exp2f(m - mn); m = mn;
            float ps = 0.f;
#pragma unroll
            for (int r = 0; r < 16; ++r) { p0[r] = __builtin_amdgcn_exp2f(p0[r] - mn); p1[r] = __builtin_amdgcn_exp2f(p1[r] - mn); ps += p0[r] + p1[r]; }
            l = l * alpha + ps;
            if (hi == 0) wsf[q] = alpha;
            bf16x8s pa[4];
            { v4u w;
              w.x = cvtpk(p0[0], p0[1]); w.y = cvtpk(p0[2], p0[3]); w.z = cvtpk(p0[4], p0[5]); w.w = cvtpk(p0[6], p0[7]); pa[0] = __builtin_bit_cast(bf16x8s, w);
              w.x = cvtpk(p0[8], p0[9]); w.y = cvtpk(p0[10], p0[11]); w.z = cvtpk(p0[12], p0[13]); w.w = cvtpk(p0[14], p0[15]); pa[1] = __builtin_bit_cast(bf16x8s, w);
              w.x = cvtpk(p1[0], p1[1]); w.y = cvtpk(p1[2], p1[3]); w.z = cvtpk(p1[4], p1[5]); w.w = cvtpk(p1[6], p1[7]); pa[2] = __builtin_bit_cast(bf16x8s, w);
              w.x = cvtpk(p1[8], p1[9]); w.y = cvtpk(p1[10], p1[11]); w.z = cvtpk(p1[12], p1[13]); w.w = cvtpk(p1[14], p1[15]); pa[3] = __builtin_bit_cast(bf16x8s, w); }
            asm volatile("s_waitcnt lgkmcnt(0)" ::: "memory");
#pragma unroll
            for (int r = 0; r < 16; ++r) { const float a = wsf[crow(r, hi)]; o0[r] *= a; o1[r] *= a; }
#pragma unroll
            for (int s4 = 0; s4 < 4; ++s4)
#pragma unroll
                for (int nb = 0; nb < 2; ++nb) {
                    const LAS unsigned char* vp = vbs + (32 * nb + q) * VS + (16 * s4 + 4 * hi) * 2;
                    const v2u lo = *(const LAS v2u*)vp, hh = *(const LAS v2u*)(vp + 16);
                    const bf16x8s vf = __builtin_bit_cast(bf16x8s, ((v4u){lo.x, lo.y, hh.x, hh.y}));
                    if (nb == 0) o0 = __builtin_amdgcn_mfma_f32_32x32x16_bf16(pa[s4], vf, o0, 0, 0, 0); else o1 = __builtin_amdgcn_mfma_f32_32x32x16_bf16(pa[s4], vf, o1, 0, 0, 0);
                }
        }
        if (i + 1 < nt) { LAS unsigned char* kn = lds + ((i + 1) & 1) * STAGE; *(LAS v4u*)(kn + (tid / KP) * KS + (tid % KP) * 16) = kr0;
            if (NKP > 512) { if (tid < NKP - 512) { const int p = 512 + tid; *(LAS v4u*)(kn + (p / KP) * KS + (p % KP) * 16) = kr1; } }
            LAS unsigned char* vb = kn + KT_BYTES + (tid >> 3) * VS + (tid & 7) * 16; *(LAS v2u*)vb = (v2u){vr.x, vr.y}; *(LAS v2u*)(vb + 8) = (v2u){vr.z, vr.w}; }
        __syncthreads();
    }
    const float lt = l + xlane32(l, lane);
    if (hi == 0) wsf[q] = 1.0f / lt;
    asm volatile("s_waitcnt lgkmcnt(0)" ::: "memory");
#pragma unroll
    for (int r = 0; r < 16; ++r) { const int qq = crow(r, hi); const float inv = wsf[qq];
        bf16* op = OCp + (size_t)row_of(b, tq0 + wave * 32 + qq) * D + hcol + q;
        op[0] = f2bf(o0[r] * inv); op[32] = f2bf(o1[r] * inv); }
    __syncthreads();
}
__device__ __forceinline__ void attn_phase(LAS unsigned char* lds, const Mix& M, const float* sink, bool with_ctx, int tid) {
    const int nunits = 512 + (with_ctx ? 64 : 0);
    for (int u = blockIdx.x; u < nunits; u += gridDim.x) {
        if (u < 512) {
            const int c = u & 255, bh = (c & 7) + 8 * (c >> 6), qb = (c >> 3) & 7, b = bh >> 2, h = bh & 3, tq0 = NC + 256 * qb;
            if (u < 256) attn_unit<96, false>(lds, M.Qm + (size_t)bh * TK * 96, M.Km + (size_t)bh * TK * 96, M.Vm + (size_t)bh * 64 * TK, M.OC, b, h * 64, tq0, 0, TK / 64, 0, 0, 0.f, tid);
            else { const int slo = 256 * qb - 128 < 0 ? 0 : 256 * qb - 128, shi = 256 * qb + 383 > NL - 1 ? NL - 1 : 256 * qb + 383;
                attn_unit<64, true>(lds, M.Qs + (size_t)bh * TK * 64, M.Ks + (size_t)(b * 2 + (h >> 1)) * TK * 64, M.Vs + (size_t)(b * 2 + (h >> 1)) * 64 * TK, M.OC, b, 512 + h * 64, tq0,
                                    0, NC / 64, (NC + slo) / 64, (NC + shi) / 64 + 1, sink[h] * LOG2E, tid); }
        } else {
            const int c = (u - 512) & 31, b = c >> 2, h = c & 3;
            if (u < 544) attn_unit<96, false>(lds, M.Qm + (size_t)c * TK * 96, M.Km + (size_t)c * TK * 96, M.Vm + (size_t)c * 64 * TK, M.OC, b, h * 64, 0, 0, NC / 64, 0, 0, 0.f, tid);
            else attn_unit<64, true>(lds, M.Qs + (size_t)c * TK * 64, M.Ks + (size_t)(b * 2 + (h >> 1)) * TK * 64, M.Vs + (size_t)(b * 2 + (h >> 1)) * 64 * TK, M.OC, b, 512 + h * 64, 0, 0, NC / 64, 0, 0, sink[h] * LOG2E, tid);
        }
    }
}
__device__ __forceinline__ float wsum(float v, int  ) {
    int x = __float_as_int(v);
    v += __int_as_float(__builtin_amdgcn_update_dpp(0, x, 0xB1, 0xF, 0xF, true)); x = __float_as_int(v);
    v += __int_as_float(__builtin_amdgcn_update_dpp(0, x, 0x4E, 0xF, 0xF, true)); x = __float_as_int(v);
    v += __int_as_float(__builtin_amdgcn_update_dpp(0, x, 0x141, 0xF, 0xF, true)); x = __float_as_int(v);
    v += __int_as_float(__builtin_amdgcn_update_dpp(0, x, 0x140, 0xF, 0xF, true)); x = __float_as_int(v);
    v += __int_as_float(__builtin_amdgcn_update_dpp(0, x, 0x142, 0xA, 0xF, false)); x = __float_as_int(v);
    v += __int_as_float(__builtin_amdgcn_update_dpp(0, x, 0x143, 0xC, 0xF, false));
    return __int_as_float(__builtin_amdgcn_readlane(__float_as_int(v), 63));
}
__device__ __forceinline__ float fma_s(float a, float b, float c) { float d; asm("v_fma_f32 %0, %1, %2, %3" : "=v"(d) : "v"(a), "v"(b), "v"(c)); return d; }
__device__ __forceinline__ float sub_s(float a, float b) { float d; asm("v_sub_f32_e32 %0, %1, %2" : "=v"(d) : "v"(a), "v"(b)); return d; }
__device__ __forceinline__ float bfl(unsigned w) { return __uint_as_float(w << 16); }
__device__ __forceinline__ float bfh(unsigned w) { return __uint_as_float(w & 0xffff0000u); }
struct PrepRegs { v2u ql, kvl; unsigned qe[4], kve[4], qp1, qp2, kp1, kp2, sq1[2], sq2[2], sk1, sk2, hz[8], r1[2], r2[2]; };
__device__ __forceinline__ void prep_load(PrepRegs& R, const bf16* p, int lane) {
    R.ql = (lane < 48) ? *(const v2u*)(p + C_QLAT + 4 * (lane < 48 ? lane : 0)) : (v2u){0u, 0u};
    R.kvl = (lane < 32) ? *(const v2u*)(p + C_KVLAT + 4 * (lane < 32 ? lane : 0)) : (v2u){0u, 0u};
#pragma unroll
    for (int h = 0; h < 4; ++h) { R.qe[h] = p[C_QE + h * 96 + lane]; R.kve[h] = p[C_KVE + h * 128 + lane]; }
    { const int h = lane >> 4, j = lane & 15; R.qp1 = p[C_QE + h * 96 + 64 + j]; R.qp2 = p[C_QE + h * 96 + 80 + j]; R.kp1 = p[C_KPE + j]; R.kp2 = p[C_KPE + 16 + j]; }
#pragma unroll
    for (int i = 0; i < 2; ++i) { const int e = lane + 64 * i, hq = e >> 5, j = e & 31; R.sq1[i] = p[C_SQ + hq * 64 + j]; R.sq2[i] = p[C_SQ + hq * 64 + 32 + j]; }
    { const int kh = lane >> 5, j = lane & 31; R.sk1 = p[C_SK + kh * 64 + j]; R.sk2 = p[C_SK + kh * 64 + 32 + j]; }
#pragma unroll
    for (int i = 0; i < 8; ++i) R.hz[i] = p[((i >> 2) ? C_HZB : C_HZF) + (i & 3) * 64 + lane];
#pragma unroll
    for (int w = 0; w < 2; ++w) { const int hh = lane >> 4, j = lane & 15; R.r1[w] = p[(w ? C_RK : C_RQ) + hh * 32 + j]; R.r2[w] = p[(w ? C_RK : C_RQ) + hh * 32 + 16 + j]; }
}
__device__ __forceinline__ void prep_compute(const Mix& M, const float* tab, const PrepRegs& R, int row, int lane) {
    int b, tq; row_split(row, b, tq); const bool lat = tq >= NC; const int t = lat ? tq - NC : 0;
    float sq, skv;
    { const float a = bfl(R.ql.x), c = bfh(R.ql.x), d = bfl(R.ql.y), e = bfh(R.ql.y); sq = (a * a + c * c) + (d * d + e * e); }
    { const float a = bfl(R.kvl.x), c = bfh(R.kvl.x), d = bfl(R.kvl.y), e = bfh(R.kvl.y); skv = (a * a + c * c) + (d * d + e * e); }
    sq = wsum(sq, lane); skv = wsum(skv, lane);
    const float rq = 1.0f / sqrtf(sq * (1.0f / 192.0f) + NORM_EPS), rkv = 1.0f / sqrtf(skv * (1.0f / 128.0f) + NORM_EPS), qs = rq * 0.10206207261596575f * LOG2E;
#pragma unroll
    for (int h = 0; h < 4; ++h) { const size_t o = ((size_t)(b * 4 + h) * TK + tq) * 96 + lane; M.Qm[o] = f2bf(bf2f((bf16)R.qe[h]) * qs); M.Km[o] = f2bf(bf2f((bf16)R.kve[h]) * rkv); }
    { const int h = lane >> 4, j = lane & 15; float c = 1.f, s = 0.f; if (lat) { c = tab[TAB_MLA + (t * 16 + j) * 2]; s = tab[TAB_MLA + (t * 16 + j) * 2 + 1]; }
      const size_t o = ((size_t)(b * 4 + h) * TK + tq) * 96 + 64 + j;
      const float q1 = bf2f((bf16)R.qp1), q2 = bf2f((bf16)R.qp2); M.Qm[o] = f2bf((q1 * c - q2 * s) * qs); M.Qm[o + 16] = f2bf((q1 * s + q2 * c) * qs);
      const float k1 = bf2f((bf16)R.kp1), k2 = bf2f((bf16)R.kp2); M.Km[o] = f2bf(k1 * c - k2 * s); M.Km[o + 16] = f2bf(k1 * s + k2 * c); }
#pragma unroll
    for (int i = 0; i < 2; ++i) { const int e = lane + 64 * i, hq = e >> 5, j = e & 31; float c = 1.f, s = 0.f; if (lat) { c = tab[TAB_SWA + (t * 32 + j) * 2]; s = tab[TAB_SWA + (t * 32 + j) * 2 + 1]; }
        const float x1 = bf2f((bf16)R.sq1[i]), x2 = bf2f((bf16)R.sq2[i]); bf16* o = M.Qs + ((size_t)(b * 4 + hq) * TK + tq) * 64 + j;
        o[0] = f2bf((x1 * c - x2 * s) * (0.125f * LOG2E)); o[32] = f2bf((x1 * s + x2 * c) * (0.125f * LOG2E)); }
    { const int kh = lane >> 5, j = lane & 31; float c = 1.f, s = 0.f; if (lat) { c = tab[TAB_SWA + (t * 32 + j) * 2]; s = tab[TAB_SWA + (t * 32 + j) * 2 + 1]; }
      const float x1 = bf2f((bf16)R.sk1), x2 = bf2f((bf16)R.sk2); bf16* o = M.Ks + ((size_t)(b * 2 + kh) * TK + tq) * 64 + j;
      o[0] = f2bf(x1 * c - x2 * s); o[32] = f2bf(x1 * s + x2 * c); }
#pragma unroll
    for (int i = 0; i < 8; ++i) { const int d = i >> 2, c = (i & 3) * 64 + lane; const float z = bf2f((bf16)R.hz[i]);
        const float a = M.loglb[d * 256 + c], bb = M.log1mlb[d * 256 + c] + log_sigmoid_f(z), mx = fmaxf(a, bb), lf = mx + log1pf(expf(-fabsf(a - bb)));
        M.HF[((size_t)d * NTOK + row) * 256 + c] = lf * LOG2E; }
#pragma unroll
    for (int w = 0; w < 2; ++w) { const int hh = lane >> 4, j = lane & 15; const float c = tab[TAB_RET + (tq * 16 + j) * 2], s = tab[TAB_RET + (tq * 16 + j) * 2 + 1];
        float* o = (w ? M.RK : M.RQ) + (size_t)row * 128 + hh * 32 + j; const float sc = w ? 1.0f : 0.17677669529663687f;
        const float x1 = bf2f((bf16)R.r1[w]), x2 = bf2f((bf16)R.r2[w]); o[0] = (x1 * c - x2 * s) * sc; o[16] = (x1 * s + x2 * c) * sc; }
}
__device__ __forceinline__ void prep_vt(const Mix& M, int g8, int lane) {
    const int row0 = g8 * 8; int b, tq0; row_split(row0, b, tq0);
    float rkv[8];
#pragma unroll
    for (int r = 0; r < 8; ++r) { float skv = 0.f; if (lane < 32) { const v2u w = *(const v2u*)(M.P + (size_t)(row0 + r) * NP + C_KVLAT + 4 * lane); const float a = bfl(w.x), c = bfh(w.x), d = bfl(w.y), e = bfh(w.y); skv = (a * a + c * c) + (d * d + e * e); }
        skv = wsum(skv, lane); rkv[r] = 1.0f / sqrtf(skv * (1.0f / 128.0f) + NORM_EPS); }
#pragma unroll
    for (int h = 0; h < 4; ++h) { float v[8];
#pragma unroll
        for (int r = 0; r < 8; ++r) v[r] = bf2f(M.P[(size_t)(row0 + r) * NP + C_KVE + h * 128 + 64 + lane]) * rkv[r];
        v4u o; o.x = pk2(v[0], v[1]); o.y = pk2(v[2], v[3]); o.z = pk2(v[4], v[5]); o.w = pk2(v[6], v[7]);
        *(v4u*)(M.Vm + ((size_t)(b * 4 + h) * 64 + lane) * TK + tq0) = o; }
#pragma unroll
    for (int kh = 0; kh < 2; ++kh) { unsigned short v[8];
#pragma unroll
        for (int r = 0; r < 8; ++r) v[r] = M.P[(size_t)(row0 + r) * NP + C_SV + kh * 64 + lane];
        v4u o; o.x = (unsigned)v[0] | ((unsigned)v[1] << 16); o.y = (unsigned)v[2] | ((unsigned)v[3] << 16); o.z = (unsigned)v[4] | ((unsigned)v[5] << 16); o.w = (unsigned)v[6] | ((unsigned)v[7] << 16);
        *(v4u*)(M.Vs + ((size_t)(b * 2 + kh) * 64 + lane) * TK + tq0) = o; }
}
constexpr int SBT = 12, NSB = CH / SBT;
__device__ __forceinline__ int scan_row(int b, int dir, int pos) { return row_of(b, dir_tq(dir, pos)); }
__device__ __forceinline__ void scan_local_wave(const Mix& M, LAS float* wl  , int unit, int lane) {
    const int c = unit % NCH, seq = unit / NCH, h = seq & 3, b = (seq >> 2) % NB, dir = seq / (4 * NB);
    const float g = expf(M.log_gamma[dir * 4 + h]);
    float S[64], R[32];
#pragma unroll
    for (int k = 0; k < 64; ++k) S[k] = 0.f;
#pragma unroll
    for (int k = 0; k < 32; ++k) R[k] = 0.f;
    float dk = 1.0f, gp = 1.0f;
    LAS float* Fs = wl; LAS float* Qs = wl + 768; LAS float* Vs = wl + 1536; LAS float* Ks = wl + 2304; LAS float* Qr = wl + 2688; LAS float* Vr = wl + 3072;
    const int tt0 = lane >> 4, k4 = (lane & 15) * 4, tr0 = lane >> 3, r4 = (lane & 7) * 4;
    for (int sb = 0; sb < NSB; ++sb) {
        const int pos0 = CH * c + SBT * sb;
        f32x4 fr[3], kr[2], qq[2]; v2u qr[3]; unsigned short vr[SBT], wr[SBT];
#pragma unroll
        for (int j = 0; j < 3; ++j) { const int row = scan_row(b, dir, pos0 + 4 * j + tt0);
            fr[j] = *(const f32x4*)(M.HF + ((size_t)dir * NTOK + row) * 256 + h * 64 + k4); qr[j] = *(const v2u*)(M.P + (size_t)row * NP + C_HQ + h * 64 + k4); }
#pragma unroll
        for (int j = 0; j < 2; ++j) { const int tt = 8 * j + tr0; const int row = scan_row(b, dir, pos0 + (tt < SBT ? tt : 0));
            kr[j] = *(const f32x4*)(M.RK + (size_t)row * 128 + h * 32 + r4); qq[j] = *(const f32x4*)(M.RQ + (size_t)row * 128 + h * 32 + r4); }
#pragma unroll
        for (int i = 0; i < SBT; ++i) { const bf16* p = M.P + (size_t)scan_row(b, dir, pos0 + i) * NP; vr[i] = p[C_HI + h * 64 + lane]; wr[i] = p[C_RV + h * 64 + lane]; }
#pragma unroll
        for (int j = 0; j < 3; ++j) { *(LAS f32x4*)(Fs + (4 * j + tt0) * 64 + k4) = fr[j];
            *(LAS f32x4*)(Qs + (4 * j + tt0) * 64 + k4) = (f32x4){bfl(qr[j].x) * 0.125f, bfh(qr[j].x) * 0.125f, bfl(qr[j].y) * 0.125f, bfh(qr[j].y) * 0.125f}; }
#pragma unroll
        for (int j = 0; j < 2; ++j) { const int tt = 8 * j + tr0; if (tt < SBT) { *(LAS f32x4*)(Ks + tt * 32 + r4) = kr[j]; *(LAS f32x4*)(Qr + tt * 32 + r4) = qq[j]; } }
#pragma unroll
        for (int i = 0; i < SBT; ++i) { Vs[i * 64 + lane] = bf2f(vr[i]); Vr[i * 64 + lane] = bf2f(wr[i]); }
        asm volatile("s_waitcnt lgkmcnt(0)" ::: "memory");
        for (int i = 0; i < SBT; ++i) {
            const int row = scan_row(b, dir, pos0 + i); const float v = Vs[i * 64 + lane], w = Vr[i * 64 + lane]; float ac[4] = {0.f, 0.f, 0.f, 0.f}, ar[4] = {0.f, 0.f, 0.f, 0.f};
            dk *= Fs[i * 64 + lane]; M.HQC[((size_t)dir * NTOK + row) * 256 + h * 64 + lane] = Qs[i * 64 + lane] * dk;
            gp *= g; if (lane < 32) M.RQC[((size_t)dir * NTOK + row) * 128 + h * 32 + lane] = Qr[i * 32 + lane] * gp;
#pragma unroll
            for (int kk = 0; kk < 16; ++kk) { const f32x4 f4 = *(const LAS f32x4*)(Fs + i * 64 + 4 * kk), q4 = *(const LAS f32x4*)(Qs + i * 64 + 4 * kk);
#pragma unroll
                for (int j = 0; j < 4; ++j) { S[4 * kk + j] = f4[j] * (S[4 * kk + j] - v) + v; ac[j] += q4[j] * S[4 * kk + j]; }
                if (kk & 1) { const int k2 = kk >> 1; const f32x4 k4v = *(const LAS f32x4*)(Ks + i * 32 + 4 * k2), p4 = *(const LAS f32x4*)(Qr + i * 32 + 4 * k2);
#pragma unroll
                    for (int j = 0; j < 4; ++j) { R[4 * k2 + j] = g * R[4 * k2 + j] + k4v[j] * w; ar[j] += p4[j] * R[4 * k2 + j]; } } }
            M.HO[((size_t)dir * NTOK + row) * 256 + h * 64 + lane] = (ac[0] + ac[1]) + (ac[2] + ac[3]);
            M.RO[((size_t)dir * NTOK + row) * 256 + h * 64 + lane] = (ar[0] + ar[1]) + (ar[2] + ar[3]);
        }
        asm volatile("s_waitcnt lgkmcnt(0)" ::: "memory");
    }
    float* u = M.HU + ((size_t)seq * NCH + c) * 4096 + lane; float* ur = M.RU + ((size_t)seq * NCH + c) * 2048 + lane;
#pragma unroll
    for (int k = 0; k < 64; ++k) u[k * 64] = S[k];
#pragma unroll
    for (int k = 0; k < 32; ++k) ur[k * 64] = R[k];
    M.HDK[((size_t)seq * NCH + c) * 64 + lane] = dk;
}
__device__ __forceinline__ int bwd_chunk(int tq) { return (tq < NC ? NC - 1 - tq : NC + (NL - 1 - (tq - NC))) / CH; }
__device__ __forceinline__ void hg_fixfin_wave(const Mix& M, LAS float* wl, int unit, int lane, int tq_min) {
    const int c = unit % NCH, bh = unit / NCH, h = bh & 3, b = bh >> 2;
    if (CH * c + CH <= tq_min) return;
    const float* uf = M.HU + ((size_t)((0 * NB + b) * 4 + h) * NCH + c) * 4096 + lane;
    float Sf[64], Sb[64];
#pragma unroll
    for (int k = 0; k < 64; ++k) { Sf[k] = uf[k * 64]; Sb[k] = 0.f; }
    int cb = -1;
    const float ng = M.hg_norm_g[h * 64 + lane];
    const int tt0 = lane >> 4, k4 = (lane & 15) * 4;
    LAS float* Af = wl; LAS float* Ab = wl + 768;
    for (int sb = 0; sb < NSB; ++sb) {
        const int tq0 = CH * c + SBT * sb;
#pragma unroll
        for (int j = 0; j < 3; ++j) { const int row = row_of(b, tq0 + 4 * j + tt0);
            *(LAS f32x4*)(Af + (4 * j + tt0) * 64 + k4) = *(const f32x4*)(M.HQC + ((size_t)0 * NTOK + row) * 256 + h * 64 + k4);
            *(LAS f32x4*)(Ab + (4 * j + tt0) * 64 + k4) = *(const f32x4*)(M.HQC + ((size_t)1 * NTOK + row) * 256 + h * 64 + k4); }
        asm volatile("s_waitcnt lgkmcnt(0)" ::: "memory");
        for (int i = 0; i < SBT; ++i) {
            const int tq = tq0 + i, row = row_of(b, tq), cbn = bwd_chunk(tq);
            if (cbn != cb) { cb = cbn; const float* ub = M.HU + ((size_t)((1 * NB + b) * 4 + h) * NCH + cb) * 4096 + lane;
#pragma unroll
                for (int k = 0; k < 64; ++k) Sb[k] = ub[k * 64]; }
            float ac[4] = {M.HO[((size_t)0 * NTOK + row) * 256 + h * 64 + lane], M.HO[((size_t)1 * NTOK + row) * 256 + h * 64 + lane], 0.f, 0.f};
            const float gate = bf2f(M.P[(size_t)row * NP + C_HG + h * 64 + lane]);
#pragma unroll
            for (int kk = 0; kk < 16; ++kk) { const f32x4 a4 = *(const LAS f32x4*)(Af + i * 64 + 4 * kk), b4 = *(const LAS f32x4*)(Ab + i * 64 + 4 * kk);
#pragma unroll
                for (int j = 0; j < 4; ++j) { ac[j] += a4[j] * Sf[4 * kk + j]; ac[j] += b4[j] * Sb[4 * kk + j]; } }
            const float acc = (ac[0] + ac[1]) + (ac[2] + ac[3]);
            const float r = 1.0f / sqrtf(wsum(acc * acc, lane) * (1.0f / 64.0f) + NORM_EPS);
            M.OC[(size_t)row * D + 256 + h * 64 + lane] = f2bf(acc * r * ng * silu_f(gate));
        }
        asm volatile("s_waitcnt lgkmcnt(0)" ::: "memory");
    }
}
__device__ __forceinline__ void ret_fixfin_wave(const Mix& M, LAS float* wl, int unit, int lane, int tq_min) {
    const int c = unit % NCH, bh = unit / NCH, h = bh & 3, b = bh >> 2;
    if (CH * c + CH <= tq_min) return;
    const float* uf = M.RU + ((size_t)((0 * NB + b) * 4 + h) * NCH + c) * 2048 + lane;
    float Sf[32], Sb[32];
#pragma unroll
    for (int k = 0; k < 32; ++k) { Sf[k] = uf[k * 64]; Sb[k] = 0.f; }
    int cb = -1;
    const float gg = M.gn_g[h * 64 + lane], gb = M.gn_b[h * 64 + lane];
    const int tt0 = lane >> 3, k4 = (lane & 7) * 4;
    LAS float* Af = wl; LAS float* Ab = wl + 768;
    for (int sb = 0; sb < NSB; ++sb) {
        const int tq0 = CH * c + SBT * sb;
#pragma unroll
        for (int j = 0; j < 2; ++j) { const int tt = 8 * j + tt0; if (tt < SBT) { const int row = row_of(b, tq0 + tt);
            *(LAS f32x4*)(Af + tt * 32 + k4) = *(const f32x4*)(M.RQC + ((size_t)0 * NTOK + row) * 128 + h * 32 + k4);
            *(LAS f32x4*)(Ab + tt * 32 + k4) = *(const f32x4*)(M.RQC + ((size_t)1 * NTOK + row) * 128 + h * 32 + k4); } }
        asm volatile("s_waitcnt lgkmcnt(0)" ::: "memory");
        for (int i = 0; i < SBT; ++i) {
            const int tq = tq0 + i, row = row_of(b, tq), cbn = bwd_chunk(tq);
            if (cbn != cb) { cb = cbn; const float* ub = M.RU + ((size_t)((1 * NB + b) * 4 + h) * NCH + cb) * 2048 + lane;
#pragma unroll
                for (int k = 0; k < 32; ++k) Sb[k] = ub[k * 64]; }
            float ac[4] = {M.RO[((size_t)0 * NTOK + row) * 256 + h * 64 + lane], M.RO[((size_t)1 * NTOK + row) * 256 + h * 64 + lane], 0.f, 0.f};
            const float gate = bf2f(M.P[(size_t)row * NP + C_RG + h * 64 + lane]);
#pragma unroll
            for (int kk = 0; kk < 8; ++kk) { const f32x4 a4 = *(const LAS f32x4*)(Af + i * 32 + 4 * kk), b4 = *(const LAS f32x4*)(Ab + i * 32 + 4 * kk);
#pragma unroll
                for (int j = 0; j < 4; ++j) { ac[j] += a4[j] * Sf[4 * kk + j]; ac[j] += b4[j] * Sb[4 * kk + j]; } }
            const float acc = (ac[0] + ac[1]) + (ac[2] + ac[3]);
            const float mu = wsum(acc, lane) * (1.0f / 64.0f), dd = acc - mu, r = 1.0f / sqrtf(wsum(dd * dd, lane) * (1.0f / 64.0f) + NORM_EPS);
            M.OC[(size_t)row * D + 768 + h * 64 + lane] = f2bf((dd * r * gg + gb) * silu_f(gate));
        }
        asm volatile("s_waitcnt lgkmcnt(0)" ::: "memory");
    }
}
typedef short s16x4 __attribute__((ext_vector_type(4)));
constexpr int MCH = 64, MNCH = TK / MCH;
constexpr int MS_PITCH = 144, MS_MAT = 16 * MS_PITCH, MS_KE = 3 * MS_MAT, MS_VT = MS_KE + 3072, MS_D = MS_VT + 3072, MS_BYTES = MS_D + 256;
static_assert(MS_BYTES <= 13312, "scan LDS block");
__device__ __forceinline__ int pk64(int k) { const int kp = k & 31; return (k & 32) + 8 * ((kp >> 2) & 3) + 4 * (kp >> 4) + (kp & 3); }
__device__ __forceinline__ void chunk_rows(int b, int dir, int c, int& r0, int& rs) {
    if (dir == 0) { r0 = row_of(b, MCH * c); rs = 1; } else { const int i0 = MCH * c; r0 = row_of(b, i0 < NC ? NC - 1 - i0 : NC + (NL - 1 - (i0 - NC))); rs = -1; }
}
typedef float f32x2t __attribute__((ext_vector_type(2))); typedef __bf16 bf16x2t __attribute__((ext_vector_type(2)));
__device__ __forceinline__ unsigned cvtpk_c(float lo, float hi) { const f32x2t v = {lo, hi}; const bf16x2t b = __builtin_convertvector(v, bf16x2t); return __builtin_bit_cast(unsigned, b); }
__device__ __forceinline__ bf16x8s pack8(const f32x4& a, const f32x4& b) { v4u w; w.x = cvtpk_c(a[0], a[1]); w.y = cvtpk_c(a[2], a[3]); w.z = cvtpk_c(b[0], b[1]); w.w = cvtpk_c(b[2], b[3]); return __builtin_bit_cast(bf16x8s, w); }
__device__ __forceinline__ s16x4 pack4(const f32x4& a) { v2u w; w.x = cvtpk_c(a[0], a[1]); w.y = cvtpk_c(a[2], a[3]); return __builtin_bit_cast(s16x4, w); }
__device__ __forceinline__ f32x4 mfma16(const s16x4& a, const s16x4& b, const f32x4& c) {
    const bf16x8s a8 = {a[0], a[1], a[2], a[3], 0, 0, 0, 0}, b8 = {b[0], b[1], b[2], b[3], 0, 0, 0, 0};
    return __builtin_amdgcn_mfma_f32_16x16x32_bf16(a8, b8, c, 0, 0, 0);
}
__device__ __forceinline__ float ex2(float x) { return __builtin_amdgcn_exp2f(x); }

template <bool HG> __device__ __forceinline__ void mscan_local(const Mix& M, LAS unsigned char* wl, int unit, int lane) {
    constexpr int DK = HG ? 64 : 32, NKB = DK / 16, NKS = DK / 32;
    const int c = unit % MNCH, seq = unit / MNCH, h = seq & 3, b = (seq >> 2) % NB, dir = seq / (4 * NB);
    const int c16 = lane & 15, g = lane >> 4;
    int r0, rs; chunk_rows(b, dir, c, r0, rs);
    LAS unsigned short* QE = (LAS unsigned short*)wl; LAS unsigned short* Qm = (LAS unsigned short*)(wl + MS_MAT); LAS unsigned short* Km = (LAS unsigned short*)(wl + 2 * MS_MAT);
    LAS unsigned char* KEt = wl + MS_KE; LAS unsigned char* VT = wl + MS_VT; LAS float* dS = (LAS float*)(wl + MS_D);
    f32x4 S[NKB][4];
#pragma unroll
    for (int kb = 0; kb < NKB; ++kb)
#pragma unroll
        for (int vb = 0; vb < 4; ++vb) S[kb][vb] = (f32x4){0.f, 0.f, 0.f, 0.f};
    const float lg2 = HG ? 0.f : M.log_gamma[dir * 4 + h] * LOG2E;
    float Bc = 0.f;
    const int kq = HG ? lane : (lane & 31), th = HG ? 0 : (lane >> 5) * 8;
    const int pkq = pk64(kq);
    for (int i = 0; i < 4; ++i) {
        const int rb = r0 + rs * 16 * i;
        unsigned short vv[16];
#pragma unroll
        for (int t = 0; t < 16; ++t) vv[t] = M.P[(size_t)(rb + rs * t) * NP + (HG ? C_HI : C_RV) + h * 64 + lane];
        if (HG) {
            float lf[16], qv[16];
#pragma unroll
            for (int t = 0; t < 16; ++t) { const int row = rb + rs * t; lf[t] = M.HF[((size_t)dir * NTOK + row) * 256 + h * 64 + lane]; qv[t] = bf2f(M.P[(size_t)row * NP + C_HQ + h * 64 + lane]) * 0.125f; }
            float bt[16]; { float a = 0.f;
#pragma unroll
                for (int t = 0; t < 16; ++t) { a += lf[t]; bt[t] = a; } }
            const float r = bt[7], bl = bt[15];
            unsigned ke[8];
#pragma unroll
            for (int t = 0; t < 16; ++t) { const int row = rb + rs * t;
                const float kk = 1.0f - ex2(lf[t]), em = ex2(bt[t] - r);
                QE[t * (MS_PITCH / 2) + pkq] = f2bf(qv[t] * ex2(bt[t])); Qm[t * (MS_PITCH / 2) + pkq] = f2bf(qv[t] * em); Km[t * (MS_PITCH / 2) + pkq] = f2bf(kk * __builtin_amdgcn_rcpf(em));
                const unsigned kev = f2bf(kk * ex2(bl - bt[t])); if (t & 1) ke[t >> 1] |= kev << 16; else ke[t >> 1] = kev;
                M.HQCb[((size_t)dir * NTOK + row) * 256 + h * 64 + lane] = f2bf(qv[t] * ex2(Bc + bt[t])); }
            *(LAS v4u*)(KEt + lane * 48) = (v4u){ke[0], ke[1], ke[2], ke[3]}; *(LAS v4u*)(KEt + lane * 48 + 16) = (v4u){ke[4], ke[5], ke[6], ke[7]};
            dS[lane] = ex2(bl); Bc += bl;
        } else {
            unsigned ke[4];
#pragma unroll
            for (int tt = 0; tt < 8; ++tt) { const int t = th + tt, row = rb + rs * t;
                const float qv = M.RQ[(size_t)row * 128 + h * 32 + kq], kv = M.RK[(size_t)row * 128 + h * 32 + kq];
                const float bt = (float)(t + 1) * lg2, em = ex2(bt - 8.0f * lg2);
                QE[t * (MS_PITCH / 2) + pkq] = f2bf(qv * ex2(bt)); Qm[t * (MS_PITCH / 2) + pkq] = f2bf(qv * em); Km[t * (MS_PITCH / 2) + pkq] = f2bf(kv * __builtin_amdgcn_rcpf(em));
                const unsigned kev = f2bf(kv * ex2(16.0f * lg2 - bt)); if (tt & 1) ke[tt >> 1] |= kev << 16; else ke[tt >> 1] = kev;
                M.RQCb[((size_t)dir * NTOK + row) * 256 + h * 64 + kq] = f2bf(qv * ex2((float)(16 * i + t + 1) * lg2)); }
            *(LAS v4u*)(KEt + kq * 48 + (th ? 16 : 0)) = (v4u){ke[0], ke[1], ke[2], ke[3]};
        }
        { v4u w0, w1; w0.x = (unsigned)vv[0] | ((unsigned)vv[1] << 16); w0.y = (unsigned)vv[2] | ((unsigned)vv[3] << 16); w0.z = (unsigned)vv[4] | ((unsigned)vv[5] << 16); w0.w = (unsigned)vv[6] | ((unsigned)vv[7] << 16);
          w1.x = (unsigned)vv[8] | ((unsigned)vv[9] << 16); w1.y = (unsigned)vv[10] | ((unsigned)vv[11] << 16); w1.z = (unsigned)vv[12] | ((unsigned)vv[13] << 16); w1.w = (unsigned)vv[14] | ((unsigned)vv[15] << 16);
          *(LAS v4u*)(VT + lane * 48) = w0; *(LAS v4u*)(VT + lane * 48 + 16) = w1; }
        asm volatile("s_waitcnt lgkmcnt(0)" ::: "memory");
        bf16x8s qeB[NKS], qmB[NKS], kmA[NKS];
#pragma unroll
        for (int ks = 0; ks < NKS; ++ks) { const int off = c16 * MS_PITCH + 64 * ks + 16 * g;
            qeB[ks] = *(const LAS bf16x8s*)(wl + off); qmB[ks] = *(const LAS bf16x8s*)(wl + MS_MAT + off); kmA[ks] = *(const LAS bf16x8s*)(wl + 2 * MS_MAT + off); }
        s16x4 vt[4];
#pragma unroll
        for (int vb = 0; vb < 4; ++vb) vt[vb] = *(const LAS s16x4*)(VT + (16 * vb + c16) * 48 + 8 * g);
        f32x4 at = (f32x4){0.f, 0.f, 0.f, 0.f};
#pragma unroll
        for (int ks = 0; ks < NKS; ++ks) at = __builtin_amdgcn_mfma_f32_16x16x32_bf16(kmA[ks], qmB[ks], at, 0, 0, 0);
#pragma unroll
        for (int r = 0; r < 4; ++r) if (4 * g + r > c16) at[r] = 0.f;
        const s16x4 atB = pack4(at);
#pragma unroll
        for (int vb = 0; vb < 4; ++vb) {
            f32x4 o = (f32x4){0.f, 0.f, 0.f, 0.f};
#pragma unroll
            for (int ks = 0; ks < NKS; ++ks) o = __builtin_amdgcn_mfma_f32_16x16x32_bf16(pack8(S[2 * ks][vb], S[2 * ks + 1][vb]), qeB[ks], o, 0, 0, 0);
            o = mfma16(vt[vb], atB, o);
            *(f32x4*)((HG ? M.HO : M.RO) + ((size_t)dir * NTOK + (rb + rs * c16)) * 256 + h * 64 + 16 * vb + 4 * g) = o;
        }
#pragma unroll
        for (int kb = 0; kb < NKB; ++kb) {
            f32x4 d4; if (HG) d4 = *(const LAS f32x4*)(dS + 16 * kb + 4 * g); else { const float dd = ex2(16.0f * lg2); d4 = (f32x4){dd, dd, dd, dd}; }
            const s16x4 keA = *(const LAS s16x4*)(KEt + (16 * kb + c16) * 48 + 8 * g);
#pragma unroll
            for (int vb = 0; vb < 4; ++vb) S[kb][vb] = mfma16(keA, vt[vb], S[kb][vb] * d4);
        }
        asm volatile("s_waitcnt lgkmcnt(0)" ::: "memory");
    }
    float* st = (HG ? M.HU : M.RU) + ((size_t)seq * MNCH + c) * (64 * DK);
#pragma unroll
    for (int kb = 0; kb < NKB; ++kb)
#pragma unroll
        for (int vb = 0; vb < 4; ++vb) *(f32x4*)(st + (16 * vb + c16) * DK + 16 * kb + 4 * g) = S[kb][vb];
    if (HG) M.HDK[((size_t)seq * MNCH + c) * 64 + lane] = ex2(Bc);
}
__device__ __forceinline__ void mscan_carry_hg(const Mix& M, int item) {
    const int e = item & 4095, seq = item >> 12, k = e & 63; float s = 0.f;
#pragma unroll 12
    for (int c = 0; c < MNCH; ++c) { float* u = M.HU + ((size_t)seq * MNCH + c) * 4096 + e; const float uu = *u; *u = s; s = M.HDK[((size_t)seq * MNCH + c) * 64 + k] * s + uu; }
}
__device__ __forceinline__ void mscan_carry_ret(const Mix& M, int item) {
    const int e = item & 2047, seq = item >> 11, h = seq & 3, dir = seq / (4 * NB); float s = 0.f;
    const float d = ex2((float)MCH * M.log_gamma[dir * 4 + h] * LOG2E);
#pragma unroll 12
    for (int c = 0; c < MNCH; ++c) { float* u = M.RU + ((size_t)seq * MNCH + c) * 2048 + e; const float uu = *u; *u = s; s = d * s + uu; }
}
template <bool HG> __device__ __forceinline__ void mscan_fixfin(const Mix& M, int unit, int lane, bool with_ctx) {
    constexpr int DK = HG ? 64 : 32, NKS = DK / 32;
    const int T = unit % MNCH, bh = unit / MNCH, h = bh & 3, b = bh >> 2;
    if (T < NC / MCH && !with_ctx) return;
    const int c16 = lane & 15, g = lane >> 4;
    const int cb = T < 4 ? 3 - T : 39 - T;
    const float* HOp = HG ? M.HO : M.RO; const bf16* QCp = HG ? M.HQCb : M.RQCb; const float* STp = HG ? M.HU : M.RU;
    bf16x8s Sf[4][NKS], Sb[4][NKS];
#pragma unroll
    for (int vb = 0; vb < 4; ++vb)
#pragma unroll
        for (int ks = 0; ks < NKS; ++ks) {
            const float* pf = STp + ((size_t)((0 * NB + b) * 4 + h) * MNCH + T) * (64 * DK) + (16 * vb + c16) * DK + 32 * ks + 8 * g;
            const float* pb = STp + ((size_t)((1 * NB + b) * 4 + h) * MNCH + cb) * (64 * DK) + (16 * vb + c16) * DK + 32 * ks + 8 * g;
            Sf[vb][ks] = pack8(*(const f32x4*)pf, *(const f32x4*)(pf + 4)); Sb[vb][ks] = pack8(*(const f32x4*)pb, *(const f32x4*)(pb + 4)); }
    f32x4 w0[4], w1[4];
#pragma unroll
    for (int vb = 0; vb < 4; ++vb) { w0[vb] = *(const f32x4*)((HG ? M.hg_norm_g : M.gn_g) + h * 64 + 16 * vb + 4 * g); w1[vb] = HG ? (f32x4){0.f, 0.f, 0.f, 0.f} : *(const f32x4*)(M.gn_b + h * 64 + 16 * vb + 4 * g); }
    const int row0 = row_of(b, MCH * T);
    for (int i = 0; i < 4; ++i) {
        const int row = row0 + 16 * i + c16;
        bf16x8s qf[NKS], qb[NKS];
#pragma unroll
        for (int ks = 0; ks < NKS; ++ks) { qf[ks] = *(const bf16x8s*)(QCp + ((size_t)0 * NTOK + row) * 256 + h * 64 + 32 * ks + 8 * g); qb[ks] = *(const bf16x8s*)(QCp + ((size_t)1 * NTOK + row) * 256 + h * 64 + 32 * ks + 8 * g); }
        f32x4 o[4]; v2u gt[4];
#pragma unroll
        for (int vb = 0; vb < 4; ++vb) { o[vb] = *(const f32x4*)(HOp + ((size_t)0 * NTOK + row) * 256 + h * 64 + 16 * vb + 4 * g) + *(const f32x4*)(HOp + ((size_t)1 * NTOK + row) * 256 + h * 64 + 16 * vb + 4 * g);
            gt[vb] = *(const v2u*)(M.P + (size_t)row * NP + (HG ? C_HG : C_RG) + h * 64 + 16 * vb + 4 * g); }
#pragma unroll
        for (int vb = 0; vb < 4; ++vb)
#pragma unroll
            for (int ks = 0; ks < NKS; ++ks) { o[vb] = __builtin_amdgcn_mfma_f32_16x16x32_bf16(Sf[vb][ks], qf[ks], o[vb], 0, 0, 0); o[vb] = __builtin_amdgcn_mfma_f32_16x16x32_bf16(Sb[vb][ks], qb[ks], o[vb], 0, 0, 0); }
        float s1 = 0.f, s2 = 0.f;
#pragma unroll
        for (int vb = 0; vb < 4; ++vb)
#pragma unroll
            for (int r = 0; r < 4; ++r) { s1 += o[vb][r]; s2 += o[vb][r] * o[vb][r]; }
        s1 += __int_as_float(__builtin_amdgcn_ds_bpermute((lane ^ 16) << 2, __float_as_int(s1))); s2 += __int_as_float(__builtin_amdgcn_ds_bpermute((lane ^ 16) << 2, __float_as_int(s2)));
        s1 += __int_as_float(__builtin_amdgcn_ds_bpermute((lane ^ 32) << 2, __float_as_int(s1))); s2 += __int_as_float(__builtin_amdgcn_ds_bpermute((lane ^ 32) << 2, __float_as_int(s2)));
        const float mu = HG ? 0.f : s1 * (1.0f / 64.0f);
        const float var = HG ? s2 * (1.0f / 64.0f) : fmaxf(s2 * (1.0f / 64.0f) - mu * mu, 0.f);
        const float rstd = 1.0f / sqrtf(var + NORM_EPS);
#pragma unroll
        for (int vb = 0; vb < 4; ++vb) { float y[4];
            const float gv[4] = {bfl(gt[vb].x), bfh(gt[vb].x), bfl(gt[vb].y), bfh(gt[vb].y)};
#pragma unroll
            for (int r = 0; r < 4; ++r) y[r] = ((o[vb][r] - mu) * rstd * w0[vb][r] + w1[vb][r]) * silu_f(gv[r]);
            v2u w; w.x = cvtpk_c(y[0], y[1]); w.y = cvtpk_c(y[2], y[3]);
            *(v2u*)(M.OC + (size_t)row * D + (HG ? 256 : 768) + h * 64 + 16 * vb + 4 * g) = w; }
    }
}
template <int KIND> __device__ __forceinline__ void norm_phase(Frame& F, int l) {
    unsigned char* ws = F.base();
    const bool combine = (KIND != 1) && l > 0 && ((l - 1) & 1);
    const bool first = (KIND == 0 && l == 0);
    const int nrows = (KIND == 2 || (KIND == 1 && l == DEPTH - 1)) ? NLAT : NTOK;
    const float* modl = F_sm + SM_MOD + (size_t)(KIND == 2 ? 0 : l) * 9 * 6144;
    const float* modp = F_sm + SM_MOD + (size_t)(l > 0 ? l - 1 : 0) * 9 * 6144;
    const int* offs = (const int*)(F_sm + SM_META) + ((l > 0 ? l - 1 : 0) >> 1) * 16;
    const float* gain = KIND == 0 ? IN(6) + l * D : (KIND == 1 ? IN(7) + l * D : IN(27));
    for (int row = F.gw; row < nrows; row += F.NGW) {
        const int bidx = row < NLAT ? row / NL : NB;
        const float* src = first ? (row < NLAT ? IN(0) + (size_t)row * D : IN(2) + (size_t)(row - NLAT) * D) : F_H + (size_t)row * D;
        f32x4 v[4];
#pragma unroll
        for (int j = 0; j < 4; ++j) v[j] = *(const f32x4*)(src + 4 * F.lane + 256 * j);
        if (combine) {
            const int* ti = F_tokinfo + (size_t)row * 8;
            const int e1 = ti[0], p1 = ti[1], e2 = ti[3], p2 = ti[4]; const float w1 = __int_as_float(ti[2]), w2 = __int_as_float(ti[5]);
            const bf16* y1 = F_Y + (size_t)(offs[e1] + p1) * D; const bf16* y2 = F_Y + (size_t)(offs[e2] + p2) * D;
#pragma unroll
            for (int j = 0; j < 4; ++j) { const int col = 4 * F.lane + 256 * j;
                const f32x4 gf = *(const f32x4*)(modp + (size_t)bidx * 6144 + 5 * 1024 + col);
                const v2u a = *(const v2u*)(y1 + col), b = *(const v2u*)(y2 + col);
                f32x4 ya, yb; ya[0] = bf2f((bf16)(a.x & 0xffff)); ya[1] = bf2f((bf16)(a.x >> 16)); ya[2] = bf2f((bf16)(a.y & 0xffff)); ya[3] = bf2f((bf16)(a.y >> 16));
                yb[0] = bf2f((bf16)(b.x & 0xffff)); yb[1] = bf2f((bf16)(b.x >> 16)); yb[2] = bf2f((bf16)(b.y & 0xffff)); yb[3] = bf2f((bf16)(b.y >> 16));
                v[j] = v[j] + gf * (ya * w1 + yb * w2); }
        }
        if (combine || first) {
#pragma unroll
            for (int j = 0; j < 4; ++j) *(f32x4*)(F_H + (size_t)row * D + 4 * F.lane + 256 * j) = v[j];
        }
        float ss = 0.f;
#pragma unroll
        for (int j = 0; j < 4; ++j) ss += (v[j][0] * v[j][0] + v[j][1] * v[j][1]) + (v[j][2] * v[j][2] + v[j][3] * v[j][3]);
        const float rstd = 1.0f / sqrtf(wave_sum(ss, F.lane) * (1.0f / D) + NORM_EPS);
        if (KIND == 2) {
#pragma unroll
            for (int j = 0; j < 4; ++j) { const int col = 4 * F.lane + 256 * j; const f32x4 g = *(const f32x4*)(gain + col); *(f32x4*)(OUTP() + (size_t)row * D + col) = v[j] * rstd * g; }
            continue;
        }
        const float* mrow = modl + (size_t)bidx * 6144 + (KIND == 0 ? 0 : 3 * 1024);
#pragma unroll
        for (int j = 0; j < 4; ++j) { const int col = 4 * F.lane + 256 * j;
            const f32x4 g = *(const f32x4*)(gain + col), sh = *(const f32x4*)(mrow + col), sc = *(const f32x4*)(mrow + 1024 + col);
            v[j] = v[j] * rstd * g * (sc + 1.0f) + sh;
            v2u o; o.x = pk2(v[j][0], v[j][1]); o.y = pk2(v[j][2], v[j][3]);
            *(v2u*)(F_A + (size_t)row * D + col) = o; }
        if (KIND == 1 && (l & 1)) {
            const int li = l >> 1; const float* wr = IN(23) + (size_t)li * D * 8;
            float lg[8];
#pragma unroll
            for (int e = 0; e < 8; ++e) lg[e] = 0.f;
#pragma unroll
            for (int j = 0; j < 4; ++j)
#pragma unroll
                for (int i = 0; i < 4; ++i) { const int col = 4 * F.lane + 256 * j + i; const f32x4 w0 = *(const f32x4*)(wr + (size_t)col * 8), w1 = *(const f32x4*)(wr + (size_t)col * 8 + 4);
#pragma unroll
                    for (int e = 0; e < 4; ++e) { lg[e] += v[j][i] * w0[e]; lg[4 + e] += v[j][i] * w1[e]; } }
#pragma unroll
            for (int e = 0; e < 8; ++e) lg[e] = wave_sum(lg[e], F.lane);
            int e1 = 0; float v1 = lg[0];
#pragma unroll
            for (int e = 1; e < 8; ++e) if (lg[e] > v1) { v1 = lg[e]; e1 = e; }
            int e2 = -1; float v2 = -3.0e38f;
#pragma unroll
            for (int e = 0; e < 8; ++e) if (e != e1 && lg[e] > v2) { v2 = lg[e]; e2 = e; }
            if (F.lane == 0) {
                const float w2 = 1.0f / (1.0f + expf(v1 - v2)), w1 = 1.0f - w2;
                const int p1 = (int)atomicAdd(F_ctl + CW_CNT + li * 8 + e1, 1u), p2 = (int)atomicAdd(F_ctl + CW_CNT + li * 8 + e2, 1u);
                F_list[(size_t)e1 * NTOK + p1] = row; F_list[(size_t)e2 * NTOK + p2] = row;
                int* ti = F_tokinfo + (size_t)row * 8; ti[0] = e1; ti[1] = p1; ti[2] = __float_as_int(w1); ti[3] = e2; ti[4] = p2; ti[5] = __float_as_int(w2);
            }
        }
    }
}
__device__ __forceinline__ void moe_tiles(Frame& F, int li, int (&tb)[9], int (&cnt)[8]) {
    unsigned char* ws = F.base();
    tb[0] = 0;
#pragma unroll
    for (int e = 0; e < 8; ++e) { cnt[e] = (int)__hip_atomic_load(F_ctl + CW_CNT + li * 8 + e, __ATOMIC_RELAXED, __HIP_MEMORY_SCOPE_AGENT); tb[e + 1] = tb[e] + ((cnt[e] + 255) >> 8); }
}
__device__ __forceinline__ void moe_gather(Frame& F, int li) {
    unsigned char* ws = F.base();
    int tb[9], cnt[8]; moe_tiles(F, li, tb, cnt);
    if (blockIdx.x == 0 && F.tid < 9) { int* meta = (int*)(F_sm + SM_META) + li * 16; int val = 0;
#pragma unroll
        for (int e = 0; e < 9; ++e) if (F.tid == e) val = tb[e] * 256;
        meta[F.tid] = val; }
    { const int T = tb[8]; unsigned* ul = (unsigned*)(F_sm + SM_ULIST) + li * (MAXTILES * 32);
      for (int L = F.gtid; L < T * 32; L += F.NT) {
          const bool gu = L < T * 28; const int nN = gu ? 28 : 4, nwg = T * nN; int wgid = gu ? L : L - T * 28;
          { const int q = nwg / 8, r = nwg % 8, xcd = wgid % 8, off = wgid / 8; wgid = (xcd < r ? xcd * (q + 1) : r * (q + 1) + (xcd - r) * q) + off; }
          const int nig = 8 * nN, gid = wgid / nig, fm = gid * 8, gsz = (T - fm) < 8 ? (T - fm) : 8;
          const int pm = fm + ((wgid % nig) % gsz), pnl = (wgid % nig) / gsz; int e = 0;
#pragma unroll
          for (int j = 1; j < 8; ++j) e += (pm >= tb[j]) ? 1 : 0;
          ul[(gu ? ULIST_GU : ULIST_D) + (gu ? L : L - T * 28)] = (unsigned)pm | ((unsigned)(e * nN + pnl) << 16);
      } }
    const int nslot = tb[8] * 256;
    for (int s = F.gw; s < nslot; s += F.NGW) {
        const int tile = s >> 8; int e = 0, base = 0, c = 0;
#pragma unroll
        for (int j = 0; j < 8; ++j) if (tile >= tb[j] && tile < tb[j + 1]) { e = j; base = tb[j] * 256; c = cnt[j]; }
        const int pos = s - base; const int tok = pos < c ? F_list[(size_t)e * NTOK + pos] : -1;
        v4u a = (v4u){0u, 0u, 0u, 0u}, b = a;
        if (tok >= 0) { const v4u* sp = (const v4u*)(F_A + (size_t)tok * D); a = sp[F.lane]; b = sp[64 + F.lane]; }
        v4u* dp = (v4u*)(F_AM + (size_t)s * D); dp[F.lane] = a; dp[64 + F.lane] = b;
    }
}

#ifndef MK_PER_PHASE
#define MK_PER_PHASE 0
#endif
#ifndef PROBE
#define PROBE 0
#endif
__device__ __forceinline__ void make_mix(Mix& M, unsigned char* ws, int l) {
    M.P = F_P; M.Qm = WSP(bf16, WS_QM); M.Km = WSP(bf16, WS_KM); M.Vm = WSP(bf16, WS_VM); M.Qs = WSP(bf16, WS_QS); M.Ks = WSP(bf16, WS_KS); M.Vs = WSP(bf16, WS_VS);
    M.HF = WSP(float, WS_HF); M.HO = WSP(float, WS_HO); M.RQ = WSP(float, WS_RQ); M.RK = WSP(float, WS_RK); M.RO = WSP(float, WS_RO); M.OC = F_OC;
    M.HU = WSP(float, WS_HU); M.HDK = WSP(float, WS_HDK); M.HQC = WSP(float, WS_HQC); M.RU = WSP(float, WS_RU); M.RQC = WSP(float, WS_RQC); M.HQCb = WSP(bf16, WS_HQC); M.RQCb = WSP(bf16, WS_RQC);
    M.loglb = F_sm + SM_LOGLB + l * 512; M.log1mlb = F_sm + SM_LOG1M + l * 512; M.hg_norm_g = IN(15) + l * 256; M.sink = IN(16) + l * 4; M.log_gamma = F_sm + SM_LGAM + l * 8;
    M.gn_g = IN(18) + l * 256; M.gn_b = IN(19) + l * 256;
}
__device__ __forceinline__ void frame_init(Frame& F, LAS unsigned char* lds, int wave_s) {
    unsigned z = 0u; asm volatile("" : "+v"(z)); int t = (int)__builtin_amdgcn_mbcnt_hi(~0u, __builtin_amdgcn_mbcnt_lo(~0u, z)); t += wave_s * 64;
    F.lds = lds; F.tid = t; F.lane = t & 63; F.wave = wave_s;
    F.gtid = blockIdx.x * NTHREADS + t; F.NT = gridDim.x * NTHREADS; { int gw_ = blockIdx.x * NWAVES + wave_s; asm volatile("" : "+s"(gw_)); F.gw = gw_; } F.NGW = gridDim.x * NWAVES;
}
__global__ void __launch_bounds__(NTHREADS, 2) fwd_kernel(Args args) {
    extern __shared__ __attribute__((aligned(16))) unsigned char lds[];
    const int wave_s = __builtin_amdgcn_readfirstlane((int)threadIdx.x >> 6);
    volatile LAS unsigned* MISC = (volatile LAS unsigned*)((LAS unsigned char*)lds + MISC_OFF);
    for (int u = threadIdx.x; u < (LDS_BYTES - 131072) / 4; u += NTHREADS) ((LAS unsigned*)((LAS unsigned char*)lds + 131072))[u] = 0u;
    __syncthreads();
    const int lo = args.ph_lo, hi = args.ph_hi;
    XcdBarrier bar; bar.w = wave_s; bar.bar = (unsigned*)(WSBASE() + WS_CTL) + CW_BAR; bar.x = 0; bar.st = nullptr;
    if (hi - lo > 1) bar = xcd_barrier_post((unsigned*)(WSBASE() + WS_CTL) + CW_BAR, MISC + 8, wave_s);
    int p = 0;
#ifndef PHMASK
#define PHMASK 0xffffffffu
#endif
#define PH_BEGIN_(k) if (((PHMASK >> (k)) & 1u) && p >= lo && p < hi) { Frame F; frame_init(F, (LAS unsigned char*)lds, wave_s); unsigned char* ws = F.base();
#define PH_END if (p + 1 < hi) xcd_barrier(bar); } ++p;

    PH_BEGIN_(0) (void)ws; prologue(F); PH_END

    for (int l = 0; l < DEPTH; ++l) {
        PH_BEGIN_(1) (void)ws; norm_phase<0>(F, l); if (l == 2) convert_moe(F, 1); PH_END
        PH_BEGIN_(2) { pg8::Gemm g{F_A, F_WIN + (size_t)l * NP * D, NTOK, NP, D}; pg8::StaticOrder S; S.init(NTOK, NP, gridDim.x, blockIdx.x);
                   pg8::EpiBf16P E{F_P, NP, NP / 256}; pg8::gemm_phase<pg8::EpiBf16P, pg8::StaticOrder, true, true>(F.lds, g, S, E, F.tid); } PH_END
#ifndef NO_MIX
        PH_BEGIN_(3) { Mix M; make_mix(M, ws, l); const float* tab = WSP(float, WS_TAB);
            for (int row = F.gw; row < NTOK; row += 2 * F.NGW) {
                PrepRegs Ra, Rb; const int r2 = row + F.NGW, r2c = r2 < NTOK ? r2 : row;
                prep_load(Ra, M.P + (size_t)row * NP, F.lane); prep_load(Rb, M.P + (size_t)r2c * NP, F.lane);
                prep_compute(M, tab, Ra, row, F.lane);
                if (r2 < NTOK) prep_compute(M, tab, Rb, r2, F.lane);
            }
            for (int g8 = F.gw; g8 < NTOK / 8; g8 += F.NGW) prep_vt(M, g8, F.lane); }
        PH_END
        PH_BEGIN_(4) { Mix M; make_mix(M, ws, l);
            attn_phase(F.lds, M, M.sink, l < DEPTH - 1, F.tid);
#if PROBE == 7
            attn_phase(F.lds, M, M.sink, l < DEPTH - 1, F.tid);
#endif
            { LAS unsigned char* wl = F.lds + F.wave * 13312;
              for (int u = F.gw; u < 2 * NB * 4 * MNCH; u += F.NGW) mscan_local<true>(M, wl, u, F.lane);
              for (int u = (F.gw + F.NGW / 2) % F.NGW; u < 2 * NB * 4 * MNCH; u += F.NGW) mscan_local<false>(M, wl, u, F.lane); } }
        PH_END
        PH_BEGIN_(14) { Mix M; make_mix(M, ws, l);
            for (int it = F.gtid; it < 2 * NB * 4 * 4096; it += F.NT) mscan_carry_hg(M, it);
            for (int it = F.gtid; it < 2 * NB * 4 * 2048; it += F.NT) mscan_carry_ret(M, it); }
        PH_END
        PH_BEGIN_(15) { Mix M; make_mix(M, ws, l);
            for (int u = F.gw; u < NB * 4 * MNCH; u += F.NGW) mscan_fixfin<true>(M, u, F.lane, l < DEPTH - 1);
            for (int u = (F.gw + F.NGW - 896) % F.NGW; u < NB * 4 * MNCH; u += F.NGW) mscan_fixfin<false>(M, u, F.lane, l < DEPTH - 1); }
        PH_END
#endif
        PH_BEGIN_(6) { const int Mr = l < DEPTH - 1 ? NTOK : NLAT; pg8::Gemm g{F_OC, F_WOUT + (size_t)l * D * D, Mr, D, D}; pg8::StaticOrder S; S.init(Mr, D, gridDim.x, blockIdx.x);
                   pg8::EpiRes E{F_H, F_sm + SM_MOD + (size_t)l * 9 * 6144 + 2 * 1024, NLAT / 256, NL / 256, NB}; pg8::gemm_phase<pg8::EpiRes, pg8::StaticOrder, true, true>(F.lds, g, S, E, F.tid); } PH_END
        PH_BEGIN_(7) (void)ws; norm_phase<1>(F, l); PH_END
        if ((l & 1) == 0) {
            const int li = l >> 1;
            PH_BEGIN_(8) { pg8::Gemm g{F_A, F_WFGU + (size_t)li * 2 * DFF * D, NTOK, 2 * DFF, D}; pg8::StaticOrder S; S.init(NTOK, 2 * DFF, gridDim.x, blockIdx.x);
                       pg8::EpiSwiglu E{F_ACT, DFF, 2 * DFF / 256}; pg8::gemm_phase<pg8::EpiSwiglu, pg8::StaticOrder, true, true>(F.lds, g, S, E, F.tid); } PH_END
            PH_BEGIN_(9) { pg8::Gemm g{F_ACT, F_WFD + (size_t)li * D * DFF, NTOK, D, DFF}; pg8::StaticOrder S; S.init(NTOK, D, gridDim.x, blockIdx.x);
                       pg8::EpiRes E{F_H, F_sm + SM_MOD + (size_t)l * 9 * 6144 + 5 * 1024, NLAT / 256, NL / 256, NB}; pg8::gemm_phase<pg8::EpiRes, pg8::StaticOrder, true, true>(F.lds, g, S, E, F.tid); } PH_END
        } else {
            const int li = l >> 1;
            PH_BEGIN_(10) (void)ws; moe_gather(F, li); PH_END
            PH_BEGIN_(11) { const int T = __builtin_amdgcn_readfirstlane((int)__hip_atomic_load((unsigned*)(F_sm + SM_META) + li * 16 + 8, __ATOMIC_RELAXED, __HIP_MEMORY_SCOPE_AGENT)) >> 8;
                       pg8::MoeOrder S; S.list = (const unsigned*)(F_sm + SM_ULIST) + li * (MAXTILES * 32) + ULIST_GU; S.nwg = T * (2 * DFE / 256); S.G = gridDim.x; S.c = blockIdx.x;
                       pg8::Gemm g{F_AM, F_WMGU, MAXTILES * 256, 8 * 2 * DFE, D};
                       pg8::EpiSwiglu E{F_ACT, DFE, 2 * DFE / 256}; pg8::gemm_phase<pg8::EpiSwiglu, pg8::MoeOrder, true, true>(F.lds, g, S, E, F.tid); } PH_END
            PH_BEGIN_(12) { const int T = __builtin_amdgcn_readfirstlane((int)__hip_atomic_load((unsigned*)(F_sm + SM_META) + li * 16 + 8, __ATOMIC_RELAXED, __HIP_MEMORY_SCOPE_AGENT)) >> 8;
                       pg8::MoeOrder S; S.list = (const unsigned*)(F_sm + SM_ULIST) + li * (MAXTILES * 32) + ULIST_D; S.nwg = T * (D / 256); S.G = gridDim.x; S.c = blockIdx.x;
                       pg8::Gemm g{F_ACT, F_WMD, MAXTILES * 256, 8 * D, DFE};
                       pg8::EpiBf16P E{F_Y, D, D / 256}; pg8::gemm_phase<pg8::EpiBf16P, pg8::MoeOrder, true, true>(F.lds, g, S, E, F.tid); } PH_END
        }
    }
    PH_BEGIN_(13) (void)ws; norm_phase<2>(F, DEPTH); PH_END
#undef PH_BEGIN_
#undef PH_END
}
constexpr int NPHASES = 1 + 2 * 10 + 2 * 11 + 1;


extern "C" void kernel_launch(void* const* d_in, const int* in_sizes, int n_in, void* d_out, int out_size, void* d_ws, size_t ws_size, hipStream_t stream) {
    static int grid = 0;
    if (grid == 0) {
        if (n_in != 28 || ws_size < WS_END || out_size != NLAT * D) { fprintf(stderr, "kernel_launch: unexpected problem shape (n_in %d, ws %zu, out %d)\n", n_in, ws_size, out_size); grid = -1; return; }
        int dev = 0, cus = 0;
        if (hipGetDevice(&dev) != hipSuccess || hipDeviceGetAttribute(&cus, hipDeviceAttributeMultiprocessorCount, dev) != hipSuccess) { grid = -1; return; }
        if (hipFuncSetAttribute((const void*)fwd_kernel, hipFuncAttributeMaxDynamicSharedMemorySize, LDS_BYTES) != hipSuccess) { fprintf(stderr, "kernel_launch: hipFuncSetAttribute failed\n"); grid = -1; return; }
        int per_cu = 0;
        if (hipOccupancyMaxActiveBlocksPerMultiprocessor(&per_cu, (const void*)fwd_kernel, NTHREADS, LDS_BYTES) != hipSuccess || per_cu < 1) { fprintf(stderr, "kernel_launch: occupancy query says %d\n", per_cu); }
        (void)hipGetLastError();
        grid = cus;
    }
    if (grid < 0) return;
    (void)hipMemsetAsync((char*)d_ws + WS_CTL, 0, CTL_ZERO_BYTES, stream);
    Args a{};
    for (int i = 0; i < 28; ++i) a.in[i] = (const float*)d_in[i];
    a.out = (float*)d_out; a.ws = (unsigned char*)d_ws;
#if MK_PER_PHASE
    for (int p = 0; p < NPHASES; ++p) { a.ph_lo = p; a.ph_hi = p + 1; hipLaunchKernelGGL(fwd_kernel, dim3(grid), dim3(NTHREADS), LDS_BYTES, stream, a);
        int l = -1, k = -1; const int base[4] = {1, 11, 22, 32}; for (int i = 0; i < 4; ++i) if (p >= base[i] && p < base[i] + (i & 1 ? 11 : 10)) { l = i; k = p - base[i]; }
        bool dup = false;
#if PROBE == 1
        dup = (p == 0);
#elif PROBE == 2
        dup = (k == 2);
#elif PROBE == 3
        dup = (k == 3);
#elif PROBE == 4
        dup = (k == 5);
#elif PROBE == 5
        dup = (k == 1);
#elif PROBE == 6
        dup = (k == 8) || ((l & 1) && (k == 9 || k == 10));
#endif
        if (dup) hipLaunchKernelGGL(fwd_kernel, dim3(grid), dim3(NTHREADS), LDS_BYTES, stream, a); }
#else
    a.ph_lo = 0; a.ph_hi = NPHASES; hipLaunchKernelGGL(fwd_kernel, dim3(grid), dim3(NTHREADS), LDS_BYTES, stream, a);
#endif
}
```

```cpp
#include <hip/hip_runtime.h>
#include <cstdio>
#include <cstdint>
#include <cmath>
#ifndef NB
#define NB 8
#endif
constexpr int D = 1024, NL = 2048, NC = 256, TK = NL + NC, DEPTH = 4, GRIDW = 64;
constexpr int NLAT = NB * NL, NCTX = NB * NC, NTOK = NLAT + NCTX;
constexpr int NP = 3840;
constexpr int DIN = 2912;
constexpr int C_QLAT = 0, C_KVLAT = 192, C_KPE = 320, C_HQ = 352, C_HZF = 608, C_HZB = 864, C_HI = 1120, C_HG = 1376;
constexpr int C_SQ = 1632, C_SK = 1888, C_SV = 2016, C_RQ = 2144, C_RK = 2272, C_RV = 2400, C_RG = 2656, C_QE = 2912, C_KVE = 3296;
constexpr int DFF = 2816, NEXP = 8, DFE = 3584;
constexpr float NORM_EPS = 1e-6f, LOG2E = 1.4426950408889634f;
typedef unsigned short bf16;

#ifdef HOST_TEST
#define HD static inline
#else
#define HD __host__ __device__ __forceinline__
#endif

HD float bf2f(bf16 b) { unsigned u = ((unsigned)b) << 16; float f; __builtin_memcpy(&f, &u, 4); return f; }
HD bf16 f2bf(float f) { unsigned u; __builtin_memcpy(&u, &f, 4); return (bf16)((u + 0x7fffu + ((u >> 16) & 1u)) >> 16); }
#define CBAR() asm volatile("" ::: "memory")
struct U4 { unsigned x, y, z, w; };
HD void ld8(const bf16* p, float (&f)[8]) {
    U4 u; __builtin_memcpy(&u, __builtin_assume_aligned(p, 16), 16);
    unsigned t;
    t = u.x << 16; __builtin_memcpy(&f[0], &t, 4); t = u.x & 0xffff0000u; __builtin_memcpy(&f[1], &t, 4);
    t = u.y << 16; __builtin_memcpy(&f[2], &t, 4); t = u.y & 0xffff0000u; __builtin_memcpy(&f[3], &t, 4);
    t = u.z << 16; __builtin_memcpy(&f[4], &t, 4); t = u.z & 0xffff0000u; __builtin_memcpy(&f[5], &t, 4);
    t = u.w << 16; __builtin_memcpy(&f[6], &t, 4); t = u.w & 0xffff0000u; __builtin_memcpy(&f[7], &t, 4);
}
HD void ld4f(const float* p, float (&f)[4]) { __builtin_memcpy(&f[0], __builtin_assume_aligned(p, 16), 16); }
HD float silu_f(float x) { return x / (1.0f + expf(-x)); }
HD int row_of(int b, int tq) { return tq < NC ? NLAT + b * NC + tq : b * NL + (tq - NC); }
HD void row_split(int row, int& b, int& tq) { if (row < NLAT) { b = row / NL; tq = NC + row % NL; } else { const int r = row - NLAT; b = r / NC; tq = r % NC; } }
HD float log_sigmoid_f(float x) { return fminf(x, 0.f) - log1pf(expf(-fabsf(x))); }

struct Mix {
    const bf16* P;
    bf16 *Qm, *Km, *Vm;
    bf16 *Qs, *Ks, *Vs;
    float* HF;
    float* HO;
    float *RQ, *RK;
    float* RO;
    bf16* OC;
    const float *loglb, *log1mlb;
    const float* hg_norm_g;
    const float* sink;
    const float* log_gamma;
    const float *gn_g, *gn_b;
    float *HU, *HDK, *HQC;
    float *RU, *RQC;
    bf16 *HQCb, *RQCb;
};
constexpr int CH = 72, NCH = TK / CH;
static_assert(NCH * CH == TK, "chunking");

HD void mla_prep_item(const Mix& M, int item) {
    const int row = item >> 2, h = item & 3; int b, tq; row_split(row, b, tq);
    const bf16* p = M.P + (size_t)row * NP;
    float sq = 0.f, skv = 0.f;
    for (int j = 0; j < 192; ++j) { const float v = bf2f(p[C_QLAT + j]); sq += v * v; }
    for (int j = 0; j < 128; ++j) { const float v = bf2f(p[C_KVLAT + j]); skv += v * v; }
    const float rq = 1.0f / sqrtf(sq * (1.0f / 192.0f) + NORM_EPS), rkv = 1.0f / sqrtf(skv * (1.0f / 128.0f) + NORM_EPS);
    const float qs = rq * 0.10206207261596575f * LOG2E;
    const size_t o96 = ((size_t)(b * 4 + h) * TK + tq) * 96;
    for (int j = 0; j < 64; ++j) {
        M.Qm[o96 + j] = f2bf(bf2f(p[C_QE + h * 96 + j]) * qs);
        M.Km[o96 + j] = f2bf(bf2f(p[C_KVE + h * 128 + j]) * rkv);
        M.Vm[((size_t)(b * 4 + h) * 64 + j) * TK + tq] = f2bf(bf2f(p[C_KVE + h * 128 + 64 + j]) * rkv);
    }
    const bool lat = tq >= NC; const int t = tq - NC;
    for (int j = 0; j < 16; ++j) {
        float c = 1.f, s = 0.f;
        if (lat) { const float inv = powf(10000.0f, -(float)(j & 7) / 8.0f); const float ang = (float)(j < 8 ? t / GRIDW : t % GRIDW) * inv; c = cosf(ang); s = sinf(ang); }
        const float q1 = bf2f(p[C_QE + h * 96 + 64 + j]), q2 = bf2f(p[C_QE + h * 96 + 80 + j]);
        M.Qm[o96 + 64 + j] = f2bf((q1 * c - q2 * s) * qs); M.Qm[o96 + 80 + j] = f2bf((q1 * s + q2 * c) * qs);
        const float k1 = bf2f(p[C_KPE + j]), k2 = bf2f(p[C_KPE + 16 + j]);
        M.Km[o96 + 64 + j] = f2bf(k1 * c - k2 * s); M.Km[o96 + 80 + j] = f2bf(k1 * s + k2 * c);
    }
}
HD void swa_prep_item(const Mix& M, int item) {
    const int row = item >> 3, s = item & 7; int b, tq; row_split(row, b, tq);
    const bf16* p = M.P + (size_t)row * NP;
    const bool lat = tq >= NC; const int t = tq - NC;
    if (s >= 6) { const int kh = s - 6; bf16* o = M.Vs + (size_t)(b * 2 + kh) * 64 * TK + tq; for (int j = 0; j < 64; ++j) o[(size_t)j * TK] = p[C_SV + kh * 64 + j]; return; }
    const bf16* src = s < 4 ? p + C_SQ + s * 64 : p + C_SK + (s - 4) * 64;
    bf16* o = s < 4 ? M.Qs + ((size_t)(b * 4 + s) * TK + tq) * 64 : M.Ks + ((size_t)(b * 2 + (s - 4)) * TK + tq) * 64;
    const float sc = s < 4 ? 0.125f * LOG2E : 1.0f;
    for (int j = 0; j < 32; ++j) {
        float c = 1.f, sn = 0.f;
        if (lat) { const float inv = powf(10000.0f, -(float)(j & 15) / 16.0f); const float ang = (float)(j < 16 ? t / GRIDW : t % GRIDW) * inv; c = cosf(ang); sn = sinf(ang); }
        const float x1 = bf2f(src[j]), x2 = bf2f(src[32 + j]);
        o[j] = f2bf((x1 * c - x2 * sn) * sc); o[32 + j] = f2bf((x1 * sn + x2 * c) * sc);
    }
}
HD void hg_prep_item(const Mix& M, int item) {
    const int row = item >> 8, c = item & 255;
    const bf16* p = M.P + (size_t)row * NP;
    for (int d = 0; d < 2; ++d) {
        const float z = bf2f(p[(d ? C_HZB : C_HZF) + c]);
        const float a = M.loglb[d * 256 + c], bb = M.log1mlb[d * 256 + c] + log_sigmoid_f(z);
        const float mx = fmaxf(a, bb), lf = mx + log1pf(expf(-fabsf(a - bb)));
        M.HF[((size_t)d * NTOK + row) * 256 + c] = expf(lf);
    }
}
HD void ret_prep_item(const Mix& M, int item) {
    const int row = item >> 3, w = (item >> 2) & 1, h = item & 3; int b, tq; row_split(row, b, tq);
    const bf16* src = M.P + (size_t)row * NP + (w ? C_RK : C_RQ) + h * 32;
    float* o = (w ? M.RK : M.RQ) + (size_t)row * 128 + h * 32;
    const float sc = w ? 1.0f : 0.17677669529663687f;
    for (int j = 0; j < 16; ++j) {
        const float inv = powf(10000.0f, -(float)j / 16.0f); const float ang = (float)tq * inv; const float c = cosf(ang), s = sinf(ang);
        const float x1 = bf2f(src[j]), x2 = bf2f(src[16 + j]);
        o[j] = (x1 * c - x2 * s) * sc; o[16 + j] = (x1 * s + x2 * c) * sc;
    }
}
HD void mla_attn_item(const Mix& M, int item) {
    const int tq = item % TK, bh = item / TK, b = bh >> 2, h = bh & 3;
    const bf16* qp = M.Qm + (size_t)item * 96;
    float q[96], o[64];
#pragma unroll
    for (int c8 = 0; c8 < 12; ++c8) { float t8[8]; ld8(qp + 8 * c8, t8);
#pragma unroll
        for (int j = 0; j < 8; ++j) q[8 * c8 + j] = t8[j]; }
#pragma unroll
    for (int j = 0; j < 64; ++j) o[j] = 0.f;
    float m = -1e30f, l = 0.f;
    const int nk = tq < NC ? NC : TK;
    const bf16* kb = M.Km + (size_t)bh * TK * 96; const bf16* vb = M.Vm + (size_t)bh * TK * 64;
    for (int k = 0; k < nk; ++k) {
        const bf16* kp = kb + (size_t)k * 96; float s = 0.f;
#pragma unroll
        for (int c8 = 0; c8 < 12; ++c8) { float t8[8]; ld8(kp + 8 * c8, t8);
#pragma unroll
            for (int j = 0; j < 8; ++j) s += q[8 * c8 + j] * t8[j];
            if ((c8 & 3) == 3) CBAR(); }
        const float mn = fmaxf(m, s), al = exp2f(m - mn), pr = exp2f(s - mn);
        l = l * al + pr; m = mn;
        const bf16* vp = vb + k;
#pragma unroll
        for (int j = 0; j < 64; ++j) o[j] = o[j] * al + pr * bf2f(vp[(size_t)j * TK]);
    }
    const float rl = 1.0f / l; bf16* op = M.OC + (size_t)row_of(b, tq) * D + h * 64;
#pragma unroll
    for (int j = 0; j < 64; ++j) op[j] = f2bf(o[j] * rl);
}
HD void swa_attn_item(const Mix& M, int item) {
    const int tq = item % TK, bh = item / TK, b = bh >> 2, hq = bh & 3, kh = hq >> 1;
    const bf16* qp = M.Qs + (size_t)item * 64;
    float q[64], o[64];
#pragma unroll
    for (int c8 = 0; c8 < 8; ++c8) { float t8[8]; ld8(qp + 8 * c8, t8);
#pragma unroll
        for (int j = 0; j < 8; ++j) { q[8 * c8 + j] = t8[j]; o[8 * c8 + j] = 0.f; } }
    float m = M.sink[hq] * LOG2E, l = 1.0f;
    const bf16* kb = M.Ks + (size_t)(b * 2 + kh) * TK * 64; const bf16* vb = M.Vs + (size_t)(b * 2 + kh) * TK * 64;
    const int t = tq - NC;
    const int lo2 = tq < NC ? 0 : (t - 128 < 0 ? 0 : t - 128), hi2 = tq < NC ? -1 : (t + 128 > NL - 1 ? NL - 1 : t + 128);
    const int n2 = hi2 - lo2 + 1;
    for (int i = 0; i < NC + n2; ++i) {
        const int k = i < NC ? i : NC + lo2 + (i - NC);
        const bf16* kp = kb + (size_t)k * 64; float s = 0.f;
#pragma unroll
        for (int c8 = 0; c8 < 8; ++c8) { float t8[8]; ld8(kp + 8 * c8, t8);
#pragma unroll
            for (int j = 0; j < 8; ++j) s += q[8 * c8 + j] * t8[j];
            if ((c8 & 3) == 3) CBAR(); }
        const float mn = fmaxf(m, s), al = exp2f(m - mn), pr = exp2f(s - mn);
        l = l * al + pr; m = mn;
        const bf16* vp = vb + k;
#pragma unroll
        for (int j = 0; j < 64; ++j) o[j] = o[j] * al + pr * bf2f(vp[(size_t)j * TK]);
    }
    const float rl = 1.0f / l; bf16* op = M.OC + (size_t)row_of(b, tq) * D + 512 + hq * 64;
#pragma unroll
    for (int j = 0; j < 64; ++j) op[j] = f2bf(o[j] * rl);
}
HD int dir_tq(int dir, int i) { return dir == 0 ? i : (i < NC ? NC - 1 - i : NC + (NL - 1 - (i - NC))); }
HD void hg_scan_item(const Mix& M, int item) {
    const int v = item & 63, h = (item >> 6) & 3, b = (item >> 8) % NB, dir = item / (256 * NB);
    float S[64];
#pragma unroll
    for (int k = 0; k < 64; ++k) S[k] = 0.f;
    for (int i = 0; i < TK; ++i) {
        const int row = row_of(b, dir_tq(dir, i));
        const bf16* p = M.P + (size_t)row * NP; const float* f = M.HF + ((size_t)dir * NTOK + row) * 256 + h * 64;
        const float vv = bf2f(p[C_HI + h * 64 + v]); float acc = 0.f;
#pragma unroll
        for (int c8 = 0; c8 < 8; ++c8) { float q8[8], fa[4], fb[4]; ld8(p + C_HQ + h * 64 + 8 * c8, q8); ld4f(f + 8 * c8, fa); ld4f(f + 8 * c8 + 4, fb);
#pragma unroll
            for (int j = 0; j < 8; ++j) { const int k = 8 * c8 + j; const float fk = j < 4 ? fa[j] : fb[j - 4]; S[k] = fk * S[k] + (1.0f - fk) * vv; acc += q8[j] * S[k]; }
            if ((c8 & 1) == 1) CBAR(); }
        M.HO[((size_t)dir * NTOK + row) * 256 + h * 64 + v] = acc * 0.125f;
    }
}
HD void ret_scan_item(const Mix& M, int item) {
    const int v = item & 63, h = (item >> 6) & 3, b = (item >> 8) % NB, dir = item / (256 * NB);
    const float g = expf(M.log_gamma[dir * 4 + h]);
    float S[32];
#pragma unroll
    for (int k = 0; k < 32; ++k) S[k] = 0.f;
    for (int i = 0; i < TK; ++i) {
        const int row = row_of(b, dir_tq(dir, i));
        const float vv = bf2f(M.P[(size_t)row * NP + C_RV + h * 64 + v]);
        const float* qk = M.RQ + (size_t)row * 128 + h * 32; const float* kk = M.RK + (size_t)row * 128 + h * 32; float acc = 0.f;
#pragma unroll
        for (int c4 = 0; c4 < 8; ++c4) { float qa[4], ka[4]; ld4f(qk + 4 * c4, qa); ld4f(kk + 4 * c4, ka);
#pragma unroll
            for (int j = 0; j < 4; ++j) { const int k = 4 * c4 + j; S[k] = g * S[k] + ka[j] * vv; acc += qa[j] * S[k]; }
            if ((c4 & 3) == 3) CBAR(); }
        M.RO[((size_t)dir * NTOK + row) * 256 + h * 64 + v] = acc;
    }
}
HD void hg_fin_item(const Mix& M, int item) {
    const int row = item >> 2, h = item & 3;
    const float* o0 = M.HO + (size_t)row * 256 + h * 64; const float* o1 = o0 + (size_t)NTOK * 256;
    float ss = 0.f;
    for (int v = 0; v < 64; ++v) { const float x = o0[v] + o1[v]; ss += x * x; }
    const float r = 1.0f / sqrtf(ss * (1.0f / 64.0f) + NORM_EPS);
    const bf16* gp = M.P + (size_t)row * NP + C_HG + h * 64; bf16* op = M.OC + (size_t)row * D + 256 + h * 64;
    for (int v = 0; v < 64; ++v) op[v] = f2bf((o0[v] + o1[v]) * r * M.hg_norm_g[h * 64 + v] * silu_f(bf2f(gp[v])));
}
HD void ret_fin_item(const Mix& M, int item) {
    const int row = item >> 2, h = item & 3;
    const float* o0 = M.RO + (size_t)row * 256 + h * 64; const float* o1 = o0 + (size_t)NTOK * 256;
    float s = 0.f;
    for (int v = 0; v < 64; ++v) s += o0[v] + o1[v];
    const float mu = s * (1.0f / 64.0f); float q = 0.f;
    for (int v = 0; v < 64; ++v) { const float d = o0[v] + o1[v] - mu; q += d * d; }
    const float r = 1.0f / sqrtf(q * (1.0f / 64.0f) + NORM_EPS);
    const bf16* gp = M.P + (size_t)row * NP + C_RG + h * 64; bf16* op = M.OC + (size_t)row * D + 768 + h * 64;
    for (int v = 0; v < 64; ++v) op[v] = f2bf(((o0[v] + o1[v] - mu) * r * M.gn_g[h * 64 + v] + M.gn_b[h * 64 + v]) * silu_f(bf2f(gp[v])));
}

HD void hg_local_item(const Mix& M, int item) {
    const int v = item & 63, c = (item >> 6) % NCH, seq = item / (64 * NCH), h = seq & 3, b = (seq >> 2) % NB, dir = seq / (4 * NB);
    float S[64];
#pragma unroll
    for (int k = 0; k < 64; ++k) S[k] = 0.f;
    float dk = 1.0f;
    for (int i = 0; i < CH; ++i) {
        const int row = row_of(b, dir_tq(dir, c * CH + i));
        const bf16* p = M.P + (size_t)row * NP; const float* f = M.HF + ((size_t)dir * NTOK + row) * 256 + h * 64;
        const float vv = bf2f(p[C_HI + h * 64 + v]); float acc = 0.f;
        dk *= f[v]; M.HQC[((size_t)dir * NTOK + row) * 256 + h * 64 + v] = bf2f(p[C_HQ + h * 64 + v]) * dk * 0.125f;
#pragma unroll
        for (int c8 = 0; c8 < 8; ++c8) { float q8[8], fa[4], fb[4]; ld8(p + C_HQ + h * 64 + 8 * c8, q8); ld4f(f + 8 * c8, fa); ld4f(f + 8 * c8 + 4, fb);
#pragma unroll
            for (int j = 0; j < 8; ++j) { const int k = 8 * c8 + j; const float fk = j < 4 ? fa[j] : fb[j - 4]; S[k] = fk * (S[k] - vv) + vv; acc += q8[j] * S[k]; }
            if ((c8 & 1) == 1) CBAR(); }
        M.HO[((size_t)dir * NTOK + row) * 256 + h * 64 + v] = acc * 0.125f;
    }
    float* u = M.HU + ((size_t)seq * NCH + c) * 4096 + v;
#pragma unroll
    for (int k = 0; k < 64; ++k) u[k * 64] = S[k];
    M.HDK[((size_t)seq * NCH + c) * 64 + v] = dk;
}
HD void hg_carry_item(const Mix& M, int item) {
    const int kv = item & 4095, seq = item >> 12, k = kv >> 6; float s = 0.f;
#pragma unroll 8
    for (int c = 0; c < NCH; ++c) { float* u = M.HU + ((size_t)seq * NCH + c) * 4096 + kv; const float uu = *u; *u = s; s = M.HDK[((size_t)seq * NCH + c) * 64 + k] * s + uu; }
}
HD void hg_fix_item(const Mix& M, int item) {
    const int v = item & 63, c = (item >> 6) % NCH, seq = item / (64 * NCH), h = seq & 3, b = (seq >> 2) % NB, dir = seq / (4 * NB);
    if (c == 0) return;
    float S[64]; const float* u = M.HU + ((size_t)seq * NCH + c) * 4096 + v;
#pragma unroll
    for (int k = 0; k < 64; ++k) S[k] = u[k * 64];
    for (int i = 0; i < CH; ++i) {
        const int row = row_of(b, dir_tq(dir, c * CH + i));
        const float* qc = M.HQC + ((size_t)dir * NTOK + row) * 256 + h * 64; float acc = 0.f;
#pragma unroll
        for (int c4 = 0; c4 < 16; ++c4) { float qa[4]; ld4f(qc + 4 * c4, qa);
#pragma unroll
            for (int j = 0; j < 4; ++j) acc += qa[j] * S[4 * c4 + j];
            if ((c4 & 3) == 3) CBAR(); }
        M.HO[((size_t)dir * NTOK + row) * 256 + h * 64 + v] += acc;
    }
}
HD void ret_local_item(const Mix& M, int item) {
    const int v = item & 63, c = (item >> 6) % NCH, seq = item / (64 * NCH), h = seq & 3, b = (seq >> 2) % NB, dir = seq / (4 * NB);
    const float g = expf(M.log_gamma[dir * 4 + h]);
    float S[32];
#pragma unroll
    for (int k = 0; k < 32; ++k) S[k] = 0.f;
    float gp = 1.0f;
    for (int i = 0; i < CH; ++i) {
        const int row = row_of(b, dir_tq(dir, c * CH + i));
        const float vv = bf2f(M.P[(size_t)row * NP + C_RV + h * 64 + v]);
        const float* qk = M.RQ + (size_t)row * 128 + h * 32; const float* kk = M.RK + (size_t)row * 128 + h * 32; float acc = 0.f;
        gp *= g; if (v < 32) M.RQC[((size_t)dir * NTOK + row) * 128 + h * 32 + v] = qk[v] * gp;
#pragma unroll
        for (int c4 = 0; c4 < 8; ++c4) { float qa[4], ka[4]; ld4f(qk + 4 * c4, qa); ld4f(kk + 4 * c4, ka);
#pragma unroll
            for (int j = 0; j < 4; ++j) { const int k = 4 * c4 + j; S[k] = g * S[k] + ka[j] * vv; acc += qa[j] * S[k]; }
            if ((c4 & 3) == 3) CBAR(); }
        M.RO[((size_t)dir * NTOK + row) * 256 + h * 64 + v] = acc;
    }
    float* u = M.RU + ((size_t)seq * NCH + c) * 2048 + v;
#pragma unroll
    for (int k = 0; k < 32; ++k) u[k * 64] = S[k];
}
HD void ret_carry_item(const Mix& M, int item) {
    const int kv = item & 2047, seq = item >> 11, h = seq & 3, dir = seq / (4 * NB); float s = 0.f;
    const float d = expf((float)CH * M.log_gamma[dir * 4 + h]);
#pragma unroll 8
    for (int c = 0; c < NCH; ++c) { float* u = M.RU + ((size_t)seq * NCH + c) * 2048 + kv; const float uu = *u; *u = s; s = d * s + uu; }
}
HD void ret_fix_item(const Mix& M, int item) {
    const int v = item & 63, c = (item >> 6) % NCH, seq = item / (64 * NCH), h = seq & 3, b = (seq >> 2) % NB, dir = seq / (4 * NB);
    if (c == 0) return;
    float S[32]; const float* u = M.RU + ((size_t)seq * NCH + c) * 2048 + v;
#pragma unroll
    for (int k = 0; k < 32; ++k) S[k] = u[k * 64];
    for (int i = 0; i < CH; ++i) {
        const int row = row_of(b, dir_tq(dir, c * CH + i));
        const float* qc = M.RQC + ((size_t)dir * NTOK + row) * 128 + h * 32; float acc = 0.f;
#pragma unroll
        for (int c4 = 0; c4 < 8; ++c4) { float qa[4]; ld4f(qc + 4 * c4, qa);
#pragma unroll
            for (int j = 0; j < 4; ++j) acc += qa[j] * S[4 * c4 + j];
            if ((c4 & 3) == 3) CBAR(); }
        M.RO[((size_t)dir * NTOK + row) * 256 + h * 64 + v] += acc;
    }
}
namespace pg8 {
#define PG8_LAS __attribute__((address_space(3)))
typedef unsigned short bf16_t;
typedef short bf16x8 __attribute__((ext_vector_type(8)));
typedef float f32x4 __attribute__((ext_vector_type(4)));
typedef unsigned u32x4 __attribute__((ext_vector_type(4)));
constexpr int BM = 256, BK = 64, HALF = 128, HTB = HALF * BK * 2  , STAGE_BYTES = 8 * HTB, NXCD = 8, WGM = 8;

__host__ __device__ __forceinline__ int lds_byte(int r, int c) { const int st = (r >> 4) * 2 + (c >> 5), rr = r & 15, cc = c & 31, ob = rr * 64 + cc * 2; return st * 1024 + (ob ^ (((ob >> 9) & 1) << 5)); }
__host__ __device__ __forceinline__ void stage_rc(int b, int& R, int& C) { const int st = b / 1024, sb = b % 1024, swz = sb ^ (((sb >> 9) & 1) << 5); R = (st >> 1) * 16 + swz / 64; C = (st & 1) * 32 + (swz % 64) / 2; }
__host__ __device__ __forceinline__ int perm32(int rho) { const int n = rho >> 4, i = rho & 15; return 8 * (i >> 2) + 4 * n + (i & 3); }

struct Unit { int pm, pn; };
struct Gemm { const bf16_t* A; const bf16_t* Bt; int M, N, K; };

struct StaticOrder {
    int nM, nN, nwg, G, c;
    __host__ __device__ void init(int M, int N, int G_, int c_) { nM = M / BM; nN = N / BM; nwg = nM * nN; G = G_; c = c_; }
    __host__ __device__ bool next(int i, Unit& u) const {
        const long L = (long)i * G + c; if (L >= nwg) return false;
        int wgid = (int)L; { const int q = nwg / NXCD, r = nwg % NXCD, xcd = wgid % NXCD, off = wgid / NXCD; wgid = (xcd < r ? xcd * (q + 1) : r * (q + 1) + (xcd - r) * q) + off; }
        const int nig = WGM * nN, gid = wgid / nig, fm = gid * WGM, gsz = (nM - fm) < WGM ? (nM - fm) : WGM;
        u.pm = fm + ((wgid % nig) % gsz); u.pn = (wgid % nig) / gsz; return true;
    }
    __device__ __forceinline__ void a_ready(const Unit&) const {}
    __device__ __forceinline__ void done(const Unit&) const {}
};

__device__ __forceinline__ unsigned cvt_pk_bf16(float lo, float hi) { unsigned r; asm volatile("v_cvt_pk_bf16_f32 %0, %1, %2" : "=v"(r) : "v"(lo), "v"(hi)); return r; }
typedef unsigned u32x2 __attribute__((ext_vector_type(2)));
struct EpiBf16P {
    static constexpr bool PERM = true, AFTER_DRAIN = false;
    bf16_t* O; int ldc; int nN;
    __device__ __forceinline__ void operator()(const f32x4 (&acc)[2][2][4][2], const Unit& u, int wr, int wc, int fr, int fq) const {
        const int row0 = u.pm * BM + wr * 64 + fr, col0 = (u.pn % nN) * BM + wc * 32 + 8 * fq;
#pragma unroll
        for (int ai = 0; ai < 2; ++ai)
#pragma unroll
            for (int m = 0; m < 4; ++m) { bf16_t* rowp = O + (size_t)(row0 + ai * HALF + m * 16) * ldc + col0;
#pragma unroll
                for (int bj = 0; bj < 2; ++bj) { const f32x4 v0 = acc[ai][bj][m][0], v1 = acc[ai][bj][m][1];
                    u32x4 w; w.x = cvt_pk_bf16(v0[0], v0[1]); w.y = cvt_pk_bf16(v0[2], v0[3]); w.z = cvt_pk_bf16(v1[0], v1[1]); w.w = cvt_pk_bf16(v1[2], v1[3]);
                    *(u32x4*)(rowp + bj * HALF) = w; } }
    }
};
struct EpiRes {
    static constexpr bool PERM = false, AFTER_DRAIN = false;
    float* H; const float* gate; int lat_tiles, tiles_per_batch, ctx_bidx;
    __device__ __forceinline__ void operator()(const f32x4 (&acc)[2][2][4][2], const Unit& u, int wr, int wc, int fr, int fq) const {
        const int bidx = u.pm < lat_tiles ? u.pm / tiles_per_batch : ctx_bidx;
        const float* g = gate + (size_t)bidx * 6144;
        const int row0 = u.pm * BM + wr * 64 + fr, col0 = u.pn * BM + wc * 32 + 4 * fq;
        f32x4 gv[2][2];
#pragma unroll
        for (int bj = 0; bj < 2; ++bj)
#pragma unroll
            for (int n = 0; n < 2; ++n) gv[bj][n] = *(const f32x4*)(g + col0 + bj * HALF + n * 16);
#pragma unroll
        for (int ai = 0; ai < 2; ++ai)
#pragma unroll
            for (int m = 0; m < 4; ++m) { float* rowp = H + (size_t)(row0 + ai * HALF + m * 16) * 1024 + col0;
#pragma unroll
                for (int bj = 0; bj < 2; ++bj)
#pragma unroll
                    for (int n = 0; n < 2; ++n) { f32x4* p = (f32x4*)(rowp + bj * HALF + n * 16); *p = *p + gv[bj][n] * acc[ai][bj][m][n]; } }
    }
};
struct EpiSwiglu {
    static constexpr bool PERM = true, AFTER_DRAIN = false;
    bf16_t* O; int ldo; int nN;
    __device__ __forceinline__ void operator()(const f32x4 (&acc)[2][2][4][2], const Unit& u, int wr, int wc, int fr, int fq) const {
        const int row0 = u.pm * BM + wr * 64 + fr, col0 = (u.pn % nN) * 128 + wc * 16 + 4 * fq;
#pragma unroll
        for (int ai = 0; ai < 2; ++ai)
#pragma unroll
            for (int m = 0; m < 4; ++m) { bf16_t* rowp = O + (size_t)(row0 + ai * HALF + m * 16) * ldo + col0;
#pragma unroll
                for (int bj = 0; bj < 2; ++bj) { const f32x4 gt = acc[ai][bj][m][0], up = acc[ai][bj][m][1]; float r[4];
#pragma unroll
                    for (int i = 0; i < 4; ++i) r[i] = gt[i] * __builtin_amdgcn_rcpf(1.0f + __builtin_amdgcn_exp2f(-1.4426950408889634f * gt[i])) * up[i];
                    u32x2 w; w.x = cvt_pk_bf16(r[0], r[1]); w.y = cvt_pk_bf16(r[2], r[3]);
                    *(u32x2*)(rowp + bj * 64) = w; } }
    }
};
struct MoeOrder {
    const unsigned* list; int nwg, G, c;
    __device__ __forceinline__ bool next(int i, Unit& u) const {
        const long L = (long)i * G + c; if (L >= nwg) return false;
        unsigned w; const unsigned* ptr = list + L;
        asm volatile("s_load_dword %0, %1, 0x0\n\ts_waitcnt lgkmcnt(0)" : "=s"(w) : "s"(ptr) : "memory");
        u.pm = (int)(w & 0xffffu); u.pn = (int)(w >> 16); return true;
    }
    __device__ __forceinline__ void a_ready(const Unit&) const {}
    __device__ __forceinline__ void done(const Unit&) const {}
};
template <class Epi, class Sched, bool ALIGN_EPI = false, bool SP2 = false>
__device__ __forceinline__ void gemm_phase(PG8_LAS unsigned char* lds, const Gemm g, const Sched& S, const Epi& E, const int tid_in) {
    const int tid = tid_in, wid = __builtin_amdgcn_readfirstlane(tid >> 6), lane = tid & 63, wr = wid >> 2, wc = wid & 3, fr = lane & 15, fq = lane >> 4;
    const int K = g.K, nt = K / BK;
    unsigned voffA[2], voffB[2];
#pragma unroll
    for (int i = 0; i < 2; ++i) { int R, C; stage_rc(tid * 16 + i * 8192, R, C); const int Rb = Epi::PERM ? ((R & ~31) + perm32(R & 31)) : R;
        voffA[i] = (unsigned)(R * K + C) * 2u; voffB[i] = (unsigned)(Rb * K + C) * 2u; }
    const size_t kstep = (size_t)(BK * 2);
    const size_t hstep = (size_t)HALF * K * 2;
    const size_t tstep = 2 * hstep;
    const unsigned ldsw = (unsigned)wid * 1024u;
    const int aoff = lds_byte(wr * 64 + fr, fq * 8), boff = lds_byte(wc * 32 + fr, fq * 8);
#define PG8_SA(b, h) (((b) * 2 + (h)) * HTB)
#define PG8_SB(b, h) ((4 + (b) * 2 + (h)) * HTB)
#define PG8_STAGE(bufoff, gbase, voff) do { _Pragma("unroll") for (int _i = 0; _i < 2; ++_i) \
        __builtin_amdgcn_global_load_lds((const unsigned*)((const char*)(gbase) + (voff)[_i]), (PG8_LAS unsigned*)(lds + (bufoff) + ldsw + _i * 8192), 16, 0, 0); } while (0)
#define PG8_LDA(dst, b, h) do { _Pragma("unroll") for (int m = 0; m < 4; ++m) _Pragma("unroll") for (int k = 0; k < 2; ++k) dst[m][k] = *(const PG8_LAS bf16x8*)(lds + PG8_SA(b, h) + aoff + m * 2048 + k * 1024); } while (0)
#define PG8_LDB(dst, b, h) do { _Pragma("unroll") for (int n = 0; n < 2; ++n) _Pragma("unroll") for (int k = 0; k < 2; ++k) dst[n][k] = *(const PG8_LAS bf16x8*)(lds + PG8_SB(b, h) + boff + n * 2048 + k * 1024); } while (0)
#define PG8_MMA(ai, bj, At, Bt) do { __builtin_amdgcn_s_setprio(1); _Pragma("unroll") for (int m = 0; m < 4; ++m) _Pragma("unroll") for (int n = 0; n < 2; ++n) _Pragma("unroll") for (int k = 0; k < 2; ++k) \
        acc[ai][bj][m][n] = __builtin_amdgcn_mfma_f32_16x16x32_bf16(Bt[n][k], At[m][k], acc[ai][bj][m][n], 0, 0, 0); __builtin_amdgcn_s_setprio(0); } while (0)
#define PG8_WAIT_V(n) asm volatile("s_waitcnt vmcnt(" #n ")" ::: "memory")
#define PG8_WAIT_L(n) asm volatile("s_waitcnt lgkmcnt(" #n ")" ::: "memory")
#define PG8_BAR __builtin_amdgcn_s_barrier()
#define PG8_SCHED __builtin_amdgcn_sched_barrier(0)
    Unit cur, nxt; int ui = 0;
    if (!S.next(0, cur)) return;
    f32x4 acc[2][2][4][2];
#pragma unroll
    for (int a = 0; a < 2; ++a)
#pragma unroll
        for (int b = 0; b < 2; ++b)
#pragma unroll
            for (int m = 0; m < 4; ++m)
#pragma unroll
                for (int n = 0; n < 2; ++n) acc[a][b][m][n] = (f32x4){0.f, 0.f, 0.f, 0.f};
    bf16x8 At[4][2], B0[2][2], B1[2][2];
    const char* cA = (const char*)g.A + (size_t)cur.pm * tstep; const char* cB = (const char*)g.Bt + (size_t)cur.pn * tstep;
    S.a_ready(cur);
    if constexpr (SP2) {
        PG8_STAGE(PG8_SB(0, 0), cB, voffB); PG8_STAGE(PG8_SB(0, 1), cB + hstep, voffB); PG8_STAGE(PG8_SA(0, 0), cA, voffA); PG8_STAGE(PG8_SA(0, 1), cA + hstep, voffA);
        if (wr == 1) PG8_BAR;
        PG8_WAIT_V(2); PG8_BAR;
        PG8_STAGE(PG8_SB(1, 0), cB + kstep, voffB); PG8_STAGE(PG8_SA(1, 0), cA + kstep, voffA); PG8_STAGE(PG8_SB(1, 1), cB + hstep + kstep, voffB);
        PG8_WAIT_V(6); PG8_BAR;
    } else {
        PG8_STAGE(PG8_SB(0, 0), cB, voffB); PG8_STAGE(PG8_SA(0, 0), cA, voffA); PG8_STAGE(PG8_SB(0, 1), cB + hstep, voffB); PG8_STAGE(PG8_SA(0, 1), cA + hstep, voffA);
        if (wr == 1) PG8_BAR;
        PG8_WAIT_V(4); PG8_BAR;
        PG8_STAGE(PG8_SB(1, 0), cB + kstep, voffB); PG8_STAGE(PG8_SA(1, 0), cA + kstep, voffA); PG8_STAGE(PG8_SB(1, 1), cB + hstep + kstep, voffB);
        PG8_WAIT_V(6); PG8_BAR;
    }
    for (;;) {
        const bool has_next = S.next(ui + 1, nxt);
        const char* nA = has_next ? (const char*)g.A + (size_t)nxt.pm * tstep : cA; const char* nB = has_next ? (const char*)g.Bt + (size_t)nxt.pn * tstep : cB;
        for (int t = 0; t < nt; t += 2) {
            const bool last = (t == nt - 2);
            const char* a1 = cA + (size_t)(t + 1) * kstep;
            const char* a2 = last ? nA : cA + (size_t)(t + 2) * kstep; const char* b2 = last ? nB : cB + (size_t)(t + 2) * kstep;
            const char* a3 = a2 + kstep; const char* b3 = b2 + kstep;
            if (last && has_next) S.a_ready(nxt);
            if constexpr (SP2) {
            PG8_LDB(B0, 0, 0); PG8_LDB(B1, 0, 1); PG8_SCHED; PG8_LDA(At, 0, 0); PG8_STAGE(PG8_SA(1, 1), a1 + hstep, voffA);
            PG8_WAIT_V(8); PG8_WAIT_L(0); PG8_BAR; PG8_MMA(0, 0, At, B0); PG8_MMA(0, 1, At, B1); PG8_BAR; PG8_SCHED;
            PG8_LDA(At, 0, 1); PG8_STAGE(PG8_SB(0, 0), b2, voffB); PG8_STAGE(PG8_SB(0, 1), b2 + hstep, voffB); PG8_STAGE(PG8_SA(0, 0), a2, voffA);
            PG8_WAIT_V(8); PG8_WAIT_L(0); PG8_BAR; PG8_MMA(1, 0, At, B0); PG8_MMA(1, 1, At, B1); PG8_BAR; PG8_SCHED;
            PG8_LDB(B0, 1, 0); PG8_LDB(B1, 1, 1); PG8_SCHED; PG8_LDA(At, 1, 0); PG8_STAGE(PG8_SA(0, 1), a2 + hstep, voffA);
            PG8_WAIT_V(8); PG8_WAIT_L(0); PG8_BAR; PG8_MMA(0, 0, At, B0); PG8_MMA(0, 1, At, B1); PG8_BAR; PG8_SCHED;
            PG8_LDA(At, 1, 1); PG8_STAGE(PG8_SB(1, 0), b3, voffB); PG8_STAGE(PG8_SB(1, 1), b3 + hstep, voffB); PG8_STAGE(PG8_SA(1, 0), a3, voffA);
            PG8_WAIT_V(8); PG8_WAIT_L(0); PG8_BAR; PG8_MMA(1, 0, At, B0); PG8_MMA(1, 1, At, B1); PG8_BAR; PG8_SCHED;
            } else {
            PG8_LDB(B0, 0, 0); PG8_SCHED; PG8_LDA(At, 0, 0); PG8_STAGE(PG8_SA(1, 1), a1 + hstep, voffA);
            PG8_WAIT_L(8); PG8_BAR; PG8_WAIT_L(0); PG8_MMA(0, 0, At, B0); PG8_BAR; PG8_SCHED;
            PG8_LDB(B1, 0, 1); PG8_STAGE(PG8_SB(0, 0), b2, voffB);
            PG8_BAR; PG8_WAIT_L(0); PG8_MMA(0, 1, At, B1); PG8_BAR;
            PG8_LDA(At, 0, 1); PG8_STAGE(PG8_SA(0, 0), a2, voffA);
            PG8_BAR; PG8_WAIT_L(0); PG8_MMA(1, 0, At, B0); PG8_BAR; PG8_SCHED;
            PG8_STAGE(PG8_SB(0, 1), b2 + hstep, voffB);
            PG8_WAIT_V(6); PG8_BAR; PG8_MMA(1, 1, At, B1); PG8_BAR;
            PG8_LDB(B0, 1, 0); PG8_SCHED; PG8_LDA(At, 1, 0); PG8_STAGE(PG8_SA(0, 1), a2 + hstep, voffA);
            PG8_WAIT_L(8); PG8_BAR; PG8_WAIT_L(0); PG8_MMA(0, 0, At, B0); PG8_BAR; PG8_SCHED;
            PG8_LDB(B1, 1, 1); PG8_STAGE(PG8_SB(1, 0), b3, voffB);
            PG8_BAR; PG8_WAIT_L(0); PG8_MMA(0, 1, At, B1); PG8_BAR;
            PG8_LDA(At, 1, 1); PG8_STAGE(PG8_SA(1, 0), a3, voffA);
            PG8_BAR; PG8_WAIT_L(0); PG8_MMA(1, 0, At, B0); PG8_BAR; PG8_SCHED;
            PG8_STAGE(PG8_SB(1, 1), b3 + hstep, voffB);
            PG8_WAIT_V(6); PG8_BAR; PG8_MMA(1, 1, At, B1); PG8_BAR;
            }
        }
        if constexpr (ALIGN_EPI) { if (wr == 0) PG8_BAR; }
        if constexpr (!Epi::AFTER_DRAIN) { unsigned z_ = 0u; asm volatile("" : "+v"(z_)); const int l2_ = (int)__builtin_amdgcn_mbcnt_hi(~0u, __builtin_amdgcn_mbcnt_lo(~0u, z_)); E(acc, cur, wr, wc, l2_ & 15, l2_ >> 4); S.done(cur); }
        if (!has_next) break;
#pragma unroll
        for (int a = 0; a < 2; ++a)
#pragma unroll
            for (int b = 0; b < 2; ++b)
#pragma unroll
                for (int m = 0; m < 4; ++m)
#pragma unroll
                    for (int n = 0; n < 2; ++n) acc[a][b][m][n] = (f32x4){0.f, 0.f, 0.f, 0.f};
        cur = nxt; cA = nA; cB = nB; ++ui;
        if constexpr (ALIGN_EPI) { if (wr == 1) PG8_BAR; }
    }
    PG8_WAIT_V(0);
    if constexpr (!ALIGN_EPI) { if (wr == 0) PG8_BAR; }
    PG8_BAR;
    if constexpr (Epi::AFTER_DRAIN) { E.fused(acc, cur, wr, wc, fr, fq, lds, wid, lane); S.done(cur); }
#undef PG8_SA
#undef PG8_SB
#undef PG8_STAGE
#undef PG8_LDA
#undef PG8_LDB
#undef PG8_MMA
#undef PG8_WAIT_V
#undef PG8_WAIT_L
#undef PG8_BAR
#undef PG8_SCHED
}
}
#ifndef LAS
#define LAS __attribute__((address_space(3)))
#endif
#define XB_TMO      128
#define XB_XCNT(j)  (256  + 64 * (j))
#define XB_XSUB(j)  (1280 + 64 * (j))
#define XB_XGEN(j)  (2304 + 64 * (j))
#define XB_TOP      3328
#define XB_TOPGEN   3392
#define XCD_BAR_WORDS 3456
#define XB_SPIN_CAP (1u << 24)

__device__ __forceinline__ unsigned xb_ld(unsigned* p)              { return __hip_atomic_load(p, __ATOMIC_RELAXED, __HIP_MEMORY_SCOPE_AGENT); }
__device__ __forceinline__ unsigned xb_add(unsigned* p, unsigned v) { return __hip_atomic_fetch_add(p, v, __ATOMIC_RELAXED, __HIP_MEMORY_SCOPE_AGENT); }
__device__ __forceinline__ unsigned xb_xcc_id() { return (unsigned)__builtin_amdgcn_s_getreg((3 << 11) | 20) & 0xFu; }
#define XB_SPIN(cond, bar) do { unsigned _sp = 0; while (cond) { __builtin_amdgcn_s_sleep(1); \
    if ((++_sp & 255u) == 0u) { if (xb_ld(&(bar)[XB_TMO])) break; if (_sp > XB_SPIN_CAP) { atomicAdd(&(bar)[XB_TMO], 1u); break; } } } } while (0)

struct XcdBarrier {
    int w;
    unsigned* bar; unsigned x;
    volatile LAS unsigned* st;
};

__device__ __forceinline__ bool xb_thread0(int w) { unsigned z = 0u; asm volatile("" : "+v"(z), "+s"(w)); return w == 0 && __builtin_amdgcn_mbcnt_hi(~0u, __builtin_amdgcn_mbcnt_lo(~0u, z)) == 0u; }
__device__ __forceinline__ XcdBarrier xcd_barrier_post(unsigned* bar, volatile LAS unsigned* st, int w) {
    XcdBarrier b; b.w = w; b.bar = bar; b.x = xb_xcc_id(); b.st = st;
    if (xb_thread0(w)) (void)xb_add(&bar[XB_XCNT(b.x)], 1u);
    return b;
}
__device__ __forceinline__ void xcd_barrier_complete(unsigned* bar, unsigned x, unsigned& nloc, unsigned& nx) {
    const unsigned G = gridDim.x * gridDim.y * gridDim.z;
    unsigned sum, cnt, mine, sp = 0u;
    for (;;) {
        sum = 0u; cnt = 0u; mine = 0u;
#pragma unroll
        for (unsigned j = 0; j < 16; ++j) { const unsigned c = xb_ld(&bar[XB_XCNT(j)]); sum += c; cnt += (c > 0u) ? 1u : 0u; mine = (j == x) ? c : mine; }
        if (sum == G) break;
        __builtin_amdgcn_s_sleep(1);
        if ((++sp & 255u) == 0u) { if (xb_ld(&bar[XB_TMO])) break; if (sp > XB_SPIN_CAP) { atomicAdd(&bar[XB_TMO], 1u); break; } }
    }
    nloc = mine > 0u ? mine : 1u; nx = cnt > 0u ? cnt : 1u;
}

__device__ __forceinline__ void xcd_barrier(const XcdBarrier& b) {
    asm volatile("s_waitcnt vmcnt(0)" ::: "memory");
    __syncthreads();
    if (xb_thread0(b.w)) {
        unsigned* bar = b.bar;
        __builtin_amdgcn_s_waitcnt(0);
        unsigned nloc = b.st[0], nx = b.st[1];
        if (nloc == 0u) { xcd_barrier_complete(bar, b.x, nloc, nx); b.st[0] = nloc; b.st[1] = nx; }
        const unsigned old = xb_add(&bar[XB_XSUB(b.x)], 1u);
        const unsigned gen = old / nloc;
        if (old + 1u == (gen + 1u) * nloc) {
            __builtin_amdgcn_fence(__ATOMIC_RELEASE, "agent");
            asm volatile("s_waitcnt vmcnt(0)" ::: "memory");
            const unsigned og = xb_add(&bar[XB_TOP], 1u);
            const unsigned tg = og / nx;
            if (og + 1u == (tg + 1u) * nx) xb_add(&bar[XB_TOPGEN], 1u);
            else XB_SPIN(xb_ld(&bar[XB_TOPGEN]) == tg, bar);
            __builtin_amdgcn_fence(__ATOMIC_ACQUIRE, "agent");
            xb_add(&bar[XB_XGEN(b.x)], 1u);
            asm volatile("s_waitcnt vmcnt(0)" ::: "memory");
        } else {
            XB_SPIN(xb_ld(&bar[XB_XGEN(b.x)]) == gen, bar);
            __builtin_amdgcn_fence(__ATOMIC_ACQUIRE, "agent");
            asm volatile("s_waitcnt vmcnt(0)" ::: "memory");
        }
    }
    __syncthreads();
}
#define GAS __attribute__((address_space(1)))
constexpr int NWAVES = 8, NTHREADS = NWAVES * 64;
constexpr size_t MiB = 1u << 20;
constexpr size_t WS_CTL = 0, CTL_ZERO_BYTES = 1 * MiB;
constexpr size_t WS_SMALL = 1 * MiB, WS_TOKINFO = 2 * MiB, WS_LIST = 3 * MiB;
constexpr size_t WS_WIN = 4 * MiB, WS_WOUT = 34 * MiB, WS_WFGU = 42 * MiB, WS_WFD = 64 * MiB, WS_WMGU = 75 * MiB, WS_WMD = 187 * MiB;
constexpr size_t WS_H = 243 * MiB, WS_A = 315 * MiB, WS_OC = 351 * MiB, WS_Y = 387 * MiB, WS_AM = 463 * MiB, WS_BIG = 539 * MiB;
constexpr size_t WS_P = WS_BIG, WS_QM = 674 * MiB, WS_KM = WS_QM + 14155776, WS_VM = WS_KM + 14155776, WS_QS = 710 * MiB, WS_KS = WS_QS + 9437184, WS_VS = WS_KS + 4718592;
constexpr size_t WS_HF = 728 * MiB, WS_HO = 764 * MiB, WS_RQ = 800 * MiB, WS_RK = 809 * MiB, WS_RO = 818 * MiB, WS_HQC = 854 * MiB, WS_HU = 872 * MiB, WS_HDK = 908 * MiB, WS_RQC = 909 * MiB, WS_RU = 927 * MiB, WS_TAB = 945 * MiB, WS_END = 947 * MiB;
constexpr size_t WS_ACT = WS_BIG;
constexpr int MAXTILES = 152;
static_assert(WS_P + (size_t)NTOK * NP * 2 <= WS_QM && WS_VM + (size_t)NB * 4 * TK * 64 * 2 <= WS_QS && WS_VS + 4718592 <= WS_HF, "ws map 1");
static_assert(WS_HQC + (size_t)2 * NTOK * 256 * 2 <= WS_HU && WS_HU + (size_t)2 * NB * 4 * 36 * 4096 * 4 <= WS_HDK && WS_RQC + (size_t)2 * NTOK * 256 * 2 <= WS_RU && WS_RU + (size_t)2 * NB * 4 * 36 * 2048 * 4 <= WS_TAB, "ws map 3");
static_assert(WS_ACT + (size_t)MAXTILES * 256 * DFE * 2 <= WS_END && (size_t)MAXTILES * 256 * D * 2 <= 76 * MiB, "ws map 2");
constexpr int SM_MOD = 0;
constexpr int SM_LOGLB = 4 * 9 * 6144, SM_LOG1M = SM_LOGLB + 4 * 512, SM_LGAM = SM_LOG1M + 4 * 512, SM_META = SM_LGAM + 64, SM_ULIST = SM_META + 32;
constexpr int ULIST_GU = 0, ULIST_D = MAXTILES * 28;
static_assert((SM_ULIST + 2 * MAXTILES * 32) * 4 <= (int)MiB, "small region");
constexpr int CW_BAR = 4096, CW_CNT = 8192;
constexpr int LDS_BYTES = 147456, MISC_OFF = 131072 + 320;

#define LAS __attribute__((address_space(3)))
typedef float f32x4 __attribute__((ext_vector_type(4)));
typedef unsigned v4u __attribute__((ext_vector_type(4)));
typedef unsigned v2u __attribute__((ext_vector_type(2)));
#define LDS_WAIT() asm volatile("s_waitcnt lgkmcnt(0)" ::: "memory")

struct Args { const float* in[28]; float* out; unsigned char* ws; int ph_lo, ph_hi; };
typedef __attribute__((address_space(4))) const unsigned long long ka_u64;
__device__ __forceinline__ const float* IN(int i) { ka_u64* ka = (ka_u64*)__builtin_amdgcn_kernarg_segment_ptr(); asm volatile("" : "+s"(ka)); return (const float*)(GAS const float*)ka[i]; }
__device__ __forceinline__ float* OUTP() { ka_u64* ka = (ka_u64*)__builtin_amdgcn_kernarg_segment_ptr(); asm volatile("" : "+s"(ka)); return (float*)(GAS float*)ka[28]; }
__device__ __forceinline__ unsigned char* WSBASE() { ka_u64* ka = (ka_u64*)__builtin_amdgcn_kernarg_segment_ptr(); asm volatile("" : "+s"(ka)); return (unsigned char*)(GAS unsigned char*)ka[29]; }
struct Frame {
    LAS unsigned char* lds;
    int tid, lane, wave, gtid, NT, gw, NGW;
    __device__ __forceinline__ unsigned char* base() const { return WSBASE(); }
};
#define WSP(T, off) ((T*)(ws + (off)))
#define F_ctl WSP(unsigned, WS_CTL)
#define F_sm WSP(float, WS_SMALL)
#define F_tokinfo WSP(int, WS_TOKINFO)
#define F_list WSP(int, WS_LIST)
#define F_H WSP(float, WS_H)
#define F_A WSP(bf16, WS_A)
#define F_OC WSP(bf16, WS_OC)
#define F_Y WSP(bf16, WS_Y)
#define F_AM WSP(bf16, WS_AM)
#define F_P WSP(bf16, WS_P)
#define F_ACT WSP(bf16, WS_ACT)
#define F_WIN WSP(bf16, WS_WIN)
#define F_WOUT WSP(bf16, WS_WOUT)
#define F_WFGU WSP(bf16, WS_WFGU)
#define F_WFD WSP(bf16, WS_WFD)
#define F_WMGU WSP(bf16, WS_WMGU)
#define F_WMD WSP(bf16, WS_WMD)
__device__ __forceinline__ float wave_sum(float v, int  ) {
    int x = __float_as_int(v);
    v += __int_as_float(__builtin_amdgcn_update_dpp(0, x, 0xB1, 0xF, 0xF, true)); x = __float_as_int(v);
    v += __int_as_float(__builtin_amdgcn_update_dpp(0, x, 0x4E, 0xF, 0xF, true)); x = __float_as_int(v);
    v += __int_as_float(__builtin_amdgcn_update_dpp(0, x, 0x141, 0xF, 0xF, true)); x = __float_as_int(v);
    v += __int_as_float(__builtin_amdgcn_update_dpp(0, x, 0x140, 0xF, 0xF, true)); x = __float_as_int(v);
    v += __int_as_float(__builtin_amdgcn_update_dpp(0, x, 0x142, 0xA, 0xF, false)); x = __float_as_int(v);
    v += __int_as_float(__builtin_amdgcn_update_dpp(0, x, 0x143, 0xC, 0xF, false));
    return __int_as_float(__builtin_amdgcn_readlane(__float_as_int(v), 63));
}
__device__ __forceinline__ unsigned pk2(float lo, float hi) { return (unsigned)f2bf(lo) | ((unsigned)f2bf(hi) << 16); }

constexpr int TAB_MLA = 0, TAB_SWA = NL * 16 * 2, TAB_RET = TAB_SWA + NL * 32 * 2, TAB_FLOATS = TAB_RET + TK * 16 * 2;
__device__ __forceinline__ void build_tables(float* tab, int gtid, int NT) {
    for (int it = gtid; it < NL * 16; it += NT) { const int t = it >> 4, j = it & 15; const float inv = powf(10000.0f, -(float)(j & 7) / 8.0f), ang = (float)(j < 8 ? t / GRIDW : t % GRIDW) * inv;
        tab[TAB_MLA + 2 * it] = cosf(ang); tab[TAB_MLA + 2 * it + 1] = sinf(ang); }
    for (int it = gtid; it < NL * 32; it += NT) { const int t = it >> 5, j = it & 31; const float inv = powf(10000.0f, -(float)(j & 15) / 16.0f), ang = (float)(j < 16 ? t / GRIDW : t % GRIDW) * inv;
        tab[TAB_SWA + 2 * it] = cosf(ang); tab[TAB_SWA + 2 * it + 1] = sinf(ang); }
    for (int it = gtid; it < TK * 16; it += NT) { const int tq = it >> 4, j = it & 15; const float inv = powf(10000.0f, -(float)j / 16.0f), ang = (float)tq * inv;
        tab[TAB_RET + 2 * it] = cosf(ang); tab[TAB_RET + 2 * it + 1] = sinf(ang); }
}
static_assert((size_t)TAB_FLOATS * 4 <= 2 * MiB, "rope tables");
template <class SrcFn> __device__ __forceinline__ void transpose_item(const SrcFn& src, int K, int nblk, bf16* WT, LAS float* scr, int item, int lane) {
    const int kb = item / nblk, nb = item % nblk, k0 = 64 * kb, n0 = 32 * nb;
    float tv[32];
#pragma unroll
    for (int i = 0; i < 32; ++i) tv[i] = src(k0 + 2 * i + (lane >> 5), n0 + (lane & 31));
#pragma unroll
    for (int i = 0; i < 32; ++i) scr[(2 * i + (lane >> 5)) * 33 + (lane & 31)] = tv[i];
    LDS_WAIT(); asm volatile("" ::: "memory");
    const int c = lane & 7;
#pragma unroll
    for (int j = 0; j < 4; ++j) { const int n = (lane >> 3) + 8 * j; const LAS float* s = scr + (8 * c) * 33 + n;
        v4u o; o.x = pk2(s[0 * 33], s[1 * 33]); o.y = pk2(s[2 * 33], s[3 * 33]); o.z = pk2(s[4 * 33], s[5 * 33]); o.w = pk2(s[6 * 33], s[7 * 33]);
        *(v4u*)(WT + (size_t)(n0 + n) * K + k0 + 8 * c) = o; }
    LDS_WAIT(); asm volatile("" ::: "memory");
}
struct SrcPlain { const float* W; int N; __device__ __forceinline__ float operator()(int k, int n) const { return W[(size_t)k * N + n]; } };
struct SrcGU { const float* Wg; long du; int NF; __device__ __forceinline__ float operator()(int k, int c) const { const int j = c >> 3, w = c & 7; return Wg[(w < 4 ? 0l : du) + (long)k * NF + 4 * j + (w & 3)]; } };

__device__ __forceinline__ void convert_moe(Frame& F, int li) {
    unsigned char* ws = F.base();
    LAS float* scr = (LAS float*)(F.lds + 40960 + F.wave * 8704);
    constexpr int I_GU = 16 * 224, I_D = 56 * 32;
    for (int it = F.gw; it < 8 * (I_GU + I_D); it += F.NGW) {
        const int e = it / (I_GU + I_D); int r = it % (I_GU + I_D);
        if (r < I_GU) { SrcGU s{IN(24) + ((size_t)li * 8 + e) * D * DFE, (long)(IN(25) - IN(24)), DFE}; transpose_item(s, D, 224, F_WMGU + (size_t)e * 2 * DFE * D, scr, r, F.lane); }
        else { r -= I_GU; SrcPlain s{IN(26) + ((size_t)li * 8 + e) * DFE * D, D}; transpose_item(s, DFE, 32, F_WMD + (size_t)e * D * DFE, scr, r, F.lane); }
    }
}
__device__ __forceinline__ void prologue(Frame& F) {
    unsigned char* ws = F.base();
    LAS float* sil = (LAS float*)F.lds;
    for (int i = F.tid; i < 9 * 1024; i += NTHREADS) { const float cv = i < 8 * 1024 ? IN(1)[i] : IN(3)[i - 8 * 1024]; sil[i] = silu_f(cv); }
    __syncthreads();
    { LAS float* red = (LAS float*)(F.lds + 36864);
      const int jc = F.tid & 63, kg = F.tid >> 6;
      for (int unit = blockIdx.x; unit < DEPTH * 96; unit += gridDim.x) {
          const int l = unit / 96, j0 = (unit % 96) * 64; const float* w = IN(4) + ((size_t)l * D + kg * 128) * 6144 + j0 + jc;
          float acc[9];
#pragma unroll
          for (int b = 0; b < 9; ++b) acc[b] = 0.f;
#pragma unroll 8
          for (int k = 0; k < 128; ++k) { const float wv = w[(size_t)k * 6144];
#pragma unroll
              for (int b = 0; b < 9; ++b) acc[b] += sil[b * 1024 + kg * 128 + k] * wv; }
#pragma unroll
          for (int b = 0; b < 9; ++b) red[(kg * 9 + b) * 64 + jc] = acc[b];
          __syncthreads();
          for (int o = F.tid; o < 9 * 64; o += NTHREADS) { float s = IN(5)[l * 6144 + j0 + (o & 63)];
#pragma unroll
              for (int g = 0; g < 8; ++g) s += red[(g * 9 + (o >> 6)) * 64 + (o & 63)];
              F_sm[SM_MOD + ((size_t)l * 9 + (o >> 6)) * 6144 + j0 + (o & 63)] = s; }
          __syncthreads();
      } }
    for (int it = F.gtid; it < 512; it += F.NT) {
        float lg[DEPTH], mx = -1e30f, s = 0.f;
#pragma unroll
        for (int l = 0; l < DEPTH; ++l) { lg[l] = IN(14)[l * 512 + it]; mx = fmaxf(mx, lg[l]); }
#pragma unroll
        for (int l = 0; l < DEPTH; ++l) { lg[l] = expf(lg[l] - mx); s += lg[l]; }
        float cum = 0.f; const float p0 = lg[0] / s;
#pragma unroll
        for (int l = 0; l < DEPTH; ++l) { cum += lg[l] / s; const float lb = cum - p0; F_sm[SM_LOGLB + l * 512 + it] = logf(fmaxf(lb, 1e-30f)); F_sm[SM_LOG1M + l * 512 + it] = log1pf(-lb); }
    }
    for (int it = F.gtid; it < DEPTH * 8; it += F.NT) F_sm[SM_LGAM + it] = log_sigmoid_f(IN(17)[it]);
    build_tables(WSP(float, WS_TAB), F.gtid, F.NT);
    LAS float* scr = (LAS float*)(F.lds + 40960 + F.wave * 8704);
    constexpr int I_IN = 16 * 91, I_OUT = 16 * 32, I_FGU = 16 * 176, I_FD = 44 * 32;
    constexpr int N_IN = DEPTH * I_IN, N_OUT = DEPTH * I_OUT, N_FGU = 2 * I_FGU, N_FD = 2 * I_FD;
    for (int it = F.gw; it < N_IN + N_OUT + N_FGU + N_FD; it += F.NGW) {
        int r = it;
        if (r < N_IN) { const int l = r / I_IN; SrcPlain s{IN(8) + (size_t)l * D * DIN, DIN}; transpose_item(s, D, 91, F_WIN + (size_t)l * NP * D, scr, r % I_IN, F.lane); continue; } r -= N_IN;
        if (r < N_OUT) { const int l = r / I_OUT; SrcPlain s{IN(9) + (size_t)l * D * D, D}; transpose_item(s, D, 32, F_WOUT + (size_t)l * D * D, scr, r % I_OUT, F.lane); continue; } r -= N_OUT;
        if (r < N_FGU) { const int l = r / I_FGU; SrcGU s{IN(20) + (size_t)l * D * DFF, (long)(IN(21) - IN(20)), DFF}; transpose_item(s, D, 176, F_WFGU + (size_t)l * 2 * DFF * D, scr, r % I_FGU, F.lane); continue; } r -= N_FGU;
        { const int l = r / I_FD; SrcPlain s{IN(22) + (size_t)l * DFF * D, D}; transpose_item(s, DFF, 32, F_WFD + (size_t)l * D * DFF, scr, r % I_FD, F.lane); }
    }
    convert_moe(F, 0);
    for (int it = F.gtid; it < DEPTH * (D / 8) * 928; it += F.NT) {
        const int n = it % 928, kg = (it / 928) % (D / 8), l = it / (928 * (D / 8));
        const float* wi = IN(8) + ((size_t)l * D + 8 * kg) * DIN; float acc[8];
#pragma unroll
        for (int r = 0; r < 8; ++r) acc[r] = 0.f;
        if (n < 384) { const float* g = IN(10) + l * 192; const float* wu = IN(11) + (size_t)l * 192 * 384 + n;
            for (int j = 0; j < 192; ++j) { const float w = g[j] * wu[(size_t)j * 384];
#pragma unroll
                for (int r = 0; r < 8; ++r) acc[r] += wi[(size_t)r * DIN + j] * w; } }
        else if (n < 896) { const float* g = IN(12) + l * 128; const float* wu = IN(13) + (size_t)l * 128 * 512 + (n - 384);
            for (int j = 0; j < 128; ++j) { const float w = g[j] * wu[(size_t)j * 512];
#pragma unroll
                for (int r = 0; r < 8; ++r) acc[r] += wi[(size_t)r * DIN + 192 + j] * w; } }
        v4u o; o.x = pk2(acc[0], acc[1]); o.y = pk2(acc[2], acc[3]); o.z = pk2(acc[4], acc[5]); o.w = pk2(acc[6], acc[7]);
        *(v4u*)(F_WIN + ((size_t)l * NP + DIN + n) * D + 8 * kg) = o;
    }
}

typedef short bf16x8s __attribute__((ext_vector_type(8)));
typedef float f32x16 __attribute__((ext_vector_type(16)));
__device__ __forceinline__ int crow(int r, int hi) { return (r & 3) + 8 * (r >> 2) + 4 * hi; }
__device__ __forceinline__ float xlane32(float v, int lane) { return __int_as_float(__builtin_amdgcn_ds_bpermute((lane ^ 32) << 2, __float_as_int(v))); }
__device__ __forceinline__ unsigned cvtpk(float lo, float hi) { unsigned r; asm volatile("v_cvt_pk_bf16_f32 %0, %1, %2" : "=v"(r) : "v"(lo), "v"(hi)); return r; }

template <int DK, bool SWA>
__device__ __forceinline__ void attn_unit(LAS unsigned char* lds, const bf16* Qg, const bf16* Kg, const bf16* Vtg, bf16* OCp, int b, int hcol, int tq0,
                                          int t0a, int t1a, int t0b, int t1b, float sink2, int tid) {
    constexpr int KS = DK * 2 + 16, VS = 136, KT_BYTES = 64 * KS, STAGE = KT_BYTES + 64 * VS, KP = DK / 8, NKP = 64 * KP, NS = DK / 16;
    const int lane = tid & 63, wave = __builtin_amdgcn_readfirstlane(tid >> 6), q = lane & 31, hi = lane >> 5;
    LAS float* wsf = (LAS float*)(lds + 2 * STAGE) + wave * 64;
    const int tq = tq0 + wave * 32 + q;
    bf16x8s qf[NS];
#pragma unroll
    for (int s = 0; s < NS; ++s) qf[s] = *(const bf16x8s*)(Qg + (size_t)tq * DK + 16 * s + 8 * hi);
    f32x16 o0, o1;
#pragma unroll
    for (int r = 0; r < 16; ++r) { o0[r] = 0.f; o1[r] = 0.f; }
    float m = SWA ? sink2 : -1e30f, l = (SWA && hi == 0) ? 1.0f : 0.f;
    const int na = t1a - t0a, nt = na + (t1b - t0b);
    const int w0 = tq0 - NC + wave * 32;
    v4u kr0, kr1 = (v4u){0u, 0u, 0u, 0u}, vr;
    { const int t = na > 0 ? t0a : t0b; const v4u* kg = (const v4u*)(Kg + (size_t)t * 64 * DK); kr0 = kg[tid]; if (NKP > 512) { if (tid < NKP - 512) kr1 = kg[512 + tid]; }
      vr = *(const v4u*)(Vtg + (size_t)(tid >> 3) * TK + t * 64 + (tid & 7) * 8); }
    { LAS unsigned char* kb = lds; *(LAS v4u*)(kb + (tid / KP) * KS + (tid % KP) * 16) = kr0;
      if (NKP > 512) { if (tid < NKP - 512) { const int p = 512 + tid; *(LAS v4u*)(kb + (p / KP) * KS + (p % KP) * 16) = kr1; } }
      LAS unsigned char* vb = kb + KT_BYTES + (tid >> 3) * VS + (tid & 7) * 16; *(LAS v2u*)vb = (v2u){vr.x, vr.y}; *(LAS v2u*)(vb + 8) = (v2u){vr.z, vr.w}; }
    __syncthreads();
    for (int i = 0; i < nt; ++i) {
        const int t = i < na ? t0a + i : t0b + (i - na);
        if (i + 1 < nt) { const int tn = (i + 1) < na ? t0a + i + 1 : t0b + (i + 1 - na); const v4u* kg = (const v4u*)(Kg + (size_t)tn * 64 * DK); kr0 = kg[tid]; if (NKP > 512) { if (tid < NKP - 512) kr1 = kg[512 + tid]; }
            vr = *(const v4u*)(Vtg + (size_t)(tid >> 3) * TK + tn * 64 + (tid & 7) * 8); }
        LAS unsigned char* kb = lds + (i & 1) * STAGE; LAS unsigned char* vbs = kb + KT_BYTES;
        const int sb = 64 * t - NC;
        const bool band = SWA && t >= 4;
        const bool skip = band && (sb + 63 < w0 - 128 || sb > w0 + 31 + 128);
        if (!skip) {
            f32x16 p0, p1;
#pragma unroll
            for (int r = 0; r < 16; ++r) { p0[r] = 0.f; p1[r] = 0.f; }
#pragma unroll
            for (int s = 0; s < NS; ++s) {
                const bf16x8s k0 = *(const LAS bf16x8s*)(kb + q * KS + (16 * s + 8 * hi) * 2);
                const bf16x8s k1 = *(const LAS bf16x8s*)(kb + (32 + q) * KS + (16 * s + 8 * hi) * 2);
                p0 = __builtin_amdgcn_mfma_f32_32x32x16_bf16(k0, qf[s], p0, 0, 0, 0);
                p1 = __builtin_amdgcn_mfma_f32_32x32x16_bf16(k1, qf[s], p1, 0, 0, 0);
            }
            if (band) { const int tl = tq - NC;
#pragma unroll
                for (int r = 0; r < 16; ++r) { const int d0 = tl - (sb + crow(r, hi)), d1 = d0 - 32;
                    if (d0 > 128 || d0 < -128) p0[r] = -1e30f; if (d1 > 128 || d1 < -128) p1[r] = -1e30f; } }
            float mx = fmaxf(p0[0], p1[0]);
#pragma unroll
            for (int r = 1; r < 16; ++r) mx = fmaxf(mx, fmaxf(p0[r], p1[r]));
            mx = fmaxf(mx, xlane32(mx, lane));
            const float mn = fmaxf(m, mx), alpha = __builtin_amdgcn_exp2f(m - mn); m = mn;
            float ps = 0.f;
#pragma unroll
            for (int r = 0; r < 16; ++r) { p0[r] = __builtin_amdgcn_exp2f(p0[r] - mn); p1[r] = __builtin_amdgcn_exp2f(p1[r] - mn); ps += p0[r] + p1[r]; }
            l = l * alpha + ps;
            if (hi == 0) wsf[q] = alpha;
            bf16x8s pa[4];
            { v4u w;
              w.x = cvtpk(p0[0], p0[1]); w.y = cvtpk(p0[2], p0[3]); w.z = cvtpk(p0[4], p0[5]); w.w = cvtpk(p0[6], p0[7]); pa[0] = __builtin_bit_cast(bf16x8s, w);
              w.x = cvtpk(p0[8], p0[9]); w.y = cvtpk(p0[10], p0[11]); w.z = cvtpk(p0[12], p0[13]); w.w = cvtpk(p0[14], p0[15]); pa[1] = __builtin_bit_cast(bf16x8s, w);
              w.x = cvtpk(p1[0], p1[1]); w.y = cvtpk(p1[2], p1[3]); w.z = cvtpk(p1[4], p1[5]); w.w = cvtpk(p1[6], p1[7]); pa[2] = __builtin_bit_cast(bf16x8s, w);
              w.x = cvtpk(p1[8], p1[9]); w.y = cvtpk(p1[10], p1[11]); w.z = cvtpk(p1[12], p1[13]); w.w = cvtpk(p1[14], p1[15]); pa[3] = __builtin_bit_cast(bf16x8s, w); }
            asm volatile("s_waitcnt lgkmcnt(0)" ::: "memory");
#pragma unroll
            for (int r = 0; r < 16; ++r) { const float a = wsf[crow(r, hi)]; o0[r] *= a; o1[r] *= a; }
#pragma unroll
            for (int s4 = 0; s4 < 4; ++s4)
#pragma unroll
                for (int nb = 0; nb < 2; ++nb) {
                    const LAS unsigned char* vp = vbs + (32 * nb + q) * VS + (16 * s4 + 4 * hi) * 2;
                    const v2u lo = *(const LAS v2u*)vp, hh = *(const LAS v2u*)(vp + 16);
                    const bf16x8s vf = __builtin_bit_cast(bf16x8s, ((v4u){lo.x, lo.y, hh.x, hh.y}));
                    if (nb == 0) o0 = __builtin_amdgcn_mfma_f32_32x32x16_bf16(pa[s4], vf, o0, 0, 0, 0); else o1 = __builtin_amdgcn_mfma_f32_32x32x16_bf16(pa[s4], vf, o1, 0, 0, 0);
                }
        }
        if (i + 1 < nt) { LAS unsigned char* kn = lds + ((i + 1) & 1) * STAGE; *(LAS v4u*)(kn + (tid / KP) * KS + (tid % KP) * 16) = kr0;
            if (NKP > 512) { if (tid < NKP - 512) { const int p = 512 + tid; *(LAS v4u*)(kn + (p / KP) * KS + (p % KP) * 16) = kr1; } }
            LAS unsigned char* vb = kn + KT_BYTES + (tid >> 3) * VS + (tid & 7) * 16; *(LAS v2u*)vb = (v2u){vr.x, vr.y}; *(LAS v2u*)(vb + 8) = (v2u){vr.z, vr.w}; }
        __syncthreads();
    }
    const float lt = l + xlane32(l, lane);
    if (hi == 0) wsf[q] = 1.0f / lt;
    asm volatile("s_waitcnt lgkmcnt(0)" ::: "memory");
#pragma unroll
    for (int r = 0; r < 16; ++r) { const int qq = crow(r, hi); const float inv = wsf[qq];
        bf16* op = OCp + (size_t)row_of(b, tq0 + wave * 32 + qq) * D + hcol + q;
        op[0] = f2bf(o0[r] * inv); op[32] = f2bf(o1[r] * inv); }
    __syncthreads();
}
__device__ __forceinline__ void attn_phase(LAS unsigned char* lds, const Mix& M, const float* sink, bool with_ctx, int tid) {
    const int nunits = 512 + (with_ctx ? 64 : 0);
    for (int u = blockIdx.x; u < nunits; u += gridDim.x) {
        if (u < 512) {
            const int c = u & 255, bh = (c & 7) + 8 * (c >> 6), qb = (c >> 3) & 7, b = bh >> 2, h = bh & 3, tq0 = NC + 256 * qb;
            if (u < 256) attn_unit<96, false>(lds, M.Qm + (size_t)bh * TK * 96, M.Km + (size_t)bh * TK * 96, M.Vm + (size_t)bh * 64 * TK, M.OC, b, h * 64, tq0, 0, TK / 64, 0, 0, 0.f, tid);
            else { const int slo = 256 * qb - 128 < 0 ? 0 : 256 * qb - 128, shi = 256 * qb + 383 > NL - 1 ? NL - 1 : 256 * qb + 383;
                attn_unit<64, true>(lds, M.Qs + (size_t)bh * TK * 64, M.Ks + (size_t)(b * 2 + (h >> 1)) * TK * 64, M.Vs + (size_t)(b * 2 + (h >> 1)) * 64 * TK, M.OC, b, 512 + h * 64, tq0,
                                    0, NC / 64, (NC + slo) / 64, (NC + shi) / 64 + 1, sink[h] * LOG2E, tid); }
        } else {
            const int c = (u - 512) & 31, b = c >> 2, h = c & 3;
            if (u < 544) attn_unit<96, false>(lds, M.Qm + (size_t)c * TK * 96, M.Km + (size_t)c * TK * 96, M.Vm + (size_t)c * 64 * TK, M.OC, b, h * 64, 0, 0, NC / 64, 0, 0, 0.f, tid);
            else attn_unit<64, true>(lds, M.Qs + (size_t)c * TK * 64, M.Ks + (size_t)(b * 2 + (h >> 1)) * TK * 64, M.Vs + (size_t)(b * 2 + (h >> 1)) * 64 * TK, M.OC, b, 512 + h * 64, 0, 0, NC / 64, 0, 0, sink[h] * LOG2E, tid);
        }
    }
}
__device__ __forceinline__ float wsum(float v, int  ) {
    int x = __float_as_int(v);
    v += __int_as_float(__builtin_amdgcn_update_dpp(0, x, 0xB1, 0xF, 0xF, true)); x = __float_as_int(v);
    v += __int_as_float(__builtin_amdgcn_update_dpp(0, x, 0x4E, 0xF, 0xF, true)); x = __float_as_int(v);
    v += __int_as_float(__builtin_amdgcn_update_dpp(0, x, 0x141, 0xF, 0xF, true)); x = __float_as_int(v);
    v += __int_as_float(__builtin_amdgcn_update_dpp(0, x, 0x140, 0xF, 0xF, true)); x = __float_as_int(v);
    v += __int_as_float(__builtin_amdgcn_update_dpp(0, x, 0x142, 0xA, 0xF, false)); x = __float_as_int(v);
    v += __int_as_float(__builtin_amdgcn_update_dpp(0, x, 0x143, 0xC, 0xF, false));
    return __int_as_float(__builtin_amdgcn_readlane(__float_as_int(v), 63));
}
__device__ __forceinline__ float fma_s(float a, float b, float c) { float d; asm("v_fma_f32 %0, %1, %2, %3" : "=v"(d) : "v"(a), "v"(b), "v"(c)); return d; }
__device__ __forceinline__ float sub_s(float a, float b) { float d; asm("v_sub_f32_e32 %0, %1, %2" : "=v"(d) : "v"(a), "v"(b)); return d; }
typedef float f32x2t __attribute__((ext_vector_type(2))); typedef __bf16 bf16x2t __attribute__((ext_vector_type(2)));
__device__ __forceinline__ unsigned cvtpk_c(float lo, float hi) { const f32x2t v = {lo, hi}; const bf16x2t b = __builtin_convertvector(v, bf16x2t); return __builtin_bit_cast(unsigned, b); }
__device__ __forceinline__ float bfl(unsigned w) { return __uint_as_float(w << 16); }
__device__ __forceinline__ float bfh(unsigned w) { return __uint_as_float(w & 0xffff0000u); }
struct PrepRegs { v2u ql, kvl, qn, kn, hzf, hzb; unsigned qp1, qp2, kp1, kp2, sq1, sq2, sk1, sk2, r1, r2; };
__device__ __forceinline__ void prep_load(PrepRegs& R, const bf16* p, int lane) {
    const int h = lane >> 4, i = lane & 15;
    R.ql = *(const v2u*)(p + C_QLAT + 4 * (lane < 48 ? lane : 0)); R.kvl = *(const v2u*)(p + C_KVLAT + 4 * (lane & 31));
    R.qn = *(const v2u*)(p + C_QE + h * 96 + 4 * i); R.kn = *(const v2u*)(p + C_KVE + h * 128 + 4 * i);
    R.qp1 = p[C_QE + h * 96 + 64 + i]; R.qp2 = p[C_QE + h * 96 + 80 + i]; R.kp1 = p[C_KPE + i]; R.kp2 = p[C_KPE + 16 + i];
    R.sq1 = *(const unsigned*)(p + C_SQ + h * 64 + 2 * i); R.sq2 = *(const unsigned*)(p + C_SQ + h * 64 + 32 + 2 * i);
    R.sk1 = *(const unsigned*)(p + C_SK + (h & 1) * 64 + 2 * i); R.sk2 = *(const unsigned*)(p + C_SK + (h & 1) * 64 + 32 + 2 * i);
    R.hzf = *(const v2u*)(p + C_HZF + 4 * lane); R.hzb = *(const v2u*)(p + C_HZB + 4 * lane);
    { const int w = lane >> 5, hh = (lane >> 3) & 3, j0 = 2 * (lane & 7); R.r1 = *(const unsigned*)(p + (w ? C_RK : C_RQ) + hh * 32 + j0); R.r2 = *(const unsigned*)(p + (w ? C_RK : C_RQ) + hh * 32 + 16 + j0); }
}
__device__ __forceinline__ float lfg(float z, float a, float bb0) { const float bb = bb0 + log_sigmoid_f(z), mx = fmaxf(a, bb); return (mx + log1pf(expf(-fabsf(a - bb)))) * LOG2E; }
__device__ __forceinline__ void prep_compute(const Mix& M, const float* tab, const PrepRegs& R, int row, int lane) {
    int b, tq; row_split(row, b, tq); const bool lat = tq >= NC; const int t = lat ? tq - NC : 0;
    const int h = lane >> 4, i = lane & 15;
    float sq = 0.f, skv = 0.f;
    if (lane < 48) { const float a = bfl(R.ql.x), c = bfh(R.ql.x), d = bfl(R.ql.y), e = bfh(R.ql.y); sq = (a * a + c * c) + (d * d + e * e); }
    if (lane < 32) { const float a = bfl(R.kvl.x), c = bfh(R.kvl.x), d = bfl(R.kvl.y), e = bfh(R.kvl.y); skv = (a * a + c * c) + (d * d + e * e); }
    sq = wsum(sq, lane); skv = wsum(skv, lane);
    const float rq = 1.0f / sqrtf(sq * (1.0f / 192.0f) + NORM_EPS), rkv = 1.0f / sqrtf(skv * (1.0f / 128.0f) + NORM_EPS), qs = rq * 0.10206207261596575f * LOG2E;
    const size_t o96 = ((size_t)(b * 4 + h) * TK + tq) * 96;
    { v2u w; w.x = cvtpk_c(bfl(R.qn.x) * qs, bfh(R.qn.x) * qs); w.y = cvtpk_c(bfl(R.qn.y) * qs, bfh(R.qn.y) * qs); *(v2u*)(M.Qm + o96 + 4 * i) = w;
      w.x = cvtpk_c(bfl(R.kn.x) * rkv, bfh(R.kn.x) * rkv); w.y = cvtpk_c(bfl(R.kn.y) * rkv, bfh(R.kn.y) * rkv); *(v2u*)(M.Km + o96 + 4 * i) = w; }
    { float c = 1.f, s = 0.f; if (lat) { const f32x2t cs = *(const f32x2t*)(tab + TAB_MLA + (t * 16 + i) * 2); c = cs.x; s = cs.y; }
      const float q1 = bf2f((bf16)R.qp1), q2 = bf2f((bf16)R.qp2); M.Qm[o96 + 64 + i] = f2bf((q1 * c - q2 * s) * qs); M.Qm[o96 + 80 + i] = f2bf((q1 * s + q2 * c) * qs);
      const float k1 = bf2f((bf16)R.kp1), k2 = bf2f((bf16)R.kp2); M.Km[o96 + 64 + i] = f2bf(k1 * c - k2 * s); M.Km[o96 + 80 + i] = f2bf(k1 * s + k2 * c); }
    { f32x4 cs = (f32x4){1.f, 0.f, 1.f, 0.f}; if (lat) cs = *(const f32x4*)(tab + TAB_SWA + (t * 32 + 2 * i) * 2);
      { const float xa = bfl(R.sq1), xb = bfh(R.sq1), ya = bfl(R.sq2), yb = bfh(R.sq2), sc2 = 0.125f * LOG2E; bf16* o = M.Qs + ((size_t)(b * 4 + h) * TK + tq) * 64 + 2 * i;
        *(unsigned*)o = cvtpk_c((xa * cs[0] - ya * cs[1]) * sc2, (xb * cs[2] - yb * cs[3]) * sc2); *(unsigned*)(o + 32) = cvtpk_c((xa * cs[1] + ya * cs[0]) * sc2, (xb * cs[3] + yb * cs[2]) * sc2); }
      if (lane < 32) { const float xa = bfl(R.sk1), xb = bfh(R.sk1), ya = bfl(R.sk2), yb = bfh(R.sk2); bf16* o = M.Ks + ((size_t)(b * 2 + h) * TK + tq) * 64 + 2 * i;
        *(unsigned*)o = cvtpk_c(xa * cs[0] - ya * cs[1], xb * cs[2] - yb * cs[3]); *(unsigned*)(o + 32) = cvtpk_c(xa * cs[1] + ya * cs[0], xb * cs[3] + yb * cs[2]); } }
    { const f32x4 a0 = *(const f32x4*)(M.loglb + 4 * lane), b0 = *(const f32x4*)(M.log1mlb + 4 * lane), a1 = *(const f32x4*)(M.loglb + 256 + 4 * lane), b1 = *(const f32x4*)(M.log1mlb + 256 + 4 * lane);
      *(f32x4*)(M.HF + ((size_t)0 * NTOK + row) * 256 + 4 * lane) = (f32x4){lfg(bfl(R.hzf.x), a0[0], b0[0]), lfg(bfh(R.hzf.x), a0[1], b0[1]), lfg(bfl(R.hzf.y), a0[2], b0[2]), lfg(bfh(R.hzf.y), a0[3], b0[3])};
      *(f32x4*)(M.HF + ((size_t)1 * NTOK + row) * 256 + 4 * lane) = (f32x4){lfg(bfl(R.hzb.x), a1[0], b1[0]), lfg(bfh(R.hzb.x), a1[1], b1[1]), lfg(bfl(R.hzb.y), a1[2], b1[2]), lfg(bfh(R.hzb.y), a1[3], b1[3])}; }
    { const int w = lane >> 5, hh = (lane >> 3) & 3, j0 = 2 * (lane & 7); const f32x4 cs = *(const f32x4*)(tab + TAB_RET + (tq * 16 + j0) * 2);
      float* o = (w ? M.RK : M.RQ) + (size_t)row * 128 + hh * 32 + j0; const float sc = w ? 1.0f : 0.17677669529663687f;
      const float xa = bfl(R.r1), xb = bfh(R.r1), ya = bfl(R.r2), yb = bfh(R.r2);
      *(f32x2t*)o = (f32x2t){(xa * cs[0] - ya * cs[1]) * sc, (xb * cs[2] - yb * cs[3]) * sc}; *(f32x2t*)(o + 16) = (f32x2t){(xa * cs[1] + ya * cs[0]) * sc, (xb * cs[3] + yb * cs[2]) * sc}; }
}
__device__ __forceinline__ void prep_vt(const Mix& M, int g8, int lane) {
    const int row0 = g8 * 8; int b, tq0; row_split(row0, b, tq0);
    float rkv[8];
#pragma unroll
    for (int r = 0; r < 8; ++r) { float skv = 0.f; if (lane < 32) { const v2u w = *(const v2u*)(M.P + (size_t)(row0 + r) * NP + C_KVLAT + 4 * lane); const float a = bfl(w.x), c = bfh(w.x), d = bfl(w.y), e = bfh(w.y); skv = (a * a + c * c) + (d * d + e * e); }
        skv = wsum(skv, lane); rkv[r] = 1.0f / sqrtf(skv * (1.0f / 128.0f) + NORM_EPS); }
#pragma unroll
    for (int h = 0; h < 4; ++h) { float v[8];
#pragma unroll
        for (int r = 0; r < 8; ++r) v[r] = bf2f(M.P[(size_t)(row0 + r) * NP + C_KVE + h * 128 + 64 + lane]) * rkv[r];
        v4u o; o.x = pk2(v[0], v[1]); o.y = pk2(v[2], v[3]); o.z = pk2(v[4], v[5]); o.w = pk2(v[6], v[7]);
        *(v4u*)(M.Vm + ((size_t)(b * 4 + h) * 64 + lane) * TK + tq0) = o; }
#pragma unroll
    for (int kh = 0; kh < 2; ++kh) { unsigned short v[8];
#pragma unroll
        for (int r = 0; r < 8; ++r) v[r] = M.P[(size_t)(row0 + r) * NP + C_SV + kh * 64 + lane];
        v4u o; o.x = (unsigned)v[0] | ((unsigned)v[1] << 16); o.y = (unsigned)v[2] | ((unsigned)v[3] << 16); o.z = (unsigned)v[4] | ((unsigned)v[5] << 16); o.w = (unsigned)v[6] | ((unsigned)v[7] << 16);
        *(v4u*)(M.Vs + ((size_t)(b * 2 + kh) * 64 + lane) * TK + tq0) = o; }
}
constexpr int SBT = 12, NSB = CH / SBT;
__device__ __forceinline__ int scan_row(int b, int dir, int pos) { return row_of(b, dir_tq(dir, pos)); }
__device__ __forceinline__ void scan_local_wave(const Mix& M, LAS float* wl  , int unit, int lane) {
    const int c = unit % NCH, seq = unit / NCH, h = seq & 3, b = (seq >> 2) % NB, dir = seq / (4 * NB);
    const float g = expf(M.log_gamma[dir * 4 + h]);
    float S[64], R[32];
#pragma unroll
    for (int k = 0; k < 64; ++k) S[k] = 0.f;
#pragma unroll
    for (int k = 0; k < 32; ++k) R[k] = 0.f;
    float dk = 1.0f, gp = 1.0f;
    LAS float* Fs = wl; LAS float* Qs = wl + 768; LAS float* Vs = wl + 1536; LAS float* Ks = wl + 2304; LAS float* Qr = wl + 2688; LAS float* Vr = wl + 3072;
    const int tt0 = lane >> 4, k4 = (lane & 15) * 4, tr0 = lane >> 3, r4 = (lane & 7) * 4;
    for (int sb = 0; sb < NSB; ++sb) {
        const int pos0 = CH * c + SBT * sb;
        f32x4 fr[3], kr[2], qq[2]; v2u qr[3]; unsigned short vr[SBT], wr[SBT];
#pragma unroll
        for (int j = 0; j < 3; ++j) { const int row = scan_row(b, dir, pos0 + 4 * j + tt0);
            fr[j] = *(const f32x4*)(M.HF + ((size_t)dir * NTOK + row) * 256 + h * 64 + k4); qr[j] = *(const v2u*)(M.P + (size_t)row * NP + C_HQ + h * 64 + k4); }
#pragma unroll
        for (int j = 0; j < 2; ++j) { const int tt = 8 * j + tr0; const int row = scan_row(b, dir, pos0 + (tt < SBT ? tt : 0));
            kr[j] = *(const f32x4*)(M.RK + (size_t)row * 128 + h * 32 + r4); qq[j] = *(const f32x4*)(M.RQ + (size_t)row * 128 + h * 32 + r4); }
#pragma unroll
        for (int i = 0; i < SBT; ++i) { const bf16* p = M.P + (size_t)scan_row(b, dir, pos0 + i) * NP; vr[i] = p[C_HI + h * 64 + lane]; wr[i] = p[C_RV + h * 64 + lane]; }
#pragma unroll
        for (int j = 0; j < 3; ++j) { *(LAS f32x4*)(Fs + (4 * j + tt0) * 64 + k4) = fr[j];
            *(LAS f32x4*)(Qs + (4 * j + tt0) * 64 + k4) = (f32x4){bfl(qr[j].x) * 0.125f, bfh(qr[j].x) * 0.125f, bfl(qr[j].y) * 0.125f, bfh(qr[j].y) * 0.125f}; }
#pragma unroll
        for (int j = 0; j < 2; ++j) { const int tt = 8 * j + tr0; if (tt < SBT) { *(LAS f32x4*)(Ks + tt * 32 + r4) = kr[j]; *(LAS f32x4*)(Qr + tt * 32 + r4) = qq[j]; } }
#pragma unroll
        for (int i = 0; i < SBT; ++i) { Vs[i * 64 + lane] = bf2f(vr[i]); Vr[i * 64 + lane] = bf2f(wr[i]); }
        asm volatile("s_waitcnt lgkmcnt(0)" ::: "memory");
        for (int i = 0; i < SBT; ++i) {
            const int row = scan_row(b, dir, pos0 + i); const float v = Vs[i * 64 + lane], w = Vr[i * 64 + lane]; float ac[4] = {0.f, 0.f, 0.f, 0.f}, ar[4] = {0.f, 0.f, 0.f, 0.f};
            dk *= Fs[i * 64 + lane]; M.HQC[((size_t)dir * NTOK + row) * 256 + h * 64 + lane] = Qs[i * 64 + lane] * dk;
            gp *= g; if (lane < 32) M.RQC[((size_t)dir * NTOK + row) * 128 + h * 32 + lane] = Qr[i * 32 + lane] * gp;
#pragma unroll
            for (int kk = 0; kk < 16; ++kk) { const f32x4 f4 = *(const LAS f32x4*)(Fs + i * 64 + 4 * kk), q4 = *(const LAS f32x4*)(Qs + i * 64 + 4 * kk);
#pragma unroll
                for (int j = 0; j < 4; ++j) { S[4 * kk + j] = f4[j] * (S[4 * kk + j] - v) + v; ac[j] += q4[j] * S[4 * kk + j]; }
                if (kk & 1) { const int k2 = kk >> 1; const f32x4 k4v = *(const LAS f32x4*)(Ks + i * 32 + 4 * k2), p4 = *(const LAS f32x4*)(Qr + i * 32 + 4 * k2);
#pragma unroll
                    for (int j = 0; j < 4; ++j) { R[4 * k2 + j] = g * R[4 * k2 + j] + k4v[j] * w; ar[j] += p4[j] * R[4 * k2 + j]; } } }
            M.HO[((size_t)dir * NTOK + row) * 256 + h * 64 + lane] = (ac[0] + ac[1]) + (ac[2] + ac[3]);
            M.RO[((size_t)dir * NTOK + row) * 256 + h * 64 + lane] = (ar[0] + ar[1]) + (ar[2] + ar[3]);
        }
        asm volatile("s_waitcnt lgkmcnt(0)" ::: "memory");
    }
    float* u = M.HU + ((size_t)seq * NCH + c) * 4096 + lane; float* ur = M.RU + ((size_t)seq * NCH + c) * 2048 + lane;
#pragma unroll
    for (int k = 0; k < 64; ++k) u[k * 64] = S[k];
#pragma unroll
    for (int k = 0; k < 32; ++k) ur[k * 64] = R[k];
    M.HDK[((size_t)seq * NCH + c) * 64 + lane] = dk;
}
__device__ __forceinline__ int bwd_chunk(int tq) { return (tq < NC ? NC - 1 - tq : NC + (NL - 1 - (tq - NC))) / CH; }
__device__ __forceinline__ void hg_fixfin_wave(const Mix& M, LAS float* wl, int unit, int lane, int tq_min) {
    const int c = unit % NCH, bh = unit / NCH, h = bh & 3, b = bh >> 2;
    if (CH * c + CH <= tq_min) return;
    const float* uf = M.HU + ((size_t)((0 * NB + b) * 4 + h) * NCH + c) * 4096 + lane;
    float Sf[64], Sb[64];
#pragma unroll
    for (int k = 0; k < 64; ++k) { Sf[k] = uf[k * 64]; Sb[k] = 0.f; }
    int cb = -1;
    const float ng = M.hg_norm_g[h * 64 + lane];
    const int tt0 = lane >> 4, k4 = (lane & 15) * 4;
    LAS float* Af = wl; LAS float* Ab = wl + 768;
    for (int sb = 0; sb < NSB; ++sb) {
        const int tq0 = CH * c + SBT * sb;
#pragma unroll
        for (int j = 0; j < 3; ++j) { const int row = row_of(b, tq0 + 4 * j + tt0);
            *(LAS f32x4*)(Af + (4 * j + tt0) * 64 + k4) = *(const f32x4*)(M.HQC + ((size_t)0 * NTOK + row) * 256 + h * 64 + k4);
            *(LAS f32x4*)(Ab + (4 * j + tt0) * 64 + k4) = *(const f32x4*)(M.HQC + ((size_t)1 * NTOK + row) * 256 + h * 64 + k4); }
        asm volatile("s_waitcnt lgkmcnt(0)" ::: "memory");
        for (int i = 0; i < SBT; ++i) {
            const int tq = tq0 + i, row = row_of(b, tq), cbn = bwd_chunk(tq);
            if (cbn != cb) { cb = cbn; const float* ub = M.HU + ((size_t)((1 * NB + b) * 4 + h) * NCH + cb) * 4096 + lane;
#pragma unroll
                for (int k = 0; k < 64; ++k) Sb[k] = ub[k * 64]; }
            float ac[4] = {M.HO[((size_t)0 * NTOK + row) * 256 + h * 64 + lane], M.HO[((size_t)1 * NTOK + row) * 256 + h * 64 + lane], 0.f, 0.f};
            const float gate = bf2f(M.P[(size_t)row * NP + C_HG + h * 64 + lane]);
#pragma unroll
            for (int kk = 0; kk < 16; ++kk) { const f32x4 a4 = *(const LAS f32x4*)(Af + i * 64 + 4 * kk), b4 = *(const LAS f32x4*)(Ab + i * 64 + 4 * kk);
#pragma unroll
                for (int j = 0; j < 4; ++j) { ac[j] += a4[j] * Sf[4 * kk + j]; ac[j] += b4[j] * Sb[4 * kk + j]; } }
            const float acc = (ac[0] + ac[1]) + (ac[2] + ac[3]);
            const float r = 1.0f / sqrtf(wsum(acc * acc, lane) * (1.0f / 64.0f) + NORM_EPS);
            M.OC[(size_t)row * D + 256 + h * 64 + lane] = f2bf(acc * r * ng * silu_f(gate));
        }
        asm volatile("s_waitcnt lgkmcnt(0)" ::: "memory");
    }
}
__device__ __forceinline__ void ret_fixfin_wave(const Mix& M, LAS float* wl, int unit, int lane, int tq_min) {
    const int c = unit % NCH, bh = unit / NCH, h = bh & 3, b = bh >> 2;
    if (CH * c + CH <= tq_min) return;
    const float* uf = M.RU + ((size_t)((0 * NB + b) * 4 + h) * NCH + c) * 2048 + lane;
    float Sf[32], Sb[32];
#pragma unroll
    for (int k = 0; k < 32; ++k) { Sf[k] = uf[k * 64]; Sb[k] = 0.f; }
    int cb = -1;
    const float gg = M.gn_g[h * 64 + lane], gb = M.gn_b[h * 64 + lane];
    const int tt0 = lane >> 3, k4 = (lane & 7) * 4;
    LAS float* Af = wl; LAS float* Ab = wl + 768;
    for (int sb = 0; sb < NSB; ++sb) {
        const int tq0 = CH * c + SBT * sb;
#pragma unroll
        for (int j = 0; j < 2; ++j) { const int tt = 8 * j + tt0; if (tt < SBT) { const int row = row_of(b, tq0 + tt);
            *(LAS f32x4*)(Af + tt * 32 + k4) = *(const f32x4*)(M.RQC + ((size_t)0 * NTOK + row) * 128 + h * 32 + k4);
            *(LAS f32x4*)(Ab + tt * 32 + k4) = *(const f32x4*)(M.RQC + ((size_t)1 * NTOK + row) * 128 + h * 32 + k4); } }
        asm volatile("s_waitcnt lgkmcnt(0)" ::: "memory");
        for (int i = 0; i < SBT; ++i) {
            const int tq = tq0 + i, row = row_of(b, tq), cbn = bwd_chunk(tq);
            if (cbn != cb) { cb = cbn; const float* ub = M.RU + ((size_t)((1 * NB + b) * 4 + h) * NCH + cb) * 2048 + lane;
#pragma unroll
                for (int k = 0; k < 32; ++k) Sb[k] = ub[k * 64]; }
            float ac[4] = {M.RO[((size_t)0 * NTOK + row) * 256 + h * 64 + lane], M.RO[((size_t)1 * NTOK + row) * 256 + h * 64 + lane], 0.f, 0.f};
            const float gate = bf2f(M.P[(size_t)row * NP + C_RG + h * 64 + lane]);
#pragma unroll
            for (int kk = 0; kk < 8; ++kk) { const f32x4 a4 = *(const LAS f32x4*)(Af + i * 32 + 4 * kk), b4 = *(const LAS f32x4*)(Ab + i * 32 + 4 * kk);
#pragma unroll
                for (int j = 0; j < 4; ++j) { ac[j] += a4[j] * Sf[4 * kk + j]; ac[j] += b4[j] * Sb[4 * kk + j]; } }
            const float acc = (ac[0] + ac[1]) + (ac[2] + ac[3]);
            const float mu = wsum(acc, lane) * (1.0f / 64.0f), dd = acc - mu, r = 1.0f / sqrtf(wsum(dd * dd, lane) * (1.0f / 64.0f) + NORM_EPS);
            M.OC[(size_t)row * D + 768 + h * 64 + lane] = f2bf((dd * r * gg + gb) * silu_f(gate));
        }
        asm volatile("s_waitcnt lgkmcnt(0)" ::: "memory");
    }
}
typedef short s16x4 __attribute__((ext_vector_type(4)));
constexpr int MCH = 64, MNCH = TK / MCH;
constexpr int MS_PITCH = 144, MS_MAT = 16 * MS_PITCH, MS_KE = 3 * MS_MAT, MS_VT = MS_KE + 3072, MS_D = MS_VT + 3072, MS_BYTES = MS_D + 256;
static_assert(MS_BYTES <= 13312, "scan LDS block");
__device__ __forceinline__ int pk64(int k) { const int kp = k & 31; return (k & 32) + 8 * ((kp >> 2) & 3) + 4 * (kp >> 4) + (kp & 3); }
__device__ __forceinline__ void chunk_rows(int b, int dir, int c, int& r0, int& rs) {
    if (dir == 0) { r0 = row_of(b, MCH * c); rs = 1; } else { const int i0 = MCH * c; r0 = row_of(b, i0 < NC ? NC - 1 - i0 : NC + (NL - 1 - (i0 - NC))); rs = -1; }
}
__device__ __forceinline__ bf16x8s pack8(const f32x4& a, const f32x4& b) { v4u w; w.x = cvtpk_c(a[0], a[1]); w.y = cvtpk_c(a[2], a[3]); w.z = cvtpk_c(b[0], b[1]); w.w = cvtpk_c(b[2], b[3]); return __builtin_bit_cast(bf16x8s, w); }
__device__ __forceinline__ s16x4 pack4(const f32x4& a) { v2u w; w.x = cvtpk_c(a[0], a[1]); w.y = cvtpk_c(a[2], a[3]); return __builtin_bit_cast(s16x4, w); }
__device__ __forceinline__ f32x4 mfma16(const s16x4& a, const s16x4& b, const f32x4& c) {
    const bf16x8s a8 = {a[0], a[1], a[2], a[3], 0, 0, 0, 0}, b8 = {b[0], b[1], b[2], b[3], 0, 0, 0, 0};
    return __builtin_amdgcn_mfma_f32_16x16x32_bf16(a8, b8, c, 0, 0, 0);
}
__device__ __forceinline__ float ex2(float x) { return __builtin_amdgcn_exp2f(x); }

template <bool HG> __device__ __forceinline__ void mscan_local(const Mix& M, LAS unsigned char* wl, int unit, int lane) {
    constexpr int DK = HG ? 64 : 32, NKB = DK / 16, NKS = DK / 32;
    const int c = unit % MNCH, seq = unit / MNCH, h = seq & 3, b = (seq >> 2) % NB, dir = seq / (4 * NB);
    const int c16 = lane & 15, g = lane >> 4;
    int r0, rs; chunk_rows(b, dir, c, r0, rs);
    LAS unsigned short* Qm = (LAS unsigned short*)wl; LAS unsigned short* Km = (LAS unsigned short*)(wl + MS_MAT);
    LAS unsigned char* KmT = wl + MS_KE; LAS unsigned char* VT = wl + MS_VT; LAS float* sc = (LAS float*)(wl + 2 * MS_MAT);
    f32x4 S[NKB][4];
#pragma unroll
    for (int kb = 0; kb < NKB; ++kb)
#pragma unroll
        for (int vb = 0; vb < 4; ++vb) S[kb][vb] = (f32x4){0.f, 0.f, 0.f, 0.f};
    const float lg2 = HG ? 0.f : M.log_gamma[dir * 4 + h] * LOG2E;
    float Bc = 0.f;
    const int kq = HG ? lane : (lane & 31), th = HG ? 0 : (lane >> 5) * 8;
    const int pkq = pk64(kq);
    unsigned short vv[16]; float lf[16]; unsigned short qh[16]; float rq8[8], rk8[8];
#define MS_LOAD(i_) do { const int rb_ = r0 + rs * 16 * (i_); \
        _Pragma("unroll") for (int t = 0; t < 16; ++t) vv[t] = M.P[(size_t)(rb_ + rs * t) * NP + (HG ? C_HI : C_RV) + h * 64 + lane]; \
        if (HG) { _Pragma("unroll") for (int t = 0; t < 16; ++t) { const int row = rb_ + rs * t; lf[t] = M.HF[((size_t)dir * NTOK + row) * 256 + h * 64 + lane]; qh[t] = M.P[(size_t)row * NP + C_HQ + h * 64 + lane]; } } \
        else { _Pragma("unroll") for (int tt = 0; tt < 8; ++tt) { const int row = rb_ + rs * (th + tt); rq8[tt] = M.RQ[(size_t)row * 128 + h * 32 + kq]; rk8[tt] = M.RK[(size_t)row * 128 + h * 32 + kq]; } } } while (0)
    MS_LOAD(0);
    for (int i = 0; i < 4; ++i) {
        const int rb = r0 + rs * 16 * i;
        if (HG) {
            float bt[16]; { float a = 0.f;
#pragma unroll
                for (int t = 0; t < 16; ++t) { a += lf[t]; bt[t] = a; } }
            const float r = bt[7], bl = bt[15], e_rc = ex2(r + Bc) * 0.125f;
            unsigned km2[8];
#pragma unroll
            for (int t = 0; t < 16; ++t) { const int row = rb + rs * t;
                const float kk = 1.0f - ex2(lf[t]), em = ex2(bt[t] - r), qv = bf2f(qh[t]);
                const float qmv = qv * em * 0.125f, kmv = kk * __builtin_amdgcn_rcpf(em);
                const unsigned pr = cvtpk_c(qmv, kmv);
                Qm[t * (MS_PITCH / 2) + pkq] = (unsigned short)pr; Km[t * (MS_PITCH / 2) + pkq] = (unsigned short)(pr >> 16);
                if (t & 1) km2[t >> 1] |= pr & 0xffff0000u; else km2[t >> 1] = pr >> 16;
                M.HQCb[((size_t)dir * NTOK + row) * 256 + h * 64 + lane] = (unsigned short)cvtpk_c(qv * em * e_rc, 0.f); }
            *(LAS v4u*)(KmT + lane * 48) = (v4u){km2[0], km2[1], km2[2], km2[3]}; *(LAS v4u*)(KmT + lane * 48 + 16) = (v4u){km2[4], km2[5], km2[6], km2[7]};
            sc[lane] = ex2(r); sc[64 + lane] = ex2(bl); sc[128 + lane] = ex2(bl - r); Bc += bl;
        } else {
            unsigned km2[4];
#pragma unroll
            for (int tt = 0; tt < 8; ++tt) { const int t = th + tt, row = rb + rs * t;
                const float em = ex2((float)(t - 7) * lg2);
                const float qmv = rq8[tt] * em, kmv = rk8[tt] * __builtin_amdgcn_rcpf(em);
                const unsigned pr = cvtpk_c(qmv, kmv);
                Qm[t * (MS_PITCH / 2) + pkq] = (unsigned short)pr; Km[t * (MS_PITCH / 2) + pkq] = (unsigned short)(pr >> 16);
                if (tt & 1) km2[tt >> 1] |= pr & 0xffff0000u; else km2[tt >> 1] = pr >> 16;
                M.RQCb[((size_t)dir * NTOK + row) * 256 + h * 64 + kq] = (unsigned short)cvtpk_c(rq8[tt] * ex2((float)(16 * i + t + 1) * lg2), 0.f); }
            *(LAS v4u*)(KmT + kq * 48 + (th ? 16 : 0)) = (v4u){km2[0], km2[1], km2[2], km2[3]};
        }
        { v4u w0, w1; w0.x = (unsigned)vv[0] | ((unsigned)vv[1] << 16); w0.y = (unsigned)vv[2] | ((unsigned)vv[3] << 16); w0.z = (unsigned)vv[4] | ((unsigned)vv[5] << 16); w0.w = (unsigned)vv[6] | ((unsigned)vv[7] << 16);
          w1.x = (unsigned)vv[8] | ((unsigned)vv[9] << 16); w1.y = (unsigned)vv[10] | ((unsigned)vv[11] << 16); w1.z = (unsigned)vv[12] | ((unsigned)vv[13] << 16); w1.w = (unsigned)vv[14] | ((unsigned)vv[15] << 16);
          *(LAS v4u*)(VT + lane * 48) = w0; *(LAS v4u*)(VT + lane * 48 + 16) = w1; }
        if (i < 3) MS_LOAD(i + 1);
        asm volatile("s_waitcnt lgkmcnt(0)" ::: "memory");
        bf16x8s qmB[NKS], kmA[NKS];
#pragma unroll
        for (int ks = 0; ks < NKS; ++ks) { const int off = c16 * MS_PITCH + 64 * ks + 16 * g; qmB[ks] = *(const LAS bf16x8s*)(wl + off); kmA[ks] = *(const LAS bf16x8s*)(wl + MS_MAT + off); }
        s16x4 vt[4];
#pragma unroll
        for (int vb = 0; vb < 4; ++vb) vt[vb] = *(const LAS s16x4*)(VT + (16 * vb + c16) * 48 + 8 * g);
        f32x4 er[NKB], ebl[NKB], ec[NKB];
#pragma unroll
        for (int kb = 0; kb < NKB; ++kb) {
            if (HG) { er[kb] = *(const LAS f32x4*)(sc + 16 * kb + 4 * g); ebl[kb] = *(const LAS f32x4*)(sc + 64 + 16 * kb + 4 * g); ec[kb] = *(const LAS f32x4*)(sc + 128 + 16 * kb + 4 * g); }
            else { const float a = ex2(8.0f * lg2), d = ex2(16.0f * lg2); er[kb] = (f32x4){a, a, a, a}; ebl[kb] = (f32x4){d, d, d, d}; ec[kb] = er[kb]; } }
        f32x4 at = (f32x4){0.f, 0.f, 0.f, 0.f};
#pragma unroll
        for (int ks = 0; ks < NKS; ++ks) at = __builtin_amdgcn_mfma_f32_16x16x32_bf16(kmA[ks], qmB[ks], at, 0, 0, 0);
#pragma unroll
        for (int r = 0; r < 4; ++r) if (4 * g + r > c16) at[r] = 0.f;
        const s16x4 atB = pack4(at);
#pragma unroll
        for (int vb = 0; vb < 4; ++vb) {
            f32x4 o = (f32x4){0.f, 0.f, 0.f, 0.f};
#pragma unroll
            for (int ks = 0; ks < NKS; ++ks) o = __builtin_amdgcn_mfma_f32_16x16x32_bf16(pack8(S[2 * ks][vb] * er[2 * ks], S[2 * ks + 1][vb] * er[2 * ks + 1]), qmB[ks], o, 0, 0, 0);
            o = mfma16(vt[vb], atB, o);
            *(f32x4*)((HG ? M.HO : M.RO) + ((size_t)dir * NTOK + (rb + rs * c16)) * 256 + h * 64 + 16 * vb + 4 * g) = o;
        }
#pragma unroll
        for (int kb = 0; kb < NKB; ++kb) {
            const s16x4 kA = *(const LAS s16x4*)(KmT + (16 * kb + c16) * 48 + 8 * g);
#pragma unroll
            for (int vb = 0; vb < 4; ++vb) { const f32x4 tkv = mfma16(kA, vt[vb], (f32x4){0.f, 0.f, 0.f, 0.f}); S[kb][vb] = S[kb][vb] * ebl[kb] + tkv * ec[kb]; }
        }
        asm volatile("s_waitcnt lgkmcnt(0)" ::: "memory");
    }
#undef MS_LOAD
    float* st = (HG ? M.HU : M.RU) + ((size_t)seq * MNCH + c) * (64 * DK);
#pragma unroll
    for (int kb = 0; kb < NKB; ++kb)
#pragma unroll
        for (int vb = 0; vb < 4; ++vb) *(f32x4*)(st + (16 * vb + c16) * DK + 16 * kb + 4 * g) = S[kb][vb];
    if (HG) M.HDK[((size_t)seq * MNCH + c) * 64 + lane] = ex2(Bc);
}
__device__ __forceinline__ void mscan_carry_hg(const Mix& M, int item) {
    const int e = item & 4095, seq = item >> 12, k = e & 63; float s = 0.f;
#pragma unroll 12
    for (int c = 0; c < MNCH; ++c) { float* u = M.HU + ((size_t)seq * MNCH + c) * 4096 + e; const float uu = *u; *u = s; s = M.HDK[((size_t)seq * MNCH + c) * 64 + k] * s + uu; }
}
__device__ __forceinline__ void mscan_carry_ret(const Mix& M, int item) {
    const int e = item & 2047, seq = item >> 11, h = seq & 3, dir = seq / (4 * NB); float s = 0.f;
    const float d = ex2((float)MCH * M.log_gamma[dir * 4 + h] * LOG2E);
#pragma unroll 12
    for (int c = 0; c < MNCH; ++c) { float* u = M.RU + ((size_t)seq * MNCH + c) * 2048 + e; const float uu = *u; *u = s; s = d * s + uu; }
}
template <bool HG> __device__ __forceinline__ void mscan_fixfin(const Mix& M, int unit, int lane, bool with_ctx) {
    constexpr int DK = HG ? 64 : 32, NKS = DK / 32;
    const int T = unit % MNCH, bh = unit / MNCH, h = bh & 3, b = bh >> 2;
    if (T < NC / MCH && !with_ctx) return;
    const int c16 = lane & 15, g = lane >> 4;
    const int cb = T < 4 ? 3 - T : 39 - T;
    const float* HOp = HG ? M.HO : M.RO; const bf16* QCp = HG ? M.HQCb : M.RQCb; const float* STp = HG ? M.HU : M.RU;
    bf16x8s Sf[4][NKS], Sb[4][NKS];
#pragma unroll
    for (int vb = 0; vb < 4; ++vb)
#pragma unroll
        for (int ks = 0; ks < NKS; ++ks) {
            const float* pf = STp + ((size_t)((0 * NB + b) * 4 + h) * MNCH + T) * (64 * DK) + (16 * vb + c16) * DK + 32 * ks + 8 * g;
            const float* pb = STp + ((size_t)((1 * NB + b) * 4 + h) * MNCH + cb) * (64 * DK) + (16 * vb + c16) * DK + 32 * ks + 8 * g;
            Sf[vb][ks] = pack8(*(const f32x4*)pf, *(const f32x4*)(pf + 4)); Sb[vb][ks] = pack8(*(const f32x4*)pb, *(const f32x4*)(pb + 4)); }
    f32x4 w0[4], w1[4];
#pragma unroll
    for (int vb = 0; vb < 4; ++vb) { w0[vb] = *(const f32x4*)((HG ? M.hg_norm_g : M.gn_g) + h * 64 + 16 * vb + 4 * g); w1[vb] = HG ? (f32x4){0.f, 0.f, 0.f, 0.f} : *(const f32x4*)(M.gn_b + h * 64 + 16 * vb + 4 * g); }
    const int row0 = row_of(b, MCH * T);
    for (int i = 0; i < 4; ++i) {
        const int row = row0 + 16 * i + c16;
        bf16x8s qf[NKS], qb[NKS];
#pragma unroll
        for (int ks = 0; ks < NKS; ++ks) { qf[ks] = *(const bf16x8s*)(QCp + ((size_t)0 * NTOK + row) * 256 + h * 64 + 32 * ks + 8 * g); qb[ks] = *(const bf16x8s*)(QCp + ((size_t)1 * NTOK + row) * 256 + h * 64 + 32 * ks + 8 * g); }
        f32x4 o[4]; v2u gt[4];
#pragma unroll
        for (int vb = 0; vb < 4; ++vb) { o[vb] = *(const f32x4*)(HOp + ((size_t)0 * NTOK + row) * 256 + h * 64 + 16 * vb + 4 * g) + *(const f32x4*)(HOp + ((size_t)1 * NTOK + row) * 256 + h * 64 + 16 * vb + 4 * g);
            gt[vb] = *(const v2u*)(M.P + (size_t)row * NP + (HG ? C_HG : C_RG) + h * 64 + 16 * vb + 4 * g); }
#pragma unroll
        for (int vb = 0; vb < 4; ++vb)
#pragma unroll
            for (int ks = 0; ks < NKS; ++ks) { o[vb] = __builtin_amdgcn_mfma_f32_16x16x32_bf16(Sf[vb][ks], qf[ks], o[vb], 0, 0, 0); o[vb] = __builtin_amdgcn_mfma_f32_16x16x32_bf16(Sb[vb][ks], qb[ks], o[vb], 0, 0, 0); }
        float s1 = 0.f, s2 = 0.f;
#pragma unroll
        for (int vb = 0; vb < 4; ++vb)
#pragma unroll
            for (int r = 0; r < 4; ++r) { s1 += o[vb][r]; s2 += o[vb][r] * o[vb][r]; }
        s1 += __int_as_float(__builtin_amdgcn_ds_bpermute((lane ^ 16) << 2, __float_as_int(s1))); s2 += __int_as_float(__builtin_amdgcn_ds_bpermute((lane ^ 16) << 2, __float_as_int(s2)));
        s1 += __int_as_float(__builtin_amdgcn_ds_bpermute((lane ^ 32) << 2, __float_as_int(s1))); s2 += __int_as_float(__builtin_amdgcn_ds_bpermute((lane ^ 32) << 2, __float_as_int(s2)));
        const float mu = HG ? 0.f : s1 * (1.0f / 64.0f);
        const float var = HG ? s2 * (1.0f / 64.0f) : fmaxf(s2 * (1.0f / 64.0f) - mu * mu, 0.f);
        const float rstd = 1.0f / sqrtf(var + NORM_EPS);
#pragma unroll
        for (int vb = 0; vb < 4; ++vb) { float y[4];
            const float gv[4] = {bfl(gt[vb].x), bfh(gt[vb].x), bfl(gt[vb].y), bfh(gt[vb].y)};
#pragma unroll
            for (int r = 0; r < 4; ++r) y[r] = ((o[vb][r] - mu) * rstd * w0[vb][r] + w1[vb][r]) * silu_f(gv[r]);
            v2u w; w.x = cvtpk_c(y[0], y[1]); w.y = cvtpk_c(y[2], y[3]);
            *(v2u*)(M.OC + (size_t)row * D + (HG ? 256 : 768) + h * 64 + 16 * vb + 4 * g) = w; }
    }
}
template <int KIND> __device__ __forceinline__ void norm_phase(Frame& F, int l) {
    unsigned char* ws = F.base();
    const bool combine = (KIND != 1) && l > 0 && ((l - 1) & 1);
    const bool first = (KIND == 0 && l == 0);
    const int nrows = (KIND == 2 || (KIND == 1 && l == DEPTH - 1)) ? NLAT : NTOK;
    const float* modl = F_sm + SM_MOD + (size_t)(KIND == 2 ? 0 : l) * 9 * 6144;
    const float* modp = F_sm + SM_MOD + (size_t)(l > 0 ? l - 1 : 0) * 9 * 6144;
    const int* offs = (const int*)(F_sm + SM_META) + ((l > 0 ? l - 1 : 0) >> 1) * 16;
    const float* gain = KIND == 0 ? IN(6) + l * D : (KIND == 1 ? IN(7) + l * D : IN(27));
    for (int row = F.gw; row < nrows; row += F.NGW) {
        const int bidx = row < NLAT ? row / NL : NB;
        const float* src = first ? (row < NLAT ? IN(0) + (size_t)row * D : IN(2) + (size_t)(row - NLAT) * D) : F_H + (size_t)row * D;
        f32x4 v[4];
#pragma unroll
        for (int j = 0; j < 4; ++j) v[j] = *(const f32x4*)(src + 4 * F.lane + 256 * j);
        if (combine) {
            const int* ti = F_tokinfo + (size_t)row * 8;
            const int e1 = ti[0], p1 = ti[1], e2 = ti[3], p2 = ti[4]; const float w1 = __int_as_float(ti[2]), w2 = __int_as_float(ti[5]);
            const bf16* y1 = F_Y + (size_t)(offs[e1] + p1) * D; const bf16* y2 = F_Y + (size_t)(offs[e2] + p2) * D;
#pragma unroll
            for (int j = 0; j < 4; ++j) { const int col = 4 * F.lane + 256 * j;
                const f32x4 gf = *(const f32x4*)(modp + (size_t)bidx * 6144 + 5 * 1024 + col);
                const v2u a = *(const v2u*)(y1 + col), b = *(const v2u*)(y2 + col);
                f32x4 ya, yb; ya[0] = bf2f((bf16)(a.x & 0xffff)); ya[1] = bf2f((bf16)(a.x >> 16)); ya[2] = bf2f((bf16)(a.y & 0xffff)); ya[3] = bf2f((bf16)(a.y >> 16));
                yb[0] = bf2f((bf16)(b.x & 0xffff)); yb[1] = bf2f((bf16)(b.x >> 16)); yb[2] = bf2f((bf16)(b.y & 0xffff)); yb[3] = bf2f((bf16)(b.y >> 16));
                v[j] = v[j] + gf * (ya * w1 + yb * w2); }
        }
        if (combine || first) {
#pragma unroll
            for (int j = 0; j < 4; ++j) *(f32x4*)(F_H + (size_t)row * D + 4 * F.lane + 256 * j) = v[j];
        }
        float ss = 0.f;
#pragma unroll
        for (int j = 0; j < 4; ++j) ss += (v[j][0] * v[j][0] + v[j][1] * v[j][1]) + (v[j][2] * v[j][2] + v[j][3] * v[j][3]);
        const float rstd = 1.0f / sqrtf(wave_sum(ss, F.lane) * (1.0f / D) + NORM_EPS);
        if (KIND == 2) {
#pragma unroll
            for (int j = 0; j < 4; ++j) { const int col = 4 * F.lane + 256 * j; const f32x4 g = *(const f32x4*)(gain + col); *(f32x4*)(OUTP() + (size_t)row * D + col) = v[j] * rstd * g; }
            continue;
        }
        const float* mrow = modl + (size_t)bidx * 6144 + (KIND == 0 ? 0 : 3 * 1024);
#pragma unroll
        for (int j = 0; j < 4; ++j) { const int col = 4 * F.lane + 256 * j;
            const f32x4 g = *(const f32x4*)(gain + col), sh = *(const f32x4*)(mrow + col), sc = *(const f32x4*)(mrow + 1024 + col);
            v[j] = v[j] * rstd * g * (sc + 1.0f) + sh;
            v2u o; o.x = pk2(v[j][0], v[j][1]); o.y = pk2(v[j][2], v[j][3]);
            *(v2u*)(F_A + (size_t)row * D + col) = o; }
        if (KIND == 1 && (l & 1)) {
            const int li = l >> 1; const float* wr = IN(23) + (size_t)li * D * 8;
            float lg[8];
#pragma unroll
            for (int e = 0; e < 8; ++e) lg[e] = 0.f;
#pragma unroll
            for (int j = 0; j < 4; ++j)
#pragma unroll
                for (int i = 0; i < 4; ++i) { const int col = 4 * F.lane + 256 * j + i; const f32x4 w0 = *(const f32x4*)(wr + (size_t)col * 8), w1 = *(const f32x4*)(wr + (size_t)col * 8 + 4);
#pragma unroll
                    for (int e = 0; e < 4; ++e) { lg[e] += v[j][i] * w0[e]; lg[4 + e] += v[j][i] * w1[e]; } }
#pragma unroll
            for (int e = 0; e < 8; ++e) lg[e] = wave_sum(lg[e], F.lane);
            int e1 = 0; float v1 = lg[0];
#pragma unroll
            for (int e = 1; e < 8; ++e) if (lg[e] > v1) { v1 = lg[e]; e1 = e; }
            int e2 = -1; float v2 = -3.0e38f;
#pragma unroll
            for (int e = 0; e < 8; ++e) if (e != e1 && lg[e] > v2) { v2 = lg[e]; e2 = e; }
            if (F.lane == 0) {
                const float w2 = 1.0f / (1.0f + expf(v1 - v2)), w1 = 1.0f - w2;
                const int p1 = (int)atomicAdd(F_ctl + CW_CNT + li * 8 + e1, 1u), p2 = (int)atomicAdd(F_ctl + CW_CNT + li * 8 + e2, 1u);
                F_list[(size_t)e1 * NTOK + p1] = row; F_list[(size_t)e2 * NTOK + p2] = row;
                int* ti = F_tokinfo + (size_t)row * 8; ti[0] = e1; ti[1] = p1; ti[2] = __float_as_int(w1); ti[3] = e2; ti[4] = p2; ti[5] = __float_as_int(w2);
            }
        }
    }
}
__device__ __forceinline__ void moe_tiles(Frame& F, int li, int (&tb)[9], int (&cnt)[8]) {
    unsigned char* ws = F.base();
    tb[0] = 0;
#pragma unroll
    for (int e = 0; e < 8; ++e) { cnt[e] = (int)__hip_atomic_load(F_ctl + CW_CNT + li * 8 + e, __ATOMIC_RELAXED, __HIP_MEMORY_SCOPE_AGENT); tb[e + 1] = tb[e] + ((cnt[e] + 255) >> 8); }
}
__device__ __forceinline__ void moe_gather(Frame& F, int li) {
    unsigned char* ws = F.base();
    int tb[9], cnt[8]; moe_tiles(F, li, tb, cnt);
    if (blockIdx.x == 0 && F.tid < 9) { int* meta = (int*)(F_sm + SM_META) + li * 16; int val = 0;
#pragma unroll
        for (int e = 0; e < 9; ++e) if (F.tid == e) val = tb[e] * 256;
        meta[F.tid] = val; }
    { const int T = tb[8]; unsigned* ul = (unsigned*)(F_sm + SM_ULIST) + li * (MAXTILES * 32);
      for (int L = F.gtid; L < T * 32; L += F.NT) {
          const bool gu = L < T * 28; const int nN = gu ? 28 : 4, nwg = T * nN; int wgid = gu ? L : L - T * 28;
          { const int q = nwg / 8, r = nwg % 8, xcd = wgid % 8, off = wgid / 8; wgid = (xcd < r ? xcd * (q + 1) : r * (q + 1) + (xcd - r) * q) + off; }
          const int nig = 8 * nN, gid = wgid / nig, fm = gid * 8, gsz = (T - fm) < 8 ? (T - fm) : 8;
          const int pm = fm + ((wgid % nig) % gsz), pnl = (wgid % nig) / gsz; int e = 0;
#pragma unroll
          for (int j = 1; j < 8; ++j) e += (pm >= tb[j]) ? 1 : 0;
          ul[(gu ? ULIST_GU : ULIST_D) + (gu ? L : L - T * 28)] = (unsigned)pm | ((unsigned)(e * nN + pnl) << 16);
      } }
    const int nslot = tb[8] * 256;
    for (int s = F.gw; s < nslot; s += F.NGW) {
        const int tile = s >> 8; int e = 0, base = 0, c = 0;
#pragma unroll
        for (int j = 0; j < 8; ++j) if (tile >= tb[j] && tile < tb[j + 1]) { e = j; base = tb[j] * 256; c = cnt[j]; }
        const int pos = s - base; const int tok = pos < c ? F_list[(size_t)e * NTOK + pos] : -1;
        v4u a = (v4u){0u, 0u, 0u, 0u}, b = a;
        if (tok >= 0) { const v4u* sp = (const v4u*)(F_A + (size_t)tok * D); a = sp[F.lane]; b = sp[64 + F.lane]; }
        v4u* dp = (v4u*)(F_AM + (size_t)s * D); dp[F.lane] = a; dp[64 + F.lane] = b;
    }
}

#ifndef MK_PER_PHASE
#define MK_PER_PHASE 0
#endif
#ifndef PROBE
#define PROBE 0
#endif
__device__ __forceinline__ void make_mix(Mix& M, unsigned char* ws, int l) {
    M.P = F_P; M.Qm = WSP(bf16, WS_QM); M.Km = WSP(bf16, WS_KM); M.Vm = WSP(bf16, WS_VM); M.Qs = WSP(bf16, WS_QS); M.Ks = WSP(bf16, WS_KS); M.Vs = WSP(bf16, WS_VS);
    M.HF = WSP(float, WS_HF); M.HO = WSP(float, WS_HO); M.RQ = WSP(float, WS_RQ); M.RK = WSP(float, WS_RK); M.RO = WSP(float, WS_RO); M.OC = F_OC;
    M.HU = WSP(float, WS_HU); M.HDK = WSP(float, WS_HDK); M.HQC = WSP(float, WS_HQC); M.RU = WSP(float, WS_RU); M.RQC = WSP(float, WS_RQC); M.HQCb = WSP(bf16, WS_HQC); M.RQCb = WSP(bf16, WS_RQC);
    M.loglb = F_sm + SM_LOGLB + l * 512; M.log1mlb = F_sm + SM_LOG1M + l * 512; M.hg_norm_g = IN(15) + l * 256; M.sink = IN(16) + l * 4; M.log_gamma = F_sm + SM_LGAM + l * 8;
    M.gn_g = IN(18) + l * 256; M.gn_b = IN(19) + l * 256;
}
__device__ __forceinline__ void frame_init(Frame& F, LAS unsigned char* lds, int wave_s) {
    unsigned z = 0u; asm volatile("" : "+v"(z)); int t = (int)__builtin_amdgcn_mbcnt_hi(~0u, __builtin_amdgcn_mbcnt_lo(~0u, z)); t += wave_s * 64;
    F.lds = lds; F.tid = t; F.lane = t & 63; F.wave = wave_s;
    F.gtid = blockIdx.x * NTHREADS + t; F.NT = gridDim.x * NTHREADS; { int gw_ = blockIdx.x * NWAVES + wave_s; asm volatile("" : "+s"(gw_)); F.gw = gw_; } F.NGW = gridDim.x * NWAVES;
}
__global__ void __launch_bounds__(NTHREADS, 2) fwd_kernel(Args args) {
    extern __shared__ __attribute__((aligned(16))) unsigned char lds[];
    const int wave_s = __builtin_amdgcn_readfirstlane((int)threadIdx.x >> 6);
    volatile LAS unsigned* MISC = (volatile LAS unsigned*)((LAS unsigned char*)lds + MISC_OFF);
    for (int u = threadIdx.x; u < (LDS_BYTES - 131072) / 4; u += NTHREADS) ((LAS unsigned*)((LAS unsigned char*)lds + 131072))[u] = 0u;
    __syncthreads();
    const int lo = args.ph_lo, hi = args.ph_hi;
    XcdBarrier bar; bar.w = wave_s; bar.bar = (unsigned*)(WSBASE() + WS_CTL) + CW_BAR; bar.x = 0; bar.st = nullptr;
    if (hi - lo > 1) bar = xcd_barrier_post((unsigned*)(WSBASE() + WS_CTL) + CW_BAR, MISC + 8, wave_s);
    int p = 0;
#ifndef PHMASK
#define PHMASK 0xffffffffu
#endif
#define PH_BEGIN_(k) if (((PHMASK >> (k)) & 1u) && p >= lo && p < hi) { Frame F; frame_init(F, (LAS unsigned char*)lds, wave_s); unsigned char* ws = F.base();
#define PH_END if (p + 1 < hi) xcd_barrier(bar); } ++p;

    PH_BEGIN_(0) (void)ws; prologue(F); PH_END

    for (int l = 0; l < DEPTH; ++l) {
        PH_BEGIN_(1) (void)ws; norm_phase<0>(F, l); if (l == 2) convert_moe(F, 1); PH_END
        PH_BEGIN_(2) { pg8::Gemm g{F_A, F_WIN + (size_t)l * NP * D, NTOK, NP, D}; pg8::StaticOrder S; S.init(NTOK, NP, gridDim.x, blockIdx.x);
                   pg8::EpiBf16P E{F_P, NP, NP / 256}; pg8::gemm_phase<pg8::EpiBf16P, pg8::StaticOrder, true, true>(F.lds, g, S, E, F.tid); } PH_END
#ifndef NO_MIX
        PH_BEGIN_(3) { Mix M; make_mix(M, ws, l); const float* tab = WSP(float, WS_TAB);
            for (int row = F.gw; row < NTOK; row += 2 * F.NGW) {
                PrepRegs Ra, Rb; const int r2 = row + F.NGW, r2c = r2 < NTOK ? r2 : row;
                prep_load(Ra, M.P + (size_t)row * NP, F.lane); prep_load(Rb, M.P + (size_t)r2c * NP, F.lane);
                prep_compute(M, tab, Ra, row, F.lane);
                if (r2 < NTOK) prep_compute(M, tab, Rb, r2, F.lane);
            }
            for (int g8 = F.gw; g8 < NTOK / 8; g8 += F.NGW) prep_vt(M, g8, F.lane); }
        PH_END
        PH_BEGIN_(4) { Mix M; make_mix(M, ws, l);
            attn_phase(F.lds, M, M.sink, l < DEPTH - 1, F.tid);
#if PROBE == 7
            attn_phase(F.lds, M, M.sink, l < DEPTH - 1, F.tid);
#endif
            { LAS unsigned char* wl = F.lds + F.wave * 13312;
              for (int u = F.gw; u < 2 * NB * 4 * MNCH; u += F.NGW) mscan_local<true>(M, wl, u, F.lane);
              for (int u = (F.gw + F.NGW / 2) % F.NGW; u < 2 * NB * 4 * MNCH; u += F.NGW) mscan_local<false>(M, wl, u, F.lane);
#if PROBE == 8
              for (int u = F.gw; u < 2 * NB * 4 * MNCH; u += F.NGW) mscan_local<true>(M, wl, u, F.lane);
              for (int u = (F.gw + F.NGW / 2) % F.NGW; u < 2 * NB * 4 * MNCH; u += F.NGW) mscan_local<false>(M, wl, u, F.lane);
#endif
#if PROBE == 9
              for (int u = F.gw; u < 2 * NB * 4 * MNCH; u += F.NGW) mscan_local<true>(M, wl, u, F.lane);
#endif
              } }
        PH_END
        PH_BEGIN_(14) { Mix M; make_mix(M, ws, l);
            for (int it = F.gtid; it < 2 * NB * 4 * 4096; it += F.NT) mscan_carry_hg(M, it);
            for (int it = F.gtid; it < 2 * NB * 4 * 2048; it += F.NT) mscan_carry_ret(M, it); }
        PH_END
        PH_BEGIN_(15) { Mix M; make_mix(M, ws, l);
            for (int u = F.gw; u < NB * 4 * MNCH; u += F.NGW) mscan_fixfin<true>(M, u, F.lane, l < DEPTH - 1);
            for (int u = (F.gw + F.NGW - 896) % F.NGW; u < NB * 4 * MNCH; u += F.NGW) mscan_fixfin<false>(M, u, F.lane, l < DEPTH - 1); }
        PH_END
#endif
        PH_BEGIN_(6) { const int Mr = l < DEPTH - 1 ? NTOK : NLAT; pg8::Gemm g{F_OC, F_WOUT + (size_t)l * D * D, Mr, D, D}; pg8::StaticOrder S; S.init(Mr, D, gridDim.x, blockIdx.x);
                   pg8::EpiRes E{F_H, F_sm + SM_MOD + (size_t)l * 9 * 6144 + 2 * 1024, NLAT / 256, NL / 256, NB}; pg8::gemm_phase<pg8::EpiRes, pg8::StaticOrder, true, true>(F.lds, g, S, E, F.tid); } PH_END
        PH_BEGIN_(7) (void)ws; norm_phase<1>(F, l); PH_END
        if ((l & 1) == 0) {
            const int li = l >> 1;
            PH_BEGIN_(8) { pg8::Gemm g{F_A, F_WFGU + (size_t)li * 2 * DFF * D, NTOK, 2 * DFF, D}; pg8::StaticOrder S; S.init(NTOK, 2 * DFF, gridDim.x, blockIdx.x);
                       pg8::EpiSwiglu E{F_ACT, DFF, 2 * DFF / 256}; pg8::gemm_phase<pg8::EpiSwiglu, pg8::StaticOrder, true, true>(F.lds, g, S, E, F.tid); } PH_END
            PH_BEGIN_(9) { pg8::Gemm g{F_ACT, F_WFD + (size_t)li * D * DFF, NTOK, D, DFF}; pg8::StaticOrder S; S.init(NTOK, D, gridDim.x, blockIdx.x);
                       pg8::EpiRes E{F_H, F_sm + SM_MOD + (size_t)l * 9 * 6144 + 5 * 1024, NLAT / 256, NL / 256, NB}; pg8::gemm_phase<pg8::EpiRes, pg8::StaticOrder, true, true>(F.lds, g, S, E, F.tid); } PH_END
        } else {
            const int li = l >> 1;
            PH_BEGIN_(10) (void)ws; moe_gather(F, li); PH_END
            PH_BEGIN_(11) { const int T = __builtin_amdgcn_readfirstlane((int)__hip_atomic_load((unsigned*)(F_sm + SM_META) + li * 16 + 8, __ATOMIC_RELAXED, __HIP_MEMORY_SCOPE_AGENT)) >> 8;
                       pg8::MoeOrder S; S.list = (const unsigned*)(F_sm + SM_ULIST) + li * (MAXTILES * 32) + ULIST_GU; S.nwg = T * (2 * DFE / 256); S.G = gridDim.x; S.c = blockIdx.x;
                       pg8::Gemm g{F_AM, F_WMGU, MAXTILES * 256, 8 * 2 * DFE, D};
                       pg8::EpiSwiglu E{F_ACT, DFE, 2 * DFE / 256}; pg8::gemm_phase<pg8::EpiSwiglu, pg8::MoeOrder, true, true>(F.lds, g, S, E, F.tid); } PH_END
            PH_BEGIN_(12) { const int T = __builtin_amdgcn_readfirstlane((int)__hip_atomic_load((unsigned*)(F_sm + SM_META) + li * 16 + 8, __ATOMIC_RELAXED, __HIP_MEMORY_SCOPE_AGENT)) >> 8;
                       pg8::MoeOrder S; S.list = (const unsigned*)(F_sm + SM_ULIST) + li * (MAXTILES * 32) + ULIST_D; S.nwg = T * (D / 256); S.G = gridDim.x; S.c = blockIdx.x;
                       pg8::Gemm g{F_ACT, F_WMD, MAXTILES * 256, 8 * D, DFE};
                       pg8::EpiBf16P E{F_Y, D, D / 256}; pg8::gemm_phase<pg8::EpiBf16P, pg8::MoeOrder, true, true>(F.lds, g, S, E, F.tid); } PH_END
        }
    }
    PH_BEGIN_(13) (void)ws; norm_phase<2>(F, DEPTH); PH_END
#undef PH_BEGIN_
#undef PH_END
}
constexpr int NPHASES = 1 + 2 * 10 + 2 * 11 + 1;


extern "C" void kernel_launch(void* const* d_in, const int* in_sizes, int n_in, void* d_out, int out_size, void* d_ws, size_t ws_size, hipStream_t stream) {
    static int grid = 0;
    if (grid == 0) {
        if (n_in != 28 || ws_size < WS_END || out_size != NLAT * D) { fprintf(stderr, "kernel_launch: unexpected problem shape (n_in %d, ws %zu, out %d)\n", n_in, ws_size, out_size); grid = -1; return; }
        int dev = 0, cus = 0;
        if (hipGetDevice(&dev) != hipSuccess || hipDeviceGetAttribute(&cus, hipDeviceAttributeMultiprocessorCount, dev) != hipSuccess) { grid = -1; return; }
        if (hipFuncSetAttribute((const void*)fwd_kernel, hipFuncAttributeMaxDynamicSharedMemorySize, LDS_BYTES) != hipSuccess) { fprintf(stderr, "kernel_launch: hipFuncSetAttribute failed\n"); grid = -1; return; }
        int per_cu = 0;
        if (hipOccupancyMaxActiveBlocksPerMultiprocessor(&per_cu, (const void*)fwd_kernel, NTHREADS, LDS_BYTES) != hipSuccess || per_cu < 1) { fprintf(stderr, "kernel_launch: occupancy query says %d\n", per_cu); }
        (void)hipGetLastError();
        grid = cus;
    }
    if (grid < 0) return;
    (void)hipMemsetAsync((char*)d_ws + WS_CTL, 0, CTL_ZERO_BYTES, stream);
    Args a{};
    for (int i = 0; i < 28; ++i) a.in[i] = (const float*)d_in[i];
    a.out = (float*)d_out; a.ws = (unsigned char*)d_ws;
#if MK_PER_PHASE
    for (int p = 0; p < NPHASES; ++p) { a.ph_lo = p; a.ph_hi = p + 1; hipLaunchKernelGGL(fwd_kernel, dim3(grid), dim3(NTHREADS), LDS_BYTES, stream, a);
        int l = -1, k = -1; const int base[4] = {1, 11, 22, 32}; for (int i = 0; i < 4; ++i) if (p >= base[i] && p < base[i] + (i & 1 ? 11 : 10)) { l = i; k = p - base[i]; }
        bool dup = false;
#if PROBE == 1
        dup = (p == 0);
#elif PROBE == 2
        dup = (k == 2);
#elif PROBE == 3
        dup = (k == 3);
#elif PROBE == 4
        dup = (k == 5);
#elif PROBE == 5
        dup = (k == 1);
#elif PROBE == 6
        dup = (k == 8) || ((l & 1) && (k == 9 || k == 10));
#endif
        if (dup) hipLaunchKernelGGL(fwd_kernel, dim3(grid), dim3(NTHREADS), LDS_BYTES, stream, a); }
#else
    a.ph_lo = 0; a.ph_hi = NPHASES; hipLaunchKernelGGL(fwd_kernel, dim3(grid), dim3(NTHREADS), LDS_BYTES, stream, a);
#endif
}
```

```cpp
#include <hip/hip_runtime.h>
#include <cstdio>
#include <cstdint>
#include <cmath>
#ifndef NB
#define NB 8
#endif
constexpr int D = 1024, NL = 2048, NC = 256, TK = NL + NC, DEPTH = 4, GRIDW = 64;
constexpr int NLAT = NB * NL, NCTX = NB * NC, NTOK = NLAT + NCTX;
constexpr int NP = 3840;
constexpr int DIN = 2912;
constexpr int C_QLAT = 0, C_KVLAT = 192, C_KPE = 320, C_HQ = 352, C_HZF = 608, C_HZB = 864, C_HI = 1120, C_HG = 1376;
constexpr int C_SQ = 1632, C_SK = 1888, C_SV = 2016, C_RQ = 2144, C_RK = 2272, C_RV = 2400, C_RG = 2656, C_QE = 2912, C_KVE = 3296;
constexpr int DFF = 2816, NEXP = 8, DFE = 3584;
constexpr float NORM_EPS = 1e-6f, LOG2E = 1.4426950408889634f;
typedef unsigned short bf16;

#ifdef HOST_TEST
#define HD static inline
#else
#define HD __host__ __device__ __forceinline__
#endif

HD float bf2f(bf16 b) { unsigned u = ((unsigned)b) << 16; float f; __builtin_memcpy(&f, &u, 4); return f; }
HD bf16 f2bf(float f) { unsigned u; __builtin_memcpy(&u, &f, 4); return (bf16)((u + 0x7fffu + ((u >> 16) & 1u)) >> 16); }
#define CBAR() asm volatile("" ::: "memory")
struct U4 { unsigned x, y, z, w; };
HD void ld8(const bf16* p, float (&f)[8]) {
    U4 u; __builtin_memcpy(&u, __builtin_assume_aligned(p, 16), 16);
    unsigned t;
    t = u.x << 16; __builtin_memcpy(&f[0], &t, 4); t = u.x & 0xffff0000u; __builtin_memcpy(&f[1], &t, 4);
    t = u.y << 16; __builtin_memcpy(&f[2], &t, 4); t = u.y & 0xffff0000u; __builtin_memcpy(&f[3], &t, 4);
    t = u.z << 16; __builtin_memcpy(&f[4], &t, 4); t = u.z & 0xffff0000u; __builtin_memcpy(&f[5], &t, 4);
    t = u.w << 16; __builtin_memcpy(&f[6], &t, 4); t = u.w & 0xffff0000u; __builtin_memcpy(&f[7], &t, 4);
}
HD void ld4f(const float* p, float (&f)[4]) { __builtin_memcpy(&f[0], __builtin_assume_aligned(p, 16), 16); }
HD float silu_f(float x) { return x / (1.0f + expf(-x)); }
HD int row_of(int b, int tq) { return tq < NC ? NLAT + b * NC + tq : b * NL + (tq - NC); }
HD void row_split(int row, int& b, int& tq) { if (row < NLAT) { b = row / NL; tq = NC + row % NL; } else { const int r = row - NLAT; b = r / NC; tq = r % NC; } }
HD float log_sigmoid_f(float x) { return fminf(x, 0.f) - log1pf(expf(-fabsf(x))); }

struct Mix {
    const bf16* P;
    bf16 *Qm, *Km, *Vm;
    bf16 *Qs, *Ks, *Vs;
    float* HF;
    float* HO;
    float *RQ, *RK;
    float* RO;
    bf16* OC;
    const float *loglb, *log1mlb;
    const float* hg_norm_g;
    const float* sink;
    const float* log_gamma;
    const float *gn_g, *gn_b;
    float *HU, *HDK, *HQC;
    float *RU, *RQC;
    float *HS, *RS;
    bf16 *HQCb, *RQCb;
};
constexpr int CH = 72, NCH = TK / CH;
static_assert(NCH * CH == TK, "chunking");

HD void mla_prep_item(const Mix& M, int item) {
    const int row = item >> 2, h = item & 3; int b, tq; row_split(row, b, tq);
    const bf16* p = M.P + (size_t)row * NP;
    float sq = 0.f, skv = 0.f;
    for (int j = 0; j < 192; ++j) { const float v = bf2f(p[C_QLAT + j]); sq += v * v; }
    for (int j = 0; j < 128; ++j) { const float v = bf2f(p[C_KVLAT + j]); skv += v * v; }
    const float rq = 1.0f / sqrtf(sq * (1.0f / 192.0f) + NORM_EPS), rkv = 1.0f / sqrtf(skv * (1.0f / 128.0f) + NORM_EPS);
    const float qs = rq * 0.10206207261596575f * LOG2E;
    const size_t o96 = ((size_t)(b * 4 + h) * TK + tq) * 96;
    for (int j = 0; j < 64; ++j) {
        M.Qm[o96 + j] = f2bf(bf2f(p[C_QE + h * 96 + j]) * qs);
        M.Km[o96 + j] = f2bf(bf2f(p[C_KVE + h * 128 + j]) * rkv);
        M.Vm[((size_t)(b * 4 + h) * 64 + j) * TK + tq] = f2bf(bf2f(p[C_KVE + h * 128 + 64 + j]) * rkv);
    }
    const bool lat = tq >= NC; const int t = tq - NC;
    for (int j = 0; j < 16; ++j) {
        float c = 1.f, s = 0.f;
        if (lat) { const float inv = powf(10000.0f, -(float)(j & 7) / 8.0f); const float ang = (float)(j < 8 ? t / GRIDW : t % GRIDW) * inv; c = cosf(ang); s = sinf(ang); }
        const float q1 = bf2f(p[C_QE + h * 96 + 64 + j]), q2 = bf2f(p[C_QE + h * 96 + 80 + j]);
        M.Qm[o96 + 64 + j] = f2bf((q1 * c - q2 * s) * qs); M.Qm[o96 + 80 + j] = f2bf((q1 * s + q2 * c) * qs);
        const float k1 = bf2f(p[C_KPE + j]), k2 = bf2f(p[C_KPE + 16 + j]);
        M.Km[o96 + 64 + j] = f2bf(k1 * c - k2 * s); M.Km[o96 + 80 + j] = f2bf(k1 * s + k2 * c);
    }
}
HD void swa_prep_item(const Mix& M, int item) {
    const int row = item >> 3, s = item & 7; int b, tq; row_split(row, b, tq);
    const bf16* p = M.P + (size_t)row * NP;
    const bool lat = tq >= NC; const int t = tq - NC;
    if (s >= 6) { const int kh = s - 6; bf16* o = M.Vs + (size_t)(b * 2 + kh) * 64 * TK + tq; for (int j = 0; j < 64; ++j) o[(size_t)j * TK] = p[C_SV + kh * 64 + j]; return; }
    const bf16* src = s < 4 ? p + C_SQ + s * 64 : p + C_SK + (s - 4) * 64;
    bf16* o = s < 4 ? M.Qs + ((size_t)(b * 4 + s) * TK + tq) * 64 : M.Ks + ((size_t)(b * 2 + (s - 4)) * TK + tq) * 64;
    const float sc = s < 4 ? 0.125f * LOG2E : 1.0f;
    for (int j = 0; j < 32; ++j) {
        float c = 1.f, sn = 0.f;
        if (lat) { const float inv = powf(10000.0f, -(float)(j & 15) / 16.0f); const float ang = (float)(j < 16 ? t / GRIDW : t % GRIDW) * inv; c = cosf(ang); sn = sinf(ang); }
        const float x1 = bf2f(src[j]), x2 = bf2f(src[32 + j]);
        o[j] = f2bf((x1 * c - x2 * sn) * sc); o[32 + j] = f2bf((x1 * sn + x2 * c) * sc);
    }
}
HD void hg_prep_item(const Mix& M, int item) {
    const int row = item >> 8, c = item & 255;
    const bf16* p = M.P + (size_t)row * NP;
    for (int d = 0; d < 2; ++d) {
        const float z = bf2f(p[(d ? C_HZB : C_HZF) + c]);
        const float a = M.loglb[d * 256 + c], bb = M.log1mlb[d * 256 + c] + log_sigmoid_f(z);
        const float mx = fmaxf(a, bb), lf = mx + log1pf(expf(-fabsf(a - bb)));
        M.HF[((size_t)d * NTOK + row) * 256 + c] = expf(lf);
    }
}
HD void ret_prep_item(const Mix& M, int item) {
    const int row = item >> 3, w = (item >> 2) & 1, h = item & 3; int b, tq; row_split(row, b, tq);
    const bf16* src = M.P + (size_t)row * NP + (w ? C_RK : C_RQ) + h * 32;
    float* o = (w ? M.RK : M.RQ) + (size_t)row * 128 + h * 32;
    const float sc = w ? 1.0f : 0.17677669529663687f;
    for (int j = 0; j < 16; ++j) {
        const float inv = powf(10000.0f, -(float)j / 16.0f); const float ang = (float)tq * inv; const float c = cosf(ang), s = sinf(ang);
        const float x1 = bf2f(src[j]), x2 = bf2f(src[16 + j]);
        o[j] = (x1 * c - x2 * s) * sc; o[16 + j] = (x1 * s + x2 * c) * sc;
    }
}
HD void mla_attn_item(const Mix& M, int item) {
    const int tq = item % TK, bh = item / TK, b = bh >> 2, h = bh & 3;
    const bf16* qp = M.Qm + (size_t)item * 96;
    float q[96], o[64];
#pragma unroll
    for (int c8 = 0; c8 < 12; ++c8) { float t8[8]; ld8(qp + 8 * c8, t8);
#pragma unroll
        for (int j = 0; j < 8; ++j) q[8 * c8 + j] = t8[j]; }
#pragma unroll
    for (int j = 0; j < 64; ++j) o[j] = 0.f;
    float m = -1e30f, l = 0.f;
    const int nk = tq < NC ? NC : TK;
    const bf16* kb = M.Km + (size_t)bh * TK * 96; const bf16* vb = M.Vm + (size_t)bh * TK * 64;
    for (int k = 0; k < nk; ++k) {
        const bf16* kp = kb + (size_t)k * 96; float s = 0.f;
#pragma unroll
        for (int c8 = 0; c8 < 12; ++c8) { float t8[8]; ld8(kp + 8 * c8, t8);
#pragma unroll
            for (int j = 0; j < 8; ++j) s += q[8 * c8 + j] * t8[j];
            if ((c8 & 3) == 3) CBAR(); }
        const float mn = fmaxf(m, s), al = exp2f(m - mn), pr = exp2f(s - mn);
        l = l * al + pr; m = mn;
        const bf16* vp = vb + k;
#pragma unroll
        for (int j = 0; j < 64; ++j) o[j] = o[j] * al + pr * bf2f(vp[(size_t)j * TK]);
    }
    const float rl = 1.0f / l; bf16* op = M.OC + (size_t)row_of(b, tq) * D + h * 64;
#pragma unroll
    for (int j = 0; j < 64; ++j) op[j] = f2bf(o[j] * rl);
}
HD void swa_attn_item(const Mix& M, int item) {
    const int tq = item % TK, bh = item / TK, b = bh >> 2, hq = bh & 3, kh = hq >> 1;
    const bf16* qp = M.Qs + (size_t)item * 64;
    float q[64], o[64];
#pragma unroll
    for (int c8 = 0; c8 < 8; ++c8) { float t8[8]; ld8(qp + 8 * c8, t8);
#pragma unroll
        for (int j = 0; j < 8; ++j) { q[8 * c8 + j] = t8[j]; o[8 * c8 + j] = 0.f; } }
    float m = M.sink[hq] * LOG2E, l = 1.0f;
    const bf16* kb = M.Ks + (size_t)(b * 2 + kh) * TK * 64; const bf16* vb = M.Vs + (size_t)(b * 2 + kh) * TK * 64;
    const int t = tq - NC;
    const int lo2 = tq < NC ? 0 : (t - 128 < 0 ? 0 : t - 128), hi2 = tq < NC ? -1 : (t + 128 > NL - 1 ? NL - 1 : t + 128);
    const int n2 = hi2 - lo2 + 1;
    for (int i = 0; i < NC + n2; ++i) {
        const int k = i < NC ? i : NC + lo2 + (i - NC);
        const bf16* kp = kb + (size_t)k * 64; float s = 0.f;
#pragma unroll
        for (int c8 = 0; c8 < 8; ++c8) { float t8[8]; ld8(kp + 8 * c8, t8);
#pragma unroll
            for (int j = 0; j < 8; ++j) s += q[8 * c8 + j] * t8[j];
            if ((c8 & 3) == 3) CBAR(); }
        const float mn = fmaxf(m, s), al = exp2f(m - mn), pr = exp2f(s - mn);
        l = l * al + pr; m = mn;
        const bf16* vp = vb + k;
#pragma unroll
        for (int j = 0; j < 64; ++j) o[j] = o[j] * al + pr * bf2f(vp[(size_t)j * TK]);
    }
    const float rl = 1.0f / l; bf16* op = M.OC + (size_t)row_of(b, tq) * D + 512 + hq * 64;
#pragma unroll
    for (int j = 0; j < 64; ++j) op[j] = f2bf(o[j] * rl);
}
HD int dir_tq(int dir, int i) { return dir == 0 ? i : (i < NC ? NC - 1 - i : NC + (NL - 1 - (i - NC))); }
HD void hg_scan_item(const Mix& M, int item) {
    const int v = item & 63, h = (item >> 6) & 3, b = (item >> 8) % NB, dir = item / (256 * NB);
    float S[64];
#pragma unroll
    for (int k = 0; k < 64; ++k) S[k] = 0.f;
    for (int i = 0; i < TK; ++i) {
        const int row = row_of(b, dir_tq(dir, i));
        const bf16* p = M.P + (size_t)row * NP; const float* f = M.HF + ((size_t)dir * NTOK + row) * 256 + h * 64;
        const float vv = bf2f(p[C_HI + h * 64 + v]); float acc = 0.f;
#pragma unroll
        for (int c8 = 0; c8 < 8; ++c8) { float q8[8], fa[4], fb[4]; ld8(p + C_HQ + h * 64 + 8 * c8, q8); ld4f(f + 8 * c8, fa); ld4f(f + 8 * c8 + 4, fb);
#pragma unroll
            for (int j = 0; j < 8; ++j) { const int k = 8 * c8 + j; const float fk = j < 4 ? fa[j] : fb[j - 4]; S[k] = fk * S[k] + (1.0f - fk) * vv; acc += q8[j] * S[k]; }
            if ((c8 & 1) == 1) CBAR(); }
        M.HO[((size_t)dir * NTOK + row) * 256 + h * 64 + v] = acc * 0.125f;
    }
}
HD void ret_scan_item(const Mix& M, int item) {
    const int v = item & 63, h = (item >> 6) & 3, b = (item >> 8) % NB, dir = item / (256 * NB);
    const float g = expf(M.log_gamma[dir * 4 + h]);
    float S[32];
#pragma unroll
    for (int k = 0; k < 32; ++k) S[k] = 0.f;
    for (int i = 0; i < TK; ++i) {
        const int row = row_of(b, dir_tq(dir, i));
        const float vv = bf2f(M.P[(size_t)row * NP + C_RV + h * 64 + v]);
        const float* qk = M.RQ + (size_t)row * 128 + h * 32; const float* kk = M.RK + (size_t)row * 128 + h * 32; float acc = 0.f;
#pragma unroll
        for (int c4 = 0; c4 < 8; ++c4) { float qa[4], ka[4]; ld4f(qk + 4 * c4, qa); ld4f(kk + 4 * c4, ka);
#pragma unroll
            for (int j = 0; j < 4; ++j) { const int k = 4 * c4 + j; S[k] = g * S[k] + ka[j] * vv; acc += qa[j] * S[k]; }
            if ((c4 & 3) == 3) CBAR(); }
        M.RO[((size_t)dir * NTOK + row) * 256 + h * 64 + v] = acc;
    }
}
HD void hg_fin_item(const Mix& M, int item) {
    const int row = item >> 2, h = item & 3;
    const float* o0 = M.HO + (size_t)row * 256 + h * 64; const float* o1 = o0 + (size_t)NTOK * 256;
    float ss = 0.f;
    for (int v = 0; v < 64; ++v) { const float x = o0[v] + o1[v]; ss += x * x; }
    const float r = 1.0f / sqrtf(ss * (1.0f / 64.0f) + NORM_EPS);
    const bf16* gp = M.P + (size_t)row * NP + C_HG + h * 64; bf16* op = M.OC + (size_t)row * D + 256 + h * 64;
    for (int v = 0; v < 64; ++v) op[v] = f2bf((o0[v] + o1[v]) * r * M.hg_norm_g[h * 64 + v] * silu_f(bf2f(gp[v])));
}
HD void ret_fin_item(const Mix& M, int item) {
    const int row = item >> 2, h = item & 3;
    const float* o0 = M.RO + (size_t)row * 256 + h * 64; const float* o1 = o0 + (size_t)NTOK * 256;
    float s = 0.f;
    for (int v = 0; v < 64; ++v) s += o0[v] + o1[v];
    const float mu = s * (1.0f / 64.0f); float q = 0.f;
    for (int v = 0; v < 64; ++v) { const float d = o0[v] + o1[v] - mu; q += d * d; }
    const float r = 1.0f / sqrtf(q * (1.0f / 64.0f) + NORM_EPS);
    const bf16* gp = M.P + (size_t)row * NP + C_RG + h * 64; bf16* op = M.OC + (size_t)row * D + 768 + h * 64;
    for (int v = 0; v < 64; ++v) op[v] = f2bf(((o0[v] + o1[v] - mu) * r * M.gn_g[h * 64 + v] + M.gn_b[h * 64 + v]) * silu_f(bf2f(gp[v])));
}

HD void hg_local_item(const Mix& M, int item) {
    const int v = item & 63, c = (item >> 6) % NCH, seq = item / (64 * NCH), h = seq & 3, b = (seq >> 2) % NB, dir = seq / (4 * NB);
    float S[64];
#pragma unroll
    for (int k = 0; k < 64; ++k) S[k] = 0.f;
    float dk = 1.0f;
    for (int i = 0; i < CH; ++i) {
        const int row = row_of(b, dir_tq(dir, c * CH + i));
        const bf16* p = M.P + (size_t)row * NP; const float* f = M.HF + ((size_t)dir * NTOK + row) * 256 + h * 64;
        const float vv = bf2f(p[C_HI + h * 64 + v]); float acc = 0.f;
        dk *= f[v]; M.HQC[((size_t)dir * NTOK + row) * 256 + h * 64 + v] = bf2f(p[C_HQ + h * 64 + v]) * dk * 0.125f;
#pragma unroll
        for (int c8 = 0; c8 < 8; ++c8) { float q8[8], fa[4], fb[4]; ld8(p + C_HQ + h * 64 + 8 * c8, q8); ld4f(f + 8 * c8, fa); ld4f(f + 8 * c8 + 4, fb);
#pragma unroll
            for (int j = 0; j < 8; ++j) { const int k = 8 * c8 + j; const float fk = j < 4 ? fa[j] : fb[j - 4]; S[k] = fk * (S[k] - vv) + vv; acc += q8[j] * S[k]; }
            if ((c8 & 1) == 1) CBAR(); }
        M.HO[((size_t)dir * NTOK + row) * 256 + h * 64 + v] = acc * 0.125f;
    }
    float* u = M.HU + ((size_t)seq * NCH + c) * 4096 + v;
#pragma unroll
    for (int k = 0; k < 64; ++k) u[k * 64] = S[k];
    M.HDK[((size_t)seq * NCH + c) * 64 + v] = dk;
}
HD void hg_carry_item(const Mix& M, int item) {
    const int kv = item & 4095, seq = item >> 12, k = kv >> 6; float s = 0.f;
#pragma unroll 8
    for (int c = 0; c < NCH; ++c) { float* u = M.HU + ((size_t)seq * NCH + c) * 4096 + kv; const float uu = *u; *u = s; s = M.HDK[((size_t)seq * NCH + c) * 64 + k] * s + uu; }
}
HD void hg_fix_item(const Mix& M, int item) {
    const int v = item & 63, c = (item >> 6) % NCH, seq = item / (64 * NCH), h = seq & 3, b = (seq >> 2) % NB, dir = seq / (4 * NB);
    if (c == 0) return;
    float S[64]; const float* u = M.HU + ((size_t)seq * NCH + c) * 4096 + v;
#pragma unroll
    for (int k = 0; k < 64; ++k) S[k] = u[k * 64];
    for (int i = 0; i < CH; ++i) {
        const int row = row_of(b, dir_tq(dir, c * CH + i));
        const float* qc = M.HQC + ((size_t)dir * NTOK + row) * 256 + h * 64; float acc = 0.f;
#pragma unroll
        for (int c4 = 0; c4 < 16; ++c4) { float qa[4]; ld4f(qc + 4 * c4, qa);
#pragma unroll
            for (int j = 0; j < 4; ++j) acc += qa[j] * S[4 * c4 + j];
            if ((c4 & 3) == 3) CBAR(); }
        M.HO[((size_t)dir * NTOK + row) * 256 + h * 64 + v] += acc;
    }
}
HD void ret_local_item(const Mix& M, int item) {
    const int v = item & 63, c = (item >> 6) % NCH, seq = item / (64 * NCH), h = seq & 3, b = (seq >> 2) % NB, dir = seq / (4 * NB);
    const float g = expf(M.log_gamma[dir * 4 + h]);
    float S[32];
#pragma unroll
    for (int k = 0; k < 32; ++k) S[k] = 0.f;
    float gp = 1.0f;
    for (int i = 0; i < CH; ++i) {
        const int row = row_of(b, dir_tq(dir, c * CH + i));
        const float vv = bf2f(M.P[(size_t)row * NP + C_RV + h * 64 + v]);
        const float* qk = M.RQ + (size_t)row * 128 + h * 32; const float* kk = M.RK + (size_t)row * 128 + h * 32; float acc = 0.f;
        gp *= g; if (v < 32) M.RQC[((size_t)dir * NTOK + row) * 128 + h * 32 + v] = qk[v] * gp;
#pragma unroll
        for (int c4 = 0; c4 < 8; ++c4) { float qa[4], ka[4]; ld4f(qk + 4 * c4, qa); ld4f(kk + 4 * c4, ka);
#pragma unroll
            for (int j = 0; j < 4; ++j) { const int k = 4 * c4 + j; S[k] = g * S[k] + ka[j] * vv; acc += qa[j] * S[k]; }
            if ((c4 & 3) == 3) CBAR(); }
        M.RO[((size_t)dir * NTOK + row) * 256 + h * 64 + v] = acc;
    }
    float* u = M.RU + ((size_t)seq * NCH + c) * 2048 + v;
#pragma unroll
    for (int k = 0; k < 32; ++k) u[k * 64] = S[k];
}
HD void ret_carry_item(const Mix& M, int item) {
    const int kv = item & 2047, seq = item >> 11, h = seq & 3, dir = seq / (4 * NB); float s = 0.f;
    const float d = expf((float)CH * M.log_gamma[dir * 4 + h]);
#pragma unroll 8
    for (int c = 0; c < NCH; ++c) { float* u = M.RU + ((size_t)seq * NCH + c) * 2048 + kv; const float uu = *u; *u = s; s = d * s + uu; }
}
HD void ret_fix_item(const Mix& M, int item) {
    const int v = item & 63, c = (item >> 6) % NCH, seq = item / (64 * NCH), h = seq & 3, b = (seq >> 2) % NB, dir = seq / (4 * NB);
    if (c == 0) return;
    float S[32]; const float* u = M.RU + ((size_t)seq * NCH + c) * 2048 + v;
#pragma unroll
    for (int k = 0; k < 32; ++k) S[k] = u[k * 64];
    for (int i = 0; i < CH; ++i) {
        const int row = row_of(b, dir_tq(dir, c * CH + i));
        const float* qc = M.RQC + ((size_t)dir * NTOK + row) * 128 + h * 32; float acc = 0.f;
#pragma unroll
        for (int c4 = 0; c4 < 8; ++c4) { float qa[4]; ld4f(qc + 4 * c4, qa);
#pragma unroll
            for (int j = 0; j < 4; ++j) acc += qa[j] * S[4 * c4 + j];
            if ((c4 & 3) == 3) CBAR(); }
        M.RO[((size_t)dir * NTOK + row) * 256 + h * 64 + v] += acc;
    }
}
namespace pg8 {
#define PG8_LAS __attribute__((address_space(3)))
typedef unsigned short bf16_t;
typedef short bf16x8 __attribute__((ext_vector_type(8)));
typedef float f32x4 __attribute__((ext_vector_type(4)));
typedef unsigned u32x4 __attribute__((ext_vector_type(4)));
constexpr int BM = 256, BK = 64, HALF = 128, HTB = HALF * BK * 2  , STAGE_BYTES = 8 * HTB, NXCD = 8, WGM = 8;

__host__ __device__ __forceinline__ int lds_byte(int r, int c) { const int st = (r >> 4) * 2 + (c >> 5), rr = r & 15, cc = c & 31, ob = rr * 64 + cc * 2; return st * 1024 + (ob ^ (((ob >> 9) & 1) << 5)); }
__host__ __device__ __forceinline__ void stage_rc(int b, int& R, int& C) { const int st = b / 1024, sb = b % 1024, swz = sb ^ (((sb >> 9) & 1) << 5); R = (st >> 1) * 16 + swz / 64; C = (st & 1) * 32 + (swz % 64) / 2; }
__host__ __device__ __forceinline__ int perm32(int rho) { const int n = rho >> 4, i = rho & 15; return 8 * (i >> 2) + 4 * n + (i & 3); }

struct Unit { int pm, pn; };
struct Gemm { const bf16_t* A; const bf16_t* Bt; int M, N, K; };

struct StaticOrder {
    int nM, nN, nwg, G, c;
    __host__ __device__ void init(int M, int N, int G_, int c_) { nM = M / BM; nN = N / BM; nwg = nM * nN; G = G_; c = c_; }
    __host__ __device__ bool next(int i, Unit& u) const {
        const long L = (long)i * G + c; if (L >= nwg) return false;
        int wgid = (int)L; { const int q = nwg / NXCD, r = nwg % NXCD, xcd = wgid % NXCD, off = wgid / NXCD; wgid = (xcd < r ? xcd * (q + 1) : r * (q + 1) + (xcd - r) * q) + off; }
        const int nig = WGM * nN, gid = wgid / nig, fm = gid * WGM, gsz = (nM - fm) < WGM ? (nM - fm) : WGM;
        u.pm = fm + ((wgid % nig) % gsz); u.pn = (wgid % nig) / gsz; return true;
    }
    __device__ __forceinline__ void a_ready(const Unit&) const {}
    __device__ __forceinline__ void done(const Unit&) const {}
};

__device__ __forceinline__ unsigned cvt_pk_bf16(float lo, float hi) { unsigned r; asm volatile("v_cvt_pk_bf16_f32 %0, %1, %2" : "=v"(r) : "v"(lo), "v"(hi)); return r; }
typedef unsigned u32x2 __attribute__((ext_vector_type(2)));
struct EpiBf16P {
    static constexpr bool PERM = true, AFTER_DRAIN = false;
    bf16_t* O; int ldc; int nN;
    __device__ __forceinline__ void operator()(const f32x4 (&acc)[2][2][4][2], const Unit& u, int wr, int wc, int fr, int fq) const {
        const int row0 = u.pm * BM + wr * 64 + fr, col0 = (u.pn % nN) * BM + wc * 32 + 8 * fq;
#pragma unroll
        for (int ai = 0; ai < 2; ++ai)
#pragma unroll
            for (int m = 0; m < 4; ++m) { bf16_t* rowp = O + (size_t)(row0 + ai * HALF + m * 16) * ldc + col0;
#pragma unroll
                for (int bj = 0; bj < 2; ++bj) { const f32x4 v0 = acc[ai][bj][m][0], v1 = acc[ai][bj][m][1];
                    u32x4 w; w.x = cvt_pk_bf16(v0[0], v0[1]); w.y = cvt_pk_bf16(v0[2], v0[3]); w.z = cvt_pk_bf16(v1[0], v1[1]); w.w = cvt_pk_bf16(v1[2], v1[3]);
                    *(u32x4*)(rowp + bj * HALF) = w; } }
    }
};
struct EpiGate {
    static constexpr bool PERM = true, AFTER_DRAIN = false;
    bf16_t* O; const float* gate; int lat_tiles, tiles_per_batch, ctx_bidx;
    __device__ __forceinline__ void operator()(const f32x4 (&acc)[2][2][4][2], const Unit& u, int wr, int wc, int fr, int fq) const {
        const int bidx = u.pm < lat_tiles ? u.pm / tiles_per_batch : ctx_bidx;
        const float* g = gate + (size_t)bidx * 6144;
        const int row0 = u.pm * BM + wr * 64 + fr, col0 = u.pn * BM + wc * 32 + 8 * fq;
        f32x4 gv[2][2];
#pragma unroll
        for (int bj = 0; bj < 2; ++bj)
#pragma unroll
            for (int n = 0; n < 2; ++n) gv[bj][n] = *(const f32x4*)(g + col0 + bj * HALF + 4 * n);
#pragma unroll
        for (int ai = 0; ai < 2; ++ai)
#pragma unroll
            for (int m = 0; m < 4; ++m) { bf16_t* rowp = O + (size_t)(row0 + ai * HALF + m * 16) * 1024 + col0;
#pragma unroll
                for (int bj = 0; bj < 2; ++bj) { const f32x4 v0 = acc[ai][bj][m][0] * gv[bj][0], v1 = acc[ai][bj][m][1] * gv[bj][1];
                    u32x4 w; w.x = cvt_pk_bf16(v0[0], v0[1]); w.y = cvt_pk_bf16(v0[2], v0[3]); w.z = cvt_pk_bf16(v1[0], v1[1]); w.w = cvt_pk_bf16(v1[2], v1[3]);
                    *(u32x4*)(rowp + bj * HALF) = w; } }
    }
};
struct EpiRes {
    static constexpr bool PERM = false, AFTER_DRAIN = false;
    float* H; const float* gate; int lat_tiles, tiles_per_batch, ctx_bidx;
    __device__ __forceinline__ void operator()(const f32x4 (&acc)[2][2][4][2], const Unit& u, int wr, int wc, int fr, int fq) const {
        const int bidx = u.pm < lat_tiles ? u.pm / tiles_per_batch : ctx_bidx;
        const float* g = gate + (size_t)bidx * 6144;
        const int row0 = u.pm * BM + wr * 64 + fr, col0 = u.pn * BM + wc * 32 + 4 * fq;
        f32x4 gv[2][2];
#pragma unroll
        for (int bj = 0; bj < 2; ++bj)
#pragma unroll
            for (int n = 0; n < 2; ++n) gv[bj][n] = *(const f32x4*)(g + col0 + bj * HALF + n * 16);
#pragma unroll
        for (int ai = 0; ai < 2; ++ai)
#pragma unroll
            for (int m = 0; m < 4; ++m) { float* rowp = H + (size_t)(row0 + ai * HALF + m * 16) * 1024 + col0;
#pragma unroll
                for (int bj = 0; bj < 2; ++bj)
#pragma unroll
                    for (int n = 0; n < 2; ++n) { f32x4* p = (f32x4*)(rowp + bj * HALF + n * 16); *p = *p + gv[bj][n] * acc[ai][bj][m][n]; } }
    }
};
struct EpiSwiglu {
    static constexpr bool PERM = true, AFTER_DRAIN = false;
    bf16_t* O; int ldo; int nN;
    __device__ __forceinline__ void operator()(const f32x4 (&acc)[2][2][4][2], const Unit& u, int wr, int wc, int fr, int fq) const {
        const int row0 = u.pm * BM + wr * 64 + fr, col0 = (u.pn % nN) * 128 + wc * 16 + 4 * fq;
#pragma unroll
        for (int ai = 0; ai < 2; ++ai)
#pragma unroll
            for (int m = 0; m < 4; ++m) { bf16_t* rowp = O + (size_t)(row0 + ai * HALF + m * 16) * ldo + col0;
#pragma unroll
                for (int bj = 0; bj < 2; ++bj) { const f32x4 gt = acc[ai][bj][m][0], up = acc[ai][bj][m][1]; float r[4];
#pragma unroll
                    for (int i = 0; i < 4; ++i) r[i] = gt[i] * __builtin_amdgcn_rcpf(1.0f + __builtin_amdgcn_exp2f(-1.4426950408889634f * gt[i])) * up[i];
                    u32x2 w; w.x = cvt_pk_bf16(r[0], r[1]); w.y = cvt_pk_bf16(r[2], r[3]);
                    *(u32x2*)(rowp + bj * 64) = w; } }
    }
};
struct MoeOrder {
    const unsigned* list; int nwg, G, c;
    __device__ __forceinline__ bool next(int i, Unit& u) const {
        const long L = (long)i * G + c; if (L >= nwg) return false;
        unsigned w; const unsigned* ptr = list + L;
        asm volatile("s_load_dword %0, %1, 0x0\n\ts_waitcnt lgkmcnt(0)" : "=s"(w) : "s"(ptr) : "memory");
        u.pm = (int)(w & 0xffffu); u.pn = (int)(w >> 16); return true;
    }
    __device__ __forceinline__ void a_ready(const Unit&) const {}
    __device__ __forceinline__ void done(const Unit&) const {}
};
template <class Epi, class Sched, bool ALIGN_EPI = false, bool SP2 = false>
__device__ __forceinline__ void gemm_phase(PG8_LAS unsigned char* lds, const Gemm g, const Sched& S, const Epi& E, const int tid_in) {
    const int tid = tid_in, wid = __builtin_amdgcn_readfirstlane(tid >> 6), lane = tid & 63, wr = wid >> 2, wc = wid & 3, fr = lane & 15, fq = lane >> 4;
    const int K = g.K, nt = K / BK;
    unsigned voffA[2], voffB[2];
#pragma unroll
    for (int i = 0; i < 2; ++i) { int R, C; stage_rc(tid * 16 + i * 8192, R, C); const int Rb = Epi::PERM ? ((R & ~31) + perm32(R & 31)) : R;
        voffA[i] = (unsigned)(R * K + C) * 2u; voffB[i] = (unsigned)(Rb * K + C) * 2u; }
    const size_t kstep = (size_t)(BK * 2);
    const size_t hstep = (size_t)HALF * K * 2;
    const size_t tstep = 2 * hstep;
    const unsigned ldsw = (unsigned)wid * 1024u;
    const int aoff = lds_byte(wr * 64 + fr, fq * 8), boff = lds_byte(wc * 32 + fr, fq * 8);
#define PG8_SA(b, h) (((b) * 2 + (h)) * HTB)
#define PG8_SB(b, h) ((4 + (b) * 2 + (h)) * HTB)
#define PG8_STAGE(bufoff, gbase, voff) do { _Pragma("unroll") for (int _i = 0; _i < 2; ++_i) \
        __builtin_amdgcn_global_load_lds((const unsigned*)((const char*)(gbase) + (voff)[_i]), (PG8_LAS unsigned*)(lds + (bufoff) + ldsw + _i * 8192), 16, 0, 0); } while (0)
#define PG8_LDA(dst, b, h) do { _Pragma("unroll") for (int m = 0; m < 4; ++m) _Pragma("unroll") for (int k = 0; k < 2; ++k) dst[m][k] = *(const PG8_LAS bf16x8*)(lds + PG8_SA(b, h) + aoff + m * 2048 + k * 1024); } while (0)
#define PG8_LDB(dst, b, h) do { _Pragma("unroll") for (int n = 0; n < 2; ++n) _Pragma("unroll") for (int k = 0; k < 2; ++k) dst[n][k] = *(const PG8_LAS bf16x8*)(lds + PG8_SB(b, h) + boff + n * 2048 + k * 1024); } while (0)
#define PG8_MMA(ai, bj, At, Bt) do { __builtin_amdgcn_s_setprio(1); _Pragma("unroll") for (int m = 0; m < 4; ++m) _Pragma("unroll") for (int n = 0; n < 2; ++n) _Pragma("unroll") for (int k = 0; k < 2; ++k) \
        acc[ai][bj][m][n] = __builtin_amdgcn_mfma_f32_16x16x32_bf16(Bt[n][k], At[m][k], acc[ai][bj][m][n], 0, 0, 0); __builtin_amdgcn_s_setprio(0); } while (0)
#define PG8_WAIT_V(n) asm volatile("s_waitcnt vmcnt(" #n ")" ::: "memory")
#define PG8_WAIT_L(n) asm volatile("s_waitcnt lgkmcnt(" #n ")" ::: "memory")
#define PG8_BAR __builtin_amdgcn_s_barrier()
#define PG8_SCHED __builtin_amdgcn_sched_barrier(0)
    Unit cur, nxt; int ui = 0;
    if (!S.next(0, cur)) return;
    f32x4 acc[2][2][4][2];
#pragma unroll
    for (int a = 0; a < 2; ++a)
#pragma unroll
        for (int b = 0; b < 2; ++b)
#pragma unroll
            for (int m = 0; m < 4; ++m)
#pragma unroll
                for (int n = 0; n < 2; ++n) acc[a][b][m][n] = (f32x4){0.f, 0.f, 0.f, 0.f};
    bf16x8 At[4][2], B0[2][2], B1[2][2];
    const char* cA = (const char*)g.A + (size_t)cur.pm * tstep; const char* cB = (const char*)g.Bt + (size_t)cur.pn * tstep;
    S.a_ready(cur);
    if constexpr (SP2) {
        PG8_STAGE(PG8_SB(0, 0), cB, voffB); PG8_STAGE(PG8_SB(0, 1), cB + hstep, voffB); PG8_STAGE(PG8_SA(0, 0), cA, voffA); PG8_STAGE(PG8_SA(0, 1), cA + hstep, voffA);
        if (wr == 1) PG8_BAR;
        PG8_WAIT_V(2); PG8_BAR;
        PG8_STAGE(PG8_SB(1, 0), cB + kstep, voffB); PG8_STAGE(PG8_SA(1, 0), cA + kstep, voffA); PG8_STAGE(PG8_SB(1, 1), cB + hstep + kstep, voffB);
        PG8_WAIT_V(6); PG8_BAR;
    } else {
        PG8_STAGE(PG8_SB(0, 0), cB, voffB); PG8_STAGE(PG8_SA(0, 0), cA, voffA); PG8_STAGE(PG8_SB(0, 1), cB + hstep, voffB); PG8_STAGE(PG8_SA(0, 1), cA + hstep, voffA);
        if (wr == 1) PG8_BAR;
        PG8_WAIT_V(4); PG8_BAR;
        PG8_STAGE(PG8_SB(1, 0), cB + kstep, voffB); PG8_STAGE(PG8_SA(1, 0), cA + kstep, voffA); PG8_STAGE(PG8_SB(1, 1), cB + hstep + kstep, voffB);
        PG8_WAIT_V(6); PG8_BAR;
    }
    for (;;) {
        const bool has_next = S.next(ui + 1, nxt);
        const char* nA = has_next ? (const char*)g.A + (size_t)nxt.pm * tstep : cA; const char* nB = has_next ? (const char*)g.Bt + (size_t)nxt.pn * tstep : cB;
        for (int t = 0; t < nt; t += 2) {
            const bool last = (t == nt - 2);
            const char* a1 = cA + (size_t)(t + 1) * kstep;
            const char* a2 = last ? nA : cA + (size_t)(t + 2) * kstep; const char* b2 = last ? nB : cB + (size_t)(t + 2) * kstep;
            const char* a3 = a2 + kstep; const char* b3 = b2 + kstep;
            if (last && has_next) S.a_ready(nxt);
            if constexpr (SP2) {
            PG8_LDB(B0, 0, 0); PG8_LDB(B1, 0, 1); PG8_SCHED; PG8_LDA(At, 0, 0); PG8_STAGE(PG8_SA(1, 1), a1 + hstep, voffA);
            PG8_WAIT_V(8); PG8_WAIT_L(0); PG8_BAR; PG8_MMA(0, 0, At, B0); PG8_MMA(0, 1, At, B1); PG8_BAR; PG8_SCHED;
            PG8_LDA(At, 0, 1); PG8_STAGE(PG8_SB(0, 0), b2, voffB); PG8_STAGE(PG8_SB(0, 1), b2 + hstep, voffB); PG8_STAGE(PG8_SA(0, 0), a2, voffA);
            PG8_WAIT_V(8); PG8_WAIT_L(0); PG8_BAR; PG8_MMA(1, 0, At, B0); PG8_MMA(1, 1, At, B1); PG8_BAR; PG8_SCHED;
            PG8_LDB(B0, 1, 0); PG8_LDB(B1, 1, 1); PG8_SCHED; PG8_LDA(At, 1, 0); PG8_STAGE(PG8_SA(0, 1), a2 + hstep, voffA);
            PG8_WAIT_V(8); PG8_WAIT_L(0); PG8_BAR; PG8_MMA(0, 0, At, B0); PG8_MMA(0, 1, At, B1); PG8_BAR; PG8_SCHED;
            PG8_LDA(At, 1, 1); PG8_STAGE(PG8_SB(1, 0), b3, voffB); PG8_STAGE(PG8_SB(1, 1), b3 + hstep, voffB); PG8_STAGE(PG8_SA(1, 0), a3, voffA);
            PG8_WAIT_V(8); PG8_WAIT_L(0); PG8_BAR; PG8_MMA(1, 0, At, B0); PG8_MMA(1, 1, At, B1); PG8_BAR; PG8_SCHED;
            } else {
            PG8_LDB(B0, 0, 0); PG8_SCHED; PG8_LDA(At, 0, 0); PG8_STAGE(PG8_SA(1, 1), a1 + hstep, voffA);
            PG8_WAIT_L(8); PG8_BAR; PG8_WAIT_L(0); PG8_MMA(0, 0, At, B0); PG8_BAR; PG8_SCHED;
            PG8_LDB(B1, 0, 1); PG8_STAGE(PG8_SB(0, 0), b2, voffB);
            PG8_BAR; PG8_WAIT_L(0); PG8_MMA(0, 1, At, B1); PG8_BAR;
            PG8_LDA(At, 0, 1); PG8_STAGE(PG8_SA(0, 0), a2, voffA);
            PG8_BAR; PG8_WAIT_L(0); PG8_MMA(1, 0, At, B0); PG8_BAR; PG8_SCHED;
            PG8_STAGE(PG8_SB(0, 1), b2 + hstep, voffB);
            PG8_WAIT_V(6); PG8_BAR; PG8_MMA(1, 1, At, B1); PG8_BAR;
            PG8_LDB(B0, 1, 0); PG8_SCHED; PG8_LDA(At, 1, 0); PG8_STAGE(PG8_SA(0, 1), a2 + hstep, voffA);
            PG8_WAIT_L(8); PG8_BAR; PG8_WAIT_L(0); PG8_MMA(0, 0, At, B0); PG8_BAR; PG8_SCHED;
            PG8_LDB(B1, 1, 1); PG8_STAGE(PG8_SB(1, 0), b3, voffB);
            PG8_BAR; PG8_WAIT_L(0); PG8_MMA(0, 1, At, B1); PG8_BAR;
            PG8_LDA(At, 1, 1); PG8_STAGE(PG8_SA(1, 0), a3, voffA);
            PG8_BAR; PG8_WAIT_L(0); PG8_MMA(1, 0, At, B0); PG8_BAR; PG8_SCHED;
            PG8_STAGE(PG8_SB(1, 1), b3 + hstep, voffB);
            PG8_WAIT_V(6); PG8_BAR; PG8_MMA(1, 1, At, B1); PG8_BAR;
            }
        }
        if constexpr (ALIGN_EPI) { if (wr == 0) PG8_BAR; }
        if constexpr (!Epi::AFTER_DRAIN) { unsigned z_ = 0u; asm volatile("" : "+v"(z_)); const int l2_ = (int)__builtin_amdgcn_mbcnt_hi(~0u, __builtin_amdgcn_mbcnt_lo(~0u, z_)); E(acc, cur, wr, wc, l2_ & 15, l2_ >> 4); S.done(cur); }
        if (!has_next) break;
#pragma unroll
        for (int a = 0; a < 2; ++a)
#pragma unroll
            for (int b = 0; b < 2; ++b)
#pragma unroll
                for (int m = 0; m < 4; ++m)
#pragma unroll
                    for (int n = 0; n < 2; ++n) acc[a][b][m][n] = (f32x4){0.f, 0.f, 0.f, 0.f};
        cur = nxt; cA = nA; cB = nB; ++ui;
        if constexpr (ALIGN_EPI) { if (wr == 1) PG8_BAR; }
    }
    PG8_WAIT_V(0);
    if constexpr (!ALIGN_EPI) { if (wr == 0) PG8_BAR; }
    PG8_BAR;
    if constexpr (Epi::AFTER_DRAIN) { E.fused(acc, cur, wr, wc, fr, fq, lds, wid, lane); S.done(cur); }
#undef PG8_SA
#undef PG8_SB
#undef PG8_STAGE
#undef PG8_LDA
#undef PG8_LDB
#undef PG8_MMA
#undef PG8_WAIT_V
#undef PG8_WAIT_L
#undef PG8_BAR
#undef PG8_SCHED
}
}
#ifndef LAS
#define LAS __attribute__((address_space(3)))
#endif
#define XB_TMO      128
#define XB_XCNT(j)  (256  + 64 * (j))
#define XB_XSUB(j)  (1280 + 64 * (j))
#define XB_XGEN(j)  (2304 + 64 * (j))
#define XB_TOP      3328
#define XB_TOPGEN   3392
#define XCD_BAR_WORDS 3456
#define XB_SPIN_CAP (1u << 24)

__device__ __forceinline__ unsigned xb_ld(unsigned* p)              { return __hip_atomic_load(p, __ATOMIC_RELAXED, __HIP_MEMORY_SCOPE_AGENT); }
__device__ __forceinline__ unsigned xb_add(unsigned* p, unsigned v) { return __hip_atomic_fetch_add(p, v, __ATOMIC_RELAXED, __HIP_MEMORY_SCOPE_AGENT); }
__device__ __forceinline__ unsigned xb_xcc_id() { return (unsigned)__builtin_amdgcn_s_getreg((3 << 11) | 20) & 0xFu; }
#define XB_SPIN(cond, bar) do { unsigned _sp = 0; while (cond) { __builtin_amdgcn_s_sleep(1); \
    if ((++_sp & 255u) == 0u) { if (xb_ld(&(bar)[XB_TMO])) break; if (_sp > XB_SPIN_CAP) { atomicAdd(&(bar)[XB_TMO], 1u); break; } } } } while (0)

struct XcdBarrier {
    int w;
    unsigned* bar; unsigned x;
    volatile LAS unsigned* st;
};

__device__ __forceinline__ bool xb_thread0(int w) { unsigned z = 0u; asm volatile("" : "+v"(z), "+s"(w)); return w == 0 && __builtin_amdgcn_mbcnt_hi(~0u, __builtin_amdgcn_mbcnt_lo(~0u, z)) == 0u; }
__device__ __forceinline__ XcdBarrier xcd_barrier_post(unsigned* bar, volatile LAS unsigned* st, int w) {
    XcdBarrier b; b.w = w; b.bar = bar; b.x = xb_xcc_id(); b.st = st;
    if (xb_thread0(w)) (void)xb_add(&bar[XB_XCNT(b.x)], 1u);
    return b;
}
__device__ __forceinline__ void xcd_barrier_complete(unsigned* bar, unsigned x, unsigned& nloc, unsigned& nx) {
    const unsigned G = gridDim.x * gridDim.y * gridDim.z;
    unsigned sum, cnt, mine, sp = 0u;
    for (;;) {
        sum = 0u; cnt = 0u; mine = 0u;
#pragma unroll
        for (unsigned j = 0; j < 16; ++j) { const unsigned c = xb_ld(&bar[XB_XCNT(j)]); sum += c; cnt += (c > 0u) ? 1u : 0u; mine = (j == x) ? c : mine; }
        if (sum == G) break;
        __builtin_amdgcn_s_sleep(1);
        if ((++sp & 255u) == 0u) { if (xb_ld(&bar[XB_TMO])) break; if (sp > XB_SPIN_CAP) { atomicAdd(&bar[XB_TMO], 1u); break; } }
    }
    nloc = mine > 0u ? mine : 1u; nx = cnt > 0u ? cnt : 1u;
}

__device__ __forceinline__ void xcd_barrier(const XcdBarrier& b) {
    asm volatile("s_waitcnt vmcnt(0)" ::: "memory");
    __syncthreads();
    if (xb_thread0(b.w)) {
        unsigned* bar = b.bar;
        __builtin_amdgcn_s_waitcnt(0);
        unsigned nloc = b.st[0], nx = b.st[1];
        if (nloc == 0u) { xcd_barrier_complete(bar, b.x, nloc, nx); b.st[0] = nloc; b.st[1] = nx; }
        const unsigned old = xb_add(&bar[XB_XSUB(b.x)], 1u);
        const unsigned gen = old / nloc;
        if (old + 1u == (gen + 1u) * nloc) {
            __builtin_amdgcn_fence(__ATOMIC_RELEASE, "agent");
            asm volatile("s_waitcnt vmcnt(0)" ::: "memory");
            const unsigned og = xb_add(&bar[XB_TOP], 1u);
            const unsigned tg = og / nx;
            if (og + 1u == (tg + 1u) * nx) xb_add(&bar[XB_TOPGEN], 1u);
            else XB_SPIN(xb_ld(&bar[XB_TOPGEN]) == tg, bar);
            __builtin_amdgcn_fence(__ATOMIC_ACQUIRE, "agent");
            xb_add(&bar[XB_XGEN(b.x)], 1u);
            asm volatile("s_waitcnt vmcnt(0)" ::: "memory");
        } else {
            XB_SPIN(xb_ld(&bar[XB_XGEN(b.x)]) == gen, bar);
            __builtin_amdgcn_fence(__ATOMIC_ACQUIRE, "agent");
            asm volatile("s_waitcnt vmcnt(0)" ::: "memory");
        }
    }
    __syncthreads();
}
#define GAS __attribute__((address_space(1)))
constexpr int NWAVES = 8, NTHREADS = NWAVES * 64;
constexpr size_t MiB = 1u << 20;
constexpr size_t WS_CTL = 0, CTL_ZERO_BYTES = 1 * MiB;
constexpr size_t WS_SMALL = 1 * MiB, WS_TOKINFO = 2 * MiB, WS_LIST = 3 * MiB;
constexpr size_t WS_WIN = 4 * MiB, WS_WOUT = 34 * MiB, WS_WFGU = 42 * MiB, WS_WFD = 64 * MiB, WS_WMGU = 75 * MiB, WS_WMD = 187 * MiB;
constexpr size_t WS_H = 243 * MiB, WS_A = 315 * MiB, WS_OC = 351 * MiB, WS_Y = 387 * MiB, WS_AM = 463 * MiB, WS_BIG = 539 * MiB;
constexpr size_t WS_P = WS_BIG, WS_QM = 674 * MiB, WS_KM = WS_QM + 14155776, WS_VM = WS_KM + 14155776, WS_QS = 710 * MiB, WS_KS = WS_QS + 9437184, WS_VS = WS_KS + 4718592;
constexpr size_t WS_HF = 728 * MiB, WS_HO = 764 * MiB, WS_RQ = 800 * MiB, WS_RK = 809 * MiB, WS_RO = 818 * MiB, WS_HQC = 854 * MiB, WS_HU = 872 * MiB, WS_HDK = 908 * MiB, WS_RQC = 909 * MiB, WS_RU = 927 * MiB, WS_TAB = 945 * MiB, WS_END = 947 * MiB;
constexpr size_t WS_ACT = WS_BIG;
constexpr int MAXTILES = 152;
static_assert(WS_P + (size_t)NTOK * NP * 2 <= WS_QM && WS_VM + (size_t)NB * 4 * TK * 64 * 2 <= WS_QS && WS_VS + 4718592 <= WS_HF, "ws map 1");
static_assert(WS_HQC + (size_t)2 * NTOK * 256 * 2 <= WS_HU && WS_HU + (size_t)2 * NB * 4 * 36 * 4096 * 4 <= WS_HDK && WS_RQC + (size_t)2 * NTOK * 256 * 2 <= WS_RU && WS_RU + (size_t)2 * NB * 4 * 36 * 2048 * 4 <= WS_TAB, "ws map 3");
static_assert(WS_ACT + (size_t)MAXTILES * 256 * DFE * 2 <= WS_END && (size_t)MAXTILES * 256 * D * 2 <= 76 * MiB, "ws map 2");
constexpr int SM_MOD = 0;
constexpr int SM_LOGLB = 4 * 9 * 6144, SM_LOG1M = SM_LOGLB + 4 * 512, SM_LGAM = SM_LOG1M + 4 * 512, SM_META = SM_LGAM + 64, SM_ULIST = SM_META + 32;
constexpr int ULIST_GU = 0, ULIST_D = MAXTILES * 28;
static_assert((SM_ULIST + 2 * MAXTILES * 32) * 4 <= (int)MiB, "small region");
constexpr int CW_BAR = 4096, CW_CNT = 8192;
constexpr int LDS_BYTES = 147456, MISC_OFF = 131072 + 320;

#define LAS __attribute__((address_space(3)))
typedef float f32x4 __attribute__((ext_vector_type(4)));
typedef unsigned v4u __attribute__((ext_vector_type(4)));
typedef unsigned v2u __attribute__((ext_vector_type(2)));
#define LDS_WAIT() asm volatile("s_waitcnt lgkmcnt(0)" ::: "memory")

struct Args { const float* in[28]; float* out; unsigned char* ws; int ph_lo, ph_hi; };
typedef __attribute__((address_space(4))) const unsigned long long ka_u64;
__device__ __forceinline__ const float* IN(int i) { ka_u64* ka = (ka_u64*)__builtin_amdgcn_kernarg_segment_ptr(); asm volatile("" : "+s"(ka)); return (const float*)(GAS const float*)ka[i]; }
__device__ __forceinline__ float* OUTP() { ka_u64* ka = (ka_u64*)__builtin_amdgcn_kernarg_segment_ptr(); asm volatile("" : "+s"(ka)); return (float*)(GAS float*)ka[28]; }
__device__ __forceinline__ unsigned char* WSBASE() { ka_u64* ka = (ka_u64*)__builtin_amdgcn_kernarg_segment_ptr(); asm volatile("" : "+s"(ka)); return (unsigned char*)(GAS unsigned char*)ka[29]; }
struct Frame {
    LAS unsigned char* lds;
    int tid, lane, wave, gtid, NT, gw, NGW;
    __device__ __forceinline__ unsigned char* base() const { return WSBASE(); }
};
#define WSP(T, off) ((T*)(ws + (off)))
#define F_ctl WSP(unsigned, WS_CTL)
#define F_sm WSP(float, WS_SMALL)
#define F_tokinfo WSP(int, WS_TOKINFO)
#define F_list WSP(int, WS_LIST)
#define F_H WSP(bf16, WS_H)
#define F_A WSP(bf16, WS_A)
#define F_OC WSP(bf16, WS_OC)
#define F_Y WSP(bf16, WS_Y)
#define F_AM WSP(bf16, WS_AM)
#define F_P WSP(bf16, WS_P)
#define F_ACT WSP(bf16, WS_ACT)
#define F_WIN WSP(bf16, WS_WIN)
#define F_WOUT WSP(bf16, WS_WOUT)
#define F_WFGU WSP(bf16, WS_WFGU)
#define F_WFD WSP(bf16, WS_WFD)
#define F_WMGU WSP(bf16, WS_WMGU)
#define F_WMD WSP(bf16, WS_WMD)
__device__ __forceinline__ float wave_sum(float v, int  ) {
    int x = __float_as_int(v);
    v += __int_as_float(__builtin_amdgcn_update_dpp(0, x, 0xB1, 0xF, 0xF, true)); x = __float_as_int(v);
    v += __int_as_float(__builtin_amdgcn_update_dpp(0, x, 0x4E, 0xF, 0xF, true)); x = __float_as_int(v);
    v += __int_as_float(__builtin_amdgcn_update_dpp(0, x, 0x141, 0xF, 0xF, true)); x = __float_as_int(v);
    v += __int_as_float(__builtin_amdgcn_update_dpp(0, x, 0x140, 0xF, 0xF, true)); x = __float_as_int(v);
    v += __int_as_float(__builtin_amdgcn_update_dpp(0, x, 0x142, 0xA, 0xF, false)); x = __float_as_int(v);
    v += __int_as_float(__builtin_amdgcn_update_dpp(0, x, 0x143, 0xC, 0xF, false));
    return __int_as_float(__builtin_amdgcn_readlane(__float_as_int(v), 63));
}
__device__ __forceinline__ unsigned pk2(float lo, float hi) { return (unsigned)f2bf(lo) | ((unsigned)f2bf(hi) << 16); }

constexpr int TAB_MLA = 0, TAB_SWA = NL * 16 * 2, TAB_RET = TAB_SWA + NL * 32 * 2, TAB_FLOATS = TAB_RET + TK * 16 * 2;
__device__ __forceinline__ void build_tables(float* tab, int gtid, int NT) {
    for (int it = gtid; it < NL * 16; it += NT) { const int t = it >> 4, j = it & 15; const float inv = powf(10000.0f, -(float)(j & 7) / 8.0f), ang = (float)(j < 8 ? t / GRIDW : t % GRIDW) * inv;
        tab[TAB_MLA + 2 * it] = cosf(ang); tab[TAB_MLA + 2 * it + 1] = sinf(ang); }
    for (int it = gtid; it < NL * 32; it += NT) { const int t = it >> 5, j = it & 31; const float inv = powf(10000.0f, -(float)(j & 15) / 16.0f), ang = (float)(j < 16 ? t / GRIDW : t % GRIDW) * inv;
        tab[TAB_SWA + 2 * it] = cosf(ang); tab[TAB_SWA + 2 * it + 1] = sinf(ang); }
    for (int it = gtid; it < TK * 16; it += NT) { const int tq = it >> 4, j = it & 15; const float inv = powf(10000.0f, -(float)j / 16.0f), ang = (float)tq * inv;
        tab[TAB_RET + 2 * it] = cosf(ang); tab[TAB_RET + 2 * it + 1] = sinf(ang); }
}
static_assert((size_t)TAB_FLOATS * 4 <= 2 * MiB, "rope tables");
struct CvItem { GAS const float* p; GAS bf16* q; int ld2, k8; };
__device__ __forceinline__ CvItem cv_plain(const float* W, int N, int K, int nblk, bf16* WT, int item, int lane) {
    const int kb = item / nblk, nb = item % nblk, k0 = 64 * kb, n0 = 32 * nb; CvItem d;
    d.p = (GAS const float*)W + (size_t)(k0 + (lane >> 5)) * N + n0 + (lane & 31); d.ld2 = 2 * N;
    d.q = (GAS bf16*)WT + (size_t)(n0 + (lane >> 3)) * K + k0 + 8 * (lane & 7); d.k8 = 8 * K; return d; }
__device__ __forceinline__ CvItem cv_gu(const float* Wg, long du, int NF, int K, int nblk, bf16* WT, int item, int lane) {
    const int kb = item / nblk, nb = item % nblk, k0 = 64 * kb, n0 = 32 * nb, c = n0 + (lane & 31), j = c >> 3, w = c & 7; CvItem d;
    d.p = (GAS const float*)Wg + (w < 4 ? 0l : du) + (size_t)(k0 + (lane >> 5)) * NF + 4 * j + (w & 3); d.ld2 = 2 * NF;
    d.q = (GAS bf16*)WT + (size_t)(n0 + (lane >> 3)) * K + k0 + 8 * (lane & 7); d.k8 = 8 * K; return d; }
__device__ __forceinline__ void cv_load(const CvItem& d, float (&tv)[32]) {
#pragma unroll
    for (int i = 0; i < 32; ++i) tv[i] = d.p[(long)i * d.ld2];
}
__device__ __forceinline__ void cv_store(const CvItem& d, const float (&tv)[32], LAS float* scr, int lane) {
#pragma unroll
    for (int i = 0; i < 32; ++i) scr[(2 * i + (lane >> 5)) * 33 + (lane & 31)] = tv[i];
    LDS_WAIT(); asm volatile("" ::: "memory");
    const int cc = lane & 7;
#pragma unroll
    for (int j = 0; j < 4; ++j) { const int n = (lane >> 3) + 8 * j; const LAS float* s = scr + (8 * cc) * 33 + n;
        v4u o; o.x = pk2(s[0 * 33], s[1 * 33]); o.y = pk2(s[2 * 33], s[3 * 33]); o.z = pk2(s[4 * 33], s[5 * 33]); o.w = pk2(s[6 * 33], s[7 * 33]);
        *(GAS v4u*)(d.q + (long)j * d.k8) = o; }
    LDS_WAIT(); asm volatile("" ::: "memory");
}
constexpr int I_IN = 16 * 91, I_OUT = 16 * 32, I_FGU = 16 * 176, I_FD = 44 * 32, I_MGU = 16 * 224, I_MD = 56 * 32, I_MOE = 8 * (I_MGU + I_MD);
constexpr int J_A = I_IN + I_OUT + I_FGU + I_FD;
constexpr int J_B = 3 * (I_IN + I_OUT) + I_FGU + I_FD;
constexpr int J_M0 = J_A + J_B, J_M1 = J_M0 + I_MOE, J_END = J_M1 + I_MOE;
__device__ __forceinline__ CvItem conv_desc(Frame& F, int it, int lane) {
    unsigned char* ws = F.base();
    if (it >= J_M0) {
        const int li = it >= J_M1 ? 1 : 0; int r = it - (li ? J_M1 : J_M0), e; bool gu;
        if (li == 0) { e = r / (I_MGU + I_MD); r %= (I_MGU + I_MD); gu = r < I_MGU; if (!gu) r -= I_MGU; }
        else { gu = r < 8 * I_MGU; if (gu) { e = r / I_MGU; r %= I_MGU; } else { r -= 8 * I_MGU; e = r / I_MD; r %= I_MD; } }
        if (gu) return cv_gu(IN(24) + ((size_t)li * 8 + e) * D * DFE, (long)(IN(25) - IN(24)), DFE, D, 224, F_WMGU + (size_t)e * 2 * DFE * D, r, lane);
        return cv_plain(IN(26) + ((size_t)li * 8 + e) * DFE * D, D, DFE, 32, F_WMD + (size_t)e * D * DFE, r, lane); }
    int l, li, r = it;
    if (r < J_A) { l = 0; li = 0; }
    else { r -= J_A; if (r < 3 * (I_IN + I_OUT)) { l = 1 + r / (I_IN + I_OUT); r %= (I_IN + I_OUT); li = 0; } else { r -= 3 * (I_IN + I_OUT); r += I_IN + I_OUT; l = 0; li = 1; } }
    if (r < I_IN) return cv_plain(IN(8) + (size_t)l * D * DIN, DIN, D, 91, F_WIN + (size_t)l * NP * D, r, lane);
    r -= I_IN;
    if (r < I_OUT) return cv_plain(IN(9) + (size_t)l * D * D, D, D, 32, F_WOUT + (size_t)l * D * D, r, lane);
    r -= I_OUT;
    if (r < I_FGU) return cv_gu(IN(20) + (size_t)li * D * DFF, (long)(IN(21) - IN(20)), DFF, D, 176, F_WFGU + (size_t)li * 2 * DFF * D, r, lane);
    r -= I_FGU;
    return cv_plain(IN(22) + (size_t)li * DFF * D, D, DFF, 32, F_WFD + (size_t)li * D * DFF, r, lane);
}
__device__ __forceinline__ void conv_range(Frame& F, int first, int count, int wg0) {
    if ((int)blockIdx.x < wg0) return;
    LAS float* scr = (LAS float*)(F.lds + 40960 + F.wave * 8704);
    const int w = ((int)blockIdx.x - wg0) * NWAVES + F.wave, nw = ((int)gridDim.x - wg0) * NWAVES, end = first + count;
    int it = first + w; if (it >= end) return;
    asm volatile("" : "+s"(it));
    unsigned z = 0u; asm volatile("" : "+v"(z)); const int lane = (int)__builtin_amdgcn_mbcnt_hi(~0u, __builtin_amdgcn_mbcnt_lo(~0u, z));
    float ta[32], tb[32];
    CvItem da = conv_desc(F, it, lane), db = da; cv_load(da, ta);
    for (;;) {
        const int i2 = it + nw; const bool hb = i2 < end;
        if (hb) { db = conv_desc(F, i2, lane); cv_load(db, tb); }
        cv_store(da, ta, scr, lane);
        if (!hb) break;
        it = i2 + nw; const bool ha = it < end;
        if (ha) { da = conv_desc(F, it, lane); cv_load(da, ta); }
        cv_store(db, tb, scr, lane);
        if (!ha) break;
    }
}
#ifndef CVS
#define CVS 100
#endif
constexpr int CVB_G1 = 2800 * CVS / 100, CVB_G2 = 3200 * CVS / 100, CVB_GU = 3000 * CVS / 100, CVB_DN = 9000 * CVS / 100;
constexpr int CV_TAIL_M0 = (CVB_G1 + CVB_G2 + CVB_GU + CVB_DN) + (CVB_G1 + CVB_G2);
constexpr int CV_P = J_M1 - CV_TAIL_M0;
static_assert(CV_P >= J_M0, "the prologue covers every dense weight");
#ifndef CVB_MD
#define CVB_MD 10000
#endif
static_assert(CVB_MD <= 8 * I_MGU, "the tail of MoE layer 0's down GEMM may only copy gate/up items of MoE layer 1 (the down buffer is being read)");
#define CV_L(l) ((l) == 0 ? CV_P : (l) == 1 ? CV_P + (CVB_G1 + CVB_G2 + CVB_GU + CVB_DN) : (l) == 2 ? J_M1 + CVB_MD : J_M1 + CVB_MD + (CVB_G1 + CVB_G2 + CVB_GU + CVB_DN))
__device__ __forceinline__ void prologue(Frame& F, int pmode) {
    unsigned char* ws = F.base();
    LAS float* sil = (LAS float*)F.lds;
    for (int i = F.tid; i < 9 * 1024; i += NTHREADS) { const float cv = i < 8 * 1024 ? IN(1)[i] : IN(3)[i - 8 * 1024]; sil[i] = silu_f(cv); }
    __syncthreads();
    if (!(pmode & 1)) { LAS float* red = (LAS float*)(F.lds + 36864);
      const int jc = F.tid & 31, kg = F.tid >> 5;
      for (int unit = blockIdx.x; unit < DEPTH * 192; unit += gridDim.x) {
          const int l = unit / 192, j0 = (unit % 192) * 32; const float* w = IN(4) + ((size_t)l * D + kg * 64) * 6144 + j0 + jc;
          float acc[9];
#pragma unroll
          for (int b = 0; b < 9; ++b) acc[b] = 0.f;
#pragma unroll 16
          for (int k = 0; k < 64; ++k) { const float wv = w[(size_t)k * 6144];
#pragma unroll
              for (int b = 0; b < 9; ++b) acc[b] += sil[b * 1024 + kg * 64 + k] * wv; }
#pragma unroll
          for (int b = 0; b < 9; ++b) red[(kg * 9 + b) * 32 + jc] = acc[b];
          __syncthreads();
          for (int o = F.tid; o < 9 * 32; o += NTHREADS) { float s = IN(5)[l * 6144 + j0 + (o & 31)];
#pragma unroll
              for (int g = 0; g < 16; ++g) s += red[(g * 9 + (o >> 5)) * 32 + (o & 31)];
              F_sm[SM_MOD + ((size_t)l * 9 + (o >> 5)) * 6144 + j0 + (o & 31)] = s; }
          __syncthreads();
      } }
    for (int it = F.gtid; it < 512; it += F.NT) {
        float lg[DEPTH], mx = -1e30f, s = 0.f;
#pragma unroll
        for (int l = 0; l < DEPTH; ++l) { lg[l] = IN(14)[l * 512 + it]; mx = fmaxf(mx, lg[l]); }
#pragma unroll
        for (int l = 0; l < DEPTH; ++l) { lg[l] = expf(lg[l] - mx); s += lg[l]; }
        float cum = 0.f; const float p0 = lg[0] / s;
#pragma unroll
        for (int l = 0; l < DEPTH; ++l) { cum += lg[l] / s; const float lb = cum - p0; F_sm[SM_LOGLB + l * 512 + it] = fmaxf(lb, 1e-30f); F_sm[SM_LOG1M + l * 512 + it] = 1.0f - lb; }
    }
    for (int it = F.gtid; it < DEPTH * 8; it += F.NT) F_sm[SM_LGAM + it] = log_sigmoid_f(IN(17)[it]);
    build_tables(WSP(float, WS_TAB), F.gtid, F.NT);
    if (!(pmode & 2)) conv_range(F, 0, CV_P, 0);
    if (!(pmode & 4)) { __syncthreads();
      LAS float* sw = (LAS float*)F.lds;
      for (int unit = blockIdx.x; unit < DEPTH * (D / 16); unit += gridDim.x) {
          const int l = unit / (D / 16), k0 = (unit % (D / 16)) * 16;
          for (int o = F.tid; o < 16 * 320; o += NTHREADS) { const int r = o / 320, j = o % 320;
              sw[j * 16 + r] = IN(8)[((size_t)l * D + k0 + r) * DIN + j] * (j < 192 ? IN(10)[l * 192 + j] : IN(12)[l * 128 + j - 192]); }
          __syncthreads();
#pragma unroll 1
          for (int pass = 0; pass < 2; ++pass) {
              const int n = F.tid + 512 * pass;
              if (n < 928) {
                  float acc[16];
#pragma unroll
                  for (int r = 0; r < 16; ++r) acc[r] = 0.f;
                  if (n < 896) {
                      const bool q = n < 384; const int K = q ? 192 : 128, st = q ? 384 : 512;
                      const float* wu = q ? IN(11) + (size_t)l * 192 * 384 + n : IN(13) + (size_t)l * 128 * 512 + (n - 384);
                      const LAS float* s = sw + (q ? 0 : 192 * 16);
#pragma unroll 8
                      for (int j = 0; j < K; ++j) { const float w = wu[(size_t)j * st];
                          const f32x4 a0 = *(const LAS f32x4*)(s + j * 16), a1 = *(const LAS f32x4*)(s + j * 16 + 4), a2 = *(const LAS f32x4*)(s + j * 16 + 8), a3 = *(const LAS f32x4*)(s + j * 16 + 12);
#pragma unroll
                          for (int i = 0; i < 4; ++i) { acc[i] += a0[i] * w; acc[4 + i] += a1[i] * w; acc[8 + i] += a2[i] * w; acc[12 + i] += a3[i] * w; } } }
                  v4u o0, o1; o0.x = pk2(acc[0], acc[1]); o0.y = pk2(acc[2], acc[3]); o0.z = pk2(acc[4], acc[5]); o0.w = pk2(acc[6], acc[7]);
                  o1.x = pk2(acc[8], acc[9]); o1.y = pk2(acc[10], acc[11]); o1.z = pk2(acc[12], acc[13]); o1.w = pk2(acc[14], acc[15]);
                  bf16* dst = F_WIN + ((size_t)l * NP + DIN + n) * D + k0; *(v4u*)dst = o0; *(v4u*)(dst + 8) = o1; } }
          __syncthreads();
      } }
}

#ifndef STG_NG
#define STG_NG 4
#endif
#ifndef STG_NS
#define STG_NS 0
#endif
__device__ __forceinline__ void stagger_start() {
    const int g = ((int)blockIdx.x >> 3) % STG_NG;
    if (STG_NS > 0 && g) { const unsigned long long t0 = __builtin_amdgcn_s_memrealtime(), d = (unsigned long long)g * STG_NS / 10ull;
        while (__builtin_amdgcn_s_memrealtime() - t0 < d) __builtin_amdgcn_s_sleep(4); }
}
typedef short bf16x8s __attribute__((ext_vector_type(8)));
typedef float f32x16 __attribute__((ext_vector_type(16)));
__device__ __forceinline__ int crow(int r, int hi) { return (r & 3) + 8 * (r >> 2) + 4 * hi; }
__device__ __forceinline__ float xlane32(float v, int lane) { return __int_as_float(__builtin_amdgcn_ds_bpermute((lane ^ 32) << 2, __float_as_int(v))); }
typedef float f32x2t __attribute__((ext_vector_type(2))); typedef __bf16 bf16x2t __attribute__((ext_vector_type(2)));
__device__ __forceinline__ unsigned cvtpk_c(float lo, float hi) { const f32x2t v = {lo, hi}; const bf16x2t b = __builtin_convertvector(v, bf16x2t); return __builtin_bit_cast(unsigned, b); }
__device__ __forceinline__ unsigned cvtpk(float lo, float hi) { return cvtpk_c(lo, hi); }

template <int DK, bool SWA>
__device__ __forceinline__ void attn_unit(LAS unsigned char* lds, const bf16* Qg, const bf16* Kg, const bf16* Vtg, bf16* OCp, int b, int hcol, int tq0,
                                          int t0a, int t1a, int t0b, int t1b, float sink2, int tid) {
    constexpr int KS = DK * 2 + 16, VS = 136, KT_BYTES = 64 * KS, STAGE = KT_BYTES + 64 * VS, KP = DK / 8, NKP = 64 * KP, NS = DK / 16;
    const int lane = tid & 63, wave = __builtin_amdgcn_readfirstlane(tid >> 6), q = lane & 31, hi = lane >> 5;
    LAS float* wsf = (LAS float*)(lds + 2 * STAGE) + wave * 64;
    const int tq = tq0 + wave * 32 + q;
    bf16x8s qf[NS];
#pragma unroll
    for (int s = 0; s < NS; ++s) qf[s] = *(const bf16x8s*)(Qg + (size_t)tq * DK + 16 * s + 8 * hi);
    f32x16 o0, o1;
#pragma unroll
    for (int r = 0; r < 16; ++r) { o0[r] = 0.f; o1[r] = 0.f; }
    float m = SWA ? sink2 : 0.f, l = (SWA && hi == 0) ? 1.0f : 0.f;
    bool first = !SWA;
    f32x16 negm;
#pragma unroll
    for (int r = 0; r < 16; ++r) negm[r] = -m;
    const int na = t1a - t0a, nt = na + (t1b - t0b);
    const int w0 = tq0 - NC + wave * 32;
    v4u kr0, kr1 = (v4u){0u, 0u, 0u, 0u}, vr;
    { const int t = na > 0 ? t0a : t0b; const v4u* kg = (const v4u*)(Kg + (size_t)t * 64 * DK); kr0 = kg[tid]; if (NKP > 512) { if (tid < NKP - 512) kr1 = kg[512 + tid]; }
      vr = *(const v4u*)(Vtg + (size_t)(tid >> 3) * TK + t * 64 + (tid & 7) * 8); }
    { LAS unsigned char* kb = lds; *(LAS v4u*)(kb + (tid / KP) * KS + (tid % KP) * 16) = kr0;
      if (NKP > 512) { if (tid < NKP - 512) { const int p = 512 + tid; *(LAS v4u*)(kb + (p / KP) * KS + (p % KP) * 16) = kr1; } }
      LAS unsigned char* vb = kb + KT_BYTES + (tid >> 3) * VS + (tid & 7) * 16; *(LAS v2u*)vb = (v2u){vr.x, vr.y}; *(LAS v2u*)(vb + 8) = (v2u){vr.z, vr.w}; }
    __syncthreads();
    for (int i = 0; i < nt; ++i) {
        const int t = i < na ? t0a + i : t0b + (i - na);
        if (i + 1 < nt) { const int tn = (i + 1) < na ? t0a + i + 1 : t0b + (i + 1 - na); const v4u* kg = (const v4u*)(Kg + (size_t)tn * 64 * DK); kr0 = kg[tid]; if (NKP > 512) { if (tid < NKP - 512) kr1 = kg[512 + tid]; }
            vr = *(const v4u*)(Vtg + (size_t)(tid >> 3) * TK + tn * 64 + (tid & 7) * 8); }
        LAS unsigned char* kb = lds + (i & 1) * STAGE; LAS unsigned char* vbs = kb + KT_BYTES;
        const int sb = 64 * t - NC;
        const bool band = SWA && t >= 4;
        const bool skip = band && (sb + 63 < w0 - 128 || sb > w0 + 31 + 128);
        if (!skip) {
            f32x16 p0 = negm, p1 = negm;
#pragma unroll
            for (int s = 0; s < NS; ++s) {
                const bf16x8s k0 = *(const LAS bf16x8s*)(kb + q * KS + (16 * s + 8 * hi) * 2);
                const bf16x8s k1 = *(const LAS bf16x8s*)(kb + (32 + q) * KS + (16 * s + 8 * hi) * 2);
                p0 = __builtin_amdgcn_mfma_f32_32x32x16_bf16(k0, qf[s], p0, 0, 0, 0);
                p1 = __builtin_amdgcn_mfma_f32_32x32x16_bf16(k1, qf[s], p1, 0, 0, 0);
            }
            if (band) { const int tl = tq - NC;
#pragma unroll
                for (int r = 0; r < 16; ++r) { const int d0 = tl - (sb + crow(r, hi)), d1 = d0 - 32;
                    if (d0 > 128 || d0 < -128) p0[r] = -1e30f; if (d1 > 128 || d1 < -128) p1[r] = -1e30f; } }
            float mx = fmaxf(p0[0], p1[0]);
#pragma unroll
            for (int r = 1; r < 16; ++r) mx = fmaxf(mx, fmaxf(p0[r], p1[r]));
            mx = fmaxf(mx, xlane32(mx, lane));
            if (first || __any(mx > 0.f)) {
                const float dl = first ? mx : fmaxf(mx, 0.f), alpha = __builtin_amdgcn_exp2f(-dl);
                m += dl; l *= alpha;
#pragma unroll
                for (int r = 0; r < 16; ++r) { p0[r] -= dl; p1[r] -= dl; negm[r] = -m; }
                if (!first) { if (hi == 0) wsf[q] = alpha;
                    asm volatile("s_waitcnt lgkmcnt(0)" ::: "memory");
#pragma unroll
                    for (int r = 0; r < 16; ++r) { const float a = wsf[crow(r, hi)]; o0[r] *= a; o1[r] *= a; } }
                first = false;
            }
            float ps = 0.f;
#pragma unroll
            for (int r = 0; r < 16; ++r) { p0[r] = __builtin_amdgcn_exp2f(p0[r]); p1[r] = __builtin_amdgcn_exp2f(p1[r]); ps += p0[r] + p1[r]; }
            l += ps;
            bf16x8s pa[4];
            { v4u w;
              w.x = cvtpk(p0[0], p0[1]); w.y = cvtpk(p0[2], p0[3]); w.z = cvtpk(p0[4], p0[5]); w.w = cvtpk(p0[6], p0[7]); pa[0] = __builtin_bit_cast(bf16x8s, w);
              w.x = cvtpk(p0[8], p0[9]); w.y = cvtpk(p0[10], p0[11]); w.z = cvtpk(p0[12], p0[13]); w.w = cvtpk(p0[14], p0[15]); pa[1] = __builtin_bit_cast(bf16x8s, w);
              w.x = cvtpk(p1[0], p1[1]); w.y = cvtpk(p1[2], p1[3]); w.z = cvtpk(p1[4], p1[5]); w.w = cvtpk(p1[6], p1[7]); pa[2] = __builtin_bit_cast(bf16x8s, w);
              w.x = cvtpk(p1[8], p1[9]); w.y = cvtpk(p1[10], p1[11]); w.z = cvtpk(p1[12], p1[13]); w.w = cvtpk(p1[14], p1[15]); pa[3] = __builtin_bit_cast(bf16x8s, w); }
#pragma unroll
            for (int s4 = 0; s4 < 4; ++s4)
#pragma unroll
                for (int nb = 0; nb < 2; ++nb) {
                    const LAS unsigned char* vp = vbs + (32 * nb + q) * VS + (16 * s4 + 4 * hi) * 2;
                    const v2u lo = *(const LAS v2u*)vp, hh = *(const LAS v2u*)(vp + 16);
                    const bf16x8s vf = __builtin_bit_cast(bf16x8s, ((v4u){lo.x, lo.y, hh.x, hh.y}));
                    if (nb == 0) o0 = __builtin_amdgcn_mfma_f32_32x32x16_bf16(pa[s4], vf, o0, 0, 0, 0); else o1 = __builtin_amdgcn_mfma_f32_32x32x16_bf16(pa[s4], vf, o1, 0, 0, 0);
                }
        }
        if (i + 1 < nt) { LAS unsigned char* kn = lds + ((i + 1) & 1) * STAGE; *(LAS v4u*)(kn + (tid / KP) * KS + (tid % KP) * 16) = kr0;
            if (NKP > 512) { if (tid < NKP - 512) { const int p = 512 + tid; *(LAS v4u*)(kn + (p / KP) * KS + (p % KP) * 16) = kr1; } }
            LAS unsigned char* vb = kn + KT_BYTES + (tid >> 3) * VS + (tid & 7) * 16; *(LAS v2u*)vb = (v2u){vr.x, vr.y}; *(LAS v2u*)(vb + 8) = (v2u){vr.z, vr.w}; }
        __syncthreads();
    }
    const float lt = l + xlane32(l, lane);
    if (hi == 0) wsf[q] = 1.0f / lt;
    asm volatile("s_waitcnt lgkmcnt(0)" ::: "memory");
#pragma unroll
    for (int r = 0; r < 16; ++r) { const int qq = crow(r, hi); const float inv = wsf[qq];
        bf16* op = OCp + (size_t)row_of(b, tq0 + wave * 32 + qq) * D + hcol + q;
        op[0] = f2bf(o0[r] * inv); op[32] = f2bf(o1[r] * inv); }
    __syncthreads();
}
__device__ __forceinline__ void attn_phase(LAS unsigned char* lds, const Mix& M, const float* sink, bool with_ctx, int tid) {
    const int nunits = 512 + (with_ctx ? 64 : 0);
    for (int u = blockIdx.x; u < nunits; u += gridDim.x) {
        if (u < 512) {
            const int c = u & 255, bh = (c & 7) + 8 * (c >> 6), qb = (c >> 3) & 7, b = bh >> 2, h = bh & 3, tq0 = NC + 256 * qb;
            if (u < 256) attn_unit<96, false>(lds, M.Qm + (size_t)bh * TK * 96, M.Km + (size_t)bh * TK * 96, M.Vm + (size_t)bh * 64 * TK, M.OC, b, h * 64, tq0, 0, TK / 64, 0, 0, 0.f, tid);
            else { const int slo = 256 * qb - 128 < 0 ? 0 : 256 * qb - 128, shi = 256 * qb + 383 > NL - 1 ? NL - 1 : 256 * qb + 383;
                attn_unit<64, true>(lds, M.Qs + (size_t)bh * TK * 64, M.Ks + (size_t)(b * 2 + (h >> 1)) * TK * 64, M.Vs + (size_t)(b * 2 + (h >> 1)) * 64 * TK, M.OC, b, 512 + h * 64, tq0,
                                    0, NC / 64, (NC + slo) / 64, (NC + shi) / 64 + 1, sink[h] * LOG2E, tid); }
        } else {
            const int c = (u - 512) & 31, b = c >> 2, h = c & 3;
            if (u < 544) attn_unit<96, false>(lds, M.Qm + (size_t)c * TK * 96, M.Km + (size_t)c * TK * 96, M.Vm + (size_t)c * 64 * TK, M.OC, b, h * 64, 0, 0, NC / 64, 0, 0, 0.f, tid);
            else attn_unit<64, true>(lds, M.Qs + (size_t)c * TK * 64, M.Ks + (size_t)(b * 2 + (h >> 1)) * TK * 64, M.Vs + (size_t)(b * 2 + (h >> 1)) * 64 * TK, M.OC, b, 512 + h * 64, 0, 0, NC / 64, 0, 0, sink[h] * LOG2E, tid);
        }
    }
}
__device__ __forceinline__ float wsum(float v, int  ) {
    int x = __float_as_int(v);
    v += __int_as_float(__builtin_amdgcn_update_dpp(0, x, 0xB1, 0xF, 0xF, true)); x = __float_as_int(v);
    v += __int_as_float(__builtin_amdgcn_update_dpp(0, x, 0x4E, 0xF, 0xF, true)); x = __float_as_int(v);
    v += __int_as_float(__builtin_amdgcn_update_dpp(0, x, 0x141, 0xF, 0xF, true)); x = __float_as_int(v);
    v += __int_as_float(__builtin_amdgcn_update_dpp(0, x, 0x140, 0xF, 0xF, true)); x = __float_as_int(v);
    v += __int_as_float(__builtin_amdgcn_update_dpp(0, x, 0x142, 0xA, 0xF, false)); x = __float_as_int(v);
    v += __int_as_float(__builtin_amdgcn_update_dpp(0, x, 0x143, 0xC, 0xF, false));
    return __int_as_float(__builtin_amdgcn_readlane(__float_as_int(v), 63));
}
__device__ __forceinline__ float fma_s(float a, float b, float c) { float d; asm("v_fma_f32 %0, %1, %2, %3" : "=v"(d) : "v"(a), "v"(b), "v"(c)); return d; }
__device__ __forceinline__ float sub_s(float a, float b) { float d; asm("v_sub_f32_e32 %0, %1, %2" : "=v"(d) : "v"(a), "v"(b)); return d; }
__device__ __forceinline__ float bfl(unsigned w) { return __uint_as_float(w << 16); }
__device__ __forceinline__ float bfh(unsigned w) { return __uint_as_float(w & 0xffff0000u); }
struct PrepRegs { v2u ql, kvl, qn, kn, hzf, hzb; unsigned qp1, qp2, kp1, kp2, sq1, sq2, sk1, sk2, r1, r2; };
__device__ __forceinline__ void prep_load(PrepRegs& R, const bf16* p, int lane) {
    const int h = lane >> 4, i = lane & 15;
    R.ql = *(const v2u*)(p + C_QLAT + 4 * (lane < 48 ? lane : 0)); R.kvl = *(const v2u*)(p + C_KVLAT + 4 * (lane & 31));
    R.qn = *(const v2u*)(p + C_QE + h * 96 + 4 * i); R.kn = *(const v2u*)(p + C_KVE + h * 128 + 4 * i);
    R.qp1 = p[C_QE + h * 96 + 64 + i]; R.qp2 = p[C_QE + h * 96 + 80 + i]; R.kp1 = p[C_KPE + i]; R.kp2 = p[C_KPE + 16 + i];
    R.sq1 = *(const unsigned*)(p + C_SQ + h * 64 + 2 * i); R.sq2 = *(const unsigned*)(p + C_SQ + h * 64 + 32 + 2 * i);
    R.sk1 = *(const unsigned*)(p + C_SK + (h & 1) * 64 + 2 * i); R.sk2 = *(const unsigned*)(p + C_SK + (h & 1) * 64 + 32 + 2 * i);
    R.hzf = *(const v2u*)(p + C_HZF + 4 * lane); R.hzb = *(const v2u*)(p + C_HZB + 4 * lane);
    { const int w = lane >> 5, hh = (lane >> 3) & 3, j0 = 2 * (lane & 7); R.r1 = *(const unsigned*)(p + (w ? C_RK : C_RQ) + hh * 32 + j0); R.r2 = *(const unsigned*)(p + (w ? C_RK : C_RQ) + hh * 32 + 16 + j0); }
}
__device__ __forceinline__ float lfg(float z, float lbf, float om) { const float s = __builtin_amdgcn_rcpf(1.0f + __builtin_amdgcn_exp2f(-LOG2E * z)); return __builtin_amdgcn_logf(fmaf(om, s, lbf)); }
__device__ __forceinline__ void prep_compute(const Mix& M, const float* tab, const PrepRegs& R, int row, int lane) {
    int b, tq; row_split(row, b, tq); const bool lat = tq >= NC; const int t = lat ? tq - NC : 0;
    const int h = lane >> 4, i = lane & 15;
    float sq = 0.f, skv = 0.f;
    if (lane < 48) { const float a = bfl(R.ql.x), c = bfh(R.ql.x), d = bfl(R.ql.y), e = bfh(R.ql.y); sq = (a * a + c * c) + (d * d + e * e); }
    if (lane < 32) { const float a = bfl(R.kvl.x), c = bfh(R.kvl.x), d = bfl(R.kvl.y), e = bfh(R.kvl.y); skv = (a * a + c * c) + (d * d + e * e); }
    sq = wsum(sq, lane); skv = wsum(skv, lane);
    const float rq = 1.0f / sqrtf(sq * (1.0f / 192.0f) + NORM_EPS), rkv = 1.0f / sqrtf(skv * (1.0f / 128.0f) + NORM_EPS), qs = rq * 0.10206207261596575f * LOG2E;
    const size_t o96 = ((size_t)(b * 4 + h) * TK + tq) * 96;
    { v2u w; w.x = cvtpk_c(bfl(R.qn.x) * qs, bfh(R.qn.x) * qs); w.y = cvtpk_c(bfl(R.qn.y) * qs, bfh(R.qn.y) * qs); *(v2u*)(M.Qm + o96 + 4 * i) = w;
      w.x = cvtpk_c(bfl(R.kn.x) * rkv, bfh(R.kn.x) * rkv); w.y = cvtpk_c(bfl(R.kn.y) * rkv, bfh(R.kn.y) * rkv); *(v2u*)(M.Km + o96 + 4 * i) = w; }
    { float c = 1.f, s = 0.f; if (lat) { const f32x2t cs = *(const f32x2t*)(tab + TAB_MLA + (t * 16 + i) * 2); c = cs.x; s = cs.y; }
      const float q1 = bf2f((bf16)R.qp1), q2 = bf2f((bf16)R.qp2); M.Qm[o96 + 64 + i] = f2bf((q1 * c - q2 * s) * qs); M.Qm[o96 + 80 + i] = f2bf((q1 * s + q2 * c) * qs);
      const float k1 = bf2f((bf16)R.kp1), k2 = bf2f((bf16)R.kp2); M.Km[o96 + 64 + i] = f2bf(k1 * c - k2 * s); M.Km[o96 + 80 + i] = f2bf(k1 * s + k2 * c); }
    { f32x4 cs = (f32x4){1.f, 0.f, 1.f, 0.f}; if (lat) cs = *(const f32x4*)(tab + TAB_SWA + (t * 32 + 2 * i) * 2);
      { const float xa = bfl(R.sq1), xb = bfh(R.sq1), ya = bfl(R.sq2), yb = bfh(R.sq2), sc2 = 0.125f * LOG2E; bf16* o = M.Qs + ((size_t)(b * 4 + h) * TK + tq) * 64 + 2 * i;
        *(unsigned*)o = cvtpk_c((xa * cs[0] - ya * cs[1]) * sc2, (xb * cs[2] - yb * cs[3]) * sc2); *(unsigned*)(o + 32) = cvtpk_c((xa * cs[1] + ya * cs[0]) * sc2, (xb * cs[3] + yb * cs[2]) * sc2); }
      if (lane < 32) { const float xa = bfl(R.sk1), xb = bfh(R.sk1), ya = bfl(R.sk2), yb = bfh(R.sk2); bf16* o = M.Ks + ((size_t)(b * 2 + h) * TK + tq) * 64 + 2 * i;
        *(unsigned*)o = cvtpk_c(xa * cs[0] - ya * cs[1], xb * cs[2] - yb * cs[3]); *(unsigned*)(o + 32) = cvtpk_c(xa * cs[1] + ya * cs[0], xb * cs[3] + yb * cs[2]); } }
    { const f32x4 a0 = *(const f32x4*)(M.loglb + 4 * lane), b0 = *(const f32x4*)(M.log1mlb + 4 * lane), a1 = *(const f32x4*)(M.loglb + 256 + 4 * lane), b1 = *(const f32x4*)(M.log1mlb + 256 + 4 * lane);
      *(f32x4*)(M.HF + ((size_t)0 * NTOK + row) * 256 + 4 * lane) = (f32x4){lfg(bfl(R.hzf.x), a0[0], b0[0]), lfg(bfh(R.hzf.x), a0[1], b0[1]), lfg(bfl(R.hzf.y), a0[2], b0[2]), lfg(bfh(R.hzf.y), a0[3], b0[3])};
      *(f32x4*)(M.HF + ((size_t)1 * NTOK + row) * 256 + 4 * lane) = (f32x4){lfg(bfl(R.hzb.x), a1[0], b1[0]), lfg(bfh(R.hzb.x), a1[1], b1[1]), lfg(bfl(R.hzb.y), a1[2], b1[2]), lfg(bfh(R.hzb.y), a1[3], b1[3])}; }
    { const int w = lane >> 5, hh = (lane >> 3) & 3, j0 = 2 * (lane & 7); const f32x4 cs = *(const f32x4*)(tab + TAB_RET + (tq * 16 + j0) * 2);
      float* o = (w ? M.RK : M.RQ) + (size_t)row * 128 + hh * 32 + j0; const float sc = w ? 1.0f : 0.17677669529663687f;
      const float xa = bfl(R.r1), xb = bfh(R.r1), ya = bfl(R.r2), yb = bfh(R.r2);
      *(f32x2t*)o = (f32x2t){(xa * cs[0] - ya * cs[1]) * sc, (xb * cs[2] - yb * cs[3]) * sc}; *(f32x2t*)(o + 16) = (f32x2t){(xa * cs[1] + ya * cs[0]) * sc, (xb * cs[3] + yb * cs[2]) * sc}; }
}
struct VtRegs { v2u kv[8]; unsigned vm[4][8], vs[2][8]; };
__device__ __forceinline__ void vt_load(VtRegs& R, const Mix& M, int g8, int lane) {
    const bf16* p = M.P + (size_t)g8 * 8 * NP;
#pragma unroll
    for (int r = 0; r < 8; ++r) R.kv[r] = *(const v2u*)(p + (size_t)r * NP + C_KVLAT + 4 * (lane & 31));
#pragma unroll
    for (int h = 0; h < 4; ++h)
#pragma unroll
        for (int r = 0; r < 8; ++r) R.vm[h][r] = p[(size_t)r * NP + C_KVE + h * 128 + 64 + lane];
#pragma unroll
    for (int kh = 0; kh < 2; ++kh)
#pragma unroll
        for (int r = 0; r < 8; ++r) R.vs[kh][r] = p[(size_t)r * NP + C_SV + kh * 64 + lane];
}
__device__ __forceinline__ void vt_store(const VtRegs& R, const Mix& M, int g8, int lane) {
    const int row0 = g8 * 8; int b, tq0; row_split(row0, b, tq0);
    float rkv[8];
#pragma unroll
    for (int r = 0; r < 8; ++r) { float skv = 0.f; if (lane < 32) { const v2u w = R.kv[r]; const float a = bfl(w.x), c = bfh(w.x), d = bfl(w.y), e = bfh(w.y); skv = (a * a + c * c) + (d * d + e * e); }
        skv = wsum(skv, lane); rkv[r] = 1.0f / sqrtf(skv * (1.0f / 128.0f) + NORM_EPS); }
#pragma unroll
    for (int h = 0; h < 4; ++h) { float v[8];
#pragma unroll
        for (int r = 0; r < 8; ++r) v[r] = bf2f((bf16)R.vm[h][r]) * rkv[r];
        v4u o; o.x = pk2(v[0], v[1]); o.y = pk2(v[2], v[3]); o.z = pk2(v[4], v[5]); o.w = pk2(v[6], v[7]);
        *(v4u*)(M.Vm + ((size_t)(b * 4 + h) * 64 + lane) * TK + tq0) = o; }
#pragma unroll
    for (int kh = 0; kh < 2; ++kh) {
        v4u o; o.x = R.vs[kh][0] | (R.vs[kh][1] << 16); o.y = R.vs[kh][2] | (R.vs[kh][3] << 16); o.z = R.vs[kh][4] | (R.vs[kh][5] << 16); o.w = R.vs[kh][6] | (R.vs[kh][7] << 16);
        *(v4u*)(M.Vs + ((size_t)(b * 2 + kh) * 64 + lane) * TK + tq0) = o; }
}
constexpr int SBT = 12, NSB = CH / SBT;
__device__ __forceinline__ int scan_row(int b, int dir, int pos) { return row_of(b, dir_tq(dir, pos)); }
__device__ __forceinline__ void scan_local_wave(const Mix& M, LAS float* wl  , int unit, int lane) {
    const int c = unit % NCH, seq = unit / NCH, h = seq & 3, b = (seq >> 2) % NB, dir = seq / (4 * NB);
    const float g = expf(M.log_gamma[dir * 4 + h]);
    float S[64], R[32];
#pragma unroll
    for (int k = 0; k < 64; ++k) S[k] = 0.f;
#pragma unroll
    for (int k = 0; k < 32; ++k) R[k] = 0.f;
    float dk = 1.0f, gp = 1.0f;
    LAS float* Fs = wl; LAS float* Qs = wl + 768; LAS float* Vs = wl + 1536; LAS float* Ks = wl + 2304; LAS float* Qr = wl + 2688; LAS float* Vr = wl + 3072;
    const int tt0 = lane >> 4, k4 = (lane & 15) * 4, tr0 = lane >> 3, r4 = (lane & 7) * 4;
    for (int sb = 0; sb < NSB; ++sb) {
        const int pos0 = CH * c + SBT * sb;
        f32x4 fr[3], kr[2], qq[2]; v2u qr[3]; unsigned short vr[SBT], wr[SBT];
#pragma unroll
        for (int j = 0; j < 3; ++j) { const int row = scan_row(b, dir, pos0 + 4 * j + tt0);
            fr[j] = *(const f32x4*)(M.HF + ((size_t)dir * NTOK + row) * 256 + h * 64 + k4); qr[j] = *(const v2u*)(M.P + (size_t)row * NP + C_HQ + h * 64 + k4); }
#pragma unroll
        for (int j = 0; j < 2; ++j) { const int tt = 8 * j + tr0; const int row = scan_row(b, dir, pos0 + (tt < SBT ? tt : 0));
            kr[j] = *(const f32x4*)(M.RK + (size_t)row * 128 + h * 32 + r4); qq[j] = *(const f32x4*)(M.RQ + (size_t)row * 128 + h * 32 + r4); }
#pragma unroll
        for (int i = 0; i < SBT; ++i) { const bf16* p = M.P + (size_t)scan_row(b, dir, pos0 + i) * NP; vr[i] = p[C_HI + h * 64 + lane]; wr[i] = p[C_RV + h * 64 + lane]; }
#pragma unroll
        for (int j = 0; j < 3; ++j) { *(LAS f32x4*)(Fs + (4 * j + tt0) * 64 + k4) = fr[j];
            *(LAS f32x4*)(Qs + (4 * j + tt0) * 64 + k4) = (f32x4){bfl(qr[j].x) * 0.125f, bfh(qr[j].x) * 0.125f, bfl(qr[j].y) * 0.125f, bfh(qr[j].y) * 0.125f}; }
#pragma unroll
        for (int j = 0; j < 2; ++j) { const int tt = 8 * j + tr0; if (tt < SBT) { *(LAS f32x4*)(Ks + tt * 32 + r4) = kr[j]; *(LAS f32x4*)(Qr + tt * 32 + r4) = qq[j]; } }
#pragma unroll
        for (int i = 0; i < SBT; ++i) { Vs[i * 64 + lane] = bf2f(vr[i]); Vr[i * 64 + lane] = bf2f(wr[i]); }
        asm volatile("s_waitcnt lgkmcnt(0)" ::: "memory");
        for (int i = 0; i < SBT; ++i) {
            const int row = scan_row(b, dir, pos0 + i); const float v = Vs[i * 64 + lane], w = Vr[i * 64 + lane]; float ac[4] = {0.f, 0.f, 0.f, 0.f}, ar[4] = {0.f, 0.f, 0.f, 0.f};
            dk *= Fs[i * 64 + lane]; M.HQC[((size_t)dir * NTOK + row) * 256 + h * 64 + lane] = Qs[i * 64 + lane] * dk;
            gp *= g; if (lane < 32) M.RQC[((size_t)dir * NTOK + row) * 128 + h * 32 + lane] = Qr[i * 32 + lane] * gp;
#pragma unroll
            for (int kk = 0; kk < 16; ++kk) { const f32x4 f4 = *(const LAS f32x4*)(Fs + i * 64 + 4 * kk), q4 = *(const LAS f32x4*)(Qs + i * 64 + 4 * kk);
#pragma unroll
                for (int j = 0; j < 4; ++j) { S[4 * kk + j] = f4[j] * (S[4 * kk + j] - v) + v; ac[j] += q4[j] * S[4 * kk + j]; }
                if (kk & 1) { const int k2 = kk >> 1; const f32x4 k4v = *(const LAS f32x4*)(Ks + i * 32 + 4 * k2), p4 = *(const LAS f32x4*)(Qr + i * 32 + 4 * k2);
#pragma unroll
                    for (int j = 0; j < 4; ++j) { R[4 * k2 + j] = g * R[4 * k2 + j] + k4v[j] * w; ar[j] += p4[j] * R[4 * k2 + j]; } } }
            M.HO[((size_t)dir * NTOK + row) * 256 + h * 64 + lane] = (ac[0] + ac[1]) + (ac[2] + ac[3]);
            M.RO[((size_t)dir * NTOK + row) * 256 + h * 64 + lane] = (ar[0] + ar[1]) + (ar[2] + ar[3]);
        }
        asm volatile("s_waitcnt lgkmcnt(0)" ::: "memory");
    }
    float* u = M.HU + ((size_t)seq * NCH + c) * 4096 + lane; float* ur = M.RU + ((size_t)seq * NCH + c) * 2048 + lane;
#pragma unroll
    for (int k = 0; k < 64; ++k) u[k * 64] = S[k];
#pragma unroll
    for (int k = 0; k < 32; ++k) ur[k * 64] = R[k];
    M.HDK[((size_t)seq * NCH + c) * 64 + lane] = dk;
}
__device__ __forceinline__ int bwd_chunk(int tq) { return (tq < NC ? NC - 1 - tq : NC + (NL - 1 - (tq - NC))) / CH; }
__device__ __forceinline__ void hg_fixfin_wave(const Mix& M, LAS float* wl, int unit, int lane, int tq_min) {
    const int c = unit % NCH, bh = unit / NCH, h = bh & 3, b = bh >> 2;
    if (CH * c + CH <= tq_min) return;
    const float* uf = M.HU + ((size_t)((0 * NB + b) * 4 + h) * NCH + c) * 4096 + lane;
    float Sf[64], Sb[64];
#pragma unroll
    for (int k = 0; k < 64; ++k) { Sf[k] = uf[k * 64]; Sb[k] = 0.f; }
    int cb = -1;
    const float ng = M.hg_norm_g[h * 64 + lane];
    const int tt0 = lane >> 4, k4 = (lane & 15) * 4;
    LAS float* Af = wl; LAS float* Ab = wl + 768;
    for (int sb = 0; sb < NSB; ++sb) {
        const int tq0 = CH * c + SBT * sb;
#pragma unroll
        for (int j = 0; j < 3; ++j) { const int row = row_of(b, tq0 + 4 * j + tt0);
            *(LAS f32x4*)(Af + (4 * j + tt0) * 64 + k4) = *(const f32x4*)(M.HQC + ((size_t)0 * NTOK + row) * 256 + h * 64 + k4);
            *(LAS f32x4*)(Ab + (4 * j + tt0) * 64 + k4) = *(const f32x4*)(M.HQC + ((size_t)1 * NTOK + row) * 256 + h * 64 + k4); }
        asm volatile("s_waitcnt lgkmcnt(0)" ::: "memory");
        for (int i = 0; i < SBT; ++i) {
            const int tq = tq0 + i, row = row_of(b, tq), cbn = bwd_chunk(tq);
            if (cbn != cb) { cb = cbn; const float* ub = M.HU + ((size_t)((1 * NB + b) * 4 + h) * NCH + cb) * 4096 + lane;
#pragma unroll
                for (int k = 0; k < 64; ++k) Sb[k] = ub[k * 64]; }
            float ac[4] = {M.HO[((size_t)0 * NTOK + row) * 256 + h * 64 + lane], M.HO[((size_t)1 * NTOK + row) * 256 + h * 64 + lane], 0.f, 0.f};
            const float gate = bf2f(M.P[(size_t)row * NP + C_HG + h * 64 + lane]);
#pragma unroll
            for (int kk = 0; kk < 16; ++kk) { const f32x4 a4 = *(const LAS f32x4*)(Af + i * 64 + 4 * kk), b4 = *(const LAS f32x4*)(Ab + i * 64 + 4 * kk);
#pragma unroll
                for (int j = 0; j < 4; ++j) { ac[j] += a4[j] * Sf[4 * kk + j]; ac[j] += b4[j] * Sb[4 * kk + j]; } }
            const float acc = (ac[0] + ac[1]) + (ac[2] + ac[3]);
            const float r = 1.0f / sqrtf(wsum(acc * acc, lane) * (1.0f / 64.0f) + NORM_EPS);
            M.OC[(size_t)row * D + 256 + h * 64 + lane] = f2bf(acc * r * ng * silu_f(gate));
        }
        asm volatile("s_waitcnt lgkmcnt(0)" ::: "memory");
    }
}
__device__ __forceinline__ void ret_fixfin_wave(const Mix& M, LAS float* wl, int unit, int lane, int tq_min) {
    const int c = unit % NCH, bh = unit / NCH, h = bh & 3, b = bh >> 2;
    if (CH * c + CH <= tq_min) return;
    const float* uf = M.RU + ((size_t)((0 * NB + b) * 4 + h) * NCH + c) * 2048 + lane;
    float Sf[32], Sb[32];
#pragma unroll
    for (int k = 0; k < 32; ++k) { Sf[k] = uf[k * 64]; Sb[k] = 0.f; }
    int cb = -1;
    const float gg = M.gn_g[h * 64 + lane], gb = M.gn_b[h * 64 + lane];
    const int tt0 = lane >> 3, k4 = (lane & 7) * 4;
    LAS float* Af = wl; LAS float* Ab = wl + 768;
    for (int sb = 0; sb < NSB; ++sb) {
        const int tq0 = CH * c + SBT * sb;
#pragma unroll
        for (int j = 0; j < 2; ++j) { const int tt = 8 * j + tt0; if (tt < SBT) { const int row = row_of(b, tq0 + tt);
            *(LAS f32x4*)(Af + tt * 32 + k4) = *(const f32x4*)(M.RQC + ((size_t)0 * NTOK + row) * 128 + h * 32 + k4);
            *(LAS f32x4*)(Ab + tt * 32 + k4) = *(const f32x4*)(M.RQC + ((size_t)1 * NTOK + row) * 128 + h * 32 + k4); } }
        asm volatile("s_waitcnt lgkmcnt(0)" ::: "memory");
        for (int i = 0; i < SBT; ++i) {
            const int tq = tq0 + i, row = row_of(b, tq), cbn = bwd_chunk(tq);
            if (cbn != cb) { cb = cbn; const float* ub = M.RU + ((size_t)((1 * NB + b) * 4 + h) * NCH + cb) * 2048 + lane;
#pragma unroll
                for (int k = 0; k < 32; ++k) Sb[k] = ub[k * 64]; }
            float ac[4] = {M.RO[((size_t)0 * NTOK + row) * 256 + h * 64 + lane], M.RO[((size_t)1 * NTOK + row) * 256 + h * 64 + lane], 0.f, 0.f};
            const float gate = bf2f(M.P[(size_t)row * NP + C_RG + h * 64 + lane]);
#pragma unroll
            for (int kk = 0; kk < 8; ++kk) { const f32x4 a4 = *(const LAS f32x4*)(Af + i * 32 + 4 * kk), b4 = *(const LAS f32x4*)(Ab + i * 32 + 4 * kk);
#pragma unroll
                for (int j = 0; j < 4; ++j) { ac[j] += a4[j] * Sf[4 * kk + j]; ac[j] += b4[j] * Sb[4 * kk + j]; } }
            const float acc = (ac[0] + ac[1]) + (ac[2] + ac[3]);
            const float mu = wsum(acc, lane) * (1.0f / 64.0f), dd = acc - mu, r = 1.0f / sqrtf(wsum(dd * dd, lane) * (1.0f / 64.0f) + NORM_EPS);
            M.OC[(size_t)row * D + 768 + h * 64 + lane] = f2bf((dd * r * gg + gb) * silu_f(gate));
        }
        asm volatile("s_waitcnt lgkmcnt(0)" ::: "memory");
    }
}
typedef short s16x4 __attribute__((ext_vector_type(4)));
constexpr int MCH = 64, MNCH = TK / MCH;
constexpr int MS_PITCH = 144, MS_MAT = 16 * MS_PITCH, MS_KE = 3 * MS_MAT, MS_VT = MS_KE + 3072, MS_D = MS_VT + 3072, MS_BYTES = MS_D + 256;
static_assert(MS_BYTES <= 13312, "scan LDS block");
__device__ __forceinline__ int pk64(int k) { const int kp = k & 31; return (k & 32) + 8 * ((kp >> 2) & 3) + 4 * (kp >> 4) + (kp & 3); }
__device__ __forceinline__ void chunk_rows(int b, int dir, int c, int& r0, int& rs) {
    if (dir == 0) { r0 = row_of(b, MCH * c); rs = 1; } else { const int i0 = MCH * c; r0 = row_of(b, i0 < NC ? NC - 1 - i0 : NC + (NL - 1 - (i0 - NC))); rs = -1; }
}
__device__ __forceinline__ bf16x8s pack8(const f32x4& a, const f32x4& b) { v4u w; w.x = cvtpk_c(a[0], a[1]); w.y = cvtpk_c(a[2], a[3]); w.z = cvtpk_c(b[0], b[1]); w.w = cvtpk_c(b[2], b[3]); return __builtin_bit_cast(bf16x8s, w); }
__device__ __forceinline__ s16x4 pack4(const f32x4& a) { v2u w; w.x = cvtpk_c(a[0], a[1]); w.y = cvtpk_c(a[2], a[3]); return __builtin_bit_cast(s16x4, w); }
__device__ __forceinline__ f32x4 mfma16(const s16x4& a, const s16x4& b, const f32x4& c) {
    const bf16x8s a8 = {a[0], a[1], a[2], a[3], 0, 0, 0, 0}, b8 = {b[0], b[1], b[2], b[3], 0, 0, 0, 0};
    return __builtin_amdgcn_mfma_f32_16x16x32_bf16(a8, b8, c, 0, 0, 0);
}
__device__ __forceinline__ float ex2(float x) { return __builtin_amdgcn_exp2f(x); }

template <bool HG> __device__ __forceinline__ void mscan_local(const Mix& M, LAS unsigned char* wl, int unit, int lane) {
    constexpr int DK = HG ? 64 : 32, NKB = DK / 16, NKS = DK / 32;
    const int c = unit % MNCH, seq = unit / MNCH, h = seq & 3, b = (seq >> 2) % NB, dir = seq / (4 * NB);
    const int c16 = lane & 15, g = lane >> 4;
    int r0, rs; chunk_rows(b, dir, c, r0, rs);
    LAS unsigned short* Qm = (LAS unsigned short*)wl; LAS unsigned short* Km = (LAS unsigned short*)(wl + MS_MAT);
    LAS unsigned char* KmT = wl + MS_KE; LAS unsigned char* VT = wl + MS_VT; LAS float* sc = (LAS float*)(wl + 2 * MS_MAT);
    f32x4 S[NKB][4];
#pragma unroll
    for (int kb = 0; kb < NKB; ++kb)
#pragma unroll
        for (int vb = 0; vb < 4; ++vb) S[kb][vb] = (f32x4){0.f, 0.f, 0.f, 0.f};
    const float lg2 = HG ? 0.f : M.log_gamma[dir * 4 + h] * LOG2E;
    float Bc = 0.f;
    const int kq = HG ? lane : (lane & 31), th = HG ? 0 : (lane >> 5) * 8;
    const int pkq = pk64(kq);
    unsigned short vv[16]; float lf[16]; unsigned short qh[16]; float rq8[8], rk8[8];
#define MS_LOAD(i_) do { const int rb_ = r0 + rs * 16 * (i_); \
        _Pragma("unroll") for (int t = 0; t < 16; ++t) vv[t] = M.P[(size_t)(rb_ + rs * t) * NP + (HG ? C_HI : C_RV) + h * 64 + lane]; \
        if (HG) { _Pragma("unroll") for (int t = 0; t < 16; ++t) { const int row = rb_ + rs * t; lf[t] = M.HF[((size_t)dir * NTOK + row) * 256 + h * 64 + lane]; qh[t] = M.P[(size_t)row * NP + C_HQ + h * 64 + lane]; } } \
        else { _Pragma("unroll") for (int tt = 0; tt < 8; ++tt) { const int row = rb_ + rs * (th + tt); rq8[tt] = M.RQ[(size_t)row * 128 + h * 32 + kq]; rk8[tt] = M.RK[(size_t)row * 128 + h * 32 + kq]; } } } while (0)
    MS_LOAD(0);
    for (int i = 0; i < 4; ++i) {
        const int rb = r0 + rs * 16 * i;
        if (HG) {
            float bt[16]; { float a = 0.f;
#pragma unroll
                for (int t = 0; t < 16; ++t) { a += lf[t]; bt[t] = a; } }
            const float r = bt[7], bl = bt[15], e_rc = ex2(r + Bc) * 0.125f;
            unsigned km2[8];
#pragma unroll
            for (int t = 0; t < 16; ++t) { const int row = rb + rs * t;
                const float kk = 1.0f - ex2(lf[t]), em = ex2(bt[t] - r), qv = bf2f(qh[t]);
                const float qmv = qv * em * 0.125f, kmv = kk * __builtin_amdgcn_rcpf(em);
                const unsigned pr = cvtpk_c(qmv, kmv);
                Qm[t * (MS_PITCH / 2) + pkq] = (unsigned short)pr; Km[t * (MS_PITCH / 2) + pkq] = (unsigned short)(pr >> 16);
                if (t & 1) km2[t >> 1] |= pr & 0xffff0000u; else km2[t >> 1] = pr >> 16;
                M.HQCb[((size_t)dir * NTOK + row) * 256 + h * 64 + lane] = (unsigned short)cvtpk_c(qv * em * e_rc, 0.f); }
            *(LAS v4u*)(KmT + lane * 48) = (v4u){km2[0], km2[1], km2[2], km2[3]}; *(LAS v4u*)(KmT + lane * 48 + 16) = (v4u){km2[4], km2[5], km2[6], km2[7]};
            sc[lane] = ex2(r); sc[64 + lane] = ex2(bl); sc[128 + lane] = ex2(bl - r); Bc += bl;
        } else {
            unsigned km2[4];
#pragma unroll
            for (int tt = 0; tt < 8; ++tt) { const int t = th + tt, row = rb + rs * t;
                const float em = ex2((float)(t - 7) * lg2);
                const float qmv = rq8[tt] * em, kmv = rk8[tt] * __builtin_amdgcn_rcpf(em);
                const unsigned pr = cvtpk_c(qmv, kmv);
                Qm[t * (MS_PITCH / 2) + pkq] = (unsigned short)pr; Km[t * (MS_PITCH / 2) + pkq] = (unsigned short)(pr >> 16);
                if (tt & 1) km2[tt >> 1] |= pr & 0xffff0000u; else km2[tt >> 1] = pr >> 16;
                M.RQCb[((size_t)dir * NTOK + row) * 256 + h * 64 + kq] = (unsigned short)cvtpk_c(rq8[tt] * ex2((float)(16 * i + t + 1) * lg2), 0.f); }
            *(LAS v4u*)(KmT + kq * 48 + (th ? 16 : 0)) = (v4u){km2[0], km2[1], km2[2], km2[3]};
        }
        { v4u w0, w1; w0.x = (unsigned)vv[0] | ((unsigned)vv[1] << 16); w0.y = (unsigned)vv[2] | ((unsigned)vv[3] << 16); w0.z = (unsigned)vv[4] | ((unsigned)vv[5] << 16); w0.w = (unsigned)vv[6] | ((unsigned)vv[7] << 16);
          w1.x = (unsigned)vv[8] | ((unsigned)vv[9] << 16); w1.y = (unsigned)vv[10] | ((unsigned)vv[11] << 16); w1.z = (unsigned)vv[12] | ((unsigned)vv[13] << 16); w1.w = (unsigned)vv[14] | ((unsigned)vv[15] << 16);
          *(LAS v4u*)(VT + lane * 48) = w0; *(LAS v4u*)(VT + lane * 48 + 16) = w1; }
        if (i < 3) MS_LOAD(i + 1);
        asm volatile("s_waitcnt lgkmcnt(0)" ::: "memory");
        bf16x8s qmB[NKS], kmA[NKS];
#pragma unroll
        for (int ks = 0; ks < NKS; ++ks) { const int off = c16 * MS_PITCH + 64 * ks + 16 * g; qmB[ks] = *(const LAS bf16x8s*)(wl + off); kmA[ks] = *(const LAS bf16x8s*)(wl + MS_MAT + off); }
        s16x4 vt[4];
#pragma unroll
        for (int vb = 0; vb < 4; ++vb) vt[vb] = *(const LAS s16x4*)(VT + (16 * vb + c16) * 48 + 8 * g);
        f32x4 er[NKB], ebl[NKB], ec[NKB];
#pragma unroll
        for (int kb = 0; kb < NKB; ++kb) {
            if (HG) { er[kb] = *(const LAS f32x4*)(sc + 16 * kb + 4 * g); ebl[kb] = *(const LAS f32x4*)(sc + 64 + 16 * kb + 4 * g); ec[kb] = *(const LAS f32x4*)(sc + 128 + 16 * kb + 4 * g); }
            else { const float a = ex2(8.0f * lg2), d = ex2(16.0f * lg2); er[kb] = (f32x4){a, a, a, a}; ebl[kb] = (f32x4){d, d, d, d}; ec[kb] = er[kb]; } }
        f32x4 at = (f32x4){0.f, 0.f, 0.f, 0.f};
#pragma unroll
        for (int ks = 0; ks < NKS; ++ks) at = __builtin_amdgcn_mfma_f32_16x16x32_bf16(kmA[ks], qmB[ks], at, 0, 0, 0);
#pragma unroll
        for (int r = 0; r < 4; ++r) if (4 * g + r > c16) at[r] = 0.f;
        const s16x4 atB = pack4(at);
#pragma unroll
        for (int vb = 0; vb < 4; ++vb) {
            f32x4 o = (f32x4){0.f, 0.f, 0.f, 0.f};
#pragma unroll
            for (int ks = 0; ks < NKS; ++ks) o = __builtin_amdgcn_mfma_f32_16x16x32_bf16(pack8(S[2 * ks][vb] * er[2 * ks], S[2 * ks + 1][vb] * er[2 * ks + 1]), qmB[ks], o, 0, 0, 0);
            o = mfma16(vt[vb], atB, o);
            *(f32x4*)((HG ? M.HO : M.RO) + ((size_t)dir * NTOK + (rb + rs * c16)) * 256 + h * 64 + 16 * vb + 4 * g) = o;
        }
#pragma unroll
        for (int kb = 0; kb < NKB; ++kb) {
            const s16x4 kA = *(const LAS s16x4*)(KmT + (16 * kb + c16) * 48 + 8 * g);
#pragma unroll
            for (int vb = 0; vb < 4; ++vb) { const f32x4 tkv = mfma16(kA, vt[vb], (f32x4){0.f, 0.f, 0.f, 0.f}); S[kb][vb] = S[kb][vb] * ebl[kb] + tkv * ec[kb]; }
        }
        asm volatile("s_waitcnt lgkmcnt(0)" ::: "memory");
    }
#undef MS_LOAD
    float* st = (HG ? M.HU : M.RU) + ((size_t)seq * MNCH + c) * (64 * DK);
#pragma unroll
    for (int kb = 0; kb < NKB; ++kb)
#pragma unroll
        for (int vb = 0; vb < 4; ++vb) *(f32x4*)(st + (16 * vb + c16) * DK + 16 * kb + 4 * g) = S[kb][vb];
    if (HG) M.HDK[((size_t)seq * MNCH + c) * 64 + lane] = ex2(Bc);
}
__device__ __forceinline__ void mscan_carry_hg(const Mix& M, int item) {
    const int e = item & 4095, seq = item >> 12, k = e & 63; float s = 0.f;
    float* u = M.HU + (size_t)seq * MNCH * 4096 + e; const float* dk = M.HDK + (size_t)seq * MNCH * 64 + k;
    float uu[MNCH], dd[MNCH];
#pragma unroll
    for (int c = 0; c < MNCH; ++c) { uu[c] = u[(size_t)c * 4096]; dd[c] = dk[c * 64]; }
#pragma unroll
    for (int c = 0; c < MNCH; ++c) { u[(size_t)c * 4096] = s; s = dd[c] * s + uu[c]; }
}
__device__ __forceinline__ void mscan_carry_ret(const Mix& M, int item) {
    const int e = item & 2047, seq = item >> 11, h = seq & 3, dir = seq / (4 * NB); float s = 0.f;
    const float d = ex2((float)MCH * M.log_gamma[dir * 4 + h] * LOG2E);
    float* u = M.RU + (size_t)seq * MNCH * 2048 + e;
    float uu[MNCH];
#pragma unroll
    for (int c = 0; c < MNCH; ++c) uu[c] = u[(size_t)c * 2048];
#pragma unroll
    for (int c = 0; c < MNCH; ++c) { u[(size_t)c * 2048] = s; s = d * s + uu[c]; }
}
template <bool HG> __device__ __forceinline__ void mscan_fixfin(const Mix& M, int unit, int lane, bool with_ctx) {
    constexpr int DK = HG ? 64 : 32, NKS = DK / 32;
    const int T = unit % MNCH, bh = unit / MNCH, h = bh & 3, b = bh >> 2;
    if (T < NC / MCH && !with_ctx) return;
    const int c16 = lane & 15, g = lane >> 4;
    const int cb = T < 4 ? 3 - T : 39 - T;
    const float* HOp = HG ? M.HO : M.RO; const bf16* QCp = HG ? M.HQCb : M.RQCb; const float* STp = HG ? M.HU : M.RU;
    bf16x8s Sf[4][NKS], Sb[4][NKS];
#pragma unroll
    for (int vb = 0; vb < 4; ++vb)
#pragma unroll
        for (int ks = 0; ks < NKS; ++ks) {
            const float* pf = STp + ((size_t)((0 * NB + b) * 4 + h) * MNCH + T) * (64 * DK) + (16 * vb + c16) * DK + 32 * ks + 8 * g;
            const float* pb = STp + ((size_t)((1 * NB + b) * 4 + h) * MNCH + cb) * (64 * DK) + (16 * vb + c16) * DK + 32 * ks + 8 * g;
            Sf[vb][ks] = pack8(*(const f32x4*)pf, *(const f32x4*)(pf + 4)); Sb[vb][ks] = pack8(*(const f32x4*)pb, *(const f32x4*)(pb + 4)); }
    f32x4 w0[4], w1[4];
#pragma unroll
    for (int vb = 0; vb < 4; ++vb) { w0[vb] = *(const f32x4*)((HG ? M.hg_norm_g : M.gn_g) + h * 64 + 16 * vb + 4 * g); w1[vb] = HG ? (f32x4){0.f, 0.f, 0.f, 0.f} : *(const f32x4*)(M.gn_b + h * 64 + 16 * vb + 4 * g); }
    const int row0 = row_of(b, MCH * T);
    for (int i = 0; i < 4; ++i) {
        const int row = row0 + 16 * i + c16;
        bf16x8s qf[NKS], qb[NKS];
#pragma unroll
        for (int ks = 0; ks < NKS; ++ks) { qf[ks] = *(const bf16x8s*)(QCp + ((size_t)0 * NTOK + row) * 256 + h * 64 + 32 * ks + 8 * g); qb[ks] = *(const bf16x8s*)(QCp + ((size_t)1 * NTOK + row) * 256 + h * 64 + 32 * ks + 8 * g); }
        f32x4 o[4]; v2u gt[4];
#pragma unroll
        for (int vb = 0; vb < 4; ++vb) { o[vb] = *(const f32x4*)(HOp + ((size_t)0 * NTOK + row) * 256 + h * 64 + 16 * vb + 4 * g) + *(const f32x4*)(HOp + ((size_t)1 * NTOK + row) * 256 + h * 64 + 16 * vb + 4 * g);
            gt[vb] = *(const v2u*)(M.P + (size_t)row * NP + (HG ? C_HG : C_RG) + h * 64 + 16 * vb + 4 * g); }
#pragma unroll
        for (int vb = 0; vb < 4; ++vb)
#pragma unroll
            for (int ks = 0; ks < NKS; ++ks) { o[vb] = __builtin_amdgcn_mfma_f32_16x16x32_bf16(Sf[vb][ks], qf[ks], o[vb], 0, 0, 0); o[vb] = __builtin_amdgcn_mfma_f32_16x16x32_bf16(Sb[vb][ks], qb[ks], o[vb], 0, 0, 0); }
        float s1 = 0.f, s2 = 0.f;
#pragma unroll
        for (int vb = 0; vb < 4; ++vb)
#pragma unroll
            for (int r = 0; r < 4; ++r) { s1 += o[vb][r]; s2 += o[vb][r] * o[vb][r]; }
        s1 += __int_as_float(__builtin_amdgcn_ds_bpermute((lane ^ 16) << 2, __float_as_int(s1))); s2 += __int_as_float(__builtin_amdgcn_ds_bpermute((lane ^ 16) << 2, __float_as_int(s2)));
        s1 += __int_as_float(__builtin_amdgcn_ds_bpermute((lane ^ 32) << 2, __float_as_int(s1))); s2 += __int_as_float(__builtin_amdgcn_ds_bpermute((lane ^ 32) << 2, __float_as_int(s2)));
        const float mu = HG ? 0.f : s1 * (1.0f / 64.0f);
        const float var = HG ? s2 * (1.0f / 64.0f) : fmaxf(s2 * (1.0f / 64.0f) - mu * mu, 0.f);
        const float rstd = 1.0f / sqrtf(var + NORM_EPS);
#pragma unroll
        for (int vb = 0; vb < 4; ++vb) { float y[4];
            const float gv[4] = {bfl(gt[vb].x), bfh(gt[vb].x), bfl(gt[vb].y), bfh(gt[vb].y)};
#pragma unroll
            for (int r = 0; r < 4; ++r) y[r] = ((o[vb][r] - mu) * rstd * w0[vb][r] + w1[vb][r]) * silu_f(gv[r]);
            v2u w; w.x = cvtpk_c(y[0], y[1]); w.y = cvtpk_c(y[2], y[3]);
            *(v2u*)(M.OC + (size_t)row * D + (HG ? 256 : 768) + h * 64 + 16 * vb + 4 * g) = w; }
    }
}
template <int KIND, bool ROUTER> __device__ __forceinline__ void norm_phase(Frame& F, int l) {
    unsigned char* ws = F.base();
    const bool combine = (KIND != 1) && l > 0 && ((l - 1) & 1);
    const bool first = (KIND == 0 && l == 0);
    const bool delta = (KIND == 1) || (KIND == 0 && l > 0 && !((l - 1) & 1));
    const int nrows = (KIND == 2 || (KIND == 1 && l == DEPTH - 1)) ? NLAT : NTOK;
    const float* modl = F_sm + SM_MOD + (size_t)(KIND == 2 ? 0 : l) * 9 * 6144;
    const float* modp = F_sm + SM_MOD + (size_t)(l > 0 ? l - 1 : 0) * 9 * 6144;
    const float* gain = KIND == 0 ? IN(6) + l * D : (KIND == 1 ? IN(7) + l * D : IN(27));
    f32x4 rw0[4][4], rw1[4][4];
    if (ROUTER) { const float* wr = IN(23) + (size_t)(l >> 1) * D * 8;
#pragma unroll
        for (int j = 0; j < 4; ++j)
#pragma unroll
            for (int i = 0; i < 4; ++i) { const int col = 4 * F.lane + 256 * j + i; rw0[j][i] = *(const f32x4*)(wr + (size_t)col * 8); rw1[j][i] = *(const f32x4*)(wr + (size_t)col * 8 + 4); } }
    LAS unsigned* lcn = (LAS unsigned*)F.lds;
    LAS int* lrec = (LAS int*)(F.lds + 64);
    int nrec = 0;
    if (ROUTER) { if (F.tid < 8) lcn[F.tid] = 0u; __syncthreads(); }
    struct NRow { f32x4 x[4]; v2u h[4], d[4], ya[4], yb[4]; int s1, s2; float w1, w2; };
    constexpr bool router = ROUTER;
    f32x4 tg[4], tsh[4], tsc[4], tgf[4]; int tb_cur = -1;
    const int rpw = (nrows + F.NGW - 1) / F.NGW, row0 = F.gw * rpw, row1 = row0 + rpw < nrows ? row0 + rpw : nrows;
    auto ld1 = [&](NRow& R, int row) {
        if (first) { const float* src = row < NLAT ? IN(0) + (size_t)row * D : IN(2) + (size_t)(row - NLAT) * D;
#pragma unroll
            for (int j = 0; j < 4; ++j) R.x[j] = *(const f32x4*)(src + 4 * F.lane + 256 * j); }
        else {
#pragma unroll
            for (int j = 0; j < 4; ++j) R.h[j] = *(const v2u*)(F_H + (size_t)row * D + 4 * F.lane + 256 * j); }
        if (delta) {
#pragma unroll
            for (int j = 0; j < 4; ++j) R.d[j] = *(const v2u*)(F_AM + (size_t)row * D + 4 * F.lane + 256 * j); }
        if (combine) { const int* ti = F_tokinfo + (size_t)row * 8; R.w1 = __int_as_float(ti[2]); R.w2 = __int_as_float(ti[5]); R.s1 = ti[6]; R.s2 = ti[7]; }
    };
    auto ld2 = [&](NRow& R) {
        if (combine) { const bf16* y1 = F_Y + (size_t)R.s1 * D; const bf16* y2 = F_Y + (size_t)R.s2 * D;
#pragma unroll
            for (int j = 0; j < 4; ++j) { R.ya[j] = *(const v2u*)(y1 + 4 * F.lane + 256 * j); R.yb[j] = *(const v2u*)(y2 + 4 * F.lane + 256 * j); } }
    };
    auto cmp = [&](const NRow& R, int row) {
        const int bidx = row < NLAT ? row / NL : NB;
        f32x4 v[4];
        if (first) {
#pragma unroll
            for (int j = 0; j < 4; ++j) v[j] = R.x[j]; }
        else {
#pragma unroll
            for (int j = 0; j < 4; ++j) { const v2u a = R.h[j];
                v[j] = (f32x4){bf2f((bf16)(a.x & 0xffff)), bf2f((bf16)(a.x >> 16)), bf2f((bf16)(a.y & 0xffff)), bf2f((bf16)(a.y >> 16))}; } }
        if (!router && bidx != tb_cur) {
            tb_cur = bidx; const float* mrow = modl + (size_t)bidx * 6144 + (KIND == 0 ? 0 : 3 * 1024);
#pragma unroll
            for (int j = 0; j < 4; ++j) { const int col = 4 * F.lane + 256 * j; tg[j] = *(const f32x4*)(gain + col);
                if (KIND != 2) { tsh[j] = *(const f32x4*)(mrow + col); tsc[j] = *(const f32x4*)(mrow + 1024 + col) + 1.0f; }
                if (combine) tgf[j] = *(const f32x4*)(modp + (size_t)bidx * 6144 + 5 * 1024 + col); } }
        if (combine) {
#pragma unroll
            for (int j = 0; j < 4; ++j) {
                const f32x4 gf = tgf[j];
                const v2u a = R.ya[j], b = R.yb[j];
                f32x4 ya, yb; ya[0] = bf2f((bf16)(a.x & 0xffff)); ya[1] = bf2f((bf16)(a.x >> 16)); ya[2] = bf2f((bf16)(a.y & 0xffff)); ya[3] = bf2f((bf16)(a.y >> 16));
                yb[0] = bf2f((bf16)(b.x & 0xffff)); yb[1] = bf2f((bf16)(b.x >> 16)); yb[2] = bf2f((bf16)(b.y & 0xffff)); yb[3] = bf2f((bf16)(b.y >> 16));
                v[j] = v[j] + gf * (ya * R.w1 + yb * R.w2); }
        }
        if (delta) {
#pragma unroll
            for (int j = 0; j < 4; ++j) { const v2u a = R.d[j];
                v[j][0] += bf2f((bf16)(a.x & 0xffff)); v[j][1] += bf2f((bf16)(a.x >> 16)); v[j][2] += bf2f((bf16)(a.y & 0xffff)); v[j][3] += bf2f((bf16)(a.y >> 16)); }
        }
        if (combine || first || delta) {
#pragma unroll
            for (int j = 0; j < 4; ++j) { v2u o; o.x = pk2(v[j][0], v[j][1]); o.y = pk2(v[j][2], v[j][3]); *(v2u*)(F_H + (size_t)row * D + 4 * F.lane + 256 * j) = o; }
        }
        float ss = 0.f;
#pragma unroll
        for (int j = 0; j < 4; ++j) ss += (v[j][0] * v[j][0] + v[j][1] * v[j][1]) + (v[j][2] * v[j][2] + v[j][3] * v[j][3]);
        const float rstd = 1.0f / sqrtf(wave_sum(ss, F.lane) * (1.0f / D) + NORM_EPS);
        if (KIND == 2) {
#pragma unroll
            for (int j = 0; j < 4; ++j) { const int col = 4 * F.lane + 256 * j; *(f32x4*)(OUTP() + (size_t)row * D + col) = v[j] * rstd * tg[j]; }
        }
        if (KIND != 2) {
        const float* mrow = modl + (size_t)bidx * 6144 + (KIND == 0 ? 0 : 3 * 1024);
#pragma unroll
        for (int j = 0; j < 4; ++j) { const int col = 4 * F.lane + 256 * j;
            f32x4 g, sh, sc1;
            if (router) { g = *(const f32x4*)(gain + col); sh = *(const f32x4*)(mrow + col); sc1 = *(const f32x4*)(mrow + 1024 + col) + 1.0f; } else { g = tg[j]; sh = tsh[j]; sc1 = tsc[j]; }
            v[j] = v[j] * rstd * g * sc1 + sh;
            v2u o; o.x = pk2(v[j][0], v[j][1]); o.y = pk2(v[j][2], v[j][3]);
            *(v2u*)(F_A + (size_t)row * D + col) = o; }
        if (ROUTER) {
            float lg[8];
#pragma unroll
            for (int e = 0; e < 8; ++e) lg[e] = 0.f;
#pragma unroll
            for (int j = 0; j < 4; ++j)
#pragma unroll
                for (int i = 0; i < 4; ++i) {
#pragma unroll
                    for (int e = 0; e < 4; ++e) { lg[e] += v[j][i] * rw0[j][i][e]; lg[4 + e] += v[j][i] * rw1[j][i][e]; } }
#pragma unroll
            for (int e = 0; e < 8; ++e) lg[e] = wave_sum(lg[e], F.lane);
            int e1 = 0; float v1 = lg[0];
#pragma unroll
            for (int e = 1; e < 8; ++e) if (lg[e] > v1) { v1 = lg[e]; e1 = e; }
            int e2 = -1; float v2 = -3.0e38f;
#pragma unroll
            for (int e = 0; e < 8; ++e) if (e != e1 && lg[e] > v2) { v2 = lg[e]; e2 = e; }
            if (F.lane == 0) {
                const float w2 = 1.0f / (1.0f + expf(v1 - v2)), w1 = 1.0f - w2;
                const int r1 = (int)__hip_atomic_fetch_add(lcn + e1, 1u, __ATOMIC_RELAXED, __HIP_MEMORY_SCOPE_WORKGROUP), r2 = (int)__hip_atomic_fetch_add(lcn + e2, 1u, __ATOMIC_RELAXED, __HIP_MEMORY_SCOPE_WORKGROUP);
                LAS int* rec = lrec + (F.wave * 16 + nrec) * 8; rec[0] = e1; rec[1] = r1; rec[2] = __float_as_int(w1); rec[3] = e2; rec[4] = r2; rec[5] = __float_as_int(w2); rec[6] = row;
            }
            ++nrec;
        }
        }
    };
    if (router) {
        for (int row = row0; row < row1; ++row) { NRow Ra; ld1(Ra, row); cmp(Ra, row); }
    } else {
        for (int row = row0; row < row1; row += 2) { NRow Ra, Rb; const int r2 = row + 1, r2c = r2 < row1 ? r2 : row;
            ld1(Ra, row); ld1(Rb, r2c); ld2(Ra); ld2(Rb); cmp(Ra, row); if (r2 < row1) cmp(Rb, r2); }
    }
    if (ROUTER) {
        const int li = l >> 1;
        __syncthreads();
        if (F.tid < 8) lcn[8 + F.tid] = atomicAdd(F_ctl + CW_CNT + li * 8 + F.tid, lcn[F.tid]);
        __syncthreads();
        if (F.lane == 0)
            for (int i = 0; i < nrec; ++i) { const LAS int* rec = lrec + (F.wave * 16 + i) * 8; const int e1 = rec[0], e2 = rec[3], row = rec[6];
                const int p1 = (int)lcn[8 + e1] + rec[1], p2 = (int)lcn[8 + e2] + rec[4];
                F_list[(size_t)e1 * NTOK + p1] = row; F_list[(size_t)e2 * NTOK + p2] = row;
                int* ti = F_tokinfo + (size_t)row * 8; ti[0] = e1; ti[1] = p1; ti[2] = rec[2]; ti[3] = e2; ti[4] = p2; ti[5] = rec[5]; }
    }
}
__device__ __forceinline__ void moe_tiles(Frame& F, int li, int (&tb)[9], int (&cnt)[8]) {
    unsigned char* ws = F.base();
    tb[0] = 0;
#pragma unroll
    for (int e = 0; e < 8; ++e) { cnt[e] = (int)__hip_atomic_load(F_ctl + CW_CNT + li * 8 + e, __ATOMIC_RELAXED, __HIP_MEMORY_SCOPE_AGENT); tb[e + 1] = tb[e] + ((cnt[e] + 255) >> 8); }
}
__device__ __forceinline__ void moe_gather(Frame& F, int li) {
    unsigned char* ws = F.base();
    int tb[9], cnt[8]; moe_tiles(F, li, tb, cnt);
    if (blockIdx.x == 0 && F.tid < 9) { int* meta = (int*)(F_sm + SM_META) + li * 16; int val = 0;
#pragma unroll
        for (int e = 0; e < 9; ++e) if (F.tid == e) val = tb[e] * 256;
        meta[F.tid] = val; }
    { const int T = tb[8]; unsigned* ul = (unsigned*)(F_sm + SM_ULIST) + li * (MAXTILES * 32);
      for (int L = F.gtid; L < T * 32; L += F.NT) {
          const bool gu = L < T * 28; const int nN = gu ? 28 : 4, nwg = T * nN; int wgid = gu ? L : L - T * 28;
          { const int q = nwg / 8, r = nwg % 8, xcd = wgid % 8, off = wgid / 8; wgid = (xcd < r ? xcd * (q + 1) : r * (q + 1) + (xcd - r) * q) + off; }
          const int nig = 8 * nN, gid = wgid / nig, fm = gid * 8, gsz = (T - fm) < 8 ? (T - fm) : 8;
          const int pm = fm + ((wgid % nig) % gsz), pnl = (wgid % nig) / gsz; int e = 0;
#pragma unroll
          for (int j = 1; j < 8; ++j) e += (pm >= tb[j]) ? 1 : 0;
          ul[(gu ? ULIST_GU : ULIST_D) + (gu ? L : L - T * 28)] = (unsigned)pm | ((unsigned)(e * nN + pnl) << 16);
      } }
    for (int tok = F.gtid; tok < NTOK; tok += F.NT) { int* ti = F_tokinfo + (size_t)tok * 8; const int e1 = ti[0], e2 = ti[3]; int o1 = 0, o2 = 0;
#pragma unroll
        for (int j = 0; j < 8; ++j) { if (j == e1) o1 = tb[j] * 256; if (j == e2) o2 = tb[j] * 256; }
        ti[6] = o1 + ti[1]; ti[7] = o2 + ti[4]; }
    const int nslot = tb[8] * 256;
    for (int s = F.gw; s < nslot; s += F.NGW) {
        const int tile = s >> 8; int e = 0, base = 0, c = 0;
#pragma unroll
        for (int j = 0; j < 8; ++j) if (tile >= tb[j] && tile < tb[j + 1]) { e = j; base = tb[j] * 256; c = cnt[j]; }
        const int pos = s - base; const int tok = pos < c ? F_list[(size_t)e * NTOK + pos] : -1;
        v4u a = (v4u){0u, 0u, 0u, 0u}, b = a;
        if (tok >= 0) { const v4u* sp = (const v4u*)(F_A + (size_t)tok * D); a = sp[F.lane]; b = sp[64 + F.lane]; }
        v4u* dp = (v4u*)(F_AM + (size_t)s * D); dp[F.lane] = a; dp[64 + F.lane] = b;
    }
}

#ifndef MK_PER_PHASE
#define MK_PER_PHASE 0
#endif
#ifndef PROBE
#define PROBE 0
#endif
__device__ __forceinline__ void make_mix(Mix& M, unsigned char* ws, int l) {
    M.P = F_P; M.Qm = WSP(bf16, WS_QM); M.Km = WSP(bf16, WS_KM); M.Vm = WSP(bf16, WS_VM); M.Qs = WSP(bf16, WS_QS); M.Ks = WSP(bf16, WS_KS); M.Vs = WSP(bf16, WS_VS);
    M.HF = WSP(float, WS_HF); M.HO = WSP(float, WS_HO); M.RQ = WSP(float, WS_RQ); M.RK = WSP(float, WS_RK); M.RO = WSP(float, WS_RO); M.OC = F_OC;
    M.HU = WSP(float, WS_HU); M.HDK = WSP(float, WS_HDK); M.HQC = WSP(float, WS_HQC); M.RU = WSP(float, WS_RU); M.RQC = WSP(float, WS_RQC); M.HQCb = WSP(bf16, WS_HQC); M.RQCb = WSP(bf16, WS_RQC);
    M.loglb = F_sm + SM_LOGLB + l * 512; M.log1mlb = F_sm + SM_LOG1M + l * 512; M.hg_norm_g = IN(15) + l * 256; M.sink = IN(16) + l * 4; M.log_gamma = F_sm + SM_LGAM + l * 8;
    M.gn_g = IN(18) + l * 256; M.gn_b = IN(19) + l * 256;
}
__device__ __forceinline__ void frame_init(Frame& F, LAS unsigned char* lds, int wave_s) {
    unsigned z = 0u; asm volatile("" : "+v"(z)); int t = (int)__builtin_amdgcn_mbcnt_hi(~0u, __builtin_amdgcn_mbcnt_lo(~0u, z)); t += wave_s * 64;
    F.lds = lds; F.tid = t; F.lane = t & 63; F.wave = wave_s;
    F.gtid = blockIdx.x * NTHREADS + t; F.NT = gridDim.x * NTHREADS; { int gw_ = blockIdx.x * NWAVES + wave_s; asm volatile("" : "+s"(gw_)); F.gw = gw_; } F.NGW = gridDim.x * NWAVES;
}
__global__ void __launch_bounds__(NTHREADS, 2) fwd_kernel(Args args) {
    extern __shared__ __attribute__((aligned(16))) unsigned char lds[];
    const int wave_s = __builtin_amdgcn_readfirstlane((int)threadIdx.x >> 6);
    volatile LAS unsigned* MISC = (volatile LAS unsigned*)((LAS unsigned char*)lds + MISC_OFF);
    for (int u = threadIdx.x; u < (LDS_BYTES - 131072) / 4; u += NTHREADS) ((LAS unsigned*)((LAS unsigned char*)lds + 131072))[u] = 0u;
    __syncthreads();
#if PROBE >= 30
    const int lo = args.ph_lo, hi = args.ph_hi & 0xffff, pmode = args.ph_hi >> 16;
#else
    const int lo = args.ph_lo, hi = args.ph_hi; constexpr int pmode = 0;
#endif
    XcdBarrier bar; bar.w = wave_s; bar.bar = (unsigned*)(WSBASE() + WS_CTL) + CW_BAR; bar.x = 0; bar.st = nullptr;
    if (hi - lo > 1) bar = xcd_barrier_post((unsigned*)(WSBASE() + WS_CTL) + CW_BAR, MISC + 8, wave_s);
    int p = 0;
#ifndef PHMASK
#define PHMASK 0xffffffffu
#endif
#ifdef TMASK
#define TSUB(id, ...) { const unsigned long long tb_ = __builtin_amdgcn_s_memrealtime(); __VA_ARGS__; if (TPART == (id)) tacc += __builtin_amdgcn_s_memrealtime() - tb_; }
    unsigned long long tacc = 0ull, tbeg = 0ull;
#define PH_BEGIN_(k) if (((PHMASK >> (k)) & 1u) && p >= lo && p < hi) { constexpr bool tsel = (TMASK >> (k)) & 1u; if (tsel) tbeg = __builtin_amdgcn_s_memrealtime(); Frame F; frame_init(F, (LAS unsigned char*)lds, wave_s); unsigned char* ws = F.base();
#ifndef TPART
#define TPART 0
#endif
#ifndef TWG
#define TWG 0
#endif
#define PH_END if (tsel && TPART == 1) tacc += __builtin_amdgcn_s_memrealtime() - tbeg; if (p + 1 < hi) xcd_barrier(bar); if (tsel && TPART == 0) tacc += __builtin_amdgcn_s_memrealtime() - tbeg; } ++p;
#else
#define TSUB(id, ...) { __VA_ARGS__; }
#define PH_BEGIN_(k) if (((PHMASK >> (k)) & 1u) && p >= lo && p < hi) { Frame F; frame_init(F, (LAS unsigned char*)lds, wave_s); unsigned char* ws = F.base();
#define PH_END if (p + 1 < hi) xcd_barrier(bar); } ++p;
#endif

    PH_BEGIN_(0) (void)ws; prologue(F, pmode); PH_END

    for (int l = 0; l < DEPTH; ++l) {
        PH_BEGIN_(1) (void)ws; norm_phase<0, false>(F, l); PH_END
        PH_BEGIN_(2) { stagger_start(); pg8::Gemm g{F_A, F_WIN + (size_t)l * NP * D, NTOK, NP, D}; pg8::StaticOrder S; S.init(NTOK, NP, gridDim.x, blockIdx.x);
                   pg8::EpiBf16P E{F_P, NP, NP / 256}; pg8::gemm_phase<pg8::EpiBf16P, pg8::StaticOrder, true, true>(F.lds, g, S, E, F.tid);
                   conv_range(F, CV_L(l) + 0, CVB_G1, (NTOK / 256 * (NP / 256)) % (int)gridDim.x);
                   } PH_END
#ifndef NO_MIX
        PH_BEGIN_(3) { Mix M; make_mix(M, ws, l); const float* tab = WSP(float, WS_TAB);
            for (int row = F.gw; row < NTOK; row += 2 * F.NGW) {
                PrepRegs Ra, Rb; const int r2 = row + F.NGW, r2c = r2 < NTOK ? r2 : row;
                prep_load(Ra, M.P + (size_t)row * NP, F.lane); prep_load(Rb, M.P + (size_t)r2c * NP, F.lane);
                prep_compute(M, tab, Ra, row, F.lane);
                if (r2 < NTOK) prep_compute(M, tab, Rb, r2, F.lane);
            }
            for (int g8 = F.gw; g8 < NTOK / 8; g8 += 2 * F.NGW) { VtRegs Va, Vb; const int g2 = g8 + F.NGW, g2c = g2 < NTOK / 8 ? g2 : g8;
                vt_load(Va, M, g8, F.lane); vt_load(Vb, M, g2c, F.lane); vt_store(Va, M, g8, F.lane); if (g2 < NTOK / 8) vt_store(Vb, M, g2, F.lane); } }
        PH_END
        PH_BEGIN_(4) { Mix M; make_mix(M, ws, l);
            TSUB(2, attn_phase(F.lds, M, M.sink, l < DEPTH - 1, F.tid))
            { LAS unsigned char* wl = F.lds + F.wave * 13312;
              const bool bal = gridDim.x * 9 == 2 * NB * 4 * MNCH;
              const int nsl = bal ? 3 : (2 * NB * 4 * MNCH + F.NGW - 1) / F.NGW;
              TSUB(3, for (int s = 0; s < nsl; ++s) { const int w = F.wave, base = (int)blockIdx.x * 9; int hu = F.gw + s * F.NGW;
                  if (bal) hu = w < 3 ? (s < 2 ? base + 2 * w + s : -1) : (w < 6 && s == 0) ? base + 3 + w : -1;
                  if (hu >= 0 && hu < 2 * NB * 4 * MNCH) mscan_local<true>(M, wl, hu, F.lane); })
              TSUB(4, for (int s = 0; s < nsl; ++s) { const int w = F.wave, base = (int)blockIdx.x * 9; int ru = F.gw + s * F.NGW;
                  if (bal) ru = w >= 6 ? base + 3 + 3 * (w - 6) + s : (w >= 3 && s == 0) ? base + w - 3 : -1;
                  if (ru >= 0 && ru < 2 * NB * 4 * MNCH) mscan_local<false>(M, wl, ru, F.lane); })
              } }
        PH_END
        PH_BEGIN_(14) { Mix M; make_mix(M, ws, l);
            for (int it = F.gtid; it < 2 * NB * 4 * 4096; it += F.NT) mscan_carry_hg(M, it);
            for (int it = F.gtid; it < 2 * NB * 4 * 2048; it += F.NT) mscan_carry_ret(M, it); }
        PH_END
        PH_BEGIN_(15) { Mix M; make_mix(M, ws, l);
            const bool bal = gridDim.x * 9 == 2 * NB * 4 * MNCH;
            const int w = F.wave, pr = (int)blockIdx.x >> 1, odd = (int)blockIdx.x & 1, nh = odd ? 4 : 5;
            TSUB(5, for (int s = 0; s < (bal ? 1 : (NB * 4 * MNCH + F.NGW - 1) / F.NGW); ++s) { int u = F.gw + s * F.NGW;
                if (bal) u = w < nh ? pr * 9 + (odd ? 5 : 0) + w : -1;
                if (u >= 0 && u < NB * 4 * MNCH) mscan_fixfin<true>(M, u, F.lane, l < DEPTH - 1); })
            TSUB(6, for (int s = 0; s < (bal ? 2 : (NB * 4 * MNCH + F.NGW - 1) / F.NGW); ++s) { int u = (F.gw + F.NGW - 896) % F.NGW + s * F.NGW;
                if (bal) u = (w >= nh && (s == 0 || w == 7)) ? pr * 9 + (odd ? 4 : 0) + (w - nh) + s : -1;
                if (u >= 0 && u < NB * 4 * MNCH) mscan_fixfin<false>(M, u, F.lane, l < DEPTH - 1); }) }
        PH_END
#endif
        PH_BEGIN_(6) { const int Mr = l < DEPTH - 1 ? NTOK : NLAT; pg8::Gemm g{F_OC, F_WOUT + (size_t)l * D * D, Mr, D, D}; pg8::StaticOrder S; S.init(Mr, D, gridDim.x, blockIdx.x);
                   pg8::EpiGate E{F_AM, F_sm + SM_MOD + (size_t)l * 9 * 6144 + 2 * 1024, NLAT / 256, NL / 256, NB}; pg8::gemm_phase<pg8::EpiGate, pg8::StaticOrder, true, true>(F.lds, g, S, E, F.tid);
                   if (l < DEPTH - 1) conv_range(F, CV_L(l) + CVB_G1, CVB_G2, (NTOK / 256 * (D / 256)) % (int)gridDim.x); } PH_END
        PH_BEGIN_(7) (void)ws; if (l & 1) norm_phase<1, true>(F, l); else norm_phase<1, false>(F, l); if (l == DEPTH - 1) conv_range(F, CV_L(3) + CVB_G1, J_END - (CV_L(3) + CVB_G1), 0); PH_END
        if ((l & 1) == 0) {
            const int li = l >> 1;
            PH_BEGIN_(8) { stagger_start(); pg8::Gemm g{F_A, F_WFGU + (size_t)li * 2 * DFF * D, NTOK, 2 * DFF, D}; pg8::StaticOrder S; S.init(NTOK, 2 * DFF, gridDim.x, blockIdx.x);
                       pg8::EpiSwiglu E{F_ACT, DFF, 2 * DFF / 256}; pg8::gemm_phase<pg8::EpiSwiglu, pg8::StaticOrder, true, true>(F.lds, g, S, E, F.tid);
                       conv_range(F, CV_L(l) + CVB_G1 + CVB_G2, CVB_GU, (NTOK / 256 * (2 * DFF / 256)) % (int)gridDim.x); } PH_END
            PH_BEGIN_(9) { pg8::Gemm g{F_ACT, F_WFD + (size_t)li * D * DFF, NTOK, D, DFF}; pg8::StaticOrder S; S.init(NTOK, D, gridDim.x, blockIdx.x);
                       pg8::EpiGate E{F_AM, F_sm + SM_MOD + (size_t)l * 9 * 6144 + 5 * 1024, NLAT / 256, NL / 256, NB}; pg8::gemm_phase<pg8::EpiGate, pg8::StaticOrder, true, true>(F.lds, g, S, E, F.tid);
                       conv_range(F, CV_L(l) + CVB_G1 + CVB_G2 + CVB_GU, CVB_DN, (NTOK / 256 * (D / 256)) % (int)gridDim.x); } PH_END
        } else {
            const int li = l >> 1;
            PH_BEGIN_(10) (void)ws; moe_gather(F, li); PH_END
            PH_BEGIN_(11) { stagger_start(); const int T = __builtin_amdgcn_readfirstlane((int)__hip_atomic_load((unsigned*)(F_sm + SM_META) + li * 16 + 8, __ATOMIC_RELAXED, __HIP_MEMORY_SCOPE_AGENT)) >> 8;
                       pg8::MoeOrder S; S.list = (const unsigned*)(F_sm + SM_ULIST) + li * (MAXTILES * 32) + ULIST_GU; S.nwg = T * (2 * DFE / 256); S.G = gridDim.x; S.c = blockIdx.x;
                       pg8::Gemm g{F_AM, F_WMGU, MAXTILES * 256, 8 * 2 * DFE, D};
                       pg8::EpiSwiglu E{F_ACT, DFE, 2 * DFE / 256}; pg8::gemm_phase<pg8::EpiSwiglu, pg8::MoeOrder, true, true>(F.lds, g, S, E, F.tid); } PH_END
            PH_BEGIN_(12) { const int T = __builtin_amdgcn_readfirstlane((int)__hip_atomic_load((unsigned*)(F_sm + SM_META) + li * 16 + 8, __ATOMIC_RELAXED, __HIP_MEMORY_SCOPE_AGENT)) >> 8;
                       pg8::MoeOrder S; S.list = (const unsigned*)(F_sm + SM_ULIST) + li * (MAXTILES * 32) + ULIST_D; S.nwg = T * (D / 256); S.G = gridDim.x; S.c = blockIdx.x;
                       pg8::Gemm g{F_ACT, F_WMD, MAXTILES * 256, 8 * D, DFE};
                       pg8::EpiBf16P E{F_Y, D, D / 256}; pg8::gemm_phase<pg8::EpiBf16P, pg8::MoeOrder, true, true>(F.lds, g, S, E, F.tid);
                       if (li == 0) conv_range(F, J_M1, CVB_MD, S.nwg % (int)gridDim.x); } PH_END
        }
    }
#if PROBE == 10
    if (hi - lo > 1) { for (int xb = 0; xb < 40; ++xb) xcd_barrier(bar); }
#endif
    PH_BEGIN_(13) (void)ws; norm_phase<2, false>(F, DEPTH); PH_END
#ifdef TMASK
    if (blockIdx.x == TWG) { const unsigned long long t0 = __builtin_amdgcn_s_memrealtime(), d = tacc * TMULT; while (__builtin_amdgcn_s_memrealtime() - t0 < d) __builtin_amdgcn_s_sleep(8); }
#endif
#undef PH_BEGIN_
#undef PH_END
}
constexpr int NPHASES = 1 + 2 * 10 + 2 * 11 + 1;


extern "C" void kernel_launch(void* const* d_in, const int* in_sizes, int n_in, void* d_out, int out_size, void* d_ws, size_t ws_size, hipStream_t stream) {
    static int grid = 0;
    if (grid == 0) {
        if (n_in != 28 || ws_size < WS_END || out_size != NLAT * D) { fprintf(stderr, "kernel_launch: unexpected problem shape (n_in %d, ws %zu, out %d)\n", n_in, ws_size, out_size); grid = -1; return; }
        int dev = 0, cus = 0;
        if (hipGetDevice(&dev) != hipSuccess || hipDeviceGetAttribute(&cus, hipDeviceAttributeMultiprocessorCount, dev) != hipSuccess) { grid = -1; return; }
        if (hipFuncSetAttribute((const void*)fwd_kernel, hipFuncAttributeMaxDynamicSharedMemorySize, LDS_BYTES) != hipSuccess) { fprintf(stderr, "kernel_launch: hipFuncSetAttribute failed\n"); grid = -1; return; }
        int per_cu = 0;
        if (hipOccupancyMaxActiveBlocksPerMultiprocessor(&per_cu, (const void*)fwd_kernel, NTHREADS, LDS_BYTES) != hipSuccess || per_cu < 1) { fprintf(stderr, "kernel_launch: occupancy query says %d\n", per_cu); }
        (void)hipGetLastError();
        grid = cus;
    }
    if (grid < 0) return;
    (void)hipMemsetAsync((char*)d_ws + WS_CTL, 0, CTL_ZERO_BYTES, stream);
    Args a{};
    for (int i = 0; i < 28; ++i) a.in[i] = (const float*)d_in[i];
    a.out = (float*)d_out; a.ws = (unsigned char*)d_ws;
#if MK_PER_PHASE
    for (int p = 0; p < NPHASES; ++p) {
        a.ph_lo = p; a.ph_hi = p + 1; hipLaunchKernelGGL(fwd_kernel, dim3(grid), dim3(NTHREADS), LDS_BYTES, stream, a);
        int l = -1, k = -1; const int base[4] = {1, 11, 22, 32}; for (int i = 0; i < 4; ++i) if (p >= base[i] && p < base[i] + (i & 1 ? 11 : 10)) { l = i; k = p - base[i]; }
        bool dup = false;
#if PROBE == 1
        dup = (p == 0);
#elif PROBE == 2
        dup = (k == 2);
#elif PROBE == 3
        dup = (k == 3);
#elif PROBE == 4
        dup = (k == 5);
#elif PROBE == 5
        dup = (k == 1);
#elif PROBE == 20
        dup = (k == 4);
#elif PROBE == 21
        dup = (k == 6);
#elif PROBE == 22
        dup = (k == 8) && !(l & 1);
#elif PROBE == 23
        dup = (k == 9) && !(l & 1);
#elif PROBE == 24
        dup = (k == 8) && (l & 1);
#elif PROBE == 25
        dup = (k == 9) && (l & 1);
#elif PROBE == 26
        dup = (k == 10) && (l & 1);
#elif PROBE == 29
        dup = (k == 7) && (l == 3);
#elif PROBE >= 30
        dup = (p == 0); a.ph_hi = (p + 1) | ((PROBE - 30) << 16);
#endif
        if (dup) hipLaunchKernelGGL(fwd_kernel, dim3(grid), dim3(NTHREADS), LDS_BYTES, stream, a); }
#else
    a.ph_lo = 0; a.ph_hi = NPHASES; hipLaunchKernelGGL(fwd_kernel, dim3(grid), dim3(NTHREADS), LDS_BYTES, stream, a);
#endif
}
```
